# Optimizing an MI355X kernel written in HIP

```python
import math
import jax, jax.numpy as jnp
from jax import lax
import numpy as np

D_MODEL = 1024
BATCH = 2
SEQ = 8192
DEPTH = 4

N_MIXERS = 2
D_FF = 2816
EPS = 1e-6
A_HEADS = 4
A_DK = 128
A_DV = 256
A_QK = A_HEADS * A_DK
A_V = A_HEADS * A_DV
A_CONV = 4
A_CHUNK = 64
A_PROJ = 2 * A_QK + 2 * A_V + 2 * A_HEADS
B_HEADS = 4
B_DH = 128
B_DV = 2 * B_DH
B_QK = B_HEADS * 2 * B_DH
B_V = B_HEADS * B_DV
B_PROJ = 2 * B_QK + B_V
ROPE_THETA = 500000.0
ROPE_DIM = B_DH // 4
Q_BLOCK = 128
N_A = (DEPTH + 1) // 2
N_B = DEPTH // 2

kernel_name = "hybrid_mlstm_diffattn_macaron_adaln"


def rmsnorm(x, g):
    x32 = x.astype(jnp.float32)
    y = x32 * lax.rsqrt(jnp.mean(x32 * x32, -1, keepdims=True) + EPS)
    return (y * g.astype(jnp.float32)).astype(x.dtype)


def modulate(x, g, shift, scale):
    return rmsnorm(x, g) * (1.0 + scale[:, None, :]) + shift[:, None, :]


def swiglu(h, w13, w2):
    gate, up = jnp.split(h @ w13, 2, axis=-1)
    return (jax.nn.silu(gate) * up) @ w2


def rope_partial(x, cos, sin):
    half = ROPE_DIM // 2
    c = cos[:, :, None, None, :]
    s = sin[:, :, None, None, :]
    x1 = x[..., :half]
    x2 = x[..., half:ROPE_DIM]
    return jnp.concatenate([x1 * c - x2 * s, x2 * c + x1 * s, x[..., ROPE_DIM:]], axis=-1)


def mlstm_cell(q, k, v, log_i, log_f):
    nb, H, S, dk = q.shape
    dv = v.shape[-1]
    L = A_CHUNK
    nc = S // L

    def to_chunks(t):
        return jnp.moveaxis(t.reshape(nb, H, nc, L, *t.shape[3:]), 2, 0)

    xs = tuple(to_chunks(t) for t in (q, k, v, log_i, log_f))
    causal = jnp.tril(jnp.ones((L, L), dtype=bool))

    def step(carry, inp):
        C, n, m = carry
        qc, kc, vc, ic, fc = inp
        b = jnp.cumsum(fc, axis=-1)
        a = b + m[..., None]
        dlog = jnp.where(causal, b[..., :, None] - b[..., None, :] + ic[..., None, :], -jnp.inf)
        m_t = jnp.maximum(a, dlog.max(-1))
        dw = jnp.exp(dlog - m_t[..., None])
        inter = jnp.exp(a - m_t)
        s = jnp.einsum('bhtd,bhsd->bhts', qc, kc) * dw
        num = inter[..., None] * jnp.einsum('bhtd,bhvd->bhtv', qc, C) + jnp.einsum('bhts,bhsv->bhtv', s, vc)
        den = inter * jnp.einsum('bhtd,bhd->bht', qc, n) + s.sum(-1)
        h = num / jnp.maximum(jnp.abs(den), jnp.exp(-m_t))[..., None]
        b_last = b[..., -1]
        wlog = b_last[..., None] - b + ic
        m_new = jnp.maximum(b_last + m, wlog.max(-1))
        decay = jnp.exp(b_last + m - m_new)
        w = jnp.exp(wlog - m_new[..., None])
        C_new = decay[..., None, None] * C + jnp.einsum('bhs,bhsv,bhsd->bhvd', w, vc, kc)
        n_new = decay[..., None] * n + jnp.einsum('bhs,bhsd->bhd', w, kc)
        return (C_new, n_new, m_new), h

    init = (jnp.zeros((nb, H, dv, dk), jnp.float32),
            jnp.zeros((nb, H, dk), jnp.float32),
            jnp.zeros((nb, H), jnp.float32))
    _, hs = lax.scan(step, init, xs)
    return jnp.moveaxis(hs, 0, 2).reshape(nb, H, S, dv)


def mlstm_mixer(h, w_in, conv_w, conv_b, b_if, norm_g, w_out):
    nb, S, _ = h.shape
    p = h @ w_in
    qk, v, o, gates = jnp.split(p, [2 * A_QK, 2 * A_QK + A_V, 2 * A_QK + 2 * A_V], axis=-1)
    qk = lax.conv_general_dilated(qk, conv_w[:, None, :], window_strides=(1,),
                                  padding=[(A_CONV - 1, 0)],
                                  dimension_numbers=('NWC', 'WIO', 'NWC'),
                                  feature_group_count=2 * A_QK) + conv_b
    qk = jax.nn.silu(qk)
    q, k = jnp.split(qk, 2, axis=-1)

    def heads(t, d):
        return t.reshape(nb, S, A_HEADS, d).transpose(0, 2, 1, 3).astype(jnp.float32)

    q = heads(q, A_DK)
    k = heads(k, A_DK) * (A_DK ** -0.5)
    v = heads(v, A_DV)
    gates = (gates + b_if).astype(jnp.float32).transpose(0, 2, 1)
    log_i = gates[:, :A_HEADS]
    log_f = jax.nn.log_sigmoid(gates[:, A_HEADS:])
    hh = mlstm_cell(q, k, v, log_i, log_f).transpose(0, 2, 1, 3)
    hh = hh * lax.rsqrt(jnp.mean(hh * hh, -1, keepdims=True) + EPS)
    hh = hh.reshape(nb, S, A_V) * norm_g.astype(jnp.float32)
    y = (jax.nn.sigmoid(o.astype(jnp.float32)) * hh).astype(h.dtype)
    return y @ w_out


def diff_attn_mixer(h, cos, sin, w_in, lam, norm_g, w_out, lam_init):
    nb, S, _ = h.shape
    p = h @ w_in
    q, k, v = jnp.split(p, [B_QK, 2 * B_QK], axis=-1)
    q = rope_partial(q.reshape(nb, S, B_HEADS, 2, B_DH).astype(jnp.float32), cos, sin) * (B_DH ** -0.5)
    k = rope_partial(k.reshape(nb, S, B_HEADS, 2, B_DH).astype(jnp.float32), cos, sin)
    v = v.reshape(nb, S, B_HEADS, B_DV).astype(jnp.float32).transpose(0, 2, 1, 3)
    lf = lam.astype(jnp.float32)
    lam_full = jnp.exp(jnp.sum(lf[0] * lf[1])) - jnp.exp(jnp.sum(lf[2] * lf[3])) + lam_init
    q = q.transpose(0, 2, 3, 1, 4)
    k = k.transpose(0, 2, 3, 1, 4)
    n_blk = S // Q_BLOCK
    qb = jnp.moveaxis(q.reshape(nb, B_HEADS, 2, n_blk, Q_BLOCK, B_DH), 3, 0)
    k_idx = jnp.arange(S)

    def block(args):
        qblk, bi = args
        q_idx = bi * Q_BLOCK + jnp.arange(Q_BLOCK)
        s = jnp.einsum('bhcqd,bhckd->bhcqk', qblk, k)
        s = jnp.where(k_idx[None, :] <= q_idx[:, None], s, -jnp.inf)
        pr = jax.nn.softmax(s, axis=-1)
        a = pr[:, :, 0] - lam_full * pr[:, :, 1]
        return jnp.einsum('bhqk,bhkd->bhqd', a, v)

    o = lax.map(block, (qb, jnp.arange(n_blk)))
    o = jnp.moveaxis(o, 0, 2).reshape(nb, B_HEADS, S, B_DV).transpose(0, 2, 1, 3)
    o = o * lax.rsqrt(jnp.mean(o * o, -1, keepdims=True) + EPS) * norm_g.astype(jnp.float32) * (1.0 - lam_init)
    return o.reshape(nb, S, B_V).astype(h.dtype) @ w_out


def setup_inputs(seed: int = 0) -> dict:
    key = jax.random.key(seed)
    ks = jax.random.split(key, 24)
    f32 = jnp.float32

    def nrm(k, shape, scale):
        return jax.random.normal(k, shape, f32) * scale

    x = nrm(ks[0], (BATCH, SEQ, D_MODEL), 1.0)
    c = nrm(ks[1], (BATCH, D_MODEL), 1.0)
    offs = jax.random.randint(ks[2], (BATCH, 1), 0, 1024, dtype=jnp.int32)
    positions = (offs + jnp.arange(SEQ, dtype=jnp.int32)[None, :]).astype(jnp.int32)

    ada_w = nrm(ks[3], (DEPTH, D_MODEL, 9 * D_MODEL), 0.3 * D_MODEL ** -0.5)
    ada_base = jnp.zeros((DEPTH, 3, 3, D_MODEL), f32).at[:, :, 2, :].set(1.0)
    ada_b = (ada_base + nrm(ks[4], (DEPTH, 3, 3, D_MODEL), 0.02)).reshape(DEPTH, 9 * D_MODEL)
    norm_g = 1.0 + nrm(ks[5], (DEPTH, 3, D_MODEL), 0.02)
    ffn_w13 = nrm(ks[6], (DEPTH, 2, D_MODEL, 2 * D_FF), D_MODEL ** -0.5)
    ffn_w2 = nrm(ks[7], (DEPTH, 2, D_FF, D_MODEL), D_FF ** -0.5)

    a_w_in = nrm(ks[8], (N_A, D_MODEL, A_PROJ), D_MODEL ** -0.5)
    a_conv_w = nrm(ks[9], (N_A, A_CONV, 2 * A_QK), A_CONV ** -0.5)
    a_conv_b = nrm(ks[10], (N_A, 2 * A_QK), 0.02)
    i_bias = nrm(ks[11], (N_A, A_HEADS), 0.1)
    f_bias = jnp.linspace(3.0, 6.0, A_HEADS, dtype=f32)[None, :] + nrm(ks[12], (N_A, A_HEADS), 0.1)
    a_b_if = jnp.concatenate([i_bias, f_bias], axis=-1)
    a_norm_g = 1.0 + nrm(ks[13], (N_A, A_V), 0.02)
    a_w_out = nrm(ks[14], (N_A, A_V, D_MODEL), A_V ** -0.5)

    b_w_in = nrm(ks[15], (N_B, D_MODEL, B_PROJ), D_MODEL ** -0.5)
    b_lam = nrm(ks[16], (N_B, 4, B_DH), 0.1)
    b_norm_g = 1.0 + nrm(ks[17], (N_B, B_DV), 0.02)
    b_w_out = nrm(ks[18], (N_B, B_V, D_MODEL), B_V ** -0.5)

    final_g = 1.0 + nrm(ks[19], (D_MODEL,), 0.02)
    return {"x": x, "c": c, "positions": positions, "ada_w": ada_w, "ada_b": ada_b,
            "norm_g": norm_g, "ffn_w13": ffn_w13, "ffn_w2": ffn_w2,
            "a_w_in": a_w_in, "a_conv_w": a_conv_w, "a_conv_b": a_conv_b, "a_b_if": a_b_if,
            "a_norm_g": a_norm_g, "a_w_out": a_w_out,
            "b_w_in": b_w_in, "b_lam": b_lam, "b_norm_g": b_norm_g, "b_w_out": b_w_out,
            "final_g": final_g}


def reference(x, c, positions, ada_w, ada_b, norm_g, ffn_w13, ffn_w2,
              a_w_in, a_conv_w, a_conv_b, a_b_if, a_norm_g, a_w_out,
              b_w_in, b_lam, b_norm_g, b_w_out, final_g):
    inv_freq = ROPE_THETA ** (-jnp.arange(0, ROPE_DIM, 2, dtype=jnp.float32) / ROPE_DIM)
    ang = positions.astype(jnp.float32)[..., None] * inv_freq
    cos, sin = jnp.cos(ang), jnp.sin(ang)
    cond = jax.nn.silu(c)
    for i in range(DEPTH):
        ada = (cond @ ada_w[i] + ada_b[i]).reshape(-1, 3, 3, D_MODEL)
        h = modulate(x, norm_g[i, 0], ada[:, 0, 0], ada[:, 0, 1])
        x = x + 0.5 * ada[:, 0, 2, None, :] * swiglu(h, ffn_w13[i, 0], ffn_w2[i, 0])
        h = modulate(x, norm_g[i, 1], ada[:, 1, 0], ada[:, 1, 1])
        j = i // N_MIXERS
        if i % N_MIXERS == 0:
            y = mlstm_mixer(h, a_w_in[j], a_conv_w[j], a_conv_b[j], a_b_if[j], a_norm_g[j], a_w_out[j])
        else:
            lam_init = 0.8 - 0.6 * math.exp(-0.3 * i)
            y = diff_attn_mixer(h, cos, sin, b_w_in[j], b_lam[j], b_norm_g[j], b_w_out[j], lam_init)
        x = x + ada[:, 1, 2, None, :] * y
        h = modulate(x, norm_g[i, 2], ada[:, 2, 0], ada[:, 2, 1])
        x = x + 0.5 * ada[:, 2, 2, None, :] * swiglu(h, ffn_w13[i, 1], ffn_w2[i, 1])
    return rmsnorm(x, final_g)
```

```cpp
#include <hip/hip_runtime.h>
#include <hip/hip_bf16.h>
#include <hip/hip_cooperative_groups.h>
#include <cstdio>
#include <cstdint>
#include <cmath>
#include <utility>
template <int MASK> __device__ __forceinline__ float swz_xor(float v) { return __builtin_bit_cast(float, __builtin_amdgcn_ds_swizzle(__builtin_bit_cast(int, v), (MASK << 10) | 0x1f)); }
__device__ __forceinline__ float sum_x32(float v) { const unsigned u = __float_as_uint(v); auto rr = __builtin_amdgcn_permlane32_swap(u, u, false, false); const unsigned r0 = rr[0], r1 = rr[1]; return __uint_as_float(r0) + __uint_as_float(r1); }
__device__ __forceinline__ float max_x32(float v) { const unsigned u = __float_as_uint(v); auto rr = __builtin_amdgcn_permlane32_swap(u, u, false, false); const unsigned r0 = rr[0], r1 = rr[1]; return fmaxf(__uint_as_float(r0), __uint_as_float(r1)); }
namespace pg8 {
#define PG8_LAS __attribute__((address_space(3)))
typedef unsigned short bf16_t;
typedef short bf16x8 __attribute__((ext_vector_type(8)));
typedef float f32x4 __attribute__((ext_vector_type(4)));
typedef unsigned u32x4 __attribute__((ext_vector_type(4)));
constexpr int BM = 256, BK = 64, HALF = 128, HTB = HALF * BK * 2  , STAGE_BYTES = 8 * HTB, NXCD = 8, WGM = 8;

__host__ __device__ __forceinline__ int lds_byte(int r, int c) { const int st = (r >> 4) * 2 + (c >> 5), rr = r & 15, cc = c & 31, ob = rr * 64 + cc * 2; return st * 1024 + (ob ^ (((ob >> 9) & 1) << 5)); }
__host__ __device__ __forceinline__ void stage_rc(int b, int& R, int& C) { const int st = b / 1024, sb = b % 1024, swz = sb ^ (((sb >> 9) & 1) << 5); R = (st >> 1) * 16 + swz / 64; C = (st & 1) * 32 + (swz % 64) / 2; }
__host__ __device__ __forceinline__ int perm32(int rho) { const int n = rho >> 4, i = rho & 15; return 8 * (i >> 2) + 4 * n + (i & 3); }

struct Unit { int pm, pn; };
struct Gemm { const bf16_t* A; const bf16_t* Bt; int M, N, K; };

struct StaticOrder {
    int nM, nN, nwg, G, c;
    __host__ __device__ void init(int M, int N, int G_, int c_) { nM = M / BM; nN = N / BM; nwg = nM * nN; G = G_; c = c_; }
    __host__ __device__ bool next(int i, Unit& u) const {
        const long L = (long)i * G + c; if (L >= nwg) return false;
        int wgid = (int)L; { const int q = nwg / NXCD, r = nwg % NXCD, xcd = wgid % NXCD, off = wgid / NXCD; wgid = (xcd < r ? xcd * (q + 1) : r * (q + 1) + (xcd - r) * q) + off; }
        const int nig = WGM * nN, gid = wgid / nig, fm = gid * WGM, gsz = (nM - fm) < WGM ? (nM - fm) : WGM;
        u.pm = fm + ((wgid % nig) % gsz); u.pn = (wgid % nig) / gsz; return true;
    }
    __device__ __forceinline__ void a_ready(const Unit&) const {}
    __device__ __forceinline__ void done(const Unit&) const {}
};
__device__ __forceinline__ unsigned cvt_pk_bf16(float lo, float hi) { unsigned r; asm volatile("v_cvt_pk_bf16_f32 %0, %1, %2" : "=v"(r) : "v"(lo), "v"(hi)); return r; }
constexpr int MROWS = 16384;
constexpr float RMS_EPS = 1e-6f;
__device__ __forceinline__ float silu_f(float g) { return g * __builtin_amdgcn_rcpf(1.0f + __expf(-g)); }
__device__ __forceinline__ float row_rstd(const float* ssqp, int row, int fq) {
    float s = 0.f;
#pragma unroll
    for (int i = 0; i < 4; ++i) s += ssqp[(size_t)(fq * 4 + i) * MROWS + row];
    s += swz_xor<16>(s); s = sum_x32(s);
    return rsqrtf(s * (1.0f / 1024.0f) + RMS_EPS);
}
struct EpiUp {
    static constexpr bool PERM = true, AFTER_DRAIN = false;
    bf16_t* H; const float* sw; const float* ssqp;
    __device__ __forceinline__ void operator()(const f32x4 (&acc)[2][2][4][2], const Unit& u, int wr, int wc, int fr, int fq) const {
        const int b = u.pm >> 5, row0 = u.pm * BM + wr * 64 + fr, c8 = wc * 32 + 8 * fq;
        const float* swp = sw + (size_t)b * 5632 + u.pn * 256 + c8;
        const f32x4 sg0 = *(const f32x4*)(swp), sg1 = *(const f32x4*)(swp + 4), su0 = *(const f32x4*)(swp + 128), su1 = *(const f32x4*)(swp + 132);
        bf16_t* hp = H + (size_t)u.pn * 128 + c8;
#pragma unroll
        for (int ai = 0; ai < 2; ++ai)
#pragma unroll
            for (int m = 0; m < 4; ++m) {
                const int row = row0 + ai * HALF + m * 16;
                const float rs = row_rstd(ssqp, row, fq);
                const f32x4 g0 = acc[ai][0][m][0] * rs + sg0, g1 = acc[ai][0][m][1] * rs + sg1;
                const f32x4 u0 = acc[ai][1][m][0] * rs + su0, u1 = acc[ai][1][m][1] * rs + su1;
                u32x4 w;
                w.x = cvt_pk_bf16(silu_f(g0[0]) * u0[0], silu_f(g0[1]) * u0[1]); w.y = cvt_pk_bf16(silu_f(g0[2]) * u0[2], silu_f(g0[3]) * u0[3]);
                w.z = cvt_pk_bf16(silu_f(g1[0]) * u1[0], silu_f(g1[1]) * u1[1]); w.w = cvt_pk_bf16(silu_f(g1[2]) * u1[2], silu_f(g1[3]) * u1[3]);
                *(u32x4*)(hp + (size_t)row * 2816) = w;
            }
    }
};
struct EpiBias {
    static constexpr bool PERM = true, AFTER_DRAIN = false;
    bf16_t* O; int ldc; const float* sw; int nsw; const float* ssqp;
    __device__ __forceinline__ void operator()(const f32x4 (&acc)[2][2][4][2], const Unit& u, int wr, int wc, int fr, int fq) const {
        const int b = u.pm >> 5, row0 = u.pm * BM + wr * 64 + fr, col0 = u.pn * BM + wc * 32 + 8 * fq;
        f32x4 sv[2][2];
#pragma unroll
        for (int bj = 0; bj < 2; ++bj)
#pragma unroll
            for (int n = 0; n < 2; ++n) sv[bj][n] = *(const f32x4*)(sw + (size_t)b * nsw + col0 + bj * HALF + 4 * n);
#pragma unroll
        for (int ai = 0; ai < 2; ++ai)
#pragma unroll
            for (int m = 0; m < 4; ++m) {
                const int row = row0 + ai * HALF + m * 16;
                const float rs = row_rstd(ssqp, row, fq);
                bf16_t* rowp = O + (size_t)row * ldc + col0;
#pragma unroll
                for (int bj = 0; bj < 2; ++bj) {
                    const f32x4 v0 = acc[ai][bj][m][0] * rs + sv[bj][0], v1 = acc[ai][bj][m][1] * rs + sv[bj][1];
                    u32x4 w; w.x = cvt_pk_bf16(v0[0], v0[1]); w.y = cvt_pk_bf16(v0[2], v0[3]); w.z = cvt_pk_bf16(v1[0], v1[1]); w.w = cvt_pk_bf16(v1[2], v1[3]);
                    *(u32x4*)(rowp + bj * HALF) = w;
                }
            }
    }
};
template <int HALFC> struct EpiResidT {
    static constexpr bool PERM = true, AFTER_DRAIN = false;
    float* x; const float* gate; const float* gsn; bf16_t* xs; float* ssqp;
    __device__ __forceinline__ void operator()(const f32x4 (&acc)[2][2][4][2], const Unit& u, int wr, int wc, int fr, int fq) const {
        const int b = u.pm >> 5, row0 = u.pm * BM + wr * 64 + fr, col0 = u.pn * BM + wc * 32 + 8 * fq;
        constexpr float gcoef = HALFC ? 0.5f : 1.0f;
        f32x4 gt[2][2], gs[2][2];
#pragma unroll
        for (int bj = 0; bj < 2; ++bj)
#pragma unroll
            for (int n = 0; n < 2; ++n) {
                gt[bj][n] = *(const f32x4*)(gate + (size_t)b * 9216 + col0 + bj * HALF + 4 * n) * gcoef;
                gs[bj][n] = *(const f32x4*)(gsn + (size_t)b * 1024 + col0 + bj * HALF + 4 * n);
            }
#pragma unroll
        for (int ai = 0; ai < 2; ++ai)
#pragma unroll
            for (int m = 0; m < 4; ++m) {
                const int row = row0 + ai * HALF + m * 16;
                float ss = 0.f;
#pragma unroll
                for (int bj = 0; bj < 2; ++bj) {
                    float* xp = x + (size_t)row * 1024 + col0 + bj * HALF;
                    f32x4 x0 = *(const f32x4*)xp, x1 = *(const f32x4*)(xp + 4);
                    x0 = x0 + gt[bj][0] * acc[ai][bj][m][0]; x1 = x1 + gt[bj][1] * acc[ai][bj][m][1];
                    *(f32x4*)xp = x0; *(f32x4*)(xp + 4) = x1;
                    ss += (x0[0] * x0[0] + x0[1] * x0[1]) + (x0[2] * x0[2] + x0[3] * x0[3]) + (x1[0] * x1[0] + x1[1] * x1[1]) + (x1[2] * x1[2] + x1[3] * x1[3]);
                    {
                        const f32x4 y0 = x0 * gs[bj][0], y1 = x1 * gs[bj][1];
                        u32x4 w; w.x = cvt_pk_bf16(y0[0], y0[1]); w.y = cvt_pk_bf16(y0[2], y0[3]); w.z = cvt_pk_bf16(y1[0], y1[1]); w.w = cvt_pk_bf16(y1[2], y1[3]);
                        *(u32x4*)(xs + (size_t)row * 1024 + col0 + bj * HALF) = w;
                    }
                }
                ss += swz_xor<16>(ss); ss = sum_x32(ss);
                if (fq == 0) ssqp[(size_t)(u.pn * 4 + wc) * MROWS + row] = ss;
            }
    }
};
__constant__ float ROPE_INVF[16] = {1.000000000e+00f, 4.403665960e-01f, 1.939227432e-01f, 8.539710194e-02f, 3.760603070e-02f, 1.656044088e-02f, 7.292664610e-03f, 3.211446106e-03f,
                                    1.414213562e-03f, 6.227724371e-04f, 2.742481884e-04f, 1.207697351e-04f, 5.318295734e-05f, 2.341999971e-05f, 1.031338525e-05f, 4.541670478e-06f};
struct EpiRope {
    static constexpr bool PERM = true, AFTER_DRAIN = false;
    bf16_t* QKV; const float* sw; const float* ssqp; const int* pos;
    __device__ __forceinline__ void operator()(const f32x4 (&acc)[2][2][4][2], const Unit& u, int wr, int wc, int fr, int fq) const {
        const int b = u.pm >> 5, row0 = u.pm * BM + wr * 64 + fr, col0 = u.pn * BM + wc * 32 + 8 * fq;
        f32x4 sv[2][2];
#pragma unroll
        for (int bj = 0; bj < 2; ++bj)
#pragma unroll
            for (int n = 0; n < 2; ++n) sv[bj][n] = *(const f32x4*)(sw + (size_t)b * 3072 + col0 + bj * HALF + 4 * n);
        const bool rot = (wc == 0) && (u.pn < 8);
        const bool lower = fq < 2;
        f32x4 fr4[2] = {{0.f, 0.f, 0.f, 0.f}, {0.f, 0.f, 0.f, 0.f}};
        if (rot) { fr4[0] = *(const f32x4*)(ROPE_INVF + 8 * (fq & 1)); fr4[1] = *(const f32x4*)(ROPE_INVF + 8 * (fq & 1) + 4); }
#pragma unroll
        for (int ai = 0; ai < 2; ++ai)
#pragma unroll
            for (int m = 0; m < 4; ++m) {
                const int row = row0 + ai * HALF + m * 16, srow = row & 8191;
                const float rs = row_rstd(ssqp, row, fq);
                f32x4 cs[2] = {{1.f, 1.f, 1.f, 1.f}, {1.f, 1.f, 1.f, 1.f}}, sn[2] = {{0.f, 0.f, 0.f, 0.f}, {0.f, 0.f, 0.f, 0.f}};
                if (rot) {
                    const float p = (float)pos[row];
#pragma unroll
                    for (int n = 0; n < 2; ++n)
#pragma unroll
                        for (int j = 0; j < 4; ++j) {
                            const float a = p * fr4[n][j];
                            const float k = rintf(a * 0.15915494309189535f);
                            float r = fmaf(-k, 6.2831854820251465f, a); r = fmaf(-k, -1.7484555314695172e-07f, r);
                            cs[n][j] = __cosf(r); sn[n][j] = lower ? -__sinf(r) : __sinf(r);
                        }
                }
#pragma unroll
                for (int bj = 0; bj < 2; ++bj) {
                    const int blk = u.pn * 2 + bj, which = blk >> 3, idx = blk & 7;
                    f32x4 v[2] = {acc[ai][bj][m][0] * rs + sv[bj][0], acc[ai][bj][m][1] * rs + sv[bj][1]};
                    if (rot) {
#pragma unroll
                        for (int n = 0; n < 2; ++n)
#pragma unroll
                            for (int j = 0; j < 4; ++j) {
                                const unsigned bits = __float_as_uint(v[n][j]);
                                auto rr = __builtin_amdgcn_permlane32_swap(bits, bits, false, false);
                                const unsigned r0 = rr[0], r1 = rr[1];
                                const float pv = __uint_as_float(lower ? r1 : r0);
                                v[n][j] = v[n][j] * cs[n][j] + pv * sn[n][j];
                            }
                    }
                    bf16_t* dp = QKV + (size_t)which * 16777216 + ((size_t)(b * 8 + idx) * 8192 + srow) * 128 + wc * 32 + 8 * fq;
                    u32x4 w; w.x = cvt_pk_bf16(v[0][0], v[0][1]); w.y = cvt_pk_bf16(v[0][2], v[0][3]); w.z = cvt_pk_bf16(v[1][0], v[1][1]); w.w = cvt_pk_bf16(v[1][2], v[1][3]);
                    *(u32x4*)dp = w;
                }
            }
    }
};
struct EpiGen {
    static constexpr bool PERM = true, AFTER_DRAIN = false;
    int kind; void* p0; const void* p1; const void* p2; const void* p3; void* p4; void* p5;
    __device__ __forceinline__ void operator()(const f32x4 (&acc)[2][2][4][2], const Unit& u, int wr, int wc, int fr, int fq) const {
        if (kind == 0) { EpiUp e{(bf16_t*)p0, (const float*)p1, (const float*)p2}; e(acc, u, wr, wc, fr, fq); }
        else if (kind == 1) { EpiResidT<1> e{(float*)p0, (const float*)p1, (const float*)p2, (bf16_t*)p4, (float*)p5}; e(acc, u, wr, wc, fr, fq); }
        else if (kind == 2) { EpiResidT<0> e{(float*)p0, (const float*)p1, (const float*)p2, (bf16_t*)p4, (float*)p5}; e(acc, u, wr, wc, fr, fq); }
        else if (kind == 3) { EpiBias e{(bf16_t*)p0, 3072, (const float*)p1, 3072, (const float*)p2}; e(acc, u, wr, wc, fr, fq); }
        else { EpiRope e{(bf16_t*)p0, (const float*)p1, (const float*)p2, (const int*)p3}; e(acc, u, wr, wc, fr, fq); }
    }
};
template <class Epi, class Sched, bool ALIGN_EPI = false, bool SP2 = false>
__device__ __forceinline__ void gemm_phase(PG8_LAS unsigned char* lds, const Gemm g, const Sched& S, const Epi& E, const int tid_in) {
    const int tid = tid_in, wid = __builtin_amdgcn_readfirstlane(tid >> 6), lane = tid & 63, wr = wid >> 2, wc = wid & 3, fr = lane & 15, fq = lane >> 4;
    const int K = g.K, nt = K / BK;
    unsigned voffA[2], voffB[2];
#pragma unroll
    for (int i = 0; i < 2; ++i) { int R, C; stage_rc(tid * 16 + i * 8192, R, C); const int Rb = Epi::PERM ? ((R & ~31) + perm32(R & 31)) : R;
        voffA[i] = (unsigned)(R * K + C) * 2u; voffB[i] = (unsigned)(Rb * K + C) * 2u; }
    const size_t kstep = (size_t)(BK * 2);
    const size_t hstep = (size_t)HALF * K * 2;
    const size_t tstep = 2 * hstep;
    const unsigned ldsw = (unsigned)wid * 1024u;
    const int aoff = lds_byte(wr * 64 + fr, fq * 8), boff = lds_byte(wc * 32 + fr, fq * 8);
#define PG8_SA(b, h) (((b) * 2 + (h)) * HTB)
#define PG8_SB(b, h) ((4 + (b) * 2 + (h)) * HTB)
#define PG8_STAGE(bufoff, gbase, voff) do { _Pragma("unroll") for (int _i = 0; _i < 2; ++_i) \
        __builtin_amdgcn_global_load_lds((const unsigned*)((const char*)(gbase) + (voff)[_i]), (PG8_LAS unsigned*)(lds + (bufoff) + ldsw + _i * 8192), 16, 0, 0); } while (0)
#define PG8_LDA(dst, b, h) do { _Pragma("unroll") for (int m = 0; m < 4; ++m) _Pragma("unroll") for (int k = 0; k < 2; ++k) dst[m][k] = *(const PG8_LAS bf16x8*)(lds + PG8_SA(b, h) + aoff + m * 2048 + k * 1024); } while (0)
#define PG8_LDB(dst, b, h) do { _Pragma("unroll") for (int n = 0; n < 2; ++n) _Pragma("unroll") for (int k = 0; k < 2; ++k) dst[n][k] = *(const PG8_LAS bf16x8*)(lds + PG8_SB(b, h) + boff + n * 2048 + k * 1024); } while (0)
#define PG8_MMA(ai, bj, At, Bt) do { __builtin_amdgcn_s_setprio(1); _Pragma("unroll") for (int m = 0; m < 4; ++m) _Pragma("unroll") for (int n = 0; n < 2; ++n) _Pragma("unroll") for (int k = 0; k < 2; ++k) \
        acc[ai][bj][m][n] = __builtin_amdgcn_mfma_f32_16x16x32_bf16(Bt[n][k], At[m][k], acc[ai][bj][m][n], 0, 0, 0); __builtin_amdgcn_s_setprio(0); } while (0)
#define PG8_WAIT_V(n) asm volatile("s_waitcnt vmcnt(" #n ")" ::: "memory")
#define PG8_WAIT_L(n) asm volatile("s_waitcnt lgkmcnt(" #n ")" ::: "memory")
#define PG8_BAR __builtin_amdgcn_s_barrier()
#define PG8_SCHED __builtin_amdgcn_sched_barrier(0)
    Unit cur, nxt; int ui = 0;
    if (!S.next(0, cur)) return;
    f32x4 acc[2][2][4][2];
#pragma unroll
    for (int a = 0; a < 2; ++a)
#pragma unroll
        for (int b = 0; b < 2; ++b)
#pragma unroll
            for (int m = 0; m < 4; ++m)
#pragma unroll
                for (int n = 0; n < 2; ++n) acc[a][b][m][n] = (f32x4){0.f, 0.f, 0.f, 0.f};
    bf16x8 At[4][2], B0[2][2], B1[2][2];
    const char* cA = (const char*)g.A + (size_t)cur.pm * tstep; const char* cB = (const char*)g.Bt + (size_t)cur.pn * tstep;
    S.a_ready(cur);
    if constexpr (SP2) {
        PG8_STAGE(PG8_SB(0, 0), cB, voffB); PG8_STAGE(PG8_SB(0, 1), cB + hstep, voffB); PG8_STAGE(PG8_SA(0, 0), cA, voffA); PG8_STAGE(PG8_SA(0, 1), cA + hstep, voffA);
        if (wr == 1) PG8_BAR;
        PG8_WAIT_V(2); PG8_BAR;
        PG8_STAGE(PG8_SB(1, 0), cB + kstep, voffB); PG8_STAGE(PG8_SA(1, 0), cA + kstep, voffA); PG8_STAGE(PG8_SB(1, 1), cB + hstep + kstep, voffB);
        PG8_WAIT_V(6); PG8_BAR;
    } else {
        PG8_STAGE(PG8_SB(0, 0), cB, voffB); PG8_STAGE(PG8_SA(0, 0), cA, voffA); PG8_STAGE(PG8_SB(0, 1), cB + hstep, voffB); PG8_STAGE(PG8_SA(0, 1), cA + hstep, voffA);
        if (wr == 1) PG8_BAR;
        PG8_WAIT_V(4); PG8_BAR;
        PG8_STAGE(PG8_SB(1, 0), cB + kstep, voffB); PG8_STAGE(PG8_SA(1, 0), cA + kstep, voffA); PG8_STAGE(PG8_SB(1, 1), cB + hstep + kstep, voffB);
        PG8_WAIT_V(6); PG8_BAR;
    }
    for (;;) {
        const bool has_next = S.next(ui + 1, nxt);
        const char* nA = has_next ? (const char*)g.A + (size_t)nxt.pm * tstep : cA; const char* nB = has_next ? (const char*)g.Bt + (size_t)nxt.pn * tstep : cB;
        for (int t = 0; t < nt; t += 2) {
            const bool last = (t == nt - 2);
            const char* a1 = cA + (size_t)(t + 1) * kstep;
            const char* a2 = last ? nA : cA + (size_t)(t + 2) * kstep; const char* b2 = last ? nB : cB + (size_t)(t + 2) * kstep;
            const char* a3 = a2 + kstep; const char* b3 = b2 + kstep;
            if (last && has_next) S.a_ready(nxt);
            if constexpr (SP2) {
            PG8_LDB(B0, 0, 0); PG8_LDB(B1, 0, 1); PG8_SCHED; PG8_LDA(At, 0, 0); PG8_STAGE(PG8_SA(1, 1), a1 + hstep, voffA);
            PG8_WAIT_V(8); PG8_WAIT_L(0); PG8_BAR; PG8_MMA(0, 0, At, B0); PG8_MMA(0, 1, At, B1); PG8_BAR; PG8_SCHED;
            PG8_LDA(At, 0, 1); PG8_STAGE(PG8_SB(0, 0), b2, voffB); PG8_STAGE(PG8_SB(0, 1), b2 + hstep, voffB); PG8_STAGE(PG8_SA(0, 0), a2, voffA);
            PG8_WAIT_V(8); PG8_WAIT_L(0); PG8_BAR; PG8_MMA(1, 0, At, B0); PG8_MMA(1, 1, At, B1); PG8_BAR; PG8_SCHED;
            PG8_LDB(B0, 1, 0); PG8_LDB(B1, 1, 1); PG8_SCHED; PG8_LDA(At, 1, 0); PG8_STAGE(PG8_SA(0, 1), a2 + hstep, voffA);
            PG8_WAIT_V(8); PG8_WAIT_L(0); PG8_BAR; PG8_MMA(0, 0, At, B0); PG8_MMA(0, 1, At, B1); PG8_BAR; PG8_SCHED;
            PG8_LDA(At, 1, 1); PG8_STAGE(PG8_SB(1, 0), b3, voffB); PG8_STAGE(PG8_SB(1, 1), b3 + hstep, voffB); PG8_STAGE(PG8_SA(1, 0), a3, voffA);
            PG8_WAIT_V(8); PG8_WAIT_L(0); PG8_BAR; PG8_MMA(1, 0, At, B0); PG8_MMA(1, 1, At, B1); PG8_BAR; PG8_SCHED;
            } else {
            PG8_LDB(B0, 0, 0); PG8_SCHED; PG8_LDA(At, 0, 0); PG8_STAGE(PG8_SA(1, 1), a1 + hstep, voffA);
            PG8_WAIT_L(8); PG8_BAR; PG8_WAIT_L(0); PG8_MMA(0, 0, At, B0); PG8_BAR; PG8_SCHED;
            PG8_LDB(B1, 0, 1); PG8_STAGE(PG8_SB(0, 0), b2, voffB);
            PG8_BAR; PG8_WAIT_L(0); PG8_MMA(0, 1, At, B1); PG8_BAR;
            PG8_LDA(At, 0, 1); PG8_STAGE(PG8_SA(0, 0), a2, voffA);
            PG8_BAR; PG8_WAIT_L(0); PG8_MMA(1, 0, At, B0); PG8_BAR; PG8_SCHED;
            PG8_STAGE(PG8_SB(0, 1), b2 + hstep, voffB);
            PG8_WAIT_V(6); PG8_BAR; PG8_MMA(1, 1, At, B1); PG8_BAR;
            PG8_LDB(B0, 1, 0); PG8_SCHED; PG8_LDA(At, 1, 0); PG8_STAGE(PG8_SA(0, 1), a2 + hstep, voffA);
            PG8_WAIT_L(8); PG8_BAR; PG8_WAIT_L(0); PG8_MMA(0, 0, At, B0); PG8_BAR; PG8_SCHED;
            PG8_LDB(B1, 1, 1); PG8_STAGE(PG8_SB(1, 0), b3, voffB);
            PG8_BAR; PG8_WAIT_L(0); PG8_MMA(0, 1, At, B1); PG8_BAR;
            PG8_LDA(At, 1, 1); PG8_STAGE(PG8_SA(1, 0), a3, voffA);
            PG8_BAR; PG8_WAIT_L(0); PG8_MMA(1, 0, At, B0); PG8_BAR; PG8_SCHED;
            PG8_STAGE(PG8_SB(1, 1), b3 + hstep, voffB);
            PG8_WAIT_V(6); PG8_BAR; PG8_MMA(1, 1, At, B1); PG8_BAR;
            }
        }
        if constexpr (ALIGN_EPI) { if (wr == 0) PG8_BAR; }
        if constexpr (!Epi::AFTER_DRAIN) { E(acc, cur, wr, wc, fr, fq); S.done(cur); }
        if (!has_next) break;
#pragma unroll
        for (int a = 0; a < 2; ++a)
#pragma unroll
            for (int b = 0; b < 2; ++b)
#pragma unroll
                for (int m = 0; m < 4; ++m)
#pragma unroll
                    for (int n = 0; n < 2; ++n) acc[a][b][m][n] = (f32x4){0.f, 0.f, 0.f, 0.f};
        cur = nxt; cA = nA; cB = nB; ++ui;
        if constexpr (ALIGN_EPI) { if (wr == 1) PG8_BAR; }
    }
    PG8_WAIT_V(0);
    if constexpr (!ALIGN_EPI) { if (wr == 0) PG8_BAR; }
    PG8_BAR;
    if constexpr (Epi::AFTER_DRAIN) { E.fused(acc, cur, wr, wc, fr, fq, lds, wid, lane); S.done(cur); }
#undef PG8_SA
#undef PG8_SB
#undef PG8_STAGE
#undef PG8_LDA
#undef PG8_LDB
#undef PG8_MMA
#undef PG8_WAIT_V
#undef PG8_WAIT_L
#undef PG8_BAR
#undef PG8_SCHED
}
}
namespace att {
using bf16 = __hip_bfloat16;
constexpr int D = 128; constexpr float THR = 8.f; constexpr bool WSKIP = false;
constexpr float SCALE = 0.08838834764831845f;
constexpr int NW = 8, QBLK = 32, KVBLK = 64, QB = NW * QBLK;
constexpr int SHM_V = KVBLK * D * 2, SHM_K = KVBLK * D * 2;
constexpr int LDS_BYTES = 2 * SHM_V + 2 * SHM_K + NW * 64 * 4;
typedef short bf16x8 __attribute__((ext_vector_type(8)));
typedef short s16x4 __attribute__((ext_vector_type(4)));
typedef float f32x16 __attribute__((ext_vector_type(16)));
typedef float f32x4 __attribute__((ext_vector_type(4)));
typedef unsigned u32x4 __attribute__((ext_vector_type(4)));
template <class A, class Bt> struct same_t { static constexpr bool v = false; };
template <class A> struct same_t<A, A> { static constexpr bool v = true; };

#define KSWZ(row, colB) ((row) * 256 + ((colB) ^ (((row) & 7) << 4)))
#define SBAR() __builtin_amdgcn_sched_barrier(0)
__device__ __forceinline__ int v_st(int k, int c) { const int kk = (k & ~0xC) | ((k & 4) << 1) | ((k & 8) >> 1); return ((kk >> 3) * 4 + (c >> 5)) * 512 + ((kk & 7) * 32 + (c & 31)) * 2; }
__device__ __forceinline__ int v_rd_base(int lane) { return ((lane & 3) << 3) | (((lane >> 2) & 3) << 6) | (((lane >> 4) & 1) << 5) | (((lane >> 5) & 1) << 8); }
constexpr int v_rd_off(int d0, int ks, int half) { return d0 * 512 + ks * 4096 + half * 2048; }
__device__ __forceinline__ int crow(int r, int hi) { return (r & 3) + 8 * (r >> 2) + 4 * hi; }
__device__ __forceinline__ unsigned cvtpk(float lo, float hi) {
    unsigned r; asm volatile("v_cvt_pk_bf16_f32 %0, %1, %2" : "=v"(r) : "v"(lo), "v"(hi)); return r;
}
__device__ __forceinline__ bf16x8 pack8(f32x4 a, f32x4 b) {
    u32x4 w = {cvtpk(a[0], a[1]), cvtpk(a[2], a[3]), cvtpk(b[0], b[1]), cvtpk(b[2], b[3])};
    return *reinterpret_cast<bf16x8*>(&w);
}
template <class T> __device__ __forceinline__ bf16x8 load8(const T* p) {
    if constexpr (same_t<T, float>::v) { return pack8(*(const f32x4*)p, *(const f32x4*)(p + 4)); }
    else { return *reinterpret_cast<const bf16x8*>(p); }
}
__device__ __forceinline__ void mask_tile(f32x16& p0, f32x16& p1, int dq, unsigned W) {
    const float NEG = -__builtin_inff();
#pragma unroll
    for (int r = 0; r < 16; ++r) {
        const int c = (r & 3) + 8 * (r >> 2);
        if ((unsigned)(dq - c) >= W) p0[r] = NEG;
        if ((unsigned)(dq - c - 32) >= W) p1[r] = NEG;
    }
}
__device__ __forceinline__ void partialSM(f32x16& p0, f32x16& p1, float& m_reg, float& mn, float& alpha) {
    float pmax = p0[0]; for (int r = 1; r < 16; ++r) pmax = fmaxf(pmax, p0[r]); for (int r = 0; r < 16; ++r) pmax = fmaxf(pmax, p1[r]);
    { auto rr = __builtin_amdgcn_permlane32_swap(__float_as_uint(pmax), __float_as_uint(pmax), false, false);
      pmax = fmaxf(__uint_as_float(rr[0]), __uint_as_float(rr[1])); }
    constexpr float C2 = 1.4426950408889634f * SCALE;
    if (__builtin_expect(__all((pmax - m_reg) * SCALE <= THR), 1)) { mn = m_reg; alpha = 1.f; }
    else { mn = fmaxf(m_reg, pmax); alpha = __builtin_amdgcn_exp2f((m_reg - mn) * C2); m_reg = mn; }
    const float mnL = -mn * C2;
    for (int r = 0; r < 16; ++r) p0[r] = fmaf(p0[r], C2, mnL); for (int r = 0; r < 16; ++r) p1[r] = fmaf(p1[r], C2, mnL);
    for (int r = 0; r < 16; ++r) p0[r] = __builtin_amdgcn_exp2f(p0[r]);
}
__device__ __forceinline__ void finishSM(f32x16& p0, f32x16& p1, float alpha, float& l_reg, bf16x8& pa0, bf16x8& pa1, bf16x8& pa2, bf16x8& pa3) {
    for (int r = 0; r < 16; ++r) p1[r] = __builtin_amdgcn_exp2f(p1[r]);
    float ps = 0; for (int r = 0; r < 16; ++r) ps += p0[r]; for (int r = 0; r < 16; ++r) ps += p1[r];
    { auto rr = __builtin_amdgcn_permlane32_swap(__float_as_uint(ps), __float_as_uint(ps), false, false);
      ps = __uint_as_float(rr[0]) + __uint_as_float(rr[1]); }
    l_reg = l_reg * alpha + ps;
#define PK4(P, B_, OUT) do { unsigned a0 = cvtpk(P[B_+0], P[B_+1]), a1 = cvtpk(P[B_+2], P[B_+3]);                          \
        unsigned b0 = cvtpk(P[B_+4], P[B_+5]), b1 = cvtpk(P[B_+6], P[B_+7]);                                             \
        auto r0 = __builtin_amdgcn_permlane32_swap(a0, b0, false, false); auto r1 = __builtin_amdgcn_permlane32_swap(a1, b1, false, false); \
        u32x4 w = {r0[0], r1[0], r0[1], r1[1]}; OUT = *reinterpret_cast<bf16x8*>(&w); } while (0)
    PK4(p0, 0, pa0); PK4(p0, 8, pa1); PK4(p1, 0, pa2); PK4(p1, 8, pa3);
#undef PK4
}
template <int KB, bool SK>
__device__ __forceinline__ void qkt(f32x16& p0, f32x16& p1, const char* K_lds, int r32, int hi, const bf16x8* qr, bool act) {
    if (SK && !act) { const float NEG = -__builtin_inff();
#pragma unroll
        for (int r = 0; r < 16; ++r) { p0[r] = NEG; p1[r] = NEG; } return; }
    p0 = f32x16{}; p1 = f32x16{};
    const char* kb[4];
#pragma unroll
    for (int dd = 0; dd < 4; ++dd) kb[dd] = K_lds + KB * SHM_K + KSWZ(r32, (dd * 16 + hi * 8) * 2);
#pragma unroll
    for (int d0 = 0; d0 < 8; ++d0) { const char* a = kb[d0 & 3] + (d0 >> 2) * 128;
        bf16x8 b0 = *reinterpret_cast<const bf16x8*>(a);
        bf16x8 b1 = *reinterpret_cast<const bf16x8*>(a + 32 * 256);
        p0 = __builtin_amdgcn_mfma_f32_32x32x16_bf16(b0, qr[d0], p0, 0, 0, 0);
        p1 = __builtin_amdgcn_mfma_f32_32x32x16_bf16(b1, qr[d0], p1, 0, 0, 0); }
}
template <int VB, bool SK>
__device__ __forceinline__ void pv_tile(f32x16* o, int vb0, bf16x8 pa0, bf16x8 pa1, bf16x8 pa2, bf16x8 pa3, bool act) {
    if (SK && !act) return;
#define TRRD(dst, off) asm volatile("ds_read_b64_tr_b16 %0, %1 offset:%2" : "=&v"(dst) : "v"(vb0), "i"(off) : "memory")
#define PV_D0(d0) do { s16x4 l0, l1, l2, l3, h0, h1, h2, h3; constexpr int b_ = VB * SHM_V + v_rd_off(d0, 0, 0);     \
        TRRD(l0, b_); TRRD(h0, b_ + 2048); TRRD(l1, b_ + 4096); TRRD(h1, b_ + 6144); TRRD(l2, b_ + 8192); TRRD(h2, b_ + 10240); TRRD(l3, b_ + 12288); TRRD(h3, b_ + 14336); \
        asm volatile("s_waitcnt lgkmcnt(0)" ::: "memory"); SBAR();                 \
        o[d0] = __builtin_amdgcn_mfma_f32_32x32x16_bf16(pa0, (bf16x8){l0[0], l0[1], l0[2], l0[3], h0[0], h0[1], h0[2], h0[3]}, o[d0], 0, 0, 0);   \
        o[d0] = __builtin_amdgcn_mfma_f32_32x32x16_bf16(pa1, (bf16x8){l1[0], l1[1], l1[2], l1[3], h1[0], h1[1], h1[2], h1[3]}, o[d0], 0, 0, 0);   \
        o[d0] = __builtin_amdgcn_mfma_f32_32x32x16_bf16(pa2, (bf16x8){l2[0], l2[1], l2[2], l2[3], h2[0], h2[1], h2[2], h2[3]}, o[d0], 0, 0, 0);   \
        o[d0] = __builtin_amdgcn_mfma_f32_32x32x16_bf16(pa3, (bf16x8){l3[0], l3[1], l3[2], l3[3], h3[0], h3[1], h3[2], h3[3]}, o[d0], 0, 0, 0); } while (0)
    PV_D0(0); PV_D0(1); PV_D0(2); PV_D0(3);
#undef PV_D0
#undef TRRD
}

template <class TIn, class TOut> struct BlockRef { const TIn* Q; const TIn* K; const TIn* V; TOut* O; int P0; };
template <class TIn> struct Seam {
    bf16x8 qr[8];
    bf16x8 st_v0, st_v1, st_k0, st_k1; f32x4 sf0, sf1, sf2, sf3;
    f32x4 tq[16];
};
__device__ __forceinline__ int swa_jlo(int P0, int W) { const int lowk = P0 - W + 1; return lowk > 0 ? lowk / KVBLK : 0; }
#define ROW(p, k0, rr) ((p) + (size_t)((k0) + (rr)) * D + sc)
#define VMW() asm volatile("s_waitcnt vmcnt(0)" ::: "memory")
#define VMWN(n) asm volatile("s_waitcnt vmcnt(%0)" :: "i"(n) : "memory")
#define SLOAD_H(Kp, Vp, k0) do { S.st_v0 = load8<TIn>(ROW(Vp, k0, sr)); S.st_v1 = load8<TIn>(ROW(Vp, k0, 32 + sr));              \
                         S.st_k0 = load8<TIn>(ROW(Kp, k0, sr)); S.st_k1 = load8<TIn>(ROW(Kp, k0, 32 + sr)); } while (0)
#define SWRITE_HK(bf) do { *(bf16x8*)(K_lds + (bf) * SHM_K + kws) = S.st_k0; *(bf16x8*)(K_lds + (bf) * SHM_K + kws + 32 * 256) = S.st_k1; } while (0)
#define SWRITE_HV(bf) do { *(bf16x8*)(V_lds + (bf) * SHM_V + vst0) = S.st_v0; *(bf16x8*)(V_lds + (bf) * SHM_V + vst1) = S.st_v1; } while (0)
#define SWRITE_H(bf) do { SWRITE_HV(bf); SWRITE_HK(bf); } while (0)
#define SLOAD_F(p, k0) do { S.sf0 = *(const f32x4*)ROW(p, k0, sr); S.sf1 = *(const f32x4*)(ROW(p, k0, sr) + 4);                \
                            S.sf2 = *(const f32x4*)ROW(p, k0, 32 + sr); S.sf3 = *(const f32x4*)(ROW(p, k0, 32 + sr) + 4); } while (0)
#define SWRITE_KF(bf) do { *(bf16x8*)(K_lds + (bf) * SHM_K + kws) = pack8(S.sf0, S.sf1); *(bf16x8*)(K_lds + (bf) * SHM_K + kws + 32 * 256) = pack8(S.sf2, S.sf3); } while (0)
#define SWRITE_VF(bf) do { *(bf16x8*)(V_lds + (bf) * SHM_V + vst0) = pack8(S.sf0, S.sf1); *(bf16x8*)(V_lds + (bf) * SHM_V + vst1) = pack8(S.sf2, S.sf3); } while (0)
template <class TIn, class TOut>
__device__ __forceinline__ void causal_swa_prime(const BlockRef<TIn, TOut>& cur, int W, char* lds, Seam<TIn>& S, int tid_in) {
    constexpr bool F32 = same_t<TIn, float>::v;
    const int tid = tid_in, wid = __builtin_amdgcn_readfirstlane(tid >> 6), lane = tid & 63, r32 = lane & 31, hi = lane >> 5;
    const int sr = tid >> 4, sc = (tid & 15) * 8, kws = KSWZ(sr, sc * 2); char* K_lds = lds + 2 * SHM_V;
    const int kb0 = swa_jlo(cur.P0, W) * KVBLK;
    for (int d0 = 0; d0 < 8; ++d0) S.qr[d0] = load8<TIn>(cur.Q + (size_t)(wid * QBLK + r32) * D + d0 * 16 + hi * 8);
    if constexpr (F32) { SLOAD_F((const float*)cur.K, kb0); VMW(); SWRITE_KF(0); SBAR(); SLOAD_F((const float*)cur.V, kb0); }
    else { SLOAD_H(cur.K, cur.V, kb0); VMW(); SWRITE_HK(0); }
    __syncthreads();
}
template <class TIn, class TOut>
__device__ __forceinline__ void causal_swa_block(const BlockRef<TIn, TOut>& cur, const BlockRef<TIn, TOut>& nxt, int skv, int W, char* lds, Seam<TIn>& S, int tid_in) {
    constexpr bool F32 = same_t<TIn, float>::v;
    const int tid = tid_in, wid = __builtin_amdgcn_readfirstlane(tid >> 6), lane = tid & 63, r32 = lane & 31, hi = lane >> 5;
    const int j_lo = swa_jlo(cur.P0, W);
    int j_hi = (cur.P0 + QB - 1) / KVBLK + 1; if (j_hi > skv / KVBLK) j_hi = skv / KVBLK;
    const int NT = j_hi - j_lo;
    const int kbn = swa_jlo(nxt.P0, W) * KVBLK;
    const int qlo = cur.P0 + wid * QBLK, qm = qlo + r32 - 4 * hi;
    char* V_lds = lds; char* K_lds = lds + 2 * SHM_V;
    float* ws = (float*)(lds + 2 * SHM_V + 2 * SHM_K) + wid * 64; float* li_l = ws, * al_l = ws + 32;
    float m_reg = -1e30f, l_reg = 0; f32x16 o[4] = {};
    const int sr = tid >> 4, sc = (tid & 15) * 8, vst0 = v_st(sr, sc), vst1 = v_st(32 + sr, sc), kws = KSWZ(sr, sc * 2);
    const int vb0 = (int)(uintptr_t)V_lds + v_rd_base(lane);
    const TIn* Kh = cur.K; const TIn* Vh = cur.V;
#define RESC(a) do { if (__any((a) < 1.f)) { if (hi == 0) al_l[r32] = (a); asm volatile("s_waitcnt lgkmcnt(0)" ::: "memory");              \
                     for (int d_ = 0; d_ < 4; ++d_) for (int r = 0; r < 16; ++r) o[d_][r] *= al_l[crow(r, hi)]; } } while (0)
#define KBASE(t) ((j_lo + (t)) * KVBLK)
#define ACT(t) (KBASE(t) <= qlo + QBLK - 1 && KBASE(t) + KVBLK - 1 >= qlo - W + 1)
#define MASKT(P0_, P1_, t) do { const int kb_ = KBASE(t); if ((!SK || ACT(t)) && (kb_ + KVBLK - 1 > qlo || kb_ <= qlo + QBLK - 1 - W)) mask_tile(P0_, P1_, qm - kb_, (unsigned)W); } while (0)
    constexpr int NQL = F32 ? 16 : 8;
    constexpr bool SK = WSKIP && !F32;
#define SEAM_K0() do { VMWN(NQL); if constexpr (F32) { SWRITE_KF(0); SBAR(); SLOAD_F((const float*)nxt.V, kbn); } else { SWRITE_HK(0); } SBAR(); } while (0)
    f32x16 pA0, pA1, pB0, pB1; float mnA, mnB, alA, alB; bf16x8 pa0, pa1, pa2, pa3;
    if constexpr (F32) { VMW(); SWRITE_VF(0); SBAR(); } else { SWRITE_HV(0); SBAR(); }
    if (NT > 1) { if constexpr (F32) SLOAD_F((const float*)Kh, KBASE(1)); else SLOAD_H(Kh, Vh, KBASE(1)); }
    SBAR(); qkt<0, SK>(pA0, pA1, K_lds, r32, hi, S.qr, ACT(0));
    if constexpr (F32) { if (NT > 1) { VMW(); SWRITE_KF(1); SBAR(); SLOAD_F((const float*)Vh, KBASE(1)); } }
    MASKT(pA0, pA1, 0); partialSM(pA0, pA1, m_reg, mnA, alA);
    if (NT > 1) { VMW(); if constexpr (F32) { SWRITE_VF(1); SBAR(); if (NT > 2) SLOAD_F((const float*)Kh, KBASE(2)); } else SWRITE_H(1); }
    __syncthreads();
#define HALF_STEP(PX0, PX1, mnX, alX, PY0, PY1, alY, t, KB, VB, SB) do {                                                      \
        SBAR(); qkt<KB, SK>(PX0, PX1, K_lds, r32, hi, S.qr, ACT(t));                                             \
        finishSM(PY0, PY1, alY, l_reg, pa0, pa1, pa2, pa3); SBAR();                                                           \
        if ((t) + 1 < NT) { if constexpr (F32) { VMW(); SWRITE_KF(SB); SBAR(); SLOAD_F((const float*)Vh, KBASE((t) + 1)); }  \
                            else { SLOAD_H(Kh, Vh, KBASE((t) + 1)); } SBAR(); }                                               \
        pv_tile<VB, SK>(o, vb0, pa0, pa1, pa2, pa3, ACT((t) - 1)); MASKT(PX0, PX1, (t)); partialSM(PX0, PX1, m_reg, mnX, alX);                                        \
        __syncthreads();                                                                                                      \
        if ((t) + 1 < NT) { VMW(); if constexpr (F32) { SWRITE_VF(SB); SBAR(); if ((t) + 2 < NT) SLOAD_F((const float*)Kh, KBASE((t) + 2)); } \
                            else { SWRITE_H(SB); } }                                                                          \
        RESC(alX); __syncthreads(); } while (0)
    for (int t = 1; t + 1 < NT; t += 2) {
        HALF_STEP(pB0, pB1, mnB, alB, pA0, pA1, alA, t, 1, 0, 0);
        HALF_STEP(pA0, pA1, mnA, alA, pB0, pB1, alB, t + 1, 0, 1, 1);
    }
    const bool even = (NT & 1) == 0;
    if (even) { SBAR(); qkt<1, SK>(pB0, pB1, K_lds, r32, hi, S.qr, ACT(NT - 1)); SBAR(); }
#define QROW(e) (nxt.Q + (size_t)(wid * QBLK + r32) * D + ((e) >> 1) * 16 + hi * 8 + ((e) & 1) * 4)
    if constexpr (F32) { SLOAD_F((const float*)nxt.K, kbn); SBAR();
#pragma unroll
        for (int e = 0; e < 8; ++e) S.tq[e] = *(const f32x4*)QROW(e); }
    else { SLOAD_H(nxt.K, nxt.V, kbn); SBAR();
#pragma unroll
        for (int d0 = 0; d0 < 8; ++d0) S.qr[d0] = load8<TIn>(nxt.Q + (size_t)(wid * QBLK + r32) * D + d0 * 16 + hi * 8); }
    SBAR();
    finishSM(pA0, pA1, alA, l_reg, pa0, pa1, pa2, pa3); SBAR();
    if constexpr (F32) {
#pragma unroll
        for (int e = 8; e < 16; ++e) S.tq[e] = *(const f32x4*)QROW(e); SBAR(); }
#undef QROW
    pv_tile<0, SK>(o, vb0, pa0, pa1, pa2, pa3, ACT(even ? NT - 2 : NT - 1));
    if (even) { MASKT(pB0, pB1, NT - 1); partialSM(pB0, pB1, m_reg, mnB, alB); __syncthreads(); RESC(alB);
        finishSM(pB0, pB1, alB, l_reg, pa0, pa1, pa2, pa3); SBAR(); pv_tile<1, SK>(o, vb0, pa0, pa1, pa2, pa3, ACT(NT - 1)); }
    SBAR(); SEAM_K0();
    if (hi == 0) li_l[r32] = l_reg; asm volatile("s_waitcnt lgkmcnt(0)" ::: "memory");
    float rli[16];
#pragma unroll
    for (int r = 0; r < 16; ++r) rli[r] = __builtin_amdgcn_rcpf(li_l[crow(r, hi)]);
    TOut* Ow = cur.O + (size_t)(wid * QBLK) * D;
    int hi_e = hi; asm volatile("" : "+v"(hi_e));
#pragma unroll
    for (int r = 0; r < 16; ++r) { const int orow = crow(r, hi_e);
#pragma unroll
        for (int d0 = 0; d0 < 4; ++d0) { const float v = o[d0][r] * rli[r];
            if constexpr (same_t<TOut, float>::v) { Ow[(size_t)orow * D + d0 * 32 + r32] = v; }
            else { const float vn = swz_xor<1>(v);
                   if ((r32 & 1) == 0) *(unsigned*)(Ow + (size_t)orow * D + d0 * 32 + r32) = cvtpk(v, vn); } } }
    if constexpr (F32) {
#pragma unroll
        for (int d0 = 0; d0 < 8; ++d0) S.qr[d0] = pack8(S.tq[2 * d0], S.tq[2 * d0 + 1]); }
    __syncthreads();
#undef RESC
#undef KBASE
#undef ACT
#undef MASKT
#undef SEAM_K0
#undef HALF_STEP
}
#undef ROW
#undef VMW
#undef VMWN
#undef SLOAD_H
#undef SWRITE_HK
#undef SWRITE_HV
#undef SWRITE_H
#undef SLOAD_F
#undef SWRITE_KF
#undef SWRITE_VF
#undef SBAR
#undef KSWZ
}
namespace cg = cooperative_groups;
#ifndef MK_DEBUG
#define MK_DEBUG 0
#endif
#define LAS __attribute__((address_space(3)))
typedef unsigned short bf16r;
typedef unsigned v4u __attribute__((ext_vector_type(4)));
typedef unsigned v2u __attribute__((ext_vector_type(2)));
typedef float f32x4 __attribute__((ext_vector_type(4)));
typedef short bf16x8 __attribute__((ext_vector_type(8)));
constexpr int M = 16384, SEQ = 8192, DM = 1024, DFF = 2816, NUP = 5632, NIN = 3072, DEPTH = 4;
constexpr float EPS = 1e-6f;
constexpr size_t MiB = 1u << 20;
constexpr size_t WS_ADA = 1 * MiB, WS_GS = 2 * MiB, WS_SWF = 3 * MiB, WS_SWM = 4 * MiB, WS_SSQP = 5 * MiB, WS_GATES = 6 * MiB, WS_BCUM = 7 * MiB, WS_LOGI = 8 * MiB,
                 WS_SCAL = 9 * MiB, WS_NLOC = 10 * MiB, WS_NST = 11 * MiB, WS_LAM = 12 * MiB;
constexpr size_t WS_W13 = 16 * MiB, WS_W2 = 104 * MiB, WS_WINA = 148 * MiB, WS_WINB = 160 * MiB, WS_WOA = 172 * MiB, WS_WOB = 176 * MiB;
constexpr size_t WS_XS = 180 * MiB, WS_H = 212 * MiB, WS_P = 300 * MiB, WS_Y = 396 * MiB, WS_U = 428 * MiB, WS_CST = 556 * MiB, WS_END = 620 * MiB;
constexpr size_t WS_O = WS_H;
constexpr int LDS_BYTES = 147456;
constexpr int NWAVES = 8;

__device__ __forceinline__ unsigned f2bf(float f) { unsigned u = __builtin_bit_cast(unsigned, f); return (u + 0x7fffu + ((u >> 16) & 1u)) >> 16; }
__device__ __forceinline__ unsigned pk2(float lo, float hi) { return f2bf(lo) | (f2bf(hi) << 16); }
__device__ __forceinline__ float bflo(unsigned w) { return __uint_as_float(w << 16); }
__device__ __forceinline__ float bfhi(unsigned w) { return __uint_as_float(w & 0xffff0000u); }
__device__ __forceinline__ float bf2f(bf16r v) { return __uint_as_float((unsigned)v << 16); }
__device__ __forceinline__ float wave_sum(float v) {
    v += swz_xor<1>(v); v += swz_xor<2>(v); v += swz_xor<4>(v); v += swz_xor<8>(v); v += swz_xor<16>(v); return sum_x32(v);
}
__device__ __forceinline__ float wave_max(float v) {
    v = fmaxf(v, swz_xor<1>(v)); v = fmaxf(v, swz_xor<2>(v)); v = fmaxf(v, swz_xor<4>(v)); v = fmaxf(v, swz_xor<8>(v)); v = fmaxf(v, swz_xor<16>(v)); return max_x32(v);
}
__device__ __forceinline__ float lane_up(float v, int lane, int o) { return __builtin_bit_cast(float, __builtin_amdgcn_ds_bpermute(((lane - o) & 63) << 2, __builtin_bit_cast(int, v))); }
#define LDS_WAIT() asm volatile("s_waitcnt lgkmcnt(0)" ::: "memory")

struct Args { const void* in[19]; float* out; unsigned char* ws; int ph_lo, ph_hi; };
typedef const Args __attribute__((address_space(4)))* KArgs;
struct Ctx { KArgs ka; float* out; unsigned char* ws; int tid, lane, wave, G, wg; };

__device__ __forceinline__ void transpose_item(const float* W, int ldw, int k0, int n0, bf16r* dst  , int Kdst, LAS float* scr, int lane) {
#pragma unroll 8
    for (int i = 0; i < 32; ++i) { const int kk = 2 * i + (lane >> 5); scr[kk * 33 + (lane & 31)] = W[(size_t)(k0 + kk) * ldw + n0 + (lane & 31)]; }
    LDS_WAIT(); asm volatile("" ::: "memory");
    const int c = lane & 7;
#pragma unroll
    for (int j = 0; j < 4; ++j) { const int n = (lane >> 3) + 8 * j; const LAS float* s = scr + (8 * c) * 33 + n;
        v4u o; o.x = pk2(s[0 * 33], s[1 * 33]); o.y = pk2(s[2 * 33], s[3 * 33]); o.z = pk2(s[4 * 33], s[5 * 33]); o.w = pk2(s[6 * 33], s[7 * 33]);
        *(v4u*)(dst + (size_t)n * Kdst + k0 + 8 * c) = o; }
    LDS_WAIT(); asm volatile("" ::: "memory");
}
__device__ __forceinline__ void p0_phase(const Ctx& F, LAS unsigned char* lds) {
#if MK_DEBUG
    if (F.wg == 0 && F.tid == 1) *(unsigned*)(F.ws + 64) = 0u;
#endif
    {
        LAS float* red = (LAS float*)lds;
        float* ADA = (float*)(F.ws + WS_ADA);
        const int l32 = F.tid & 31, kg = F.tid >> 5;
        for (int task = F.wg; task < 4 * 72; task += F.G) {
            const int l = task / 72, col0 = (task % 72) * 128;
            f32x4 a0 = {0.f, 0.f, 0.f, 0.f}, a1 = {0.f, 0.f, 0.f, 0.f};
            const float* wp = ((const float*)F.ka->in[3]) + ((size_t)l * 1024 + kg * 64) * 9216 + col0 + l32 * 4;
#pragma unroll 8
            for (int kk = 0; kk < 64; ++kk) {
                const f32x4 w = *(const f32x4*)(wp + (size_t)kk * 9216);
                const float c0 = ((const float*)F.ka->in[1])[kg * 64 + kk], c1 = ((const float*)F.ka->in[1])[1024 + kg * 64 + kk];
                a0 += w * pg8::silu_f(c0); a1 += w * pg8::silu_f(c1);
            }
            *(LAS f32x4*)(red + (kg * 2 + 0) * 128 + l32 * 4) = a0; *(LAS f32x4*)(red + (kg * 2 + 1) * 128 + l32 * 4) = a1;
            __syncthreads();
            if (F.tid < 256) { const int b = F.tid >> 7, col = F.tid & 127; float s = 0.f;
#pragma unroll
                for (int g = 0; g < 16; ++g) s += red[(g * 2 + b) * 128 + col];
                ADA[(size_t)(l * 2 + b) * 9216 + col0 + col] = s + ((const float*)F.ka->in[4])[(size_t)l * 9216 + col0 + col]; }
            __syncthreads();
        }
    }
    {
        LAS float* scr = (LAS float*)(lds + 16384 + F.wave * 8448);
        const int gw = F.wg * NWAVES + F.wave, NGW = F.G * NWAVES;
        constexpr int I13 = 16 * 176, I2 = 44 * 32, IIN = 16 * 96, IOUT = 16 * 32;
        constexpr int T0 = 8 * I13, T1 = T0 + 8 * I2, T2 = T1 + 2 * IIN, T3 = T2 + 2 * IIN, T4 = T3 + 2 * IOUT, T5 = T4 + 2 * IOUT;
        for (int it = gw; it < T5; it += NGW) {
            if (it < T0) { const int mat = it / I13, r = it % I13, kb = r / 176, n0 = (r % 176) * 32;
                const int drow = n0 < 2816 ? (n0 >> 7) * 256 + (n0 & 127) : ((n0 - 2816) >> 7) * 256 + 128 + ((n0 - 2816) & 127);
                transpose_item(((const float*)F.ka->in[6]) + (size_t)mat * 1024 * 5632, 5632, kb * 64, n0, (bf16r*)(F.ws + WS_W13) + ((size_t)mat * 5632 + drow) * 1024, 1024, scr, F.lane); }
            else if (it < T1) { const int q = it - T0, mat = q / I2, r = q % I2, kb = r / 32, n0 = (r % 32) * 32;
                transpose_item(((const float*)F.ka->in[7]) + (size_t)mat * 2816 * 1024, 1024, kb * 64, n0, (bf16r*)(F.ws + WS_W2) + ((size_t)mat * 1024 + n0) * 2816, 2816, scr, F.lane); }
            else if (it < T2) { const int q = it - T1, mat = q / IIN, r = q % IIN, kb = r / 96, n0 = (r % 96) * 32;
                transpose_item(((const float*)F.ka->in[8]) + (size_t)mat * 1024 * 3080, 3080, kb * 64, n0, (bf16r*)(F.ws + WS_WINA) + ((size_t)mat * 3072 + n0) * 1024, 1024, scr, F.lane); }
            else if (it < T3) { const int q = it - T2, mat = q / IIN, r = q % IIN, kb = r / 96, n0 = (r % 96) * 32;
                transpose_item(((const float*)F.ka->in[14]) + (size_t)mat * 1024 * 3072, 3072, kb * 64, n0, (bf16r*)(F.ws + WS_WINB) + ((size_t)mat * 3072 + n0) * 1024, 1024, scr, F.lane); }
            else if (it < T4) { const int q = it - T3, mat = q / IOUT, r = q % IOUT, kb = r / 32, n0 = (r % 32) * 32;
                transpose_item(((const float*)F.ka->in[13]) + (size_t)mat * 1024 * 1024, 1024, kb * 64, n0, (bf16r*)(F.ws + WS_WOA) + ((size_t)mat * 1024 + n0) * 1024, 1024, scr, F.lane); }
            else { const int q = it - T4, mat = q / IOUT, r = q % IOUT, kb = r / 32, n0 = (r % 32) * 32;
                transpose_item(((const float*)F.ka->in[17]) + (size_t)mat * 1024 * 1024, 1024, kb * 64, n0, (bf16r*)(F.ws + WS_WOB) + ((size_t)mat * 1024 + n0) * 1024, 1024, scr, F.lane); }
        }
    }
}
__device__ __forceinline__ void p1_phase(const Ctx& F) {
    const float* ADA = (const float*)(F.ws + WS_ADA);
    float* GS = (float*)(F.ws + WS_GS);
    const int gw = F.wg * NWAVES + F.wave, NGW = F.G * NWAVES;
    for (int i = F.wg * 512 + F.tid; i < 4 * 3 * 2 * 1024; i += F.G * 512) {
        const int d = i & 1023, b = (i >> 10) & 1, ls = i >> 11, l = ls / 3, sub = ls % 3;
        GS[i] = ((const float*)F.ka->in[5])[(size_t)ls * 1024 + d] * (1.0f + ADA[(size_t)(l * 2 + b) * 9216 + sub * 3072 + 1024 + d]);
    }
    if (F.wg == 0 && F.tid < 2) {
        const float* lm = ((const float*)F.ka->in[15]) + F.tid * 512; float s1 = 0.f, s2 = 0.f;
        for (int k = 0; k < 128; ++k) { s1 += lm[k] * lm[128 + k]; s2 += lm[256 + k] * lm[384 + k]; }
        const float lam_init = F.tid == 0 ? 0.35550906759096934f : 0.5560582041556406f;
        ((float*)(F.ws + WS_LAM))[F.tid] = expf(s1) - expf(s2) + lam_init;
    }
    {
        float* ssqp = (float*)(F.ws + WS_SSQP); bf16r* XS = (bf16r*)(F.ws + WS_XS);
        for (int m = gw; m < M; m += NGW) {
            const int b = m >> 13;
            const f32x4* xr = (const f32x4*)(((const float*)F.ka->in[0]) + (size_t)m * 1024) + F.lane;
            f32x4* orow = (f32x4*)(F.out + (size_t)m * 1024) + F.lane;
            v2u* xsr = (v2u*)(XS + (size_t)m * 1024) + F.lane;
            float ss = 0.f;
#pragma unroll
            for (int j = 0; j < 4; ++j) {
                const f32x4 v = xr[64 * j]; orow[64 * j] = v;
                ss += (v[0] * v[0] + v[1] * v[1]) + (v[2] * v[2] + v[3] * v[3]);
                const int col = 4 * F.lane + 256 * j;
                const f32x4 ng = *(const f32x4*)(((const float*)F.ka->in[5]) + col);
                const f32x4 sc = *(const f32x4*)(ADA + (size_t)b * 9216 + 1024 + col);
                const f32x4 y = v * ng * (sc + 1.0f);
                v2u w; w.x = pk2(y[0], y[1]); w.y = pk2(y[2], y[3]); xsr[64 * j] = w;
            }
            ss = wave_sum(ss);
            if (F.lane < 16) ssqp[(size_t)F.lane * M + m] = F.lane == 0 ? ss : 0.f;
        }
    }
    {
        float* SWF = (float*)(F.ws + WS_SWF); float* SWM = (float*)(F.ws + WS_SWM);
        constexpr int RF = 8 * 5632, RT = RF + 4 * 3072;
        for (int r = gw; r < RT; r += NGW) {
            const bf16r* wt; const float* sh; float* o; int ostride;
            if (r < RF) { const int q = r / 5632, n = r % 5632, l = q >> 1, f = q & 1;
                wt = (const bf16r*)(F.ws + WS_W13) + (size_t)r * 1024; sh = ADA + (size_t)l * 2 * 9216 + (f ? 2 : 0) * 3072; o = SWF + (size_t)q * 2 * 5632 + n; ostride = 5632; }
            else { const int rr = r - RF, l = rr / 3072, n = rr % 3072;
                wt = (const bf16r*)(F.ws + ((l & 1) ? WS_WINB : WS_WINA)) + ((size_t)(l >> 1) * 3072 + n) * 1024; sh = ADA + (size_t)l * 2 * 9216 + 3072; o = SWM + (size_t)l * 2 * 3072 + n; ostride = 3072; }
            const v4u w0 = *(const v4u*)(wt + F.lane * 16), w1 = *(const v4u*)(wt + F.lane * 16 + 8);
            float wv[16] = {bflo(w0.x), bfhi(w0.x), bflo(w0.y), bfhi(w0.y), bflo(w0.z), bfhi(w0.z), bflo(w0.w), bfhi(w0.w),
                            bflo(w1.x), bfhi(w1.x), bflo(w1.y), bfhi(w1.y), bflo(w1.z), bfhi(w1.z), bflo(w1.w), bfhi(w1.w)};
            float s0 = 0.f, s1 = 0.f;
#pragma unroll
            for (int j = 0; j < 4; ++j) {
                const f32x4 h0 = *(const f32x4*)(sh + F.lane * 16 + 4 * j), h1 = *(const f32x4*)(sh + 9216 + F.lane * 16 + 4 * j);
#pragma unroll
                for (int e = 0; e < 4; ++e) { s0 += wv[4 * j + e] * h0[e]; s1 += wv[4 * j + e] * h1[e]; }
            }
            s0 = wave_sum(s0); s1 = wave_sum(s1);
            if (F.lane == 0) { o[0] = s0; o[ostride] = s1; }
        }
    }
}
__device__ __forceinline__ void gates_phase(const Ctx& F, LAS unsigned char* lds, int l) {
    const int j = l >> 1;
    LAS float* wg = (LAS float*)lds;
    LAS float* swg = (LAS float*)(lds + 32768);
    const float* ADA = (const float*)(F.ws + WS_ADA); const float* ssqp = (const float*)(F.ws + WS_SSQP);
    const bf16r* XS = (const bf16r*)(F.ws + WS_XS); float* GT = (float*)(F.ws + WS_GATES);
    const float* src = ((const float*)F.ka->in[8]) + (size_t)j * 1024 * 3080 + 3072;
    for (int ch = F.wg; ch < 256; ch += F.G) {
        const int b = ch >> 7, m0 = ch * 64;
        for (int i = F.tid; i < 8192; i += 512) { const int k = i >> 3, g = i & 7; wg[g * 1024 + k] = src[(size_t)k * 3080 + g]; }
        __syncthreads();
        { const float* sh = ADA + (size_t)(l * 2 + b) * 9216 + 3072; float s = 0.f;
#pragma unroll
          for (int q = 0; q < 16; ++q) s += sh[q * 64 + F.lane] * wg[F.wave * 1024 + q * 64 + F.lane];
          s = wave_sum(s); if (F.lane == 0) swg[F.wave] = s; }
        __syncthreads();
        for (int i = 0; i < 8; ++i) {
            const int row = m0 + F.wave * 8 + i;
            float a[8] = {0.f, 0.f, 0.f, 0.f, 0.f, 0.f, 0.f, 0.f};
#pragma unroll
            for (int q = 0; q < 16; ++q) { const float xv = bf2f(XS[(size_t)row * 1024 + q * 64 + F.lane]);
#pragma unroll
                for (int g = 0; g < 8; ++g) a[g] += xv * wg[g * 1024 + q * 64 + F.lane]; }
            float ss = F.lane < 16 ? ssqp[(size_t)F.lane * M + row] : 0.f; ss = wave_sum(ss);
            const float rs = rsqrtf(ss * (1.0f / 1024.0f) + EPS);
#pragma unroll
            for (int g = 0; g < 8; ++g) { const float s = wave_sum(a[g]); if (F.lane == g) GT[(size_t)row * 8 + g] = s * rs + swg[g]; }
        }
        __syncthreads();
    }
}
__device__ __forceinline__ bf16x8 ldfrag(const LAS bf16r* base, int row0, int stride, int k0, int lane) {
    return *(const LAS bf16x8*)(base + (row0 + (lane & 15)) * stride + k0 + (lane >> 4) * 8);
}
__device__ __forceinline__ void conv8(const bf16r* P, size_t mrow, int ps, int ch0, const float* cw, const float* cb, float scale, float (&o)[8]) {
    float acc[8];
    { const f32x4 b0 = *(const f32x4*)(cb + ch0), b1 = *(const f32x4*)(cb + ch0 + 4); acc[0] = b0[0]; acc[1] = b0[1]; acc[2] = b0[2]; acc[3] = b0[3]; acc[4] = b1[0]; acc[5] = b1[1]; acc[6] = b1[2]; acc[7] = b1[3]; }
#pragma unroll
    for (int jt = 0; jt < 4; ++jt) {
        if (ps - 3 + jt >= 0) {
            const v4u w = *(const v4u*)(P + (mrow - 3 + jt) * 3072 + ch0);
            const f32x4 c0 = *(const f32x4*)(cw + jt * 1024 + ch0), c1 = *(const f32x4*)(cw + jt * 1024 + ch0 + 4);
            acc[0] += bflo(w.x) * c0[0]; acc[1] += bfhi(w.x) * c0[1]; acc[2] += bflo(w.y) * c0[2]; acc[3] += bfhi(w.y) * c0[3];
            acc[4] += bflo(w.z) * c1[0]; acc[5] += bfhi(w.z) * c1[1]; acc[6] += bflo(w.w) * c1[2]; acc[7] += bfhi(w.w) * c1[3];
        }
    }
#pragma unroll
    for (int e = 0; e < 8; ++e) o[e] = pg8::silu_f(acc[e]) * scale;
}
constexpr int VT_STRIDE = 72, QK_STRIDE = 136;
__device__ __forceinline__ void s1_phase(const Ctx& F, LAS unsigned char* lds, int l) {
    const int j = l >> 1;
    LAS bf16r* VT = (LAS bf16r*)lds;
    LAS bf16r* KT = (LAS bf16r*)(lds + 36864);
    LAS float* wS = (LAS float*)(lds + 36864 + 18432);
    const bf16r* P = (const bf16r*)(F.ws + WS_P); const float* GT = (const float*)(F.ws + WS_GATES);
    float* BCUM = (float*)(F.ws + WS_BCUM); float* LOGI = (float*)(F.ws + WS_LOGI); float* BLAST = (float*)(F.ws + WS_SCAL); float* MLOC = BLAST + 16384;
    float* NLOC = (float*)(F.ws + WS_NLOC); float* U = (float*)(F.ws + WS_U);
    const float* cw = ((const float*)F.ka->in[9]) + (size_t)j * 4096; const float* cb = ((const float*)F.ka->in[10]) + (size_t)j * 1024; const float* bif = ((const float*)F.ka->in[11]) + j * 8;
    for (int u = F.wg; u < 1024; u += F.G) {
        const int b = u >> 9, h = (u >> 7) & 3, c = u & 127, bh = b * 4 + h;
        const size_t m0 = (size_t)b * 8192 + c * 64;
        if (F.wave == 0) {
            const int s = F.lane;
            const float gi = GT[(m0 + s) * 8 + h] + bif[h], gf = GT[(m0 + s) * 8 + 4 + h] + bif[4 + h];
            const float lf = fminf(gf, 0.f) - log1pf(expf(-fabsf(gf)));
            float bc = lf;
#pragma unroll
            for (int o = 1; o < 64; o <<= 1) { const float t = lane_up(bc, s, o); if (s >= o) bc += t; }
            const float blast = __builtin_bit_cast(float, __builtin_amdgcn_readlane(__builtin_bit_cast(int, bc), 63));
            const float wl = blast - bc + gi;
            const float mloc = wave_max(wl);
            wS[s] = expf(wl - mloc);
            BCUM[(size_t)bh * 8192 + c * 64 + s] = bc; LOGI[(size_t)bh * 8192 + c * 64 + s] = gi;
            if (s == 0) { BLAST[bh * 128 + c] = blast; MLOC[bh * 128 + c] = mloc; }
        }
        __syncthreads();
        for (int t = F.tid; t < 1024; t += 512) {
            const int cg = t & 15, s = t >> 4; float kv[8];
            conv8(P, m0 + s, c * 64 + s, 512 + h * 128 + cg * 8, cw, cb, 0.08838834764831845f, kv);
            const float w = wS[s];
#pragma unroll
            for (int e = 0; e < 8; ++e) KT[(cg * 8 + e) * VT_STRIDE + s] = (bf16r)f2bf(kv[e] * w);
        }
        for (int t = F.tid; t < 2048; t += 512) {
            const int vg = t & 31, s = t >> 5;
            const v4u w = *(const v4u*)(P + (m0 + s) * 3072 + 1024 + h * 256 + vg * 8);
            LAS bf16r* d = VT + (vg * 8) * VT_STRIDE + s;
            d[0] = (bf16r)(w.x & 0xffffu); d[VT_STRIDE] = (bf16r)(w.x >> 16); d[2 * VT_STRIDE] = (bf16r)(w.y & 0xffffu); d[3 * VT_STRIDE] = (bf16r)(w.y >> 16);
            d[4 * VT_STRIDE] = (bf16r)(w.z & 0xffffu); d[5 * VT_STRIDE] = (bf16r)(w.z >> 16); d[6 * VT_STRIDE] = (bf16r)(w.w & 0xffffu); d[7 * VT_STRIDE] = (bf16r)(w.w >> 16);
        }
        __syncthreads();
        { const int d = F.tid >> 2, q4 = F.tid & 3; float s = 0.f;
#pragma unroll
          for (int e = 0; e < 16; ++e) s += bf2f(KT[d * VT_STRIDE + q4 * 16 + e]);
          s += swz_xor<1>(s); s += swz_xor<2>(s);
          if (q4 == 0) NLOC[(size_t)u * 128 + d] = s; }
        {
            f32x4 acc[2][8];
#pragma unroll
            for (int mt = 0; mt < 2; ++mt)
#pragma unroll
                for (int nt = 0; nt < 8; ++nt) acc[mt][nt] = (f32x4){0.f, 0.f, 0.f, 0.f};
#pragma unroll
            for (int ks = 0; ks < 2; ++ks) {
                bf16x8 av[2];
#pragma unroll
                for (int mt = 0; mt < 2; ++mt) av[mt] = ldfrag(VT, 32 * F.wave + 16 * mt, VT_STRIDE, ks * 32, F.lane);
#pragma unroll
                for (int nt = 0; nt < 8; ++nt) { const bf16x8 bk = ldfrag(KT, 16 * nt, VT_STRIDE, ks * 32, F.lane);
#pragma unroll
                    for (int mt = 0; mt < 2; ++mt) acc[mt][nt] = __builtin_amdgcn_mfma_f32_16x16x32_bf16(bk, av[mt], acc[mt][nt], 0, 0, 0); }
            }
            float* up = U + (size_t)u * 32768;
#pragma unroll
            for (int mt = 0; mt < 2; ++mt)
#pragma unroll
                for (int nt = 0; nt < 8; ++nt) *(f32x4*)(up + (size_t)(32 * F.wave + 16 * mt + (F.lane & 15)) * 128 + 16 * nt + 4 * (F.lane >> 4)) = acc[mt][nt];
        }
        __syncthreads();
    }
}
__device__ __forceinline__ void s2_phase(const Ctx& F) {
    const float* BLAST = (const float*)(F.ws + WS_SCAL); const float* MLOC = BLAST + 16384; float* MST = (float*)(F.ws + WS_SCAL) + 32768;
    const float* U = (const float*)(F.ws + WS_U); const float* NLOC = (const float*)(F.ws + WS_NLOC); float* NST = (float*)(F.ws + WS_NST); bf16r* CST = (bf16r*)(F.ws + WS_CST);
    constexpr int QPB = 8192 + 32;
    for (int q = F.wg * 512 + F.tid; q < 8 * QPB; q += F.G * 512) {
        const int bh = q / QPB, e = q % QPB; const bool isn = e >= 8192;
        f32x4 S = {0.f, 0.f, 0.f, 0.f}; float m = 0.f;
        for (int c0 = 0; c0 < 128; c0 += 8) {
            f32x4 uv[8];
#pragma unroll
            for (int i = 0; i < 8; ++i) { const size_t unit = (size_t)bh * 128 + c0 + i;
                uv[i] = isn ? *(const f32x4*)(NLOC + unit * 128 + (e - 8192) * 4) : *(const f32x4*)(U + unit * 32768 + (size_t)e * 4); }
#pragma unroll
            for (int i = 0; i < 8; ++i) { const int c = c0 + i; const size_t unit = (size_t)bh * 128 + c;
                if (isn) *(f32x4*)(NST + unit * 128 + (e - 8192) * 4) = S;
                else { v2u w; w.x = pk2(S[0], S[1]); w.y = pk2(S[2], S[3]); *(v2u*)(CST + unit * 32768 + (size_t)e * 4) = w; }
                if (e == 0) MST[unit] = m;
                const float bl = BLAST[unit], ml = MLOC[unit];
                const float mn = fmaxf(bl + m, ml);
                const float dec = expf(bl + m - mn), gain = expf(ml - mn);
                S = S * dec + uv[i] * gain; m = mn; }
        }
    }
}
__device__ __forceinline__ void s3_phase(const Ctx& F, LAS unsigned char* lds, int l) {
    const int j = l >> 1;
    LAS bf16r* VT = (LAS bf16r*)lds;
    LAS bf16r* Qs = (LAS bf16r*)(lds + 36864);
    LAS bf16r* Ks = (LAS bf16r*)(lds + 36864 + 17408);
    LAS bf16r* Sw = (LAS bf16r*)(lds + 36864 + 34816);
    LAS float* fa = (LAS float*)(lds + 36864 + 34816 + 9216);
    LAS float* bS = fa, *zS = fa + 64, *mtS = fa + 128, *inS = fa + 192, *dnS = fa + 256, *nS = fa + 320  , *sqS = fa + 448  ;
    const bf16r* P = (const bf16r*)(F.ws + WS_P);
    const float* BCUM = (const float*)(F.ws + WS_BCUM); const float* LOGI = (const float*)(F.ws + WS_LOGI); const float* MST = (const float*)(F.ws + WS_SCAL) + 32768;
    const float* NST = (const float*)(F.ws + WS_NST); const bf16r* CST = (const bf16r*)(F.ws + WS_CST); bf16r* Y = (bf16r*)(F.ws + WS_Y);
    const float* cw = ((const float*)F.ka->in[9]) + (size_t)j * 4096; const float* cb = ((const float*)F.ka->in[10]) + (size_t)j * 1024; const float* ng = ((const float*)F.ka->in[12]) + (size_t)j * 1024;
    const int lane = F.lane, w = F.wave, fr = lane & 15, fq = lane >> 4;
    for (int u = F.wg; u < 1024; u += F.G) {
        const int b = u >> 9, h = (u >> 7) & 3, c = u & 127, bh = b * 4 + h;
        const size_t m0 = (size_t)b * 8192 + c * 64;
        bf16x8 cf[2][4];
#pragma unroll
        for (int nt = 0; nt < 2; ++nt)
#pragma unroll
            for (int ks = 0; ks < 4; ++ks) cf[nt][ks] = *(const bf16x8*)(CST + (size_t)u * 32768 + (size_t)(32 * w + 16 * nt + fr) * 128 + ks * 32 + fq * 8);
        if (w == 0) {
            const int s = lane;
            const float bs = BCUM[(size_t)bh * 8192 + c * 64 + s], li = LOGI[(size_t)bh * 8192 + c * 64 + s], mc = MST[bh * 128 + c];
            const float a = bs + mc, z = li - bs;
            float pm = z;
#pragma unroll
            for (int o = 1; o < 64; o <<= 1) { const float t = lane_up(pm, s, o); if (s >= o) pm = fmaxf(pm, t); }
            const float mt = fmaxf(a, bs + pm);
            bS[s] = bs; zS[s] = z; mtS[s] = mt; inS[s] = expf(a - mt);
        } else if (w <= 2) { const int d = (w - 1) * 64 + lane; nS[d] = NST[(size_t)u * 128 + d]; }
        for (int t = F.tid; t < 2048; t += 512) {
            const int cg = t & 15, s = (t >> 4) & 63, isk = t >> 10; float kv[8];
            conv8(P, m0 + s, c * 64 + s, isk * 512 + h * 128 + cg * 8, cw, cb, isk ? 0.08838834764831845f : 1.0f, kv);
            v4u o; o.x = pk2(kv[0], kv[1]); o.y = pk2(kv[2], kv[3]); o.z = pk2(kv[4], kv[5]); o.w = pk2(kv[6], kv[7]);
            *(LAS v4u*)((isk ? Ks : Qs) + s * QK_STRIDE + cg * 8) = o;
        }
        for (int t = F.tid; t < 2048; t += 512) {
            const int vg = t & 31, s = t >> 5;
            const v4u wv = *(const v4u*)(P + (m0 + s) * 3072 + 1024 + h * 256 + vg * 8);
            LAS bf16r* d = VT + (vg * 8) * VT_STRIDE + s;
            d[0] = (bf16r)(wv.x & 0xffffu); d[VT_STRIDE] = (bf16r)(wv.x >> 16); d[2 * VT_STRIDE] = (bf16r)(wv.y & 0xffffu); d[3 * VT_STRIDE] = (bf16r)(wv.y >> 16);
            d[4 * VT_STRIDE] = (bf16r)(wv.z & 0xffffu); d[5 * VT_STRIDE] = (bf16r)(wv.z >> 16); d[6 * VT_STRIDE] = (bf16r)(wv.w & 0xffffu); d[7 * VT_STRIDE] = (bf16r)(wv.w >> 16);
        }
        __syncthreads();
        {
            const int tt = w >> 1;
            const int t = 16 * tt + fr; const float bt = bS[t], mt = mtS[t];
#pragma unroll
            for (int i = 0; i < 2; ++i) {
                const int st = 2 * (w & 1) + i;
                f32x4 acc = {0.f, 0.f, 0.f, 0.f};
                if (st <= tt) {
#pragma unroll
                    for (int ks = 0; ks < 4; ++ks) acc = __builtin_amdgcn_mfma_f32_16x16x32_bf16(ldfrag(Ks, 16 * st, QK_STRIDE, ks * 32, lane), ldfrag(Qs, 16 * tt, QK_STRIDE, ks * 32, lane), acc, 0, 0, 0);
                }
                float o[4];
#pragma unroll
                for (int e = 0; e < 4; ++e) { const int s = 16 * st + 4 * fq + e; o[e] = (s <= t) ? acc[e] * expf(bt + zS[s] - mt) : 0.f; }
                v2u pw; pw.x = pk2(o[0], o[1]); pw.y = pk2(o[2], o[3]);
                *(LAS v2u*)(Sw + t * VT_STRIDE + 16 * st + 4 * fq) = pw;
            }
        }
        __syncthreads();
        { const int t = F.tid >> 3, part = F.tid & 7; float rsum = 0.f, qn = 0.f;
#pragma unroll
          for (int e = 0; e < 8; ++e) rsum += bf2f(Sw[t * VT_STRIDE + part * 8 + e]);
#pragma unroll
          for (int e = 0; e < 16; ++e) qn += bf2f(Qs[t * QK_STRIDE + part * 16 + e]) * nS[part * 16 + e];
          rsum += swz_xor<1>(rsum); rsum += swz_xor<2>(rsum); rsum += swz_xor<4>(rsum);
          qn += swz_xor<1>(qn); qn += swz_xor<2>(qn); qn += swz_xor<4>(qn);
          if (part == 0) { const float den = inS[t] * qn + rsum; dnS[t] = 1.0f / fmaxf(fabsf(den), expf(-mtS[t])); } }
        f32x4 a1[4][2], a2[4][2];
#pragma unroll
        for (int mt = 0; mt < 4; ++mt)
#pragma unroll
            for (int nt = 0; nt < 2; ++nt) { a1[mt][nt] = (f32x4){0.f, 0.f, 0.f, 0.f}; a2[mt][nt] = (f32x4){0.f, 0.f, 0.f, 0.f}; }
#pragma unroll
        for (int ks = 0; ks < 4; ++ks)
#pragma unroll
            for (int mt = 0; mt < 4; ++mt) { const bf16x8 qf = ldfrag(Qs, 16 * mt, QK_STRIDE, ks * 32, lane);
#pragma unroll
                for (int nt = 0; nt < 2; ++nt) a1[mt][nt] = __builtin_amdgcn_mfma_f32_16x16x32_bf16(cf[nt][ks], qf, a1[mt][nt], 0, 0, 0); }
#pragma unroll
        for (int ks = 0; ks < 2; ++ks) {
            bf16x8 vf[2];
#pragma unroll
            for (int nt = 0; nt < 2; ++nt) vf[nt] = ldfrag(VT, 32 * w + 16 * nt, VT_STRIDE, ks * 32, lane);
#pragma unroll
            for (int mt = 0; mt < 4; ++mt) { const bf16x8 sf = ldfrag(Sw, 16 * mt, VT_STRIDE, ks * 32, lane);
#pragma unroll
                for (int nt = 0; nt < 2; ++nt) a2[mt][nt] = __builtin_amdgcn_mfma_f32_16x16x32_bf16(vf[nt], sf, a2[mt][nt], 0, 0, 0); }
        }
        __syncthreads();
#pragma unroll
        for (int mt = 0; mt < 4; ++mt) {
            const int t = 16 * mt + fr; const float it = inS[t], dn = dnS[t]; float ss = 0.f;
#pragma unroll
            for (int nt = 0; nt < 2; ++nt) { a1[mt][nt] = (a1[mt][nt] * it + a2[mt][nt]) * dn;
                ss += (a1[mt][nt][0] * a1[mt][nt][0] + a1[mt][nt][1] * a1[mt][nt][1]) + (a1[mt][nt][2] * a1[mt][nt][2] + a1[mt][nt][3] * a1[mt][nt][3]); }
            ss += swz_xor<16>(ss); ss = sum_x32(ss);
            if (fq == 0) sqS[w * 64 + t] = ss;
        }
        __syncthreads();
#pragma unroll
        for (int mt = 0; mt < 4; ++mt) {
            const int t = 16 * mt + fr; float tot = 0.f;
#pragma unroll
            for (int ww = 0; ww < 8; ++ww) tot += sqS[ww * 64 + t];
            const float r = rsqrtf(tot * (1.0f / 256.0f) + EPS);
#pragma unroll
            for (int nt = 0; nt < 2; ++nt) {
                const int vv = 32 * w + 16 * nt + 4 * fq;
                const v2u ow = *(const v2u*)(P + (m0 + t) * 3072 + 2048 + h * 256 + vv);
                const f32x4 g = *(const f32x4*)(ng + h * 256 + vv);
                const float o0 = bflo(ow.x), o1 = bfhi(ow.x), o2 = bflo(ow.y), o3 = bfhi(ow.y);
                const f32x4 hv = a1[mt][nt] * r * g;
                v2u yw; yw.x = pk2(hv[0] * __builtin_amdgcn_rcpf(1.0f + __expf(-o0)), hv[1] * __builtin_amdgcn_rcpf(1.0f + __expf(-o1)));
                yw.y = pk2(hv[2] * __builtin_amdgcn_rcpf(1.0f + __expf(-o2)), hv[3] * __builtin_amdgcn_rcpf(1.0f + __expf(-o3)));
                *(v2u*)(Y + (m0 + t) * 1024 + h * 256 + vv) = yw;
            }
        }
        __syncthreads();
    }
}
__device__ __forceinline__ att::BlockRef<att::bf16, att::bf16> attn_ref(int L, int pass, const att::bf16* Qb, const att::bf16* Kb, const att::bf16* Vb, att::bf16* Ob) {
    const int hd = L >> 4, y = L & 15, qb = pass ? 31 - y : y;
    const int b = hd >> 4, h = (hd >> 2) & 3, c = (hd >> 1) & 1, vh = hd & 1;
    att::BlockRef<att::bf16, att::bf16> r;
    r.Q = Qb + ((size_t)(b * 8 + h * 2 + c) * 8192 + (size_t)qb * 256) * 128;
    r.K = Kb + (size_t)(b * 8 + h * 2 + c) * 8192 * 128;
    r.V = Vb + (size_t)(b * 8 + h * 2 + vh) * 8192 * 128;
    r.O = Ob + ((size_t)hd * 8192 + (size_t)qb * 256) * 128;
    r.P0 = qb * 256;
    return r;
}
__device__ __forceinline__ void attn_phase(const Ctx& F, char* lds) {
    const att::bf16* Qb = (const att::bf16*)(F.ws + WS_P); const att::bf16* Kb = Qb + 16777216; const att::bf16* Vb = Kb + 16777216; att::bf16* Ob = (att::bf16*)(F.ws + WS_O);
    constexpr int total = 512; const int stride = F.G;
    int L = F.wg; if (L >= total) return;
    int pass = 0;
    att::BlockRef<att::bf16, att::bf16> cur = attn_ref(L, 0, Qb, Kb, Vb, Ob);
    att::Seam<att::bf16> S;
    att::causal_swa_prime<att::bf16, att::bf16>(cur, 8192, lds, S, F.tid);
    for (;;) {
        const bool more_pass = pass == 0, more_item = L + stride < total, last = !more_pass && !more_item;
        int passn = pass + 1, Ln = L;
        if (!more_pass) { passn = 0; Ln = more_item ? L + stride : L; }
        const att::BlockRef<att::bf16, att::bf16> nxt = last ? cur : attn_ref(Ln, passn, Qb, Kb, Vb, Ob);
        att::causal_swa_block<att::bf16, att::bf16>(cur, nxt, 8192, 8192, lds, S, F.tid);
        if (last) break;
        cur = nxt; pass = passn; L = Ln;
    }
}
__device__ __forceinline__ void combine_phase(const Ctx& F, int l) {
    const int j = l >> 1;
    const bf16r* Ob = (const bf16r*)(F.ws + WS_O); bf16r* Y = (bf16r*)(F.ws + WS_Y);
    const float lam = ((const float*)(F.ws + WS_LAM))[j];
    const float omi = 1.0f - (j == 0 ? 0.35550906759096934f : 0.5560582041556406f);
    const float* ng = ((const float*)F.ka->in[16]) + j * 256;
    const int gw = F.wg * NWAVES + F.wave, NGW = F.G * NWAVES;
    const int vv = F.lane * 4, vh = vv >> 7, dd = vv & 127;
    const f32x4 g = *(const f32x4*)(ng + vv);
    for (int task = gw; task < M * 4; task += NGW) {
        const int m = task >> 2, h = task & 3, b = m >> 13, s = m & 8191;
        const int hd0 = ((b * 4 + h) * 2 + 0) * 2 + vh, hd1 = hd0 + 2;
        const v2u w0 = *(const v2u*)(Ob + ((size_t)hd0 * 8192 + s) * 128 + dd), w1 = *(const v2u*)(Ob + ((size_t)hd1 * 8192 + s) * 128 + dd);
        f32x4 o = {bflo(w0.x) - lam * bflo(w1.x), bfhi(w0.x) - lam * bfhi(w1.x), bflo(w0.y) - lam * bflo(w1.y), bfhi(w0.y) - lam * bfhi(w1.y)};
        const float ss = wave_sum((o[0] * o[0] + o[1] * o[1]) + (o[2] * o[2] + o[3] * o[3]));
        const float r = rsqrtf(ss * (1.0f / 256.0f) + EPS) * omi;
        o = o * r * g;
        v2u yw; yw.x = pk2(o[0], o[1]); yw.y = pk2(o[2], o[3]);
        *(v2u*)(Y + (size_t)m * 1024 + h * 256 + vv) = yw;
    }
}
__device__ __forceinline__ void final_phase(const Ctx& F) {
    const float* ssqp = (const float*)(F.ws + WS_SSQP);
    const int gw = F.wg * NWAVES + F.wave, NGW = F.G * NWAVES;
    for (int m = gw; m < M; m += NGW) {
        float ss = F.lane < 16 ? ssqp[(size_t)F.lane * M + m] : 0.f; ss = wave_sum(ss);
        const float rs = rsqrtf(ss * (1.0f / 1024.0f) + EPS);
        f32x4* orow = (f32x4*)(F.out + (size_t)m * 1024) + F.lane;
#pragma unroll
        for (int jj = 0; jj < 4; ++jj) { const f32x4 g = *(const f32x4*)(((const float*)F.ka->in[18]) + 4 * F.lane + 256 * jj); orow[64 * jj] = orow[64 * jj] * rs * g; }
    }
}

#if MK_DEBUG
#ifndef DBG_SET
#define DBG_SET 0
#endif
__device__ __forceinline__ void dbg_flag(const Ctx& F, bool bad, unsigned code) {
    int bit = -1;
    switch (code) { case 30: bit = 0; break; case 8: case 31: case 9: bit = 1; break; case 10: bit = 2; break; case 11: bit = 3; break; case 13: case 14: case 15: bit = 4; break;
                    case 16: case 17: bit = 5; break; case 18: bit = 6; break; case 19: bit = 7; break; case 20: bit = 8; break; case 21: bit = 9; break; case 23: bit = 10; break; default: break; }
    if (bad && bit >= 0) atomicOr((unsigned*)(F.ws + 64), 1u << bit);
}
__device__ __forceinline__ bool dbg_ne(float got, float ref) { return !(fabsf(got - ref) <= 0.03f * fabsf(ref) + 0.03f); }
__device__ __forceinline__ unsigned dbg_hash(unsigned i) { i = i * 2654435761u + 12345u; i ^= i >> 15; i *= 2246822519u; i ^= i >> 13; i *= 3266489917u; i ^= i >> 16; return i; }
__device__ __forceinline__ float dbg_rstd(const Ctx& F, int m) { const float* ssqp = (const float*)(F.ws + WS_SSQP); float s = 0.f; for (int p = 0; p < 16; ++p) s += ssqp[(size_t)p * M + m]; return rsqrtf(s * (1.0f / 1024.0f) + EPS); }
__device__ __forceinline__ float dbg_silu(float g) { return g / (1.0f + expf(-g)); }
__device__ __forceinline__ void dbg_check_p0(const Ctx& F) {
    if (F.wg != 0) return;
    const unsigned r = dbg_hash(F.tid);
    const float* ADA = (const float*)(F.ws + WS_ADA);
    { const float t = wave_sum((float)(F.lane + 1)), t2 = wave_max((float)((F.lane * 37) & 63)); dbg_flag(F, t != 2080.0f || t2 != 63.0f, 30); }
    { const int l = r % 4, b = (r >> 2) & 1, j = (r >> 3) % 9216; float ref = ((const float*)F.ka->in[4])[(size_t)l * 9216 + j];
      for (int k = 0; k < 1024; ++k) ref += dbg_silu(((const float*)F.ka->in[1])[b * 1024 + k]) * ((const float*)F.ka->in[3])[((size_t)l * 1024 + k) * 9216 + j];
      dbg_flag(F, dbg_ne(ADA[(size_t)(l * 2 + b) * 9216 + j], ref), 1); }
    { const int mat = r % 8, k = (r >> 3) % 1024, n = (r >> 13) % 5632; const float src = ((const float*)F.ka->in[6])[((size_t)mat * 1024 + k) * 5632 + n];
      const int drow = n < 2816 ? (n >> 7) * 256 + (n & 127) : ((n - 2816) >> 7) * 256 + 128 + ((n - 2816) & 127);
      dbg_flag(F, dbg_ne(bf2f(((const bf16r*)(F.ws + WS_W13))[((size_t)mat * 5632 + drow) * 1024 + k]), src), 2); }
    { const int mat = r % 8, k = (r >> 3) % 2816, n = (r >> 15) % 1024; const float src = ((const float*)F.ka->in[7])[((size_t)mat * 2816 + k) * 1024 + n];
      dbg_flag(F, dbg_ne(bf2f(((const bf16r*)(F.ws + WS_W2))[((size_t)mat * 1024 + n) * 2816 + k]), src), 3); }
    { const int mat = r % 2, k = (r >> 1) % 1024, n = (r >> 11) % 3072; const float src = ((const float*)F.ka->in[8])[((size_t)mat * 1024 + k) * 3080 + n];
      dbg_flag(F, dbg_ne(bf2f(((const bf16r*)(F.ws + WS_WINA))[((size_t)mat * 3072 + n) * 1024 + k]), src), 4); }
    { const int mat = r % 2, k = (r >> 1) % 1024, n = (r >> 11) % 3072; const float src = ((const float*)F.ka->in[14])[((size_t)mat * 1024 + k) * 3072 + n];
      dbg_flag(F, dbg_ne(bf2f(((const bf16r*)(F.ws + WS_WINB))[((size_t)mat * 3072 + n) * 1024 + k]), src), 5); }
    { const int mat = r % 2, k = (r >> 1) % 1024, n = (r >> 11) % 1024; const float sa = ((const float*)F.ka->in[13])[((size_t)mat * 1024 + k) * 1024 + n], sb = ((const float*)F.ka->in[17])[((size_t)mat * 1024 + k) * 1024 + n];
      dbg_flag(F, dbg_ne(bf2f(((const bf16r*)(F.ws + WS_WOA))[((size_t)mat * 1024 + n) * 1024 + k]), sa) || dbg_ne(bf2f(((const bf16r*)(F.ws + WS_WOB))[((size_t)mat * 1024 + n) * 1024 + k]), sb), 6); }
}
__device__ __forceinline__ void dbg_check_p1(const Ctx& F) {
    if (F.wg != 0) return;
    const unsigned r = dbg_hash(F.tid + 1000);
    const float* ADA = (const float*)(F.ws + WS_ADA);
    { const int m = r % 16384, col = (r >> 14) % 1024, b = m >> 13;
      const float ref = ((const float*)F.ka->in[0])[(size_t)m * 1024 + col] * ((const float*)F.ka->in[5])[col] * (1.0f + ADA[(size_t)b * 9216 + 1024 + col]);
      dbg_flag(F, dbg_ne(bf2f(((const bf16r*)(F.ws + WS_XS))[(size_t)m * 1024 + col]), ref) || dbg_ne(F.out[(size_t)m * 1024 + col], ((const float*)F.ka->in[0])[(size_t)m * 1024 + col]), 7); }
    { const int q = r % 8, b = (r >> 3) & 1, n = (r >> 4) % 5632, l = q >> 1, f = q & 1; float ref = 0.f;
      for (int k = 0; k < 1024; ++k) ref += ADA[(size_t)(l * 2 + b) * 9216 + (f ? 2 : 0) * 3072 + k] * bf2f(((const bf16r*)(F.ws + WS_W13))[((size_t)q * 5632 + n) * 1024 + k]);
      dbg_flag(F, dbg_ne(((const float*)(F.ws + WS_SWF))[(size_t)(q * 2 + b) * 5632 + n], ref), b ? 31 : 8); }
    { const int l = r % 4, b = (r >> 2) & 1, n = (r >> 3) % 3072; const bf16r* W = (const bf16r*)(F.ws + ((l & 1) ? WS_WINB : WS_WINA)) + ((size_t)(l >> 1) * 3072 + n) * 1024; float ref = 0.f;
      for (int k = 0; k < 1024; ++k) ref += ADA[(size_t)(l * 2 + b) * 9216 + 3072 + k] * bf2f(W[k]);
      dbg_flag(F, dbg_ne(((const float*)(F.ws + WS_SWM))[(size_t)(l * 2 + b) * 3072 + n], ref), 9); }
    { const int m = r % 16384; float s = 0.f; for (int k = 0; k < 1024; ++k) { const float v = ((const float*)F.ka->in[0])[(size_t)m * 1024 + k]; s += v * v; }
      const float rs = rsqrtf(s * (1.0f / 1024.0f) + EPS); dbg_flag(F, fabsf(dbg_rstd(F, m) - rs) > 1e-3f * rs, 10); }
}
__device__ __forceinline__ void dbg_check_up(const Ctx& F) {
    if (F.wg != 0) return;
    const unsigned r = dbg_hash(F.tid + 2000);
    const int m = r % 16384, n = (r >> 14) % 2816, b = m >> 13, grow = (n >> 7) * 256 + (n & 127), urow = grow + 128;
    const float rs = dbg_rstd(F, m); const bf16r* XS = (const bf16r*)(F.ws + WS_XS) + (size_t)m * 1024; const bf16r* W = (const bf16r*)(F.ws + WS_W13);
    float g = 0.f, u = 0.f;
    for (int k = 0; k < 1024; ++k) { const float xv = bf2f(XS[k]); g += xv * bf2f(W[(size_t)grow * 1024 + k]); u += xv * bf2f(W[(size_t)urow * 1024 + k]); }
    const float* SWF = (const float*)(F.ws + WS_SWF) + (size_t)b * 5632;
    g = g * rs + SWF[grow]; u = u * rs + SWF[urow];
    dbg_flag(F, dbg_ne(bf2f(((const bf16r*)(F.ws + WS_H))[(size_t)m * 2816 + n]), dbg_silu(g) * u), 11);
}
__device__ __forceinline__ void dbg_check_down(const Ctx& F) {
    if (F.wg != 0) return;
    const unsigned r = dbg_hash(F.tid + 3000);
    const int m = r % 16384, n = (r >> 14) % 1024, b = m >> 13;
    const bf16r* H = (const bf16r*)(F.ws + WS_H) + (size_t)m * 2816; const bf16r* W = (const bf16r*)(F.ws + WS_W2) + (size_t)n * 2816;
    float d = 0.f; for (int k = 0; k < 2816; ++k) d += bf2f(H[k]) * bf2f(W[k]);
    const float* ADA = (const float*)(F.ws + WS_ADA);
    const float ref = ((const float*)F.ka->in[0])[(size_t)m * 1024 + n] + 0.5f * ADA[(size_t)b * 9216 + 2048 + n] * d, got = F.out[(size_t)m * 1024 + n];
    dbg_flag(F, dbg_ne(got, ref), 13);
    dbg_flag(F, dbg_ne(bf2f(((const bf16r*)(F.ws + WS_XS))[(size_t)m * 1024 + n]), got * ((const float*)(F.ws + WS_GS))[(size_t)(0 * 3 + 1) * 2048 + b * 1024 + n]), 14);
    float s = 0.f; for (int k = 0; k < 1024; ++k) { const float v = F.out[(size_t)m * 1024 + k]; s += v * v; }
    const float rs = rsqrtf(s * (1.0f / 1024.0f) + EPS); dbg_flag(F, fabsf(dbg_rstd(F, m) - rs) > 1e-3f * rs, 15);
}
__device__ __forceinline__ float dbg_inproj(const Ctx& F, int l, int m, int n) {
    const int b = m >> 13; const float rs = dbg_rstd(F, m);
    const bf16r* XS = (const bf16r*)(F.ws + WS_XS) + (size_t)m * 1024; const bf16r* W = (const bf16r*)(F.ws + ((l & 1) ? WS_WINB : WS_WINA)) + ((size_t)(l >> 1) * 3072 + n) * 1024;
    float a = 0.f; for (int k = 0; k < 1024; ++k) a += bf2f(XS[k]) * bf2f(W[k]);
    return a * rs + ((const float*)(F.ws + WS_SWM))[(size_t)(l * 2 + b) * 3072 + n];
}
__device__ __forceinline__ void dbg_check_inproj0(const Ctx& F) {
    if (F.wg != 0) return;
    const unsigned r = dbg_hash(F.tid + 4000);
    const int m = r % 16384, n = (r >> 14) % 3072, b = m >> 13;
    dbg_flag(F, dbg_ne(bf2f(((const bf16r*)(F.ws + WS_P))[(size_t)m * 3072 + n]), dbg_inproj(F, 0, m, n)), 16);
    const int g = n & 7; const float rs = dbg_rstd(F, m); const bf16r* XS = (const bf16r*)(F.ws + WS_XS) + (size_t)m * 1024; const float* ADA = (const float*)(F.ws + WS_ADA);
    float a = 0.f, sgw = 0.f; for (int k = 0; k < 1024; ++k) { const float w = ((const float*)F.ka->in[8])[(size_t)k * 3080 + 3072 + g]; a += bf2f(XS[k]) * w; sgw += ADA[(size_t)b * 9216 + 3072 + k] * w; }
    dbg_flag(F, dbg_ne(((const float*)(F.ws + WS_GATES))[(size_t)m * 8 + g], a * rs + sgw), 17);
}
__device__ __forceinline__ void dbg_check_inproj1(const Ctx& F) {
    if (F.wg != 0) return;
    const unsigned r = dbg_hash(F.tid + 5000);
    const int m = r % 16384, n = (r >> 14) % 3072, b = m >> 13, s = m & 8191, blk = n >> 7, d = n & 127, which = blk >> 3, idx = blk & 7;
    float ref = dbg_inproj(F, 1, m, n);
    if (which < 2 && d < 32) {
        const int fi = d & 15; const float other = dbg_inproj(F, 1, m, d < 16 ? n + 16 : n - 16);
        const float a = (float)((const int*)F.ka->in[2])[m] * pg8::ROPE_INVF[fi];
        const float kk = rintf(a * 0.15915494309189535f); float rr = fmaf(-kk, 6.2831854820251465f, a); rr = fmaf(-kk, -1.7484555314695172e-07f, rr);
        const float c = __cosf(rr), sn = __sinf(rr);
        ref = d < 16 ? ref * c - other * sn : ref * c + other * sn;
    }
    dbg_flag(F, dbg_ne(bf2f(((const bf16r*)(F.ws + WS_P))[(size_t)which * 16777216 + ((size_t)(b * 8 + idx) * 8192 + s) * 128 + d]), ref), 20);
}
__device__ __forceinline__ void dbg_check_mlstm(const Ctx& F, LAS unsigned char* lds) {
    if (F.wg != 0) return;
    LAS float* C = (LAS float*)lds;
    LAS float* qs = C + 32768, *ks = qs + 128, *vs = ks + 128, *nn = vs + 256, *hv = nn + 128, *red = hv + 256;
    const int h = 1, tid = F.tid;
    const bf16r* P = (const bf16r*)(F.ws + WS_P); const float* GT = (const float*)(F.ws + WS_GATES); const bf16r* Y = (const bf16r*)(F.ws + WS_Y);
    const float* cw = (const float*)F.ka->in[9]; const float* cb = (const float*)F.ka->in[10]; const float* bif = (const float*)F.ka->in[11]; const float* ng = (const float*)F.ka->in[12];
    for (int i = tid; i < 32768; i += 512) C[i] = 0.f;
    if (tid < 128) nn[tid] = 0.f;
    float mstate = 0.f;
    __syncthreads();
    for (int t = 0; t < 160; ++t) {
        if (tid < 256) { const int isk = tid >> 7, d = tid & 127, ch = isk * 512 + h * 128 + d; float a = cb[ch];
            for (int jt = 0; jt < 4; ++jt) if (t - 3 + jt >= 0) a += cw[jt * 1024 + ch] * bf2f(P[(size_t)(t - 3 + jt) * 3072 + ch]);
            a = dbg_silu(a); if (isk) ks[d] = a * 0.08838834764831845f; else qs[d] = a; }
        else { const int v = tid - 256; vs[v] = bf2f(P[(size_t)t * 3072 + 1024 + h * 256 + v]); }
        __syncthreads();
        const float li = GT[(size_t)t * 8 + h] + bif[h], gf = GT[(size_t)t * 8 + 4 + h] + bif[4 + h];
        const float lf = fminf(gf, 0.f) - log1pf(expf(-fabsf(gf)));
        const float mn = fmaxf(lf + mstate, li), fd = expf(lf + mstate - mn), ig = expf(li - mn);
        for (int i = tid; i < 32768; i += 512) { const int v = i >> 7, d = i & 127; C[i] = fd * C[i] + ig * vs[v] * ks[d]; }
        if (tid < 128) nn[tid] = fd * nn[tid] + ig * ks[tid];
        mstate = mn;
        __syncthreads();
        float den = 0.f; for (int d = 0; d < 128; ++d) den += nn[d] * qs[d];
        const float dn = 1.0f / fmaxf(fabsf(den), expf(-mn));
        { const int v = tid >> 1, half = tid & 1; float a = 0.f; for (int d = 0; d < 64; ++d) a += C[v * 128 + half * 64 + d] * qs[half * 64 + d];
          a += swz_xor<1>(a); if (half == 0) hv[v] = a * dn; }
        __syncthreads();
        float ss = 0.f; for (int v = 0; v < 256; ++v) ss += hv[v] * hv[v];
        const float rr = rsqrtf(ss * (1.0f / 256.0f) + EPS);
        if (tid < 256) { const int v = tid; const float o = bf2f(P[(size_t)t * 3072 + 2048 + h * 256 + v]);
            const float ref = hv[v] * rr * ng[h * 256 + v] / (1.0f + expf(-o));
            dbg_flag(F, dbg_ne(bf2f(Y[(size_t)t * 1024 + h * 256 + v]), ref), t < 64 ? 18 : 19); }
        __syncthreads();
    }
}
__device__ __forceinline__ void dbg_check_attn(const Ctx& F) {
    if (F.wg >= 8) return;
    const bf16r* Qb = (const bf16r*)(F.ws + WS_P); const bf16r* Kb = Qb + 16777216; const bf16r* Vb = Kb + 16777216; const bf16r* Ob = (const bf16r*)(F.ws + WS_O);
    const unsigned r = dbg_hash(F.wg * 8 + F.wave + 6000);
    const int hd = r % 32, row = (F.wave == 0) ? (int)((r >> 5) % 300) : (int)((r >> 5) % 8192);
    const int b = hd >> 4, h = (hd >> 2) & 3, c = (hd >> 1) & 1, vh = hd & 1, lane = F.lane;
    const bf16r* q = Qb + ((size_t)(b * 8 + h * 2 + c) * 8192 + row) * 128; const bf16r* K = Kb + (size_t)(b * 8 + h * 2 + c) * 8192 * 128; const bf16r* V = Vb + (size_t)(b * 8 + h * 2 + vh) * 8192 * 128;
    const float q0 = bf2f(q[lane * 2]), q1 = bf2f(q[lane * 2 + 1]);
    float mx = -1e30f, l = 0.f, o0 = 0.f, o1 = 0.f;
    for (int jk = 0; jk <= row; ++jk) {
        float sc = q0 * bf2f(K[(size_t)jk * 128 + lane * 2]) + q1 * bf2f(K[(size_t)jk * 128 + lane * 2 + 1]); sc = wave_sum(sc) * 0.08838834764831845f;
        const float mn = fmaxf(mx, sc), al = expf(mx - mn), p = expf(sc - mn);
        l = l * al + p; o0 = o0 * al + p * bf2f(V[(size_t)jk * 128 + lane * 2]); o1 = o1 * al + p * bf2f(V[(size_t)jk * 128 + lane * 2 + 1]); mx = mn;
    }
    const bf16r* O = Ob + ((size_t)hd * 8192 + row) * 128;
    dbg_flag(F, dbg_ne(bf2f(O[lane * 2]), o0 / l) || dbg_ne(bf2f(O[lane * 2 + 1]), o1 / l), 21);
}
__device__ __forceinline__ void dbg_check_combine(const Ctx& F) {
    if (F.wg != 0) return;
    const unsigned r = dbg_hash(F.tid + 7000);
    const int m = r % 16384, h = (r >> 14) & 3, vv = (r >> 16) & 255, b = m >> 13, s = m & 8191;
    const bf16r* Ob = (const bf16r*)(F.ws + WS_O); const float lam = ((const float*)(F.ws + WS_LAM))[0];
    float ss = 0.f, mine = 0.f;
    for (int v = 0; v < 256; ++v) { const int hd0 = ((b * 4 + h) * 2) * 2 + (v >> 7);
        const float o = bf2f(Ob[((size_t)hd0 * 8192 + s) * 128 + (v & 127)]) - lam * bf2f(Ob[((size_t)(hd0 + 2) * 8192 + s) * 128 + (v & 127)]); ss += o * o; if (v == vv) mine = o; }
    const float ref = mine * rsqrtf(ss * (1.0f / 256.0f) + EPS) * ((const float*)F.ka->in[16])[vv] * (1.0f - 0.35550906759096934f);
    dbg_flag(F, dbg_ne(bf2f(((const bf16r*)(F.ws + WS_Y))[(size_t)m * 1024 + h * 256 + vv]), ref), 23);
}
#endif

constexpr int N_PHASES = 2 + 9 * DEPTH + 1;
constexpr int PH_ATT1 = 2 + 9 * 1 + 3, PH_ATT3 = 2 + 9 * 3 + 3;
#ifndef MK_ONE_LAUNCH
#define MK_ONE_LAUNCH 0
#endif
__device__ __forceinline__ Ctx make_ctx(int wave_s) {
    KArgs ka = (KArgs)__builtin_amdgcn_kernarg_segment_ptr();
    asm volatile("" : "+s"(ka));
    Ctx F; F.ka = ka; F.out = ka->out; F.ws = ka->ws;
    { unsigned z0 = 0u; asm volatile("" : "+v"(z0)); const int t0 = wave_s * 64 + (int)__builtin_amdgcn_mbcnt_hi(~0u, __builtin_amdgcn_mbcnt_lo(~0u, z0)); F.tid = t0 & 511; }
    F.lane = F.tid & 63; F.wave = __builtin_amdgcn_readfirstlane(F.tid >> 6);
    { int g0 = gridDim.x, w0 = blockIdx.x; asm volatile("" : "+s"(g0), "+s"(w0)); F.G = g0; F.wg = w0; }
    return F;
}
template <bool FIRST> __device__ __forceinline__ void grid_seam(const Ctx& F, int& epoch) {
    if (FIRST && epoch == 0) {
        if (F.wg == 0 && F.tid == 0) __hip_atomic_store((unsigned*)F.ws, 0u, __ATOMIC_RELAXED, __HIP_MEMORY_SCOPE_AGENT);
        __threadfence(); cg::this_grid().sync(); epoch = 1; return;
    }
    asm volatile("s_waitcnt vmcnt(0) lgkmcnt(0)" ::: "memory");
    __syncthreads();
    if (F.tid == 0) {
        unsigned* cnt = (unsigned*)F.ws;
        __builtin_amdgcn_fence(__ATOMIC_RELEASE, "agent");
        asm volatile("s_waitcnt vmcnt(0)" ::: "memory");
        __hip_atomic_fetch_add(cnt, 1u, __ATOMIC_RELAXED, __HIP_MEMORY_SCOPE_AGENT);
        const unsigned target = (unsigned)epoch * (unsigned)F.G;
        while (__hip_atomic_load(cnt, __ATOMIC_RELAXED, __HIP_MEMORY_SCOPE_AGENT) < target) __builtin_amdgcn_s_sleep(2);
        __builtin_amdgcn_fence(__ATOMIC_ACQUIRE, "agent");
        asm volatile("s_waitcnt vmcnt(0)" ::: "memory");
    }
    __syncthreads();
    epoch += 1;
}
template <int PH> __device__ __forceinline__ void do_phase(int lo, int hi, int wave_s, LAS unsigned char* lds, unsigned char* lds_raw, int& epoch) {
    if (!(lo <= PH && PH < hi)) return;
    const Ctx F = make_ctx(wave_s);
    unsigned char* ws = F.ws;
    const float* ADA = (const float*)(ws + WS_ADA); const float* GS = (const float*)(ws + WS_GS); float* SSQP = (float*)(ws + WS_SSQP);
    bf16r* XS = (bf16r*)(ws + WS_XS); bf16r* H = (bf16r*)(ws + WS_H); bf16r* P = (bf16r*)(ws + WS_P); bf16r* Y = (bf16r*)(ws + WS_Y);
    constexpr bool is_layer = PH >= 2 && PH < N_PHASES - 1;
    constexpr int l = is_layer ? (PH - 2) / 9 : 0, s = is_layer ? (PH - 2) % 9 : -1, isattn = l & 1, j = l >> 1;
    constexpr bool empty = is_layer && s == 5 && isattn;
#if MK_DEBUG
    if constexpr (PH == 1) dbg_check_p0(F); else if constexpr (PH == 2) dbg_check_p1(F); else if constexpr (PH == 3) dbg_check_up(F); else if constexpr (PH == 4) dbg_check_down(F);
    else if constexpr (PH == 5) dbg_check_inproj0(F); else if constexpr (PH == 8) dbg_check_mlstm(F, lds); else if constexpr (PH == 14) dbg_check_inproj1(F);
    else if constexpr (PH == 15) dbg_check_attn(F); else if constexpr (PH == 17) dbg_check_combine(F);
    __syncthreads();
#endif
    if constexpr (PH == 0) p0_phase(F, lds);
    else if constexpr (PH == 1) p1_phase(F);
    else if constexpr (PH == N_PHASES - 1) { final_phase(F);
#if MK_DEBUG
        if (F.wg == 0) { asm volatile("s_waitcnt vmcnt(0)" ::: "memory"); __syncthreads(); const unsigned code = *(const unsigned*)(F.ws + 64); if (code) { float v = (float)(10 + (code % 90)) * 100.0f; for (unsigned q = 0; q < code / 90; ++q) v *= 10.0f; F.out[F.tid] = v; } }
#endif
    }
    else if constexpr (s == 0 || s == 7) {
        constexpr int f = s == 0 ? 0 : 1;
        pg8::Gemm g{XS, (const bf16r*)(ws + WS_W13) + (size_t)(l * 2 + f) * NUP * 1024, M, NUP, 1024};
        pg8::EpiGen E{0, H, (const float*)(ws + WS_SWF) + (size_t)(l * 2 + f) * 2 * NUP, SSQP, nullptr, nullptr, nullptr};
        pg8::StaticOrder S; S.init(M, NUP, F.G, F.wg);
        pg8::gemm_phase<pg8::EpiGen, pg8::StaticOrder, true, true>(lds, g, S, E, F.tid);
    } else if constexpr (s == 1 || s == 8) {
        constexpr int f = s == 1 ? 0 : 1, sub = f ? 2 : 0;
        pg8::Gemm g{H, (const bf16r*)(ws + WS_W2) + (size_t)(l * 2 + f) * 1024 * DFF, M, 1024, DFF};
        const float* gsn = f == 0 ? GS + (size_t)(l * 3 + 1) * 2048 : GS + (size_t)((l + 1 < DEPTH ? l + 1 : 0) * 3) * 2048;
        pg8::EpiGen E{1, F.out, ADA + (size_t)l * 2 * 9216 + sub * 3072 + 2048, gsn, nullptr, XS, SSQP};
        pg8::StaticOrder S; S.init(M, 1024, F.G, F.wg);
        pg8::gemm_phase<pg8::EpiGen, pg8::StaticOrder, true, true>(lds, g, S, E, F.tid);
    } else if constexpr (s == 2) {
        pg8::Gemm g{XS, (const bf16r*)(ws + (isattn ? WS_WINB : WS_WINA)) + (size_t)j * NIN * 1024, M, NIN, 1024};
        pg8::EpiGen E{isattn ? 4 : 3, P, (const float*)(ws + WS_SWM) + (size_t)l * 2 * NIN, SSQP, ((const int*)F.ka->in[2]), nullptr, nullptr};
        pg8::StaticOrder S; S.init(M, NIN, F.G, F.wg);
        pg8::gemm_phase<pg8::EpiGen, pg8::StaticOrder, true, true>(lds, g, S, E, F.tid);
        if constexpr (!isattn) { __syncthreads(); gates_phase(F, lds, l); }
    } else if constexpr (s == 6) {
        pg8::Gemm g{Y, (const bf16r*)(ws + (isattn ? WS_WOB : WS_WOA)) + (size_t)j * 1024 * 1024, M, 1024, 1024};
        pg8::EpiGen E{2, F.out, ADA + (size_t)l * 2 * 9216 + 3072 + 2048, GS + (size_t)(l * 3 + 2) * 2048, nullptr, XS, SSQP};
        pg8::StaticOrder S; S.init(M, 1024, F.G, F.wg);
        pg8::gemm_phase<pg8::EpiGen, pg8::StaticOrder, true, true>(lds, g, S, E, F.tid);
    }
    else if constexpr (s == 3) { if constexpr (isattn) attn_phase(F, (char*)lds_raw); else s1_phase(F, lds, l); }
    else if constexpr (s == 4) { if constexpr (isattn) combine_phase(F, l); else s2_phase(F); }
    else if constexpr (s == 5) { if constexpr (!isattn) s3_phase(F, lds, l); }
    if (PH + 1 < hi && !empty) grid_seam<PH == 0>(F, epoch);
}
template <int... I> __device__ __forceinline__ void all_phases(std::integer_sequence<int, I...>, int lo, int hi, int wave_s, LAS unsigned char* lds, unsigned char* lds_raw, int& epoch) {
    (do_phase<I>(lo, hi, wave_s, lds, lds_raw, epoch), ...);
}
__global__ void __launch_bounds__(NWAVES * 64, 2) mk_fwd(Args args) {
    extern __shared__ __attribute__((aligned(16))) unsigned char lds_raw[];
    LAS unsigned char* lds = (LAS unsigned char*)lds_raw;
    const int ph_lo = args.ph_lo, ph_hi = args.ph_hi;
    const int wave_s = __builtin_amdgcn_readfirstlane(threadIdx.x >> 6);
    if (ph_lo != 0 && ph_hi - ph_lo > 1) return;
    int epoch = 0;
    all_phases(std::make_integer_sequence<int, N_PHASES>{}, ph_lo, ph_hi, wave_s, lds, lds_raw, epoch);
}

extern "C" void kernel_launch(void* const* d_in, const int* in_sizes, int n_in, void* d_out, int out_size, void* d_ws, size_t ws_size, hipStream_t stream) {
    static int grid = 0;
    if (grid == 0) {
        if (n_in != 19 || out_size != M * DM || ws_size < WS_END) { fprintf(stderr, "kernel_launch: unexpected shapes (n_in %d out %d ws %zu)\n", n_in, out_size, ws_size); grid = -1; return; }
        int dev = 0, cus = 0, per_cu = 0;
        (void)hipGetDevice(&dev); (void)hipDeviceGetAttribute(&cus, hipDeviceAttributeMultiprocessorCount, dev);
        if (hipFuncSetAttribute((const void*)mk_fwd, hipFuncAttributeMaxDynamicSharedMemorySize, LDS_BYTES) != hipSuccess) { fprintf(stderr, "kernel_launch: hipFuncSetAttribute failed\n"); grid = -1; return; }
        if (hipOccupancyMaxActiveBlocksPerMultiprocessor(&per_cu, (const void*)mk_fwd, NWAVES * 64, LDS_BYTES) != hipSuccess || per_cu < 1) { fprintf(stderr, "kernel_launch: occupancy query gave %d\n", per_cu); per_cu = 1; }
        (void)hipGetLastError();
        grid = cus > 0 ? cus : 256;
    }
    if (grid < 0) return;
    Args a{};
    for (int i = 0; i < 19; ++i) a.in[i] = d_in[i];
    a.out = (float*)d_out; a.ws = (unsigned char*)d_ws;
#if MK_ONE_LAUNCH
    a.ph_lo = 0; a.ph_hi = N_PHASES;
    void* kargs[] = {&a};
    hipError_t e = hipLaunchCooperativeKernel((const void*)mk_fwd, dim3(grid), dim3(NWAVES * 64), kargs, LDS_BYTES, stream);
    if (e != hipSuccess) fprintf(stderr, "kernel_launch: cooperative launch failed: %s (grid %d)\n", hipGetErrorString(e), grid);
#else
    for (int ph = 0; ph < N_PHASES; ++ph) {
        if (ph >= 2 && ph < N_PHASES - 1 && ((ph - 2) / 9 & 1) && ((ph - 2) % 9 == 5)) continue;
        a.ph_lo = ph; a.ph_hi = ph + 1;
        hipLaunchKernelGGL(mk_fwd, dim3(grid), dim3(NWAVES * 64), LDS_BYTES, stream, a);
    }
#endif
}
```

```cpp
#include <hip/hip_runtime.h>
#include <hip/hip_bf16.h>
#include <hip/hip_cooperative_groups.h>
#include <cstdio>
#include <cstdint>
#include <cmath>
#include <utility>
template <int MASK> __device__ __forceinline__ float swz_xor(float v) { return __builtin_bit_cast(float, __builtin_amdgcn_ds_swizzle(__builtin_bit_cast(int, v), (MASK << 10) | 0x1f)); }
__device__ __forceinline__ float sum_x32(float v) { const unsigned u = __float_as_uint(v); auto rr = __builtin_amdgcn_permlane32_swap(u, u, false, false); const unsigned r0 = rr[0], r1 = rr[1]; return __uint_as_float(r0) + __uint_as_float(r1); }
__device__ __forceinline__ float max_x32(float v) { const unsigned u = __float_as_uint(v); auto rr = __builtin_amdgcn_permlane32_swap(u, u, false, false); const unsigned r0 = rr[0], r1 = rr[1]; return fmaxf(__uint_as_float(r0), __uint_as_float(r1)); }
namespace pg8 {
#define PG8_LAS __attribute__((address_space(3)))
typedef unsigned short bf16_t;
typedef short bf16x8 __attribute__((ext_vector_type(8)));
typedef float f32x4 __attribute__((ext_vector_type(4)));
typedef unsigned u32x4 __attribute__((ext_vector_type(4)));
constexpr int BM = 256, BK = 64, HALF = 128, HTB = HALF * BK * 2  , STAGE_BYTES = 8 * HTB, NXCD = 8, WGM = 8;

__host__ __device__ __forceinline__ int lds_byte(int r, int c) { const int st = (r >> 4) * 2 + (c >> 5), rr = r & 15, cc = c & 31, ob = rr * 64 + cc * 2; return st * 1024 + (ob ^ (((ob >> 9) & 1) << 5)); }
__host__ __device__ __forceinline__ void stage_rc(int b, int& R, int& C) { const int st = b / 1024, sb = b % 1024, swz = sb ^ (((sb >> 9) & 1) << 5); R = (st >> 1) * 16 + swz / 64; C = (st & 1) * 32 + (swz % 64) / 2; }
__host__ __device__ __forceinline__ int perm32(int rho) { const int n = rho >> 4, i = rho & 15; return 8 * (i >> 2) + 4 * n + (i & 3); }

struct Unit { int pm, pn; };
struct Gemm { const bf16_t* A; const bf16_t* Bt; int M, N, K; };

struct StaticOrder {
    int nM, nN, nwg, G, c;
    __host__ __device__ void init(int M, int N, int G_, int c_) { nM = M / BM; nN = N / BM; nwg = nM * nN; G = G_; c = c_; }
    __host__ __device__ bool next(int i, Unit& u) const {
        const long L = (long)i * G + c; if (L >= nwg) return false;
        int wgid = (int)L; { const int q = nwg / NXCD, r = nwg % NXCD, xcd = wgid % NXCD, off = wgid / NXCD; wgid = (xcd < r ? xcd * (q + 1) : r * (q + 1) + (xcd - r) * q) + off; }
        const int nig = WGM * nN, gid = wgid / nig, fm = gid * WGM, gsz = (nM - fm) < WGM ? (nM - fm) : WGM;
        u.pm = fm + ((wgid % nig) % gsz); u.pn = (wgid % nig) / gsz; return true;
    }
    __device__ __forceinline__ void a_ready(const Unit&) const {}
    __device__ __forceinline__ void done(const Unit&) const {}
};
__device__ __forceinline__ unsigned cvt_pk_bf16(float lo, float hi) { unsigned r; asm volatile("v_cvt_pk_bf16_f32 %0, %1, %2" : "=v"(r) : "v"(lo), "v"(hi)); return r; }
constexpr int MROWS = 16384;
constexpr float RMS_EPS = 1e-6f;
__device__ __forceinline__ float silu_f(float g) { return g * __builtin_amdgcn_rcpf(1.0f + __expf(-g)); }
__device__ __forceinline__ float row_rstd(const float* ssqp, int row, int fq) {
    float s = 0.f;
#pragma unroll
    for (int i = 0; i < 4; ++i) s += ssqp[(size_t)(fq * 4 + i) * MROWS + row];
    s += swz_xor<16>(s); s = sum_x32(s);
    return rsqrtf(s * (1.0f / 1024.0f) + RMS_EPS);
}
struct EpiUp {
    static constexpr bool PERM = true, AFTER_DRAIN = false;
    bf16_t* H; const float* sw; const float* ssqp;
    __device__ __forceinline__ void operator()(const f32x4 (&acc)[2][2][4][2], const Unit& u, int wr, int wc, int fr, int fq) const {
        const int b = u.pm >> 5, row0 = u.pm * BM + wr * 64 + fr, c8 = wc * 32 + 8 * fq;
        const float* swp = sw + (size_t)b * 5632 + u.pn * 256 + c8;
        const f32x4 sg0 = *(const f32x4*)(swp), sg1 = *(const f32x4*)(swp + 4), su0 = *(const f32x4*)(swp + 128), su1 = *(const f32x4*)(swp + 132);
        bf16_t* hp = H + (size_t)u.pn * 128 + c8;
#pragma unroll
        for (int ai = 0; ai < 2; ++ai)
#pragma unroll
            for (int m = 0; m < 4; ++m) {
                const int row = row0 + ai * HALF + m * 16;
                const float rs = row_rstd(ssqp, row, fq);
                const f32x4 g0 = acc[ai][0][m][0] * rs + sg0, g1 = acc[ai][0][m][1] * rs + sg1;
                const f32x4 u0 = acc[ai][1][m][0] * rs + su0, u1 = acc[ai][1][m][1] * rs + su1;
                u32x4 w;
                w.x = cvt_pk_bf16(silu_f(g0[0]) * u0[0], silu_f(g0[1]) * u0[1]); w.y = cvt_pk_bf16(silu_f(g0[2]) * u0[2], silu_f(g0[3]) * u0[3]);
                w.z = cvt_pk_bf16(silu_f(g1[0]) * u1[0], silu_f(g1[1]) * u1[1]); w.w = cvt_pk_bf16(silu_f(g1[2]) * u1[2], silu_f(g1[3]) * u1[3]);
                *(u32x4*)(hp + (size_t)row * 2816) = w;
            }
    }
};
struct EpiBias {
    static constexpr bool PERM = true, AFTER_DRAIN = false;
    bf16_t* O; int ldc; const float* sw; int nsw; const float* ssqp;
    __device__ __forceinline__ void operator()(const f32x4 (&acc)[2][2][4][2], const Unit& u, int wr, int wc, int fr, int fq) const {
        const int b = u.pm >> 5, row0 = u.pm * BM + wr * 64 + fr, col0 = u.pn * BM + wc * 32 + 8 * fq;
        f32x4 sv[2][2];
#pragma unroll
        for (int bj = 0; bj < 2; ++bj)
#pragma unroll
            for (int n = 0; n < 2; ++n) sv[bj][n] = *(const f32x4*)(sw + (size_t)b * nsw + col0 + bj * HALF + 4 * n);
#pragma unroll
        for (int ai = 0; ai < 2; ++ai)
#pragma unroll
            for (int m = 0; m < 4; ++m) {
                const int row = row0 + ai * HALF + m * 16;
                const float rs = row_rstd(ssqp, row, fq);
                bf16_t* rowp = O + (size_t)row * ldc + col0;
#pragma unroll
                for (int bj = 0; bj < 2; ++bj) {
                    const f32x4 v0 = acc[ai][bj][m][0] * rs + sv[bj][0], v1 = acc[ai][bj][m][1] * rs + sv[bj][1];
                    u32x4 w; w.x = cvt_pk_bf16(v0[0], v0[1]); w.y = cvt_pk_bf16(v0[2], v0[3]); w.z = cvt_pk_bf16(v1[0], v1[1]); w.w = cvt_pk_bf16(v1[2], v1[3]);
                    *(u32x4*)(rowp + bj * HALF) = w;
                }
            }
    }
};
template <int HALFC> struct EpiResidT {
    static constexpr bool PERM = true, AFTER_DRAIN = false;
    float* x; const float* gate; const float* gsn; bf16_t* xs; float* ssqp;
    __device__ __forceinline__ void operator()(const f32x4 (&acc)[2][2][4][2], const Unit& u, int wr, int wc, int fr, int fq) const {
        const int b = u.pm >> 5, row0 = u.pm * BM + wr * 64 + fr, col0 = u.pn * BM + wc * 32 + 8 * fq;
        constexpr float gcoef = HALFC ? 0.5f : 1.0f;
        f32x4 gt[2][2], gs[2][2];
#pragma unroll
        for (int bj = 0; bj < 2; ++bj)
#pragma unroll
            for (int n = 0; n < 2; ++n) {
                gt[bj][n] = *(const f32x4*)(gate + (size_t)b * 9216 + col0 + bj * HALF + 4 * n) * gcoef;
                gs[bj][n] = *(const f32x4*)(gsn + (size_t)b * 1024 + col0 + bj * HALF + 4 * n);
            }
#pragma unroll
        for (int ai = 0; ai < 2; ++ai)
#pragma unroll
            for (int m = 0; m < 4; ++m) {
                const int row = row0 + ai * HALF + m * 16;
                float ss = 0.f;
#pragma unroll
                for (int bj = 0; bj < 2; ++bj) {
                    float* xp = x + (size_t)row * 1024 + col0 + bj * HALF;
                    f32x4 x0 = *(const f32x4*)xp, x1 = *(const f32x4*)(xp + 4);
                    x0 = x0 + gt[bj][0] * acc[ai][bj][m][0]; x1 = x1 + gt[bj][1] * acc[ai][bj][m][1];
                    *(f32x4*)xp = x0; *(f32x4*)(xp + 4) = x1;
                    ss += (x0[0] * x0[0] + x0[1] * x0[1]) + (x0[2] * x0[2] + x0[3] * x0[3]) + (x1[0] * x1[0] + x1[1] * x1[1]) + (x1[2] * x1[2] + x1[3] * x1[3]);
                    {
                        const f32x4 y0 = x0 * gs[bj][0], y1 = x1 * gs[bj][1];
                        u32x4 w; w.x = cvt_pk_bf16(y0[0], y0[1]); w.y = cvt_pk_bf16(y0[2], y0[3]); w.z = cvt_pk_bf16(y1[0], y1[1]); w.w = cvt_pk_bf16(y1[2], y1[3]);
                        *(u32x4*)(xs + (size_t)row * 1024 + col0 + bj * HALF) = w;
                    }
                }
                ss += swz_xor<16>(ss); ss = sum_x32(ss);
                if (fq == 0) ssqp[(size_t)(u.pn * 4 + wc) * MROWS + row] = ss;
            }
    }
};
__constant__ float ROPE_INVF[16] = {1.000000000e+00f, 4.403665960e-01f, 1.939227432e-01f, 8.539710194e-02f, 3.760603070e-02f, 1.656044088e-02f, 7.292664610e-03f, 3.211446106e-03f,
                                    1.414213562e-03f, 6.227724371e-04f, 2.742481884e-04f, 1.207697351e-04f, 5.318295734e-05f, 2.341999971e-05f, 1.031338525e-05f, 4.541670478e-06f};
struct EpiRope {
    static constexpr bool PERM = true, AFTER_DRAIN = false;
    bf16_t* QKV; const float* sw; const float* ssqp; const int* pos;
    __device__ __forceinline__ void operator()(const f32x4 (&acc)[2][2][4][2], const Unit& u, int wr, int wc, int fr, int fq) const {
        const int b = u.pm >> 5, row0 = u.pm * BM + wr * 64 + fr, col0 = u.pn * BM + wc * 32 + 8 * fq;
        f32x4 sv[2][2];
#pragma unroll
        for (int bj = 0; bj < 2; ++bj)
#pragma unroll
            for (int n = 0; n < 2; ++n) sv[bj][n] = *(const f32x4*)(sw + (size_t)b * 3072 + col0 + bj * HALF + 4 * n);
        const bool rot = (wc == 0) && (u.pn < 8);
        const bool lower = fq < 2;
        f32x4 fr4[2] = {{0.f, 0.f, 0.f, 0.f}, {0.f, 0.f, 0.f, 0.f}};
        if (rot) { fr4[0] = *(const f32x4*)(ROPE_INVF + 8 * (fq & 1)); fr4[1] = *(const f32x4*)(ROPE_INVF + 8 * (fq & 1) + 4); }
#pragma unroll
        for (int ai = 0; ai < 2; ++ai)
#pragma unroll
            for (int m = 0; m < 4; ++m) {
                const int row = row0 + ai * HALF + m * 16, srow = row & 8191;
                const float rs = row_rstd(ssqp, row, fq);
                f32x4 cs[2] = {{1.f, 1.f, 1.f, 1.f}, {1.f, 1.f, 1.f, 1.f}}, sn[2] = {{0.f, 0.f, 0.f, 0.f}, {0.f, 0.f, 0.f, 0.f}};
                if (rot) {
                    const float p = (float)pos[row];
#pragma unroll
                    for (int n = 0; n < 2; ++n)
#pragma unroll
                        for (int j = 0; j < 4; ++j) {
                            const float a = p * fr4[n][j];
                            const float k = rintf(a * 0.15915494309189535f);
                            float r = fmaf(-k, 6.2831854820251465f, a); r = fmaf(-k, -1.7484555314695172e-07f, r);
                            cs[n][j] = __cosf(r); sn[n][j] = lower ? -__sinf(r) : __sinf(r);
                        }
                }
#pragma unroll
                for (int bj = 0; bj < 2; ++bj) {
                    const int blk = u.pn * 2 + bj, which = blk >> 3, idx = blk & 7;
                    f32x4 v[2] = {acc[ai][bj][m][0] * rs + sv[bj][0], acc[ai][bj][m][1] * rs + sv[bj][1]};
                    if (rot) {
#pragma unroll
                        for (int n = 0; n < 2; ++n)
#pragma unroll
                            for (int j = 0; j < 4; ++j) {
                                const unsigned bits = __float_as_uint(v[n][j]);
                                auto rr = __builtin_amdgcn_permlane32_swap(bits, bits, false, false);
                                const unsigned r0 = rr[0], r1 = rr[1];
                                const float pv = __uint_as_float(lower ? r1 : r0);
                                v[n][j] = v[n][j] * cs[n][j] + pv * sn[n][j];
                            }
                    }
                    bf16_t* dp = QKV + (size_t)which * 16777216 + ((size_t)(b * 8 + idx) * 8192 + srow) * 128 + wc * 32 + 8 * fq;
                    u32x4 w; w.x = cvt_pk_bf16(v[0][0], v[0][1]); w.y = cvt_pk_bf16(v[0][2], v[0][3]); w.z = cvt_pk_bf16(v[1][0], v[1][1]); w.w = cvt_pk_bf16(v[1][2], v[1][3]);
                    *(u32x4*)dp = w;
                }
            }
    }
};
struct EpiGen {
    static constexpr bool PERM = true, AFTER_DRAIN = false;
    int kind; void* p0; const void* p1; const void* p2; const void* p3; void* p4; void* p5;
    __device__ __forceinline__ void operator()(const f32x4 (&acc)[2][2][4][2], const Unit& u, int wr, int wc, int fr, int fq) const {
        if (kind == 0) { EpiUp e{(bf16_t*)p0, (const float*)p1, (const float*)p2}; e(acc, u, wr, wc, fr, fq); }
        else if (kind == 1) { EpiResidT<1> e{(float*)p0, (const float*)p1, (const float*)p2, (bf16_t*)p4, (float*)p5}; e(acc, u, wr, wc, fr, fq); }
        else if (kind == 2) { EpiResidT<0> e{(float*)p0, (const float*)p1, (const float*)p2, (bf16_t*)p4, (float*)p5}; e(acc, u, wr, wc, fr, fq); }
        else if (kind == 3) { EpiBias e{(bf16_t*)p0, 3072, (const float*)p1, 3072, (const float*)p2}; e(acc, u, wr, wc, fr, fq); }
        else { EpiRope e{(bf16_t*)p0, (const float*)p1, (const float*)p2, (const int*)p3}; e(acc, u, wr, wc, fr, fq); }
    }
};
template <class Epi, class Sched, bool ALIGN_EPI = false, bool SP2 = false>
__device__ __forceinline__ void gemm_phase(PG8_LAS unsigned char* lds, const Gemm g, const Sched& S, const Epi& E, const int tid_in) {
    const int tid = tid_in, wid = __builtin_amdgcn_readfirstlane(tid >> 6), lane = tid & 63, wr = wid >> 2, wc = wid & 3, fr = lane & 15, fq = lane >> 4;
    const int K = g.K, nt = K / BK;
    unsigned voffA[2], voffB[2];
#pragma unroll
    for (int i = 0; i < 2; ++i) { int R, C; stage_rc(tid * 16 + i * 8192, R, C); const int Rb = Epi::PERM ? ((R & ~31) + perm32(R & 31)) : R;
        voffA[i] = (unsigned)(R * K + C) * 2u; voffB[i] = (unsigned)(Rb * K + C) * 2u; }
    const size_t kstep = (size_t)(BK * 2);
    const size_t hstep = (size_t)HALF * K * 2;
    const size_t tstep = 2 * hstep;
    const unsigned ldsw = (unsigned)wid * 1024u;
    const int aoff = lds_byte(wr * 64 + fr, fq * 8), boff = lds_byte(wc * 32 + fr, fq * 8);
#define PG8_SA(b, h) (((b) * 2 + (h)) * HTB)
#define PG8_SB(b, h) ((4 + (b) * 2 + (h)) * HTB)
#define PG8_STAGE(bufoff, gbase, voff) do { _Pragma("unroll") for (int _i = 0; _i < 2; ++_i) \
        __builtin_amdgcn_global_load_lds((const unsigned*)((const char*)(gbase) + (voff)[_i]), (PG8_LAS unsigned*)(lds + (bufoff) + ldsw + _i * 8192), 16, 0, 0); } while (0)
#define PG8_LDA(dst, b, h) do { _Pragma("unroll") for (int m = 0; m < 4; ++m) _Pragma("unroll") for (int k = 0; k < 2; ++k) dst[m][k] = *(const PG8_LAS bf16x8*)(lds + PG8_SA(b, h) + aoff + m * 2048 + k * 1024); } while (0)
#define PG8_LDB(dst, b, h) do { _Pragma("unroll") for (int n = 0; n < 2; ++n) _Pragma("unroll") for (int k = 0; k < 2; ++k) dst[n][k] = *(const PG8_LAS bf16x8*)(lds + PG8_SB(b, h) + boff + n * 2048 + k * 1024); } while (0)
#define PG8_MMA(ai, bj, At, Bt) do { __builtin_amdgcn_s_setprio(1); _Pragma("unroll") for (int m = 0; m < 4; ++m) _Pragma("unroll") for (int n = 0; n < 2; ++n) _Pragma("unroll") for (int k = 0; k < 2; ++k) \
        acc[ai][bj][m][n] = __builtin_amdgcn_mfma_f32_16x16x32_bf16(Bt[n][k], At[m][k], acc[ai][bj][m][n], 0, 0, 0); __builtin_amdgcn_s_setprio(0); } while (0)
#define PG8_WAIT_V(n) asm volatile("s_waitcnt vmcnt(" #n ")" ::: "memory")
#define PG8_WAIT_L(n) asm volatile("s_waitcnt lgkmcnt(" #n ")" ::: "memory")
#define PG8_BAR __builtin_amdgcn_s_barrier()
#define PG8_SCHED __builtin_amdgcn_sched_barrier(0)
    Unit cur, nxt; int ui = 0;
    if (!S.next(0, cur)) return;
    f32x4 acc[2][2][4][2];
#pragma unroll
    for (int a = 0; a < 2; ++a)
#pragma unroll
        for (int b = 0; b < 2; ++b)
#pragma unroll
            for (int m = 0; m < 4; ++m)
#pragma unroll
                for (int n = 0; n < 2; ++n) acc[a][b][m][n] = (f32x4){0.f, 0.f, 0.f, 0.f};
    bf16x8 At[4][2], B0[2][2], B1[2][2];
    const char* cA = (const char*)g.A + (size_t)cur.pm * tstep; const char* cB = (const char*)g.Bt + (size_t)cur.pn * tstep;
    S.a_ready(cur);
    if constexpr (SP2) {
        PG8_STAGE(PG8_SB(0, 0), cB, voffB); PG8_STAGE(PG8_SB(0, 1), cB + hstep, voffB); PG8_STAGE(PG8_SA(0, 0), cA, voffA); PG8_STAGE(PG8_SA(0, 1), cA + hstep, voffA);
        if (wr == 1) PG8_BAR;
        PG8_WAIT_V(2); PG8_BAR;
        PG8_STAGE(PG8_SB(1, 0), cB + kstep, voffB); PG8_STAGE(PG8_SA(1, 0), cA + kstep, voffA); PG8_STAGE(PG8_SB(1, 1), cB + hstep + kstep, voffB);
        PG8_WAIT_V(6); PG8_BAR;
    } else {
        PG8_STAGE(PG8_SB(0, 0), cB, voffB); PG8_STAGE(PG8_SA(0, 0), cA, voffA); PG8_STAGE(PG8_SB(0, 1), cB + hstep, voffB); PG8_STAGE(PG8_SA(0, 1), cA + hstep, voffA);
        if (wr == 1) PG8_BAR;
        PG8_WAIT_V(4); PG8_BAR;
        PG8_STAGE(PG8_SB(1, 0), cB + kstep, voffB); PG8_STAGE(PG8_SA(1, 0), cA + kstep, voffA); PG8_STAGE(PG8_SB(1, 1), cB + hstep + kstep, voffB);
        PG8_WAIT_V(6); PG8_BAR;
    }
    for (;;) {
        const bool has_next = S.next(ui + 1, nxt);
        const char* nA = has_next ? (const char*)g.A + (size_t)nxt.pm * tstep : cA; const char* nB = has_next ? (const char*)g.Bt + (size_t)nxt.pn * tstep : cB;
        for (int t = 0; t < nt; t += 2) {
            const bool last = (t == nt - 2);
            const char* a1 = cA + (size_t)(t + 1) * kstep;
            const char* a2 = last ? nA : cA + (size_t)(t + 2) * kstep; const char* b2 = last ? nB : cB + (size_t)(t + 2) * kstep;
            const char* a3 = a2 + kstep; const char* b3 = b2 + kstep;
            if (last && has_next) S.a_ready(nxt);
            if constexpr (SP2) {
            PG8_LDB(B0, 0, 0); PG8_LDB(B1, 0, 1); PG8_SCHED; PG8_LDA(At, 0, 0); PG8_STAGE(PG8_SA(1, 1), a1 + hstep, voffA);
            PG8_WAIT_V(8); PG8_WAIT_L(0); PG8_BAR; PG8_MMA(0, 0, At, B0); PG8_MMA(0, 1, At, B1); PG8_BAR; PG8_SCHED;
            PG8_LDA(At, 0, 1); PG8_STAGE(PG8_SB(0, 0), b2, voffB); PG8_STAGE(PG8_SB(0, 1), b2 + hstep, voffB); PG8_STAGE(PG8_SA(0, 0), a2, voffA);
            PG8_WAIT_V(8); PG8_WAIT_L(0); PG8_BAR; PG8_MMA(1, 0, At, B0); PG8_MMA(1, 1, At, B1); PG8_BAR; PG8_SCHED;
            PG8_LDB(B0, 1, 0); PG8_LDB(B1, 1, 1); PG8_SCHED; PG8_LDA(At, 1, 0); PG8_STAGE(PG8_SA(0, 1), a2 + hstep, voffA);
            PG8_WAIT_V(8); PG8_WAIT_L(0); PG8_BAR; PG8_MMA(0, 0, At, B0); PG8_MMA(0, 1, At, B1); PG8_BAR; PG8_SCHED;
            PG8_LDA(At, 1, 1); PG8_STAGE(PG8_SB(1, 0), b3, voffB); PG8_STAGE(PG8_SB(1, 1), b3 + hstep, voffB); PG8_STAGE(PG8_SA(1, 0), a3, voffA);
            PG8_WAIT_V(8); PG8_WAIT_L(0); PG8_BAR; PG8_MMA(1, 0, At, B0); PG8_MMA(1, 1, At, B1); PG8_BAR; PG8_SCHED;
            } else {
            PG8_LDB(B0, 0, 0); PG8_SCHED; PG8_LDA(At, 0, 0); PG8_STAGE(PG8_SA(1, 1), a1 + hstep, voffA);
            PG8_WAIT_L(8); PG8_BAR; PG8_WAIT_L(0); PG8_MMA(0, 0, At, B0); PG8_BAR; PG8_SCHED;
            PG8_LDB(B1, 0, 1); PG8_STAGE(PG8_SB(0, 0), b2, voffB);
            PG8_BAR; PG8_WAIT_L(0); PG8_MMA(0, 1, At, B1); PG8_BAR;
            PG8_LDA(At, 0, 1); PG8_STAGE(PG8_SA(0, 0), a2, voffA);
            PG8_BAR; PG8_WAIT_L(0); PG8_MMA(1, 0, At, B0); PG8_BAR; PG8_SCHED;
            PG8_STAGE(PG8_SB(0, 1), b2 + hstep, voffB);
            PG8_WAIT_V(6); PG8_BAR; PG8_MMA(1, 1, At, B1); PG8_BAR;
            PG8_LDB(B0, 1, 0); PG8_SCHED; PG8_LDA(At, 1, 0); PG8_STAGE(PG8_SA(0, 1), a2 + hstep, voffA);
            PG8_WAIT_L(8); PG8_BAR; PG8_WAIT_L(0); PG8_MMA(0, 0, At, B0); PG8_BAR; PG8_SCHED;
            PG8_LDB(B1, 1, 1); PG8_STAGE(PG8_SB(1, 0), b3, voffB);
            PG8_BAR; PG8_WAIT_L(0); PG8_MMA(0, 1, At, B1); PG8_BAR;
            PG8_LDA(At, 1, 1); PG8_STAGE(PG8_SA(1, 0), a3, voffA);
            PG8_BAR; PG8_WAIT_L(0); PG8_MMA(1, 0, At, B0); PG8_BAR; PG8_SCHED;
            PG8_STAGE(PG8_SB(1, 1), b3 + hstep, voffB);
            PG8_WAIT_V(6); PG8_BAR; PG8_MMA(1, 1, At, B1); PG8_BAR;
            }
        }
        if constexpr (ALIGN_EPI) { if (wr == 0) PG8_BAR; }
        if constexpr (!Epi::AFTER_DRAIN) { E(acc, cur, wr, wc, fr, fq); S.done(cur); }
        if (!has_next) break;
#pragma unroll
        for (int a = 0; a < 2; ++a)
#pragma unroll
            for (int b = 0; b < 2; ++b)
#pragma unroll
                for (int m = 0; m < 4; ++m)
#pragma unroll
                    for (int n = 0; n < 2; ++n) acc[a][b][m][n] = (f32x4){0.f, 0.f, 0.f, 0.f};
        cur = nxt; cA = nA; cB = nB; ++ui;
        if constexpr (ALIGN_EPI) { if (wr == 1) PG8_BAR; }
    }
    PG8_WAIT_V(0);
    if constexpr (!ALIGN_EPI) { if (wr == 0) PG8_BAR; }
    PG8_BAR;
    if constexpr (Epi::AFTER_DRAIN) { E.fused(acc, cur, wr, wc, fr, fq, lds, wid, lane); S.done(cur); }
#undef PG8_SA
#undef PG8_SB
#undef PG8_STAGE
#undef PG8_LDA
#undef PG8_LDB
#undef PG8_MMA
#undef PG8_WAIT_V
#undef PG8_WAIT_L
#undef PG8_BAR
#undef PG8_SCHED
}
}
namespace att {
using bf16 = __hip_bfloat16;
constexpr int D = 128; constexpr float THR = 8.f; constexpr bool WSKIP = false;
constexpr float SCALE = 0.08838834764831845f;
constexpr int NW = 8, QBLK = 32, KVBLK = 64, QB = NW * QBLK;
constexpr int SHM_V = KVBLK * D * 2, SHM_K = KVBLK * D * 2;
constexpr int LDS_BYTES = 2 * SHM_V + 2 * SHM_K + NW * 64 * 4;
typedef short bf16x8 __attribute__((ext_vector_type(8)));
typedef short s16x4 __attribute__((ext_vector_type(4)));
typedef float f32x16 __attribute__((ext_vector_type(16)));
typedef float f32x4 __attribute__((ext_vector_type(4)));
typedef unsigned u32x4 __attribute__((ext_vector_type(4)));
template <class A, class Bt> struct same_t { static constexpr bool v = false; };
template <class A> struct same_t<A, A> { static constexpr bool v = true; };

#define KSWZ(row, colB) ((row) * 256 + ((colB) ^ (((row) & 7) << 4)))
#define SBAR() __builtin_amdgcn_sched_barrier(0)
__device__ __forceinline__ int v_st(int k, int c) { const int kk = (k & ~0xC) | ((k & 4) << 1) | ((k & 8) >> 1); return ((kk >> 3) * 4 + (c >> 5)) * 512 + ((kk & 7) * 32 + (c & 31)) * 2; }
__device__ __forceinline__ int v_rd_base(int lane) { return ((lane & 3) << 3) | (((lane >> 2) & 3) << 6) | (((lane >> 4) & 1) << 5) | (((lane >> 5) & 1) << 8); }
constexpr int v_rd_off(int d0, int ks, int half) { return d0 * 512 + ks * 4096 + half * 2048; }
__device__ __forceinline__ int crow(int r, int hi) { return (r & 3) + 8 * (r >> 2) + 4 * hi; }
__device__ __forceinline__ unsigned cvtpk(float lo, float hi) {
    unsigned r; asm volatile("v_cvt_pk_bf16_f32 %0, %1, %2" : "=v"(r) : "v"(lo), "v"(hi)); return r;
}
__device__ __forceinline__ bf16x8 pack8(f32x4 a, f32x4 b) {
    u32x4 w = {cvtpk(a[0], a[1]), cvtpk(a[2], a[3]), cvtpk(b[0], b[1]), cvtpk(b[2], b[3])};
    return *reinterpret_cast<bf16x8*>(&w);
}
template <class T> __device__ __forceinline__ bf16x8 load8(const T* p) {
    if constexpr (same_t<T, float>::v) { return pack8(*(const f32x4*)p, *(const f32x4*)(p + 4)); }
    else { return *reinterpret_cast<const bf16x8*>(p); }
}
__device__ __forceinline__ void mask_tile(f32x16& p0, f32x16& p1, int dq, unsigned W) {
    const float NEG = -__builtin_inff();
#pragma unroll
    for (int r = 0; r < 16; ++r) {
        const int c = (r & 3) + 8 * (r >> 2);
        if ((unsigned)(dq - c) >= W) p0[r] = NEG;
        if ((unsigned)(dq - c - 32) >= W) p1[r] = NEG;
    }
}
__device__ __forceinline__ void partialSM(f32x16& p0, f32x16& p1, float& m_reg, float& mn, float& alpha) {
    float pmax = p0[0]; for (int r = 1; r < 16; ++r) pmax = fmaxf(pmax, p0[r]); for (int r = 0; r < 16; ++r) pmax = fmaxf(pmax, p1[r]);
    { auto rr = __builtin_amdgcn_permlane32_swap(__float_as_uint(pmax), __float_as_uint(pmax), false, false);
      pmax = fmaxf(__uint_as_float(rr[0]), __uint_as_float(rr[1])); }
    constexpr float C2 = 1.4426950408889634f * SCALE;
    if (__builtin_expect(__all((pmax - m_reg) * SCALE <= THR), 1)) { mn = m_reg; alpha = 1.f; }
    else { mn = fmaxf(m_reg, pmax); alpha = __builtin_amdgcn_exp2f((m_reg - mn) * C2); m_reg = mn; }
    const float mnL = -mn * C2;
    for (int r = 0; r < 16; ++r) p0[r] = fmaf(p0[r], C2, mnL); for (int r = 0; r < 16; ++r) p1[r] = fmaf(p1[r], C2, mnL);
    for (int r = 0; r < 16; ++r) p0[r] = __builtin_amdgcn_exp2f(p0[r]);
}
__device__ __forceinline__ void finishSM(f32x16& p0, f32x16& p1, float alpha, float& l_reg, bf16x8& pa0, bf16x8& pa1, bf16x8& pa2, bf16x8& pa3) {
    for (int r = 0; r < 16; ++r) p1[r] = __builtin_amdgcn_exp2f(p1[r]);
    float ps = 0; for (int r = 0; r < 16; ++r) ps += p0[r]; for (int r = 0; r < 16; ++r) ps += p1[r];
    { auto rr = __builtin_amdgcn_permlane32_swap(__float_as_uint(ps), __float_as_uint(ps), false, false);
      ps = __uint_as_float(rr[0]) + __uint_as_float(rr[1]); }
    l_reg = l_reg * alpha + ps;
#define PK4(P, B_, OUT) do { unsigned a0 = cvtpk(P[B_+0], P[B_+1]), a1 = cvtpk(P[B_+2], P[B_+3]);                          \
        unsigned b0 = cvtpk(P[B_+4], P[B_+5]), b1 = cvtpk(P[B_+6], P[B_+7]);                                             \
        auto r0 = __builtin_amdgcn_permlane32_swap(a0, b0, false, false); auto r1 = __builtin_amdgcn_permlane32_swap(a1, b1, false, false); \
        u32x4 w = {r0[0], r1[0], r0[1], r1[1]}; OUT = *reinterpret_cast<bf16x8*>(&w); } while (0)
    PK4(p0, 0, pa0); PK4(p0, 8, pa1); PK4(p1, 0, pa2); PK4(p1, 8, pa3);
#undef PK4
}
template <int KB, bool SK>
__device__ __forceinline__ void qkt(f32x16& p0, f32x16& p1, const char* K_lds, int r32, int hi, const bf16x8* qr, bool act) {
    if (SK && !act) { const float NEG = -__builtin_inff();
#pragma unroll
        for (int r = 0; r < 16; ++r) { p0[r] = NEG; p1[r] = NEG; } return; }
    p0 = f32x16{}; p1 = f32x16{};
    const char* kb[4];
#pragma unroll
    for (int dd = 0; dd < 4; ++dd) kb[dd] = K_lds + KB * SHM_K + KSWZ(r32, (dd * 16 + hi * 8) * 2);
#pragma unroll
    for (int d0 = 0; d0 < 8; ++d0) { const char* a = kb[d0 & 3] + (d0 >> 2) * 128;
        bf16x8 b0 = *reinterpret_cast<const bf16x8*>(a);
        bf16x8 b1 = *reinterpret_cast<const bf16x8*>(a + 32 * 256);
        p0 = __builtin_amdgcn_mfma_f32_32x32x16_bf16(b0, qr[d0], p0, 0, 0, 0);
        p1 = __builtin_amdgcn_mfma_f32_32x32x16_bf16(b1, qr[d0], p1, 0, 0, 0); }
}
template <int VB, bool SK>
__device__ __forceinline__ void pv_tile(f32x16* o, int vb0, bf16x8 pa0, bf16x8 pa1, bf16x8 pa2, bf16x8 pa3, bool act) {
    if (SK && !act) return;
#define TRRD(dst, off) asm volatile("ds_read_b64_tr_b16 %0, %1 offset:%2" : "=&v"(dst) : "v"(vb0), "i"(off) : "memory")
#define PV_D0(d0) do { s16x4 l0, l1, l2, l3, h0, h1, h2, h3; constexpr int b_ = VB * SHM_V + v_rd_off(d0, 0, 0);     \
        TRRD(l0, b_); TRRD(h0, b_ + 2048); TRRD(l1, b_ + 4096); TRRD(h1, b_ + 6144); TRRD(l2, b_ + 8192); TRRD(h2, b_ + 10240); TRRD(l3, b_ + 12288); TRRD(h3, b_ + 14336); \
        asm volatile("s_waitcnt lgkmcnt(0)" ::: "memory"); SBAR();                 \
        o[d0] = __builtin_amdgcn_mfma_f32_32x32x16_bf16(pa0, (bf16x8){l0[0], l0[1], l0[2], l0[3], h0[0], h0[1], h0[2], h0[3]}, o[d0], 0, 0, 0);   \
        o[d0] = __builtin_amdgcn_mfma_f32_32x32x16_bf16(pa1, (bf16x8){l1[0], l1[1], l1[2], l1[3], h1[0], h1[1], h1[2], h1[3]}, o[d0], 0, 0, 0);   \
        o[d0] = __builtin_amdgcn_mfma_f32_32x32x16_bf16(pa2, (bf16x8){l2[0], l2[1], l2[2], l2[3], h2[0], h2[1], h2[2], h2[3]}, o[d0], 0, 0, 0);   \
        o[d0] = __builtin_amdgcn_mfma_f32_32x32x16_bf16(pa3, (bf16x8){l3[0], l3[1], l3[2], l3[3], h3[0], h3[1], h3[2], h3[3]}, o[d0], 0, 0, 0); } while (0)
    PV_D0(0); PV_D0(1); PV_D0(2); PV_D0(3);
#undef PV_D0
#undef TRRD
}

template <class TIn, class TOut> struct BlockRef { const TIn* Q; const TIn* K; const TIn* V; TOut* O; int P0; };
template <class TIn> struct Seam {
    bf16x8 qr[8];
    bf16x8 st_v0, st_v1, st_k0, st_k1; f32x4 sf0, sf1, sf2, sf3;
    f32x4 tq[16];
};
__device__ __forceinline__ int swa_jlo(int P0, int W) { const int lowk = P0 - W + 1; return lowk > 0 ? lowk / KVBLK : 0; }
#define ROW(p, k0, rr) ((p) + (size_t)((k0) + (rr)) * D + sc)
#define VMW() asm volatile("s_waitcnt vmcnt(0)" ::: "memory")
#define VMWN(n) asm volatile("s_waitcnt vmcnt(%0)" :: "i"(n) : "memory")
#define SLOAD_H(Kp, Vp, k0) do { S.st_v0 = load8<TIn>(ROW(Vp, k0, sr)); S.st_v1 = load8<TIn>(ROW(Vp, k0, 32 + sr));              \
                         S.st_k0 = load8<TIn>(ROW(Kp, k0, sr)); S.st_k1 = load8<TIn>(ROW(Kp, k0, 32 + sr)); } while (0)
#define SWRITE_HK(bf) do { *(bf16x8*)(K_lds + (bf) * SHM_K + kws) = S.st_k0; *(bf16x8*)(K_lds + (bf) * SHM_K + kws + 32 * 256) = S.st_k1; } while (0)
#define SWRITE_HV(bf) do { *(bf16x8*)(V_lds + (bf) * SHM_V + vst0) = S.st_v0; *(bf16x8*)(V_lds + (bf) * SHM_V + vst1) = S.st_v1; } while (0)
#define SWRITE_H(bf) do { SWRITE_HV(bf); SWRITE_HK(bf); } while (0)
#define SLOAD_F(p, k0) do { S.sf0 = *(const f32x4*)ROW(p, k0, sr); S.sf1 = *(const f32x4*)(ROW(p, k0, sr) + 4);                \
                            S.sf2 = *(const f32x4*)ROW(p, k0, 32 + sr); S.sf3 = *(const f32x4*)(ROW(p, k0, 32 + sr) + 4); } while (0)
#define SWRITE_KF(bf) do { *(bf16x8*)(K_lds + (bf) * SHM_K + kws) = pack8(S.sf0, S.sf1); *(bf16x8*)(K_lds + (bf) * SHM_K + kws + 32 * 256) = pack8(S.sf2, S.sf3); } while (0)
#define SWRITE_VF(bf) do { *(bf16x8*)(V_lds + (bf) * SHM_V + vst0) = pack8(S.sf0, S.sf1); *(bf16x8*)(V_lds + (bf) * SHM_V + vst1) = pack8(S.sf2, S.sf3); } while (0)
template <class TIn, class TOut>
__device__ __forceinline__ void causal_swa_prime(const BlockRef<TIn, TOut>& cur, int W, char* lds, Seam<TIn>& S, int tid_in) {
    constexpr bool F32 = same_t<TIn, float>::v;
    const int tid = tid_in, wid = __builtin_amdgcn_readfirstlane(tid >> 6), lane = tid & 63, r32 = lane & 31, hi = lane >> 5;
    const int sr = tid >> 4, sc = (tid & 15) * 8, kws = KSWZ(sr, sc * 2); char* K_lds = lds + 2 * SHM_V;
    const int kb0 = swa_jlo(cur.P0, W) * KVBLK;
    for (int d0 = 0; d0 < 8; ++d0) S.qr[d0] = load8<TIn>(cur.Q + (size_t)(wid * QBLK + r32) * D + d0 * 16 + hi * 8);
    if constexpr (F32) { SLOAD_F((const float*)cur.K, kb0); VMW(); SWRITE_KF(0); SBAR(); SLOAD_F((const float*)cur.V, kb0); }
    else { SLOAD_H(cur.K, cur.V, kb0); VMW(); SWRITE_HK(0); }
    __syncthreads();
}
template <class TIn, class TOut>
__device__ __forceinline__ void causal_swa_block(const BlockRef<TIn, TOut>& cur, const BlockRef<TIn, TOut>& nxt, int skv, int W, char* lds, Seam<TIn>& S, int tid_in) {
    constexpr bool F32 = same_t<TIn, float>::v;
    const int tid = tid_in, wid = __builtin_amdgcn_readfirstlane(tid >> 6), lane = tid & 63, r32 = lane & 31, hi = lane >> 5;
    const int j_lo = swa_jlo(cur.P0, W);
    int j_hi = (cur.P0 + QB - 1) / KVBLK + 1; if (j_hi > skv / KVBLK) j_hi = skv / KVBLK;
    const int NT = j_hi - j_lo;
    const int kbn = swa_jlo(nxt.P0, W) * KVBLK;
    const int qlo = cur.P0 + wid * QBLK, qm = qlo + r32 - 4 * hi;
    char* V_lds = lds; char* K_lds = lds + 2 * SHM_V;
    float* ws = (float*)(lds + 2 * SHM_V + 2 * SHM_K) + wid * 64; float* li_l = ws, * al_l = ws + 32;
    float m_reg = -1e30f, l_reg = 0; f32x16 o[4] = {};
    const int sr = tid >> 4, sc = (tid & 15) * 8, vst0 = v_st(sr, sc), vst1 = v_st(32 + sr, sc), kws = KSWZ(sr, sc * 2);
    const int vb0 = (int)(uintptr_t)V_lds + v_rd_base(lane);
    const TIn* Kh = cur.K; const TIn* Vh = cur.V;
#define RESC(a) do { if (__any((a) < 1.f)) { if (hi == 0) al_l[r32] = (a); asm volatile("s_waitcnt lgkmcnt(0)" ::: "memory");              \
                     for (int d_ = 0; d_ < 4; ++d_) for (int r = 0; r < 16; ++r) o[d_][r] *= al_l[crow(r, hi)]; } } while (0)
#define KBASE(t) ((j_lo + (t)) * KVBLK)
#define ACT(t) (KBASE(t) <= qlo + QBLK - 1 && KBASE(t) + KVBLK - 1 >= qlo - W + 1)
#define MASKT(P0_, P1_, t) do { const int kb_ = KBASE(t); if ((!SK || ACT(t)) && (kb_ + KVBLK - 1 > qlo || kb_ <= qlo + QBLK - 1 - W)) mask_tile(P0_, P1_, qm - kb_, (unsigned)W); } while (0)
    constexpr int NQL = F32 ? 16 : 8;
    constexpr bool SK = WSKIP && !F32;
#define SEAM_K0() do { VMWN(NQL); if constexpr (F32) { SWRITE_KF(0); SBAR(); SLOAD_F((const float*)nxt.V, kbn); } else { SWRITE_HK(0); } SBAR(); } while (0)
    f32x16 pA0, pA1, pB0, pB1; float mnA, mnB, alA, alB; bf16x8 pa0, pa1, pa2, pa3;
    if constexpr (F32) { VMW(); SWRITE_VF(0); SBAR(); } else { SWRITE_HV(0); SBAR(); }
    if (NT > 1) { if constexpr (F32) SLOAD_F((const float*)Kh, KBASE(1)); else SLOAD_H(Kh, Vh, KBASE(1)); }
    SBAR(); qkt<0, SK>(pA0, pA1, K_lds, r32, hi, S.qr, ACT(0));
    if constexpr (F32) { if (NT > 1) { VMW(); SWRITE_KF(1); SBAR(); SLOAD_F((const float*)Vh, KBASE(1)); } }
    MASKT(pA0, pA1, 0); partialSM(pA0, pA1, m_reg, mnA, alA);
    if (NT > 1) { VMW(); if constexpr (F32) { SWRITE_VF(1); SBAR(); if (NT > 2) SLOAD_F((const float*)Kh, KBASE(2)); } else SWRITE_H(1); }
    __syncthreads();
#define HALF_STEP(PX0, PX1, mnX, alX, PY0, PY1, alY, t, KB, VB, SB) do {                                                      \
        SBAR(); qkt<KB, SK>(PX0, PX1, K_lds, r32, hi, S.qr, ACT(t));                                             \
        finishSM(PY0, PY1, alY, l_reg, pa0, pa1, pa2, pa3); SBAR();                                                           \
        if ((t) + 1 < NT) { if constexpr (F32) { VMW(); SWRITE_KF(SB); SBAR(); SLOAD_F((const float*)Vh, KBASE((t) + 1)); }  \
                            else { SLOAD_H(Kh, Vh, KBASE((t) + 1)); } SBAR(); }                                               \
        pv_tile<VB, SK>(o, vb0, pa0, pa1, pa2, pa3, ACT((t) - 1)); MASKT(PX0, PX1, (t)); partialSM(PX0, PX1, m_reg, mnX, alX);                                        \
        __syncthreads();                                                                                                      \
        if ((t) + 1 < NT) { VMW(); if constexpr (F32) { SWRITE_VF(SB); SBAR(); if ((t) + 2 < NT) SLOAD_F((const float*)Kh, KBASE((t) + 2)); } \
                            else { SWRITE_H(SB); } }                                                                          \
        RESC(alX); __syncthreads(); } while (0)
    for (int t = 1; t + 1 < NT; t += 2) {
        HALF_STEP(pB0, pB1, mnB, alB, pA0, pA1, alA, t, 1, 0, 0);
        HALF_STEP(pA0, pA1, mnA, alA, pB0, pB1, alB, t + 1, 0, 1, 1);
    }
    const bool even = (NT & 1) == 0;
    if (even) { SBAR(); qkt<1, SK>(pB0, pB1, K_lds, r32, hi, S.qr, ACT(NT - 1)); SBAR(); }
#define QROW(e) (nxt.Q + (size_t)(wid * QBLK + r32) * D + ((e) >> 1) * 16 + hi * 8 + ((e) & 1) * 4)
    if constexpr (F32) { SLOAD_F((const float*)nxt.K, kbn); SBAR();
#pragma unroll
        for (int e = 0; e < 8; ++e) S.tq[e] = *(const f32x4*)QROW(e); }
    else { SLOAD_H(nxt.K, nxt.V, kbn); SBAR();
#pragma unroll
        for (int d0 = 0; d0 < 8; ++d0) S.qr[d0] = load8<TIn>(nxt.Q + (size_t)(wid * QBLK + r32) * D + d0 * 16 + hi * 8); }
    SBAR();
    finishSM(pA0, pA1, alA, l_reg, pa0, pa1, pa2, pa3); SBAR();
    if constexpr (F32) {
#pragma unroll
        for (int e = 8; e < 16; ++e) S.tq[e] = *(const f32x4*)QROW(e); SBAR(); }
#undef QROW
    pv_tile<0, SK>(o, vb0, pa0, pa1, pa2, pa3, ACT(even ? NT - 2 : NT - 1));
    if (even) { MASKT(pB0, pB1, NT - 1); partialSM(pB0, pB1, m_reg, mnB, alB); __syncthreads(); RESC(alB);
        finishSM(pB0, pB1, alB, l_reg, pa0, pa1, pa2, pa3); SBAR(); pv_tile<1, SK>(o, vb0, pa0, pa1, pa2, pa3, ACT(NT - 1)); }
    SBAR(); SEAM_K0();
    if (hi == 0) li_l[r32] = l_reg; asm volatile("s_waitcnt lgkmcnt(0)" ::: "memory");
    float rli[16];
#pragma unroll
    for (int r = 0; r < 16; ++r) rli[r] = __builtin_amdgcn_rcpf(li_l[crow(r, hi)]);
    TOut* Ow = cur.O + (size_t)(wid * QBLK) * D;
    int hi_e = hi; asm volatile("" : "+v"(hi_e));
#pragma unroll
    for (int r = 0; r < 16; ++r) { const int orow = crow(r, hi_e);
#pragma unroll
        for (int d0 = 0; d0 < 4; ++d0) { const float v = o[d0][r] * rli[r];
            if constexpr (same_t<TOut, float>::v) { Ow[(size_t)orow * D + d0 * 32 + r32] = v; }
            else { const float vn = swz_xor<1>(v);
                   if ((r32 & 1) == 0) *(unsigned*)(Ow + (size_t)orow * D + d0 * 32 + r32) = cvtpk(v, vn); } } }
    if constexpr (F32) {
#pragma unroll
        for (int d0 = 0; d0 < 8; ++d0) S.qr[d0] = pack8(S.tq[2 * d0], S.tq[2 * d0 + 1]); }
    __syncthreads();
#undef RESC
#undef KBASE
#undef ACT
#undef MASKT
#undef SEAM_K0
#undef HALF_STEP
}
#undef ROW
#undef VMW
#undef VMWN
#undef SLOAD_H
#undef SWRITE_HK
#undef SWRITE_HV
#undef SWRITE_H
#undef SLOAD_F
#undef SWRITE_KF
#undef SWRITE_VF
#undef SBAR
#undef KSWZ
}
namespace cg = cooperative_groups;
#ifndef MK_DEBUG
#define MK_DEBUG 0
#endif
#define LAS __attribute__((address_space(3)))
typedef unsigned short bf16r;
typedef unsigned v4u __attribute__((ext_vector_type(4)));
typedef unsigned v2u __attribute__((ext_vector_type(2)));
typedef float f32x4 __attribute__((ext_vector_type(4)));
typedef short bf16x8 __attribute__((ext_vector_type(8)));
constexpr int M = 16384, SEQ = 8192, DM = 1024, DFF = 2816, NUP = 5632, NIN = 3072, DEPTH = 4;
constexpr float EPS = 1e-6f;
constexpr size_t MiB = 1u << 20;
constexpr size_t WS_ADA = 1 * MiB, WS_GS = 2 * MiB, WS_SWF = 3 * MiB, WS_SWM = 4 * MiB, WS_SSQP = 5 * MiB, WS_GATES = 6 * MiB, WS_BCUM = 7 * MiB, WS_LOGI = 8 * MiB,
                 WS_SCAL = 9 * MiB, WS_NLOC = 10 * MiB, WS_NST = 11 * MiB, WS_LAM = 12 * MiB;
constexpr size_t WS_W13 = 16 * MiB, WS_W2 = 104 * MiB, WS_WINA = 148 * MiB, WS_WINB = 160 * MiB, WS_WOA = 172 * MiB, WS_WOB = 176 * MiB;
constexpr size_t WS_XS = 180 * MiB, WS_H = 212 * MiB, WS_P = 300 * MiB, WS_Y = 396 * MiB, WS_U = 428 * MiB, WS_CST = 556 * MiB, WS_END = 620 * MiB;
constexpr size_t WS_O = WS_H;
constexpr int LDS_BYTES = 147456;
constexpr int NWAVES = 8;

__device__ __forceinline__ unsigned f2bf(float f) { unsigned u = __builtin_bit_cast(unsigned, f); return (u + 0x7fffu + ((u >> 16) & 1u)) >> 16; }
__device__ __forceinline__ unsigned pk2(float lo, float hi) { return f2bf(lo) | (f2bf(hi) << 16); }
__device__ __forceinline__ float bflo(unsigned w) { return __uint_as_float(w << 16); }
__device__ __forceinline__ float bfhi(unsigned w) { return __uint_as_float(w & 0xffff0000u); }
__device__ __forceinline__ float bf2f(bf16r v) { return __uint_as_float((unsigned)v << 16); }
__device__ __forceinline__ float wave_sum(float v) {
    v += swz_xor<1>(v); v += swz_xor<2>(v); v += swz_xor<4>(v); v += swz_xor<8>(v); v += swz_xor<16>(v); return sum_x32(v);
}
__device__ __forceinline__ float wave_max(float v) {
    v = fmaxf(v, swz_xor<1>(v)); v = fmaxf(v, swz_xor<2>(v)); v = fmaxf(v, swz_xor<4>(v)); v = fmaxf(v, swz_xor<8>(v)); v = fmaxf(v, swz_xor<16>(v)); return max_x32(v);
}
__device__ __forceinline__ float lane_up(float v, int lane, int o) { return __builtin_bit_cast(float, __builtin_amdgcn_ds_bpermute(((lane - o) & 63) << 2, __builtin_bit_cast(int, v))); }
#define LDS_WAIT() asm volatile("s_waitcnt lgkmcnt(0)" ::: "memory")

struct Args { const void* in[19]; float* out; unsigned char* ws; int ph_lo, ph_hi; };
typedef const Args __attribute__((address_space(4)))* KArgs;
struct Ctx { KArgs ka; float* out; unsigned char* ws; int tid, lane, wave, G, wg; };

__device__ __forceinline__ void transpose_item(const float* W, int ldw, int k0, int n0, bf16r* dst  , int Kdst, LAS float* scr, int lane) {
#pragma unroll 8
    for (int i = 0; i < 32; ++i) { const int kk = 2 * i + (lane >> 5); scr[kk * 33 + (lane & 31)] = W[(size_t)(k0 + kk) * ldw + n0 + (lane & 31)]; }
    LDS_WAIT(); asm volatile("" ::: "memory");
    const int c = lane & 7;
#pragma unroll
    for (int j = 0; j < 4; ++j) { const int n = (lane >> 3) + 8 * j; const LAS float* s = scr + (8 * c) * 33 + n;
        v4u o; o.x = pk2(s[0 * 33], s[1 * 33]); o.y = pk2(s[2 * 33], s[3 * 33]); o.z = pk2(s[4 * 33], s[5 * 33]); o.w = pk2(s[6 * 33], s[7 * 33]);
        *(v4u*)(dst + (size_t)n * Kdst + k0 + 8 * c) = o; }
    LDS_WAIT(); asm volatile("" ::: "memory");
}
__device__ __forceinline__ void p0_phase(const Ctx& F, LAS unsigned char* lds) {
#if MK_DEBUG
    if (F.wg == 0 && F.tid == 1) *(unsigned*)(F.ws + 64) = 0u;
#endif
    {
        LAS float* red = (LAS float*)lds;
        float* ADA = (float*)(F.ws + WS_ADA);
        const int l32 = F.tid & 31, kg = F.tid >> 5;
        for (int task = F.wg; task < 4 * 72; task += F.G) {
            const int l = task / 72, col0 = (task % 72) * 128;
            f32x4 a0 = {0.f, 0.f, 0.f, 0.f}, a1 = {0.f, 0.f, 0.f, 0.f};
            const float* wp = ((const float*)F.ka->in[3]) + ((size_t)l * 1024 + kg * 64) * 9216 + col0 + l32 * 4;
#pragma unroll 8
            for (int kk = 0; kk < 64; ++kk) {
                const f32x4 w = *(const f32x4*)(wp + (size_t)kk * 9216);
                const float c0 = ((const float*)F.ka->in[1])[kg * 64 + kk], c1 = ((const float*)F.ka->in[1])[1024 + kg * 64 + kk];
                a0 += w * pg8::silu_f(c0); a1 += w * pg8::silu_f(c1);
            }
            *(LAS f32x4*)(red + (kg * 2 + 0) * 128 + l32 * 4) = a0; *(LAS f32x4*)(red + (kg * 2 + 1) * 128 + l32 * 4) = a1;
            __syncthreads();
            if (F.tid < 256) { const int b = F.tid >> 7, col = F.tid & 127; float s = 0.f;
#pragma unroll
                for (int g = 0; g < 16; ++g) s += red[(g * 2 + b) * 128 + col];
                ADA[(size_t)(l * 2 + b) * 9216 + col0 + col] = s + ((const float*)F.ka->in[4])[(size_t)l * 9216 + col0 + col]; }
            __syncthreads();
        }
    }
    {
        LAS float* scr = (LAS float*)(lds + 16384 + F.wave * 8448);
        const int gw = F.wg * NWAVES + F.wave, NGW = F.G * NWAVES;
        constexpr int I13 = 16 * 176, I2 = 44 * 32, IIN = 16 * 96, IOUT = 16 * 32;
        constexpr int T0 = 8 * I13, T1 = T0 + 8 * I2, T2 = T1 + 2 * IIN, T3 = T2 + 2 * IIN, T4 = T3 + 2 * IOUT, T5 = T4 + 2 * IOUT;
        for (int it = gw; it < T5; it += NGW) {
            if (it < T0) { const int mat = it / I13, r = it % I13, kb = r / 176, n0 = (r % 176) * 32;
                const int drow = n0 < 2816 ? (n0 >> 7) * 256 + (n0 & 127) : ((n0 - 2816) >> 7) * 256 + 128 + ((n0 - 2816) & 127);
                transpose_item(((const float*)F.ka->in[6]) + (size_t)mat * 1024 * 5632, 5632, kb * 64, n0, (bf16r*)(F.ws + WS_W13) + ((size_t)mat * 5632 + drow) * 1024, 1024, scr, F.lane); }
            else if (it < T1) { const int q = it - T0, mat = q / I2, r = q % I2, kb = r / 32, n0 = (r % 32) * 32;
                transpose_item(((const float*)F.ka->in[7]) + (size_t)mat * 2816 * 1024, 1024, kb * 64, n0, (bf16r*)(F.ws + WS_W2) + ((size_t)mat * 1024 + n0) * 2816, 2816, scr, F.lane); }
            else if (it < T2) { const int q = it - T1, mat = q / IIN, r = q % IIN, kb = r / 96, n0 = (r % 96) * 32;
                transpose_item(((const float*)F.ka->in[8]) + (size_t)mat * 1024 * 3080, 3080, kb * 64, n0, (bf16r*)(F.ws + WS_WINA) + ((size_t)mat * 3072 + n0) * 1024, 1024, scr, F.lane); }
            else if (it < T3) { const int q = it - T2, mat = q / IIN, r = q % IIN, kb = r / 96, n0 = (r % 96) * 32;
                transpose_item(((const float*)F.ka->in[14]) + (size_t)mat * 1024 * 3072, 3072, kb * 64, n0, (bf16r*)(F.ws + WS_WINB) + ((size_t)mat * 3072 + n0) * 1024, 1024, scr, F.lane); }
            else if (it < T4) { const int q = it - T3, mat = q / IOUT, r = q % IOUT, kb = r / 32, n0 = (r % 32) * 32;
                transpose_item(((const float*)F.ka->in[13]) + (size_t)mat * 1024 * 1024, 1024, kb * 64, n0, (bf16r*)(F.ws + WS_WOA) + ((size_t)mat * 1024 + n0) * 1024, 1024, scr, F.lane); }
            else { const int q = it - T4, mat = q / IOUT, r = q % IOUT, kb = r / 32, n0 = (r % 32) * 32;
                transpose_item(((const float*)F.ka->in[17]) + (size_t)mat * 1024 * 1024, 1024, kb * 64, n0, (bf16r*)(F.ws + WS_WOB) + ((size_t)mat * 1024 + n0) * 1024, 1024, scr, F.lane); }
        }
    }
}
__device__ __forceinline__ void p1_phase(const Ctx& F) {
    const float* ADA = (const float*)(F.ws + WS_ADA);
    float* GS = (float*)(F.ws + WS_GS);
    const int gw = F.wg * NWAVES + F.wave, NGW = F.G * NWAVES;
    for (int i = F.wg * 512 + F.tid; i < 4 * 3 * 2 * 1024; i += F.G * 512) {
        const int d = i & 1023, b = (i >> 10) & 1, ls = i >> 11, l = ls / 3, sub = ls % 3;
        GS[i] = ((const float*)F.ka->in[5])[(size_t)ls * 1024 + d] * (1.0f + ADA[(size_t)(l * 2 + b) * 9216 + sub * 3072 + 1024 + d]);
    }
    if (F.wg == 0 && F.tid < 2) {
        const float* lm = ((const float*)F.ka->in[15]) + F.tid * 512; float s1 = 0.f, s2 = 0.f;
        for (int k = 0; k < 128; ++k) { s1 += lm[k] * lm[128 + k]; s2 += lm[256 + k] * lm[384 + k]; }
        const float lam_init = F.tid == 0 ? 0.35550906759096934f : 0.5560582041556406f;
        ((float*)(F.ws + WS_LAM))[F.tid] = expf(s1) - expf(s2) + lam_init;
    }
    {
        float* ssqp = (float*)(F.ws + WS_SSQP); bf16r* XS = (bf16r*)(F.ws + WS_XS);
        for (int m = gw; m < M; m += NGW) {
            const int b = m >> 13;
            const f32x4* xr = (const f32x4*)(((const float*)F.ka->in[0]) + (size_t)m * 1024) + F.lane;
            f32x4* orow = (f32x4*)(F.out + (size_t)m * 1024) + F.lane;
            v2u* xsr = (v2u*)(XS + (size_t)m * 1024) + F.lane;
            float ss = 0.f;
#pragma unroll
            for (int j = 0; j < 4; ++j) {
                const f32x4 v = xr[64 * j]; orow[64 * j] = v;
                ss += (v[0] * v[0] + v[1] * v[1]) + (v[2] * v[2] + v[3] * v[3]);
                const int col = 4 * F.lane + 256 * j;
                const f32x4 ng = *(const f32x4*)(((const float*)F.ka->in[5]) + col);
                const f32x4 sc = *(const f32x4*)(ADA + (size_t)b * 9216 + 1024 + col);
                const f32x4 y = v * ng * (sc + 1.0f);
                v2u w; w.x = pk2(y[0], y[1]); w.y = pk2(y[2], y[3]); xsr[64 * j] = w;
            }
            ss = wave_sum(ss);
            if (F.lane < 16) ssqp[(size_t)F.lane * M + m] = F.lane == 0 ? ss : 0.f;
        }
    }
    {
        float* SWF = (float*)(F.ws + WS_SWF); float* SWM = (float*)(F.ws + WS_SWM);
        constexpr int RF = 8 * 5632, RT = RF + 4 * 3072;
        for (int r = gw; r < RT; r += NGW) {
            const bf16r* wt; const float* sh; float* o; int ostride;
            if (r < RF) { const int q = r / 5632, n = r % 5632, l = q >> 1, f = q & 1;
                wt = (const bf16r*)(F.ws + WS_W13) + (size_t)r * 1024; sh = ADA + (size_t)l * 2 * 9216 + (f ? 2 : 0) * 3072; o = SWF + (size_t)q * 2 * 5632 + n; ostride = 5632; }
            else { const int rr = r - RF, l = rr / 3072, n = rr % 3072;
                wt = (const bf16r*)(F.ws + ((l & 1) ? WS_WINB : WS_WINA)) + ((size_t)(l >> 1) * 3072 + n) * 1024; sh = ADA + (size_t)l * 2 * 9216 + 3072; o = SWM + (size_t)l * 2 * 3072 + n; ostride = 3072; }
            const v4u w0 = *(const v4u*)(wt + F.lane * 16), w1 = *(const v4u*)(wt + F.lane * 16 + 8);
            float wv[16] = {bflo(w0.x), bfhi(w0.x), bflo(w0.y), bfhi(w0.y), bflo(w0.z), bfhi(w0.z), bflo(w0.w), bfhi(w0.w),
                            bflo(w1.x), bfhi(w1.x), bflo(w1.y), bfhi(w1.y), bflo(w1.z), bfhi(w1.z), bflo(w1.w), bfhi(w1.w)};
            float s0 = 0.f, s1 = 0.f;
#pragma unroll
            for (int j = 0; j < 4; ++j) {
                const f32x4 h0 = *(const f32x4*)(sh + F.lane * 16 + 4 * j), h1 = *(const f32x4*)(sh + 9216 + F.lane * 16 + 4 * j);
#pragma unroll
                for (int e = 0; e < 4; ++e) { s0 += wv[4 * j + e] * h0[e]; s1 += wv[4 * j + e] * h1[e]; }
            }
            s0 = wave_sum(s0); s1 = wave_sum(s1);
            if (F.lane == 0) { o[0] = s0; o[ostride] = s1; }
        }
    }
}
__device__ __forceinline__ void gates_phase(const Ctx& F, LAS unsigned char* lds, int l) {
    const int j = l >> 1;
    LAS float* wg = (LAS float*)lds;
    LAS float* swg = (LAS float*)(lds + 32768);
    const float* ADA = (const float*)(F.ws + WS_ADA); const float* ssqp = (const float*)(F.ws + WS_SSQP);
    const bf16r* XS = (const bf16r*)(F.ws + WS_XS); float* GT = (float*)(F.ws + WS_GATES);
    const float* src = ((const float*)F.ka->in[8]) + (size_t)j * 1024 * 3080 + 3072;
    for (int ch = F.wg; ch < 256; ch += F.G) {
        const int b = ch >> 7, m0 = ch * 64;
        for (int i = F.tid; i < 8192; i += 512) { const int k = i >> 3, g = i & 7; wg[g * 1024 + k] = src[(size_t)k * 3080 + g]; }
        __syncthreads();
        { const float* sh = ADA + (size_t)(l * 2 + b) * 9216 + 3072; float s = 0.f;
#pragma unroll
          for (int q = 0; q < 16; ++q) s += sh[q * 64 + F.lane] * wg[F.wave * 1024 + q * 64 + F.lane];
          s = wave_sum(s); if (F.lane == 0) swg[F.wave] = s; }
        __syncthreads();
        for (int i = 0; i < 8; ++i) {
            const int row = m0 + F.wave * 8 + i;
            float a[8] = {0.f, 0.f, 0.f, 0.f, 0.f, 0.f, 0.f, 0.f};
#pragma unroll
            for (int q = 0; q < 16; ++q) { const float xv = bf2f(XS[(size_t)row * 1024 + q * 64 + F.lane]);
#pragma unroll
                for (int g = 0; g < 8; ++g) a[g] += xv * wg[g * 1024 + q * 64 + F.lane]; }
            float ss = F.lane < 16 ? ssqp[(size_t)F.lane * M + row] : 0.f; ss = wave_sum(ss);
            const float rs = rsqrtf(ss * (1.0f / 1024.0f) + EPS);
#pragma unroll
            for (int g = 0; g < 8; ++g) { const float s = wave_sum(a[g]); if (F.lane == g) GT[(size_t)row * 8 + g] = s * rs + swg[g]; }
        }
        __syncthreads();
    }
}
__device__ __forceinline__ bf16x8 ldfrag(const LAS bf16r* base, int row0, int stride, int k0, int lane) {
    return *(const LAS bf16x8*)(base + (row0 + (lane & 15)) * stride + k0 + (lane >> 4) * 8);
}
__device__ __forceinline__ void conv8(const bf16r* P, size_t mrow, int ps, int ch0, const float* cw, const float* cb, float scale, float (&o)[8]) {
    float acc[8];
    { const f32x4 b0 = *(const f32x4*)(cb + ch0), b1 = *(const f32x4*)(cb + ch0 + 4); acc[0] = b0[0]; acc[1] = b0[1]; acc[2] = b0[2]; acc[3] = b0[3]; acc[4] = b1[0]; acc[5] = b1[1]; acc[6] = b1[2]; acc[7] = b1[3]; }
#pragma unroll
    for (int jt = 0; jt < 4; ++jt) {
        if (ps - 3 + jt >= 0) {
            const v4u w = *(const v4u*)(P + (mrow - 3 + jt) * 3072 + ch0);
            const f32x4 c0 = *(const f32x4*)(cw + jt * 1024 + ch0), c1 = *(const f32x4*)(cw + jt * 1024 + ch0 + 4);
            acc[0] += bflo(w.x) * c0[0]; acc[1] += bfhi(w.x) * c0[1]; acc[2] += bflo(w.y) * c0[2]; acc[3] += bfhi(w.y) * c0[3];
            acc[4] += bflo(w.z) * c1[0]; acc[5] += bfhi(w.z) * c1[1]; acc[6] += bflo(w.w) * c1[2]; acc[7] += bfhi(w.w) * c1[3];
        }
    }
#pragma unroll
    for (int e = 0; e < 8; ++e) o[e] = pg8::silu_f(acc[e]) * scale;
}
constexpr int VT_STRIDE = 72, QK_STRIDE = 136;
__device__ __forceinline__ void s1_phase(const Ctx& F, LAS unsigned char* lds, int l) {
    const int j = l >> 1;
    LAS bf16r* VT = (LAS bf16r*)lds;
    LAS bf16r* KT = (LAS bf16r*)(lds + 36864);
    LAS float* wS = (LAS float*)(lds + 36864 + 18432);
    const bf16r* P = (const bf16r*)(F.ws + WS_P); const float* GT = (const float*)(F.ws + WS_GATES);
    float* BCUM = (float*)(F.ws + WS_BCUM); float* LOGI = (float*)(F.ws + WS_LOGI); float* BLAST = (float*)(F.ws + WS_SCAL); float* MLOC = BLAST + 16384;
    float* NLOC = (float*)(F.ws + WS_NLOC); float* U = (float*)(F.ws + WS_U);
    const float* cw = ((const float*)F.ka->in[9]) + (size_t)j * 4096; const float* cb = ((const float*)F.ka->in[10]) + (size_t)j * 1024; const float* bif = ((const float*)F.ka->in[11]) + j * 8;
    for (int u = F.wg; u < 1024; u += F.G) {
        const int b = u >> 9, h = (u >> 7) & 3, c = u & 127, bh = b * 4 + h;
        const size_t m0 = (size_t)b * 8192 + c * 64;
        if (F.wave == 0) {
            const int s = F.lane;
            const float gi = GT[(m0 + s) * 8 + h] + bif[h], gf = GT[(m0 + s) * 8 + 4 + h] + bif[4 + h];
            const float lf = fminf(gf, 0.f) - log1pf(expf(-fabsf(gf)));
            float bc = lf;
#pragma unroll
            for (int o = 1; o < 64; o <<= 1) { const float t = lane_up(bc, s, o); if (s >= o) bc += t; }
            const float blast = __builtin_bit_cast(float, __builtin_amdgcn_readlane(__builtin_bit_cast(int, bc), 63));
            const float wl = blast - bc + gi;
            const float mloc = wave_max(wl);
            wS[s] = expf(wl - mloc);
            BCUM[(size_t)bh * 8192 + c * 64 + s] = bc; LOGI[(size_t)bh * 8192 + c * 64 + s] = gi;
            if (s == 0) { BLAST[bh * 128 + c] = blast; MLOC[bh * 128 + c] = mloc; }
        }
        __syncthreads();
        for (int t = F.tid; t < 1024; t += 512) {
            const int cg = t & 15, s = t >> 4; float kv[8];
            conv8(P, m0 + s, c * 64 + s, 512 + h * 128 + cg * 8, cw, cb, 0.08838834764831845f, kv);
            const float w = wS[s];
#pragma unroll
            for (int e = 0; e < 8; ++e) KT[(cg * 8 + e) * VT_STRIDE + s] = (bf16r)f2bf(kv[e] * w);
        }
        for (int t = F.tid; t < 2048; t += 512) {
            const int vg = t & 31, s = t >> 5;
            const v4u w = *(const v4u*)(P + (m0 + s) * 3072 + 1024 + h * 256 + vg * 8);
            LAS bf16r* d = VT + (vg * 8) * VT_STRIDE + s;
            d[0] = (bf16r)(w.x & 0xffffu); d[VT_STRIDE] = (bf16r)(w.x >> 16); d[2 * VT_STRIDE] = (bf16r)(w.y & 0xffffu); d[3 * VT_STRIDE] = (bf16r)(w.y >> 16);
            d[4 * VT_STRIDE] = (bf16r)(w.z & 0xffffu); d[5 * VT_STRIDE] = (bf16r)(w.z >> 16); d[6 * VT_STRIDE] = (bf16r)(w.w & 0xffffu); d[7 * VT_STRIDE] = (bf16r)(w.w >> 16);
        }
        __syncthreads();
        { const int d = F.tid >> 2, q4 = F.tid & 3; float s = 0.f;
#pragma unroll
          for (int e = 0; e < 16; ++e) s += bf2f(KT[d * VT_STRIDE + q4 * 16 + e]);
          s += swz_xor<1>(s); s += swz_xor<2>(s);
          if (q4 == 0) NLOC[(size_t)u * 128 + d] = s; }
        {
            f32x4 acc[2][8];
#pragma unroll
            for (int mt = 0; mt < 2; ++mt)
#pragma unroll
                for (int nt = 0; nt < 8; ++nt) acc[mt][nt] = (f32x4){0.f, 0.f, 0.f, 0.f};
#pragma unroll
            for (int ks = 0; ks < 2; ++ks) {
                bf16x8 av[2];
#pragma unroll
                for (int mt = 0; mt < 2; ++mt) av[mt] = ldfrag(VT, 32 * F.wave + 16 * mt, VT_STRIDE, ks * 32, F.lane);
#pragma unroll
                for (int nt = 0; nt < 8; ++nt) { const bf16x8 bk = ldfrag(KT, 16 * nt, VT_STRIDE, ks * 32, F.lane);
#pragma unroll
                    for (int mt = 0; mt < 2; ++mt) acc[mt][nt] = __builtin_amdgcn_mfma_f32_16x16x32_bf16(bk, av[mt], acc[mt][nt], 0, 0, 0); }
            }
            float* up = U + (size_t)u * 32768;
#pragma unroll
            for (int mt = 0; mt < 2; ++mt)
#pragma unroll
                for (int nt = 0; nt < 8; ++nt) *(f32x4*)(up + (size_t)(32 * F.wave + 16 * mt + (F.lane & 15)) * 128 + 16 * nt + 4 * (F.lane >> 4)) = acc[mt][nt];
        }
        __syncthreads();
    }
}
__device__ __forceinline__ void s2_phase(const Ctx& F) {
    const float* BLAST = (const float*)(F.ws + WS_SCAL); const float* MLOC = BLAST + 16384; float* MST = (float*)(F.ws + WS_SCAL) + 32768;
    const float* U = (const float*)(F.ws + WS_U); const float* NLOC = (const float*)(F.ws + WS_NLOC); float* NST = (float*)(F.ws + WS_NST); bf16r* CST = (bf16r*)(F.ws + WS_CST);
    constexpr int QPB = 8192 + 32;
    for (int q = F.wg * 512 + F.tid; q < 8 * QPB; q += F.G * 512) {
        const int bh = q / QPB, e = q % QPB; const bool isn = e >= 8192;
        f32x4 S = {0.f, 0.f, 0.f, 0.f}; float m = 0.f;
        for (int c0 = 0; c0 < 128; c0 += 8) {
            f32x4 uv[8];
#pragma unroll
            for (int i = 0; i < 8; ++i) { const size_t unit = (size_t)bh * 128 + c0 + i;
                uv[i] = isn ? *(const f32x4*)(NLOC + unit * 128 + (e - 8192) * 4) : *(const f32x4*)(U + unit * 32768 + (size_t)e * 4); }
#pragma unroll
            for (int i = 0; i < 8; ++i) { const int c = c0 + i; const size_t unit = (size_t)bh * 128 + c;
                if (isn) *(f32x4*)(NST + unit * 128 + (e - 8192) * 4) = S;
                else { v2u w; w.x = pk2(S[0], S[1]); w.y = pk2(S[2], S[3]); *(v2u*)(CST + unit * 32768 + (size_t)e * 4) = w; }
                if (e == 0) MST[unit] = m;
                const float bl = BLAST[unit], ml = MLOC[unit];
                const float mn = fmaxf(bl + m, ml);
                const float dec = expf(bl + m - mn), gain = expf(ml - mn);
                S = S * dec + uv[i] * gain; m = mn; }
        }
    }
}
__device__ __forceinline__ void s3_phase(const Ctx& F, LAS unsigned char* lds, int l) {
    const int j = l >> 1;
    LAS bf16r* VT = (LAS bf16r*)lds;
    LAS bf16r* Qs = (LAS bf16r*)(lds + 36864);
    LAS bf16r* Ks = (LAS bf16r*)(lds + 36864 + 17408);
    LAS bf16r* Sw = (LAS bf16r*)(lds + 36864 + 34816);
    LAS float* fa = (LAS float*)(lds + 36864 + 34816 + 9216);
    LAS float* bS = fa, *zS = fa + 64, *mtS = fa + 128, *inS = fa + 192, *dnS = fa + 256, *nS = fa + 320  , *sqS = fa + 448  ;
    const bf16r* P = (const bf16r*)(F.ws + WS_P);
    const float* BCUM = (const float*)(F.ws + WS_BCUM); const float* LOGI = (const float*)(F.ws + WS_LOGI); const float* MST = (const float*)(F.ws + WS_SCAL) + 32768;
    const float* NST = (const float*)(F.ws + WS_NST); const bf16r* CST = (const bf16r*)(F.ws + WS_CST); bf16r* Y = (bf16r*)(F.ws + WS_Y);
    const float* cw = ((const float*)F.ka->in[9]) + (size_t)j * 4096; const float* cb = ((const float*)F.ka->in[10]) + (size_t)j * 1024; const float* ng = ((const float*)F.ka->in[12]) + (size_t)j * 1024;
    const int lane = F.lane, w = F.wave, fr = lane & 15, fq = lane >> 4;
    for (int u = F.wg; u < 1024; u += F.G) {
        const int b = u >> 9, h = (u >> 7) & 3, c = u & 127, bh = b * 4 + h;
        const size_t m0 = (size_t)b * 8192 + c * 64;
        bf16x8 cf[2][4];
#pragma unroll
        for (int nt = 0; nt < 2; ++nt)
#pragma unroll
            for (int ks = 0; ks < 4; ++ks) cf[nt][ks] = *(const bf16x8*)(CST + (size_t)u * 32768 + (size_t)(32 * w + 16 * nt + fr) * 128 + ks * 32 + fq * 8);
        if (w == 0) {
            const int s = lane;
            const float bs = BCUM[(size_t)bh * 8192 + c * 64 + s], li = LOGI[(size_t)bh * 8192 + c * 64 + s], mc = MST[bh * 128 + c];
            const float a = bs + mc, z = li - bs;
            float pm = z;
#pragma unroll
            for (int o = 1; o < 64; o <<= 1) { const float t = lane_up(pm, s, o); if (s >= o) pm = fmaxf(pm, t); }
            const float mt = fmaxf(a, bs + pm);
            bS[s] = bs; zS[s] = z; mtS[s] = mt; inS[s] = expf(a - mt);
        } else if (w <= 2) { const int d = (w - 1) * 64 + lane; nS[d] = NST[(size_t)u * 128 + d]; }
        for (int t = F.tid; t < 2048; t += 512) {
            const int cg = t & 15, s = (t >> 4) & 63, isk = t >> 10; float kv[8];
            conv8(P, m0 + s, c * 64 + s, isk * 512 + h * 128 + cg * 8, cw, cb, isk ? 0.08838834764831845f : 1.0f, kv);
            v4u o; o.x = pk2(kv[0], kv[1]); o.y = pk2(kv[2], kv[3]); o.z = pk2(kv[4], kv[5]); o.w = pk2(kv[6], kv[7]);
            *(LAS v4u*)((isk ? Ks : Qs) + s * QK_STRIDE + cg * 8) = o;
        }
        for (int t = F.tid; t < 2048; t += 512) {
            const int vg = t & 31, s = t >> 5;
            const v4u wv = *(const v4u*)(P + (m0 + s) * 3072 + 1024 + h * 256 + vg * 8);
            LAS bf16r* d = VT + (vg * 8) * VT_STRIDE + s;
            d[0] = (bf16r)(wv.x & 0xffffu); d[VT_STRIDE] = (bf16r)(wv.x >> 16); d[2 * VT_STRIDE] = (bf16r)(wv.y & 0xffffu); d[3 * VT_STRIDE] = (bf16r)(wv.y >> 16);
            d[4 * VT_STRIDE] = (bf16r)(wv.z & 0xffffu); d[5 * VT_STRIDE] = (bf16r)(wv.z >> 16); d[6 * VT_STRIDE] = (bf16r)(wv.w & 0xffffu); d[7 * VT_STRIDE] = (bf16r)(wv.w >> 16);
        }
        __syncthreads();
        {
            const int tt = w >> 1;
            const int t = 16 * tt + fr; const float bt = bS[t], mt = mtS[t];
#pragma unroll
            for (int i = 0; i < 2; ++i) {
                const int st = 2 * (w & 1) + i;
                f32x4 acc = {0.f, 0.f, 0.f, 0.f};
                if (st <= tt) {
#pragma unroll
                    for (int ks = 0; ks < 4; ++ks) acc = __builtin_amdgcn_mfma_f32_16x16x32_bf16(ldfrag(Ks, 16 * st, QK_STRIDE, ks * 32, lane), ldfrag(Qs, 16 * tt, QK_STRIDE, ks * 32, lane), acc, 0, 0, 0);
                }
                float o[4];
#pragma unroll
                for (int e = 0; e < 4; ++e) { const int s = 16 * st + 4 * fq + e; o[e] = (s <= t) ? acc[e] * expf(bt + zS[s] - mt) : 0.f; }
                v2u pw; pw.x = pk2(o[0], o[1]); pw.y = pk2(o[2], o[3]);
                *(LAS v2u*)(Sw + t * VT_STRIDE + 16 * st + 4 * fq) = pw;
            }
        }
        __syncthreads();
        { const int t = F.tid >> 3, part = F.tid & 7; float rsum = 0.f, qn = 0.f;
#pragma unroll
          for (int e = 0; e < 8; ++e) rsum += bf2f(Sw[t * VT_STRIDE + part * 8 + e]);
#pragma unroll
          for (int e = 0; e < 16; ++e) qn += bf2f(Qs[t * QK_STRIDE + part * 16 + e]) * nS[part * 16 + e];
          rsum += swz_xor<1>(rsum); rsum += swz_xor<2>(rsum); rsum += swz_xor<4>(rsum);
          qn += swz_xor<1>(qn); qn += swz_xor<2>(qn); qn += swz_xor<4>(qn);
          if (part == 0) { const float den = inS[t] * qn + rsum; dnS[t] = 1.0f / fmaxf(fabsf(den), expf(-mtS[t])); } }
        f32x4 a1[4][2], a2[4][2];
#pragma unroll
        for (int mt = 0; mt < 4; ++mt)
#pragma unroll
            for (int nt = 0; nt < 2; ++nt) { a1[mt][nt] = (f32x4){0.f, 0.f, 0.f, 0.f}; a2[mt][nt] = (f32x4){0.f, 0.f, 0.f, 0.f}; }
#pragma unroll
        for (int ks = 0; ks < 4; ++ks)
#pragma unroll
            for (int mt = 0; mt < 4; ++mt) { const bf16x8 qf = ldfrag(Qs, 16 * mt, QK_STRIDE, ks * 32, lane);
#pragma unroll
                for (int nt = 0; nt < 2; ++nt) a1[mt][nt] = __builtin_amdgcn_mfma_f32_16x16x32_bf16(cf[nt][ks], qf, a1[mt][nt], 0, 0, 0); }
#pragma unroll
        for (int ks = 0; ks < 2; ++ks) {
            bf16x8 vf[2];
#pragma unroll
            for (int nt = 0; nt < 2; ++nt) vf[nt] = ldfrag(VT, 32 * w + 16 * nt, VT_STRIDE, ks * 32, lane);
#pragma unroll
            for (int mt = 0; mt < 4; ++mt) { const bf16x8 sf = ldfrag(Sw, 16 * mt, VT_STRIDE, ks * 32, lane);
#pragma unroll
                for (int nt = 0; nt < 2; ++nt) a2[mt][nt] = __builtin_amdgcn_mfma_f32_16x16x32_bf16(vf[nt], sf, a2[mt][nt], 0, 0, 0); }
        }
        __syncthreads();
#pragma unroll
        for (int mt = 0; mt < 4; ++mt) {
            const int t = 16 * mt + fr; const float it = inS[t], dn = dnS[t]; float ss = 0.f;
#pragma unroll
            for (int nt = 0; nt < 2; ++nt) { a1[mt][nt] = (a1[mt][nt] * it + a2[mt][nt]) * dn;
                ss += (a1[mt][nt][0] * a1[mt][nt][0] + a1[mt][nt][1] * a1[mt][nt][1]) + (a1[mt][nt][2] * a1[mt][nt][2] + a1[mt][nt][3] * a1[mt][nt][3]); }
            ss += swz_xor<16>(ss); ss = sum_x32(ss);
            if (fq == 0) sqS[w * 64 + t] = ss;
        }
        __syncthreads();
#pragma unroll
        for (int mt = 0; mt < 4; ++mt) {
            const int t = 16 * mt + fr; float tot = 0.f;
#pragma unroll
            for (int ww = 0; ww < 8; ++ww) tot += sqS[ww * 64 + t];
            const float r = rsqrtf(tot * (1.0f / 256.0f) + EPS);
#pragma unroll
            for (int nt = 0; nt < 2; ++nt) {
                const int vv = 32 * w + 16 * nt + 4 * fq;
                const v2u ow = *(const v2u*)(P + (m0 + t) * 3072 + 2048 + h * 256 + vv);
                const f32x4 g = *(const f32x4*)(ng + h * 256 + vv);
                const float o0 = bflo(ow.x), o1 = bfhi(ow.x), o2 = bflo(ow.y), o3 = bfhi(ow.y);
                const f32x4 hv = a1[mt][nt] * r * g;
                v2u yw; yw.x = pk2(hv[0] * __builtin_amdgcn_rcpf(1.0f + __expf(-o0)), hv[1] * __builtin_amdgcn_rcpf(1.0f + __expf(-o1)));
                yw.y = pk2(hv[2] * __builtin_amdgcn_rcpf(1.0f + __expf(-o2)), hv[3] * __builtin_amdgcn_rcpf(1.0f + __expf(-o3)));
                *(v2u*)(Y + (m0 + t) * 1024 + h * 256 + vv) = yw;
            }
        }
        __syncthreads();
    }
}
__device__ __forceinline__ att::BlockRef<att::bf16, att::bf16> attn_ref(int L, int pass, const att::bf16* Qb, const att::bf16* Kb, const att::bf16* Vb, att::bf16* Ob) {
    const int hd = L >> 4, y = L & 15, qb = pass ? 31 - y : y;
    const int b = hd >> 4, h = (hd >> 2) & 3, c = (hd >> 1) & 1, vh = hd & 1;
    att::BlockRef<att::bf16, att::bf16> r;
    r.Q = Qb + ((size_t)(b * 8 + h * 2 + c) * 8192 + (size_t)qb * 256) * 128;
    r.K = Kb + (size_t)(b * 8 + h * 2 + c) * 8192 * 128;
    r.V = Vb + (size_t)(b * 8 + h * 2 + vh) * 8192 * 128;
    r.O = Ob + ((size_t)hd * 8192 + (size_t)qb * 256) * 128;
    r.P0 = qb * 256;
    return r;
}
__device__ __forceinline__ void attn_phase(const Ctx& F, char* lds) {
    const att::bf16* Qb = (const att::bf16*)(F.ws + WS_P); const att::bf16* Kb = Qb + 16777216; const att::bf16* Vb = Kb + 16777216; att::bf16* Ob = (att::bf16*)(F.ws + WS_O);
    constexpr int total = 512; const int stride = F.G;
    int L = F.wg; if (L >= total) return;
    int pass = 0;
    att::BlockRef<att::bf16, att::bf16> cur = attn_ref(L, 0, Qb, Kb, Vb, Ob);
    att::Seam<att::bf16> S;
    att::causal_swa_prime<att::bf16, att::bf16>(cur, 8192, lds, S, F.tid);
    for (;;) {
        const bool more_pass = pass == 0, more_item = L + stride < total, last = !more_pass && !more_item;
        int passn = pass + 1, Ln = L;
        if (!more_pass) { passn = 0; Ln = more_item ? L + stride : L; }
        const att::BlockRef<att::bf16, att::bf16> nxt = last ? cur : attn_ref(Ln, passn, Qb, Kb, Vb, Ob);
        att::causal_swa_block<att::bf16, att::bf16>(cur, nxt, 8192, 8192, lds, S, F.tid);
        if (last) break;
        cur = nxt; pass = passn; L = Ln;
    }
}
__device__ __forceinline__ void combine_phase(const Ctx& F, int l) {
    const int j = l >> 1;
    const bf16r* Ob = (const bf16r*)(F.ws + WS_O); bf16r* Y = (bf16r*)(F.ws + WS_Y);
    const float lam = ((const float*)(F.ws + WS_LAM))[j];
    const float omi = 1.0f - (j == 0 ? 0.35550906759096934f : 0.5560582041556406f);
    const float* ng = ((const float*)F.ka->in[16]) + j * 256;
    const int gw = F.wg * NWAVES + F.wave, NGW = F.G * NWAVES;
    const int vv = F.lane * 4, vh = vv >> 7, dd = vv & 127;
    const f32x4 g = *(const f32x4*)(ng + vv);
    for (int task = gw; task < M * 4; task += NGW) {
        const int m = task >> 2, h = task & 3, b = m >> 13, s = m & 8191;
        const int hd0 = ((b * 4 + h) * 2 + 0) * 2 + vh, hd1 = hd0 + 2;
        const v2u w0 = *(const v2u*)(Ob + ((size_t)hd0 * 8192 + s) * 128 + dd), w1 = *(const v2u*)(Ob + ((size_t)hd1 * 8192 + s) * 128 + dd);
        f32x4 o = {bflo(w0.x) - lam * bflo(w1.x), bfhi(w0.x) - lam * bfhi(w1.x), bflo(w0.y) - lam * bflo(w1.y), bfhi(w0.y) - lam * bfhi(w1.y)};
        const float ss = wave_sum((o[0] * o[0] + o[1] * o[1]) + (o[2] * o[2] + o[3] * o[3]));
        const float r = rsqrtf(ss * (1.0f / 256.0f) + EPS) * omi;
        o = o * r * g;
        v2u yw; yw.x = pk2(o[0], o[1]); yw.y = pk2(o[2], o[3]);
        *(v2u*)(Y + (size_t)m * 1024 + h * 256 + vv) = yw;
    }
}
__device__ __forceinline__ void final_phase(const Ctx& F) {
    const float* ssqp = (const float*)(F.ws + WS_SSQP);
    const int gw = F.wg * NWAVES + F.wave, NGW = F.G * NWAVES;
    for (int m = gw; m < M; m += NGW) {
        float ss = F.lane < 16 ? ssqp[(size_t)F.lane * M + m] : 0.f; ss = wave_sum(ss);
        const float rs = rsqrtf(ss * (1.0f / 1024.0f) + EPS);
        f32x4* orow = (f32x4*)(F.out + (size_t)m * 1024) + F.lane;
#pragma unroll
        for (int jj = 0; jj < 4; ++jj) { const f32x4 g = *(const f32x4*)(((const float*)F.ka->in[18]) + 4 * F.lane + 256 * jj); orow[64 * jj] = orow[64 * jj] * rs * g; }
    }
}

#if MK_DEBUG
#ifndef DBG_SET
#define DBG_SET 0
#endif
__device__ __forceinline__ void dbg_flag(const Ctx& F, bool bad, unsigned code) {
    int bit = -1;
    switch (code) { case 30: bit = 0; break; case 8: case 31: case 9: bit = 1; break; case 10: bit = 2; break; case 11: bit = 3; break; case 13: case 14: case 15: bit = 4; break;
                    case 16: case 17: bit = 5; break; case 18: bit = 6; break; case 19: bit = 7; break; case 20: bit = 8; break; case 21: bit = 9; break; case 23: bit = 10; break; default: break; }
    if (bad && bit >= 0) atomicOr((unsigned*)(F.ws + 64), 1u << bit);
}
__device__ __forceinline__ bool dbg_ne(float got, float ref) { return !(fabsf(got - ref) <= 0.03f * fabsf(ref) + 0.03f); }
__device__ __forceinline__ unsigned dbg_hash(unsigned i) { i = i * 2654435761u + 12345u; i ^= i >> 15; i *= 2246822519u; i ^= i >> 13; i *= 3266489917u; i ^= i >> 16; return i; }
__device__ __forceinline__ float dbg_rstd(const Ctx& F, int m) { const float* ssqp = (const float*)(F.ws + WS_SSQP); float s = 0.f; for (int p = 0; p < 16; ++p) s += ssqp[(size_t)p * M + m]; return rsqrtf(s * (1.0f / 1024.0f) + EPS); }
__device__ __forceinline__ float dbg_silu(float g) { return g / (1.0f + expf(-g)); }
__device__ __forceinline__ void dbg_check_p0(const Ctx& F) {
    if (F.wg != 0) return;
    const unsigned r = dbg_hash(F.tid);
    const float* ADA = (const float*)(F.ws + WS_ADA);
    { const float t = wave_sum((float)(F.lane + 1)), t2 = wave_max((float)((F.lane * 37) & 63)); dbg_flag(F, t != 2080.0f || t2 != 63.0f, 30); }
    { const int l = r % 4, b = (r >> 2) & 1, j = (r >> 3) % 9216; float ref = ((const float*)F.ka->in[4])[(size_t)l * 9216 + j];
      for (int k = 0; k < 1024; ++k) ref += dbg_silu(((const float*)F.ka->in[1])[b * 1024 + k]) * ((const float*)F.ka->in[3])[((size_t)l * 1024 + k) * 9216 + j];
      dbg_flag(F, dbg_ne(ADA[(size_t)(l * 2 + b) * 9216 + j], ref), 1); }
    { const int mat = r % 8, k = (r >> 3) % 1024, n = (r >> 13) % 5632; const float src = ((const float*)F.ka->in[6])[((size_t)mat * 1024 + k) * 5632 + n];
      const int drow = n < 2816 ? (n >> 7) * 256 + (n & 127) : ((n - 2816) >> 7) * 256 + 128 + ((n - 2816) & 127);
      dbg_flag(F, dbg_ne(bf2f(((const bf16r*)(F.ws + WS_W13))[((size_t)mat * 5632 + drow) * 1024 + k]), src), 2); }
    { const int mat = r % 8, k = (r >> 3) % 2816, n = (r >> 15) % 1024; const float src = ((const float*)F.ka->in[7])[((size_t)mat * 2816 + k) * 1024 + n];
      dbg_flag(F, dbg_ne(bf2f(((const bf16r*)(F.ws + WS_W2))[((size_t)mat * 1024 + n) * 2816 + k]), src), 3); }
    { const int mat = r % 2, k = (r >> 1) % 1024, n = (r >> 11) % 3072; const float src = ((const float*)F.ka->in[8])[((size_t)mat * 1024 + k) * 3080 + n];
      dbg_flag(F, dbg_ne(bf2f(((const bf16r*)(F.ws + WS_WINA))[((size_t)mat * 3072 + n) * 1024 + k]), src), 4); }
    { const int mat = r % 2, k = (r >> 1) % 1024, n = (r >> 11) % 3072; const float src = ((const float*)F.ka->in[14])[((size_t)mat * 1024 + k) * 3072 + n];
      dbg_flag(F, dbg_ne(bf2f(((const bf16r*)(F.ws + WS_WINB))[((size_t)mat * 3072 + n) * 1024 + k]), src), 5); }
    { const int mat = r % 2, k = (r >> 1) % 1024, n = (r >> 11) % 1024; const float sa = ((const float*)F.ka->in[13])[((size_t)mat * 1024 + k) * 1024 + n], sb = ((const float*)F.ka->in[17])[((size_t)mat * 1024 + k) * 1024 + n];
      dbg_flag(F, dbg_ne(bf2f(((const bf16r*)(F.ws + WS_WOA))[((size_t)mat * 1024 + n) * 1024 + k]), sa) || dbg_ne(bf2f(((const bf16r*)(F.ws + WS_WOB))[((size_t)mat * 1024 + n) * 1024 + k]), sb), 6); }
}
__device__ __forceinline__ void dbg_check_p1(const Ctx& F) {
    if (F.wg != 0) return;
    const unsigned r = dbg_hash(F.tid + 1000);
    const float* ADA = (const float*)(F.ws + WS_ADA);
    { const int m = r % 16384, col = (r >> 14) % 1024, b = m >> 13;
      const float ref = ((const float*)F.ka->in[0])[(size_t)m * 1024 + col] * ((const float*)F.ka->in[5])[col] * (1.0f + ADA[(size_t)b * 9216 + 1024 + col]);
      dbg_flag(F, dbg_ne(bf2f(((const bf16r*)(F.ws + WS_XS))[(size_t)m * 1024 + col]), ref) || dbg_ne(F.out[(size_t)m * 1024 + col], ((const float*)F.ka->in[0])[(size_t)m * 1024 + col]), 7); }
    { const int q = r % 8, b = (r >> 3) & 1, n = (r >> 4) % 5632, l = q >> 1, f = q & 1; float ref = 0.f;
      for (int k = 0; k < 1024; ++k) ref += ADA[(size_t)(l * 2 + b) * 9216 + (f ? 2 : 0) * 3072 + k] * bf2f(((const bf16r*)(F.ws + WS_W13))[((size_t)q * 5632 + n) * 1024 + k]);
      dbg_flag(F, dbg_ne(((const float*)(F.ws + WS_SWF))[(size_t)(q * 2 + b) * 5632 + n], ref), b ? 31 : 8); }
    { const int l = r % 4, b = (r >> 2) & 1, n = (r >> 3) % 3072; const bf16r* W = (const bf16r*)(F.ws + ((l & 1) ? WS_WINB : WS_WINA)) + ((size_t)(l >> 1) * 3072 + n) * 1024; float ref = 0.f;
      for (int k = 0; k < 1024; ++k) ref += ADA[(size_t)(l * 2 + b) * 9216 + 3072 + k] * bf2f(W[k]);
      dbg_flag(F, dbg_ne(((const float*)(F.ws + WS_SWM))[(size_t)(l * 2 + b) * 3072 + n], ref), 9); }
    { const int m = r % 16384; float s = 0.f; for (int k = 0; k < 1024; ++k) { const float v = ((const float*)F.ka->in[0])[(size_t)m * 1024 + k]; s += v * v; }
      const float rs = rsqrtf(s * (1.0f / 1024.0f) + EPS); dbg_flag(F, fabsf(dbg_rstd(F, m) - rs) > 1e-3f * rs, 10); }
}
__device__ __forceinline__ void dbg_check_up(const Ctx& F) {
    if (F.wg != 0) return;
    const unsigned r = dbg_hash(F.tid + 2000);
    const int m = r % 16384, n = (r >> 14) % 2816, b = m >> 13, grow = (n >> 7) * 256 + (n & 127), urow = grow + 128;
    const float rs = dbg_rstd(F, m); const bf16r* XS = (const bf16r*)(F.ws + WS_XS) + (size_t)m * 1024; const bf16r* W = (const bf16r*)(F.ws + WS_W13);
    float g = 0.f, u = 0.f;
    for (int k = 0; k < 1024; ++k) { const float xv = bf2f(XS[k]); g += xv * bf2f(W[(size_t)grow * 1024 + k]); u += xv * bf2f(W[(size_t)urow * 1024 + k]); }
    const float* SWF = (const float*)(F.ws + WS_SWF) + (size_t)b * 5632;
    g = g * rs + SWF[grow]; u = u * rs + SWF[urow];
    dbg_flag(F, dbg_ne(bf2f(((const bf16r*)(F.ws + WS_H))[(size_t)m * 2816 + n]), dbg_silu(g) * u), 11);
}
__device__ __forceinline__ void dbg_check_down(const Ctx& F) {
    if (F.wg != 0) return;
    const unsigned r = dbg_hash(F.tid + 3000);
    const int m = r % 16384, n = (r >> 14) % 1024, b = m >> 13;
    const bf16r* H = (const bf16r*)(F.ws + WS_H) + (size_t)m * 2816; const bf16r* W = (const bf16r*)(F.ws + WS_W2) + (size_t)n * 2816;
    float d = 0.f; for (int k = 0; k < 2816; ++k) d += bf2f(H[k]) * bf2f(W[k]);
    const float* ADA = (const float*)(F.ws + WS_ADA);
    const float ref = ((const float*)F.ka->in[0])[(size_t)m * 1024 + n] + 0.5f * ADA[(size_t)b * 9216 + 2048 + n] * d, got = F.out[(size_t)m * 1024 + n];
    dbg_flag(F, dbg_ne(got, ref), 13);
    dbg_flag(F, dbg_ne(bf2f(((const bf16r*)(F.ws + WS_XS))[(size_t)m * 1024 + n]), got * ((const float*)(F.ws + WS_GS))[(size_t)(0 * 3 + 1) * 2048 + b * 1024 + n]), 14);
    float s = 0.f; for (int k = 0; k < 1024; ++k) { const float v = F.out[(size_t)m * 1024 + k]; s += v * v; }
    const float rs = rsqrtf(s * (1.0f / 1024.0f) + EPS); dbg_flag(F, fabsf(dbg_rstd(F, m) - rs) > 1e-3f * rs, 15);
}
__device__ __forceinline__ float dbg_inproj(const Ctx& F, int l, int m, int n) {
    const int b = m >> 13; const float rs = dbg_rstd(F, m);
    const bf16r* XS = (const bf16r*)(F.ws + WS_XS) + (size_t)m * 1024; const bf16r* W = (const bf16r*)(F.ws + ((l & 1) ? WS_WINB : WS_WINA)) + ((size_t)(l >> 1) * 3072 + n) * 1024;
    float a = 0.f; for (int k = 0; k < 1024; ++k) a += bf2f(XS[k]) * bf2f(W[k]);
    return a * rs + ((const float*)(F.ws + WS_SWM))[(size_t)(l * 2 + b) * 3072 + n];
}
__device__ __forceinline__ void dbg_check_inproj0(const Ctx& F) {
    if (F.wg != 0) return;
    const unsigned r = dbg_hash(F.tid + 4000);
    const int m = r % 16384, n = (r >> 14) % 3072, b = m >> 13;
    dbg_flag(F, dbg_ne(bf2f(((const bf16r*)(F.ws + WS_P))[(size_t)m * 3072 + n]), dbg_inproj(F, 0, m, n)), 16);
    const int g = n & 7; const float rs = dbg_rstd(F, m); const bf16r* XS = (const bf16r*)(F.ws + WS_XS) + (size_t)m * 1024; const float* ADA = (const float*)(F.ws + WS_ADA);
    float a = 0.f, sgw = 0.f; for (int k = 0; k < 1024; ++k) { const float w = ((const float*)F.ka->in[8])[(size_t)k * 3080 + 3072 + g]; a += bf2f(XS[k]) * w; sgw += ADA[(size_t)b * 9216 + 3072 + k] * w; }
    dbg_flag(F, dbg_ne(((const float*)(F.ws + WS_GATES))[(size_t)m * 8 + g], a * rs + sgw), 17);
}
__device__ __forceinline__ void dbg_check_inproj1(const Ctx& F) {
    if (F.wg != 0) return;
    const unsigned r = dbg_hash(F.tid + 5000);
    const int m = r % 16384, n = (r >> 14) % 3072, b = m >> 13, s = m & 8191, blk = n >> 7, d = n & 127, which = blk >> 3, idx = blk & 7;
    float ref = dbg_inproj(F, 1, m, n);
    if (which < 2 && d < 32) {
        const int fi = d & 15; const float other = dbg_inproj(F, 1, m, d < 16 ? n + 16 : n - 16);
        const float a = (float)((const int*)F.ka->in[2])[m] * pg8::ROPE_INVF[fi];
        const float kk = rintf(a * 0.15915494309189535f); float rr = fmaf(-kk, 6.2831854820251465f, a); rr = fmaf(-kk, -1.7484555314695172e-07f, rr);
        const float c = __cosf(rr), sn = __sinf(rr);
        ref = d < 16 ? ref * c - other * sn : ref * c + other * sn;
    }
    dbg_flag(F, dbg_ne(bf2f(((const bf16r*)(F.ws + WS_P))[(size_t)which * 16777216 + ((size_t)(b * 8 + idx) * 8192 + s) * 128 + d]), ref), 20);
}
__device__ __forceinline__ void dbg_check_mlstm(const Ctx& F, LAS unsigned char* lds) {
    if (F.wg != 0) return;
    LAS float* C = (LAS float*)lds;
    LAS float* qs = C + 32768, *ks = qs + 128, *vs = ks + 128, *nn = vs + 256, *hv = nn + 128, *red = hv + 256;
    const int h = 1, tid = F.tid;
    const bf16r* P = (const bf16r*)(F.ws + WS_P); const float* GT = (const float*)(F.ws + WS_GATES); const bf16r* Y = (const bf16r*)(F.ws + WS_Y);
    const float* cw = (const float*)F.ka->in[9]; const float* cb = (const float*)F.ka->in[10]; const float* bif = (const float*)F.ka->in[11]; const float* ng = (const float*)F.ka->in[12];
    for (int i = tid; i < 32768; i += 512) C[i] = 0.f;
    if (tid < 128) nn[tid] = 0.f;
    float mstate = 0.f;
    __syncthreads();
    for (int t = 0; t < 160; ++t) {
        if (tid < 256) { const int isk = tid >> 7, d = tid & 127, ch = isk * 512 + h * 128 + d; float a = cb[ch];
            for (int jt = 0; jt < 4; ++jt) if (t - 3 + jt >= 0) a += cw[jt * 1024 + ch] * bf2f(P[(size_t)(t - 3 + jt) * 3072 + ch]);
            a = dbg_silu(a); if (isk) ks[d] = a * 0.08838834764831845f; else qs[d] = a; }
        else { const int v = tid - 256; vs[v] = bf2f(P[(size_t)t * 3072 + 1024 + h * 256 + v]); }
        __syncthreads();
        const float li = GT[(size_t)t * 8 + h] + bif[h], gf = GT[(size_t)t * 8 + 4 + h] + bif[4 + h];
        const float lf = fminf(gf, 0.f) - log1pf(expf(-fabsf(gf)));
        const float mn = fmaxf(lf + mstate, li), fd = expf(lf + mstate - mn), ig = expf(li - mn);
        for (int i = tid; i < 32768; i += 512) { const int v = i >> 7, d = i & 127; C[i] = fd * C[i] + ig * vs[v] * ks[d]; }
        if (tid < 128) nn[tid] = fd * nn[tid] + ig * ks[tid];
        mstate = mn;
        __syncthreads();
        float den = 0.f; for (int d = 0; d < 128; ++d) den += nn[d] * qs[d];
        const float dn = 1.0f / fmaxf(fabsf(den), expf(-mn));
        { const int v = tid >> 1, half = tid & 1; float a = 0.f; for (int d = 0; d < 64; ++d) a += C[v * 128 + half * 64 + d] * qs[half * 64 + d];
          a += swz_xor<1>(a); if (half == 0) hv[v] = a * dn; }
        __syncthreads();
        float ss = 0.f; for (int v = 0; v < 256; ++v) ss += hv[v] * hv[v];
        const float rr = rsqrtf(ss * (1.0f / 256.0f) + EPS);
        if (tid < 256) { const int v = tid; const float o = bf2f(P[(size_t)t * 3072 + 2048 + h * 256 + v]);
            const float ref = hv[v] * rr * ng[h * 256 + v] / (1.0f + expf(-o));
            dbg_flag(F, dbg_ne(bf2f(Y[(size_t)t * 1024 + h * 256 + v]), ref), t < 64 ? 18 : 19); }
        __syncthreads();
    }
}
__device__ __forceinline__ void dbg_check_attn(const Ctx& F) {
    if (F.wg >= 8) return;
    const bf16r* Qb = (const bf16r*)(F.ws + WS_P); const bf16r* Kb = Qb + 16777216; const bf16r* Vb = Kb + 16777216; const bf16r* Ob = (const bf16r*)(F.ws + WS_O);
    const unsigned r = dbg_hash(F.wg * 8 + F.wave + 6000);
    const int hd = r % 32, row = (F.wave == 0) ? (int)((r >> 5) % 300) : (int)((r >> 5) % 8192);
    const int b = hd >> 4, h = (hd >> 2) & 3, c = (hd >> 1) & 1, vh = hd & 1, lane = F.lane;
    const bf16r* q = Qb + ((size_t)(b * 8 + h * 2 + c) * 8192 + row) * 128; const bf16r* K = Kb + (size_t)(b * 8 + h * 2 + c) * 8192 * 128; const bf16r* V = Vb + (size_t)(b * 8 + h * 2 + vh) * 8192 * 128;
    const float q0 = bf2f(q[lane * 2]), q1 = bf2f(q[lane * 2 + 1]);
    float mx = -1e30f, l = 0.f, o0 = 0.f, o1 = 0.f;
    for (int jk = 0; jk <= row; ++jk) {
        float sc = q0 * bf2f(K[(size_t)jk * 128 + lane * 2]) + q1 * bf2f(K[(size_t)jk * 128 + lane * 2 + 1]); sc = wave_sum(sc) * 0.08838834764831845f;
        const float mn = fmaxf(mx, sc), al = expf(mx - mn), p = expf(sc - mn);
        l = l * al + p; o0 = o0 * al + p * bf2f(V[(size_t)jk * 128 + lane * 2]); o1 = o1 * al + p * bf2f(V[(size_t)jk * 128 + lane * 2 + 1]); mx = mn;
    }
    const bf16r* O = Ob + ((size_t)hd * 8192 + row) * 128;
    dbg_flag(F, dbg_ne(bf2f(O[lane * 2]), o0 / l) || dbg_ne(bf2f(O[lane * 2 + 1]), o1 / l), 21);
}
__device__ __forceinline__ void dbg_check_combine(const Ctx& F) {
    if (F.wg != 0) return;
    const unsigned r = dbg_hash(F.tid + 7000);
    const int m = r % 16384, h = (r >> 14) & 3, vv = (r >> 16) & 255, b = m >> 13, s = m & 8191;
    const bf16r* Ob = (const bf16r*)(F.ws + WS_O); const float lam = ((const float*)(F.ws + WS_LAM))[0];
    float ss = 0.f, mine = 0.f;
    for (int v = 0; v < 256; ++v) { const int hd0 = ((b * 4 + h) * 2) * 2 + (v >> 7);
        const float o = bf2f(Ob[((size_t)hd0 * 8192 + s) * 128 + (v & 127)]) - lam * bf2f(Ob[((size_t)(hd0 + 2) * 8192 + s) * 128 + (v & 127)]); ss += o * o; if (v == vv) mine = o; }
    const float ref = mine * rsqrtf(ss * (1.0f / 256.0f) + EPS) * ((const float*)F.ka->in[16])[vv] * (1.0f - 0.35550906759096934f);
    dbg_flag(F, dbg_ne(bf2f(((const bf16r*)(F.ws + WS_Y))[(size_t)m * 1024 + h * 256 + vv]), ref), 23);
}
#endif

constexpr int N_PHASES = 2 + 9 * DEPTH + 1;
constexpr int PH_ATT1 = 2 + 9 * 1 + 3, PH_ATT3 = 2 + 9 * 3 + 3;
#ifndef MK_ONE_LAUNCH
#define MK_ONE_LAUNCH 1
#endif
__device__ __forceinline__ Ctx make_ctx(int wave_s) {
    KArgs ka = (KArgs)__builtin_amdgcn_kernarg_segment_ptr();
    asm volatile("" : "+s"(ka));
    Ctx F; F.ka = ka; F.out = ka->out; F.ws = ka->ws;
    { unsigned z0 = 0u; asm volatile("" : "+v"(z0)); const int t0 = wave_s * 64 + (int)__builtin_amdgcn_mbcnt_hi(~0u, __builtin_amdgcn_mbcnt_lo(~0u, z0)); F.tid = t0 & 511; }
    F.lane = F.tid & 63; F.wave = __builtin_amdgcn_readfirstlane(F.tid >> 6);
    { int g0 = gridDim.x, w0 = blockIdx.x; asm volatile("" : "+s"(g0), "+s"(w0)); F.G = g0; F.wg = w0; }
    return F;
}
template <bool FIRST> __device__ __forceinline__ void grid_seam(const Ctx& F, int& epoch) {
    if (FIRST && epoch == 0) {
        if (F.wg == 0 && F.tid == 0) __hip_atomic_store((unsigned*)F.ws, 0u, __ATOMIC_RELAXED, __HIP_MEMORY_SCOPE_AGENT);
        __threadfence(); cg::this_grid().sync(); epoch = 1; return;
    }
    asm volatile("s_waitcnt vmcnt(0) lgkmcnt(0)" ::: "memory");
    __syncthreads();
    if (F.tid == 0) {
        unsigned* cnt = (unsigned*)F.ws;
        __builtin_amdgcn_fence(__ATOMIC_RELEASE, "agent");
        asm volatile("s_waitcnt vmcnt(0)" ::: "memory");
        __hip_atomic_fetch_add(cnt, 1u, __ATOMIC_RELAXED, __HIP_MEMORY_SCOPE_AGENT);
        const unsigned target = (unsigned)epoch * (unsigned)F.G;
        while (__hip_atomic_load(cnt, __ATOMIC_RELAXED, __HIP_MEMORY_SCOPE_AGENT) < target) __builtin_amdgcn_s_sleep(2);
        __builtin_amdgcn_fence(__ATOMIC_ACQUIRE, "agent");
        asm volatile("s_waitcnt vmcnt(0)" ::: "memory");
    }
    __syncthreads();
    epoch += 1;
}
template <int PH> __device__ __forceinline__ void do_phase(int lo, int hi, int wave_s, LAS unsigned char* lds, unsigned char* lds_raw, int& epoch) {
    if (!(lo <= PH && PH < hi)) return;
    const Ctx F = make_ctx(wave_s);
    unsigned char* ws = F.ws;
    const float* ADA = (const float*)(ws + WS_ADA); const float* GS = (const float*)(ws + WS_GS); float* SSQP = (float*)(ws + WS_SSQP);
    bf16r* XS = (bf16r*)(ws + WS_XS); bf16r* H = (bf16r*)(ws + WS_H); bf16r* P = (bf16r*)(ws + WS_P); bf16r* Y = (bf16r*)(ws + WS_Y);
    constexpr bool is_layer = PH >= 2 && PH < N_PHASES - 1;
    constexpr int l = is_layer ? (PH - 2) / 9 : 0, s = is_layer ? (PH - 2) % 9 : -1, isattn = l & 1, j = l >> 1;
    constexpr bool empty = is_layer && s == 5 && isattn;
#if MK_DEBUG
    if constexpr (PH == 1) dbg_check_p0(F); else if constexpr (PH == 2) dbg_check_p1(F); else if constexpr (PH == 3) dbg_check_up(F); else if constexpr (PH == 4) dbg_check_down(F);
    else if constexpr (PH == 5) dbg_check_inproj0(F); else if constexpr (PH == 8) dbg_check_mlstm(F, lds); else if constexpr (PH == 14) dbg_check_inproj1(F);
    else if constexpr (PH == 15) dbg_check_attn(F); else if constexpr (PH == 17) dbg_check_combine(F);
    __syncthreads();
#endif
    if constexpr (PH == 0) p0_phase(F, lds);
    else if constexpr (PH == 1) p1_phase(F);
    else if constexpr (PH == N_PHASES - 1) { final_phase(F);
#if MK_DEBUG
        if (F.wg == 0) { asm volatile("s_waitcnt vmcnt(0)" ::: "memory"); __syncthreads(); const unsigned code = *(const unsigned*)(F.ws + 64); if (code) { float v = (float)(10 + (code % 90)) * 100.0f; for (unsigned q = 0; q < code / 90; ++q) v *= 10.0f; F.out[F.tid] = v; } }
#endif
    }
    else if constexpr (s == 0 || s == 7) {
        constexpr int f = s == 0 ? 0 : 1;
        pg8::Gemm g{XS, (const bf16r*)(ws + WS_W13) + (size_t)(l * 2 + f) * NUP * 1024, M, NUP, 1024};
        pg8::EpiGen E{0, H, (const float*)(ws + WS_SWF) + (size_t)(l * 2 + f) * 2 * NUP, SSQP, nullptr, nullptr, nullptr};
        pg8::StaticOrder S; S.init(M, NUP, F.G, F.wg);
        pg8::gemm_phase<pg8::EpiGen, pg8::StaticOrder, true, true>(lds, g, S, E, F.tid);
    } else if constexpr (s == 1 || s == 8) {
        constexpr int f = s == 1 ? 0 : 1, sub = f ? 2 : 0;
        pg8::Gemm g{H, (const bf16r*)(ws + WS_W2) + (size_t)(l * 2 + f) * 1024 * DFF, M, 1024, DFF};
        const float* gsn = f == 0 ? GS + (size_t)(l * 3 + 1) * 2048 : GS + (size_t)((l + 1 < DEPTH ? l + 1 : 0) * 3) * 2048;
        pg8::EpiGen E{1, F.out, ADA + (size_t)l * 2 * 9216 + sub * 3072 + 2048, gsn, nullptr, XS, SSQP};
        pg8::StaticOrder S; S.init(M, 1024, F.G, F.wg);
        pg8::gemm_phase<pg8::EpiGen, pg8::StaticOrder, true, true>(lds, g, S, E, F.tid);
    } else if constexpr (s == 2) {
        pg8::Gemm g{XS, (const bf16r*)(ws + (isattn ? WS_WINB : WS_WINA)) + (size_t)j * NIN * 1024, M, NIN, 1024};
        pg8::EpiGen E{isattn ? 4 : 3, P, (const float*)(ws + WS_SWM) + (size_t)l * 2 * NIN, SSQP, ((const int*)F.ka->in[2]), nullptr, nullptr};
        pg8::StaticOrder S; S.init(M, NIN, F.G, F.wg);
        pg8::gemm_phase<pg8::EpiGen, pg8::StaticOrder, true, true>(lds, g, S, E, F.tid);
        if constexpr (!isattn) { __syncthreads(); gates_phase(F, lds, l); }
    } else if constexpr (s == 6) {
        pg8::Gemm g{Y, (const bf16r*)(ws + (isattn ? WS_WOB : WS_WOA)) + (size_t)j * 1024 * 1024, M, 1024, 1024};
        pg8::EpiGen E{2, F.out, ADA + (size_t)l * 2 * 9216 + 3072 + 2048, GS + (size_t)(l * 3 + 2) * 2048, nullptr, XS, SSQP};
        pg8::StaticOrder S; S.init(M, 1024, F.G, F.wg);
        pg8::gemm_phase<pg8::EpiGen, pg8::StaticOrder, true, true>(lds, g, S, E, F.tid);
    }
    else if constexpr (s == 3) { if constexpr (isattn) attn_phase(F, (char*)lds_raw); else s1_phase(F, lds, l); }
    else if constexpr (s == 4) { if constexpr (isattn) combine_phase(F, l); else s2_phase(F); }
    else if constexpr (s == 5) { if constexpr (!isattn) s3_phase(F, lds, l); }
    if (PH + 1 < hi && !empty) grid_seam<PH == 0>(F, epoch);
}
template <int... I> __device__ __forceinline__ void all_phases(std::integer_sequence<int, I...>, int lo, int hi, int wave_s, LAS unsigned char* lds, unsigned char* lds_raw, int& epoch) {
    (do_phase<I>(lo, hi, wave_s, lds, lds_raw, epoch), ...);
}
__global__ void __launch_bounds__(NWAVES * 64, 2) mk_fwd(Args args) {
    extern __shared__ __attribute__((aligned(16))) unsigned char lds_raw[];
    LAS unsigned char* lds = (LAS unsigned char*)lds_raw;
    const int ph_lo = args.ph_lo, ph_hi = args.ph_hi;
    const int wave_s = __builtin_amdgcn_readfirstlane(threadIdx.x >> 6);
    if (ph_lo != 0 && ph_hi - ph_lo > 1) return;
    int epoch = 0;
    all_phases(std::make_integer_sequence<int, N_PHASES>{}, ph_lo, ph_hi, wave_s, lds, lds_raw, epoch);
}

extern "C" void kernel_launch(void* const* d_in, const int* in_sizes, int n_in, void* d_out, int out_size, void* d_ws, size_t ws_size, hipStream_t stream) {
    static int grid = 0;
    if (grid == 0) {
        if (n_in != 19 || out_size != M * DM || ws_size < WS_END) { fprintf(stderr, "kernel_launch: unexpected shapes (n_in %d out %d ws %zu)\n", n_in, out_size, ws_size); grid = -1; return; }
        int dev = 0, cus = 0, per_cu = 0;
        (void)hipGetDevice(&dev); (void)hipDeviceGetAttribute(&cus, hipDeviceAttributeMultiprocessorCount, dev);
        if (hipFuncSetAttribute((const void*)mk_fwd, hipFuncAttributeMaxDynamicSharedMemorySize, LDS_BYTES) != hipSuccess) { fprintf(stderr, "kernel_launch: hipFuncSetAttribute failed\n"); grid = -1; return; }
        if (hipOccupancyMaxActiveBlocksPerMultiprocessor(&per_cu, (const void*)mk_fwd, NWAVES * 64, LDS_BYTES) != hipSuccess || per_cu < 1) { fprintf(stderr, "kernel_launch: occupancy query gave %d\n", per_cu); per_cu = 1; }
        (void)hipGetLastError();
        grid = cus > 0 ? cus : 256;
    }
    if (grid < 0) return;
    Args a{};
    for (int i = 0; i < 19; ++i) a.in[i] = d_in[i];
    a.out = (float*)d_out; a.ws = (unsigned char*)d_ws;
#if MK_ONE_LAUNCH
    a.ph_lo = 0; a.ph_hi = N_PHASES;
    void* kargs[] = {&a};
    hipError_t e = hipLaunchCooperativeKernel((const void*)mk_fwd, dim3(grid), dim3(NWAVES * 64), kargs, LDS_BYTES, stream);
    if (e != hipSuccess) fprintf(stderr, "kernel_launch: cooperative launch failed: %s (grid %d)\n", hipGetErrorString(e), grid);
#else
    for (int ph = 0; ph < N_PHASES; ++ph) {
        if (ph >= 2 && ph < N_PHASES - 1 && ((ph - 2) / 9 & 1) && ((ph - 2) % 9 == 5)) continue;
        a.ph_lo = ph; a.ph_hi = ph + 1;
        hipLaunchKernelGGL(mk_fwd, dim3(grid), dim3(NWAVES * 64), LDS_BYTES, stream, a);
    }
#endif
}
```

```cpp
#include <hip/hip_runtime.h>
#include <hip/hip_bf16.h>
#include <hip/hip_cooperative_groups.h>
#include <cstdio>
#include <cstdint>
#include <cmath>
#include <utility>
template <int MASK> __device__ __forceinline__ float swz_xor(float v) { return __builtin_bit_cast(float, __builtin_amdgcn_ds_swizzle(__builtin_bit_cast(int, v), (MASK << 10) | 0x1f)); }
__device__ __forceinline__ float sum_x32(float v) { const unsigned u = __float_as_uint(v); auto rr = __builtin_amdgcn_permlane32_swap(u, u, false, false); const unsigned r0 = rr[0], r1 = rr[1]; return __uint_as_float(r0) + __uint_as_float(r1); }
__device__ __forceinline__ float max_x32(float v) { const unsigned u = __float_as_uint(v); auto rr = __builtin_amdgcn_permlane32_swap(u, u, false, false); const unsigned r0 = rr[0], r1 = rr[1]; return fmaxf(__uint_as_float(r0), __uint_as_float(r1)); }
namespace pg8 {
#define PG8_LAS __attribute__((address_space(3)))
typedef unsigned short bf16_t;
typedef short bf16x8 __attribute__((ext_vector_type(8)));
typedef float f32x4 __attribute__((ext_vector_type(4)));
typedef unsigned u32x4 __attribute__((ext_vector_type(4)));
constexpr int BM = 256, BK = 64, HALF = 128, HTB = HALF * BK * 2  , STAGE_BYTES = 8 * HTB, NXCD = 8, WGM = 8;

__host__ __device__ __forceinline__ int lds_byte(int r, int c) { const int st = (r >> 4) * 2 + (c >> 5), rr = r & 15, cc = c & 31, ob = rr * 64 + cc * 2; return st * 1024 + (ob ^ (((ob >> 9) & 1) << 5)); }
__host__ __device__ __forceinline__ void stage_rc(int b, int& R, int& C) { const int st = b / 1024, sb = b % 1024, swz = sb ^ (((sb >> 9) & 1) << 5); R = (st >> 1) * 16 + swz / 64; C = (st & 1) * 32 + (swz % 64) / 2; }
__host__ __device__ __forceinline__ int perm32(int rho) { const int n = rho >> 4, i = rho & 15; return 8 * (i >> 2) + 4 * n + (i & 3); }

struct Unit { int pm, pn; };
struct Gemm { const bf16_t* A; const bf16_t* Bt; int M, N, K; };

struct StaticOrder {
    int nM, nN, nwg, G, c;
    __host__ __device__ void init(int M, int N, int G_, int c_) { nM = M / BM; nN = N / BM; nwg = nM * nN; G = G_; c = c_; }
    __host__ __device__ bool next(int i, Unit& u) const {
        const long L = (long)i * G + c; if (L >= nwg) return false;
        int wgid = (int)L; { const int q = nwg / NXCD, r = nwg % NXCD, xcd = wgid % NXCD, off = wgid / NXCD; wgid = (xcd < r ? xcd * (q + 1) : r * (q + 1) + (xcd - r) * q) + off; }
        const int nig = WGM * nN, gid = wgid / nig, fm = gid * WGM, gsz = (nM - fm) < WGM ? (nM - fm) : WGM;
        u.pm = fm + ((wgid % nig) % gsz); u.pn = (wgid % nig) / gsz; return true;
    }
    __device__ __forceinline__ void a_ready(const Unit&) const {}
    __device__ __forceinline__ void done(const Unit&) const {}
};
__device__ __forceinline__ unsigned cvt_pk_bf16(float lo, float hi) { unsigned r; asm volatile("v_cvt_pk_bf16_f32 %0, %1, %2" : "=v"(r) : "v"(lo), "v"(hi)); return r; }
constexpr int MROWS = 16384;
constexpr float RMS_EPS = 1e-6f;
__device__ __forceinline__ float silu_f(float g) { return g * __builtin_amdgcn_rcpf(1.0f + __expf(-g)); }
__device__ __forceinline__ void rows_rstd(const float* ssqp, int row0, int fq, float (&rs)[2][4]) {
    float s[2][4];
#pragma unroll
    for (int ai = 0; ai < 2; ++ai)
#pragma unroll
        for (int m = 0; m < 4; ++m) { const float* p = ssqp + (size_t)(fq * 4) * MROWS + row0 + ai * HALF + m * 16;
            s[ai][m] = (p[0] + p[MROWS]) + (p[2 * MROWS] + p[3 * MROWS]); }
#pragma unroll
    for (int ai = 0; ai < 2; ++ai)
#pragma unroll
        for (int m = 0; m < 4; ++m) { float t = s[ai][m]; t += swz_xor<16>(t); t = sum_x32(t); rs[ai][m] = rsqrtf(t * (1.0f / 1024.0f) + RMS_EPS); }
}
__device__ __forceinline__ float row_rstd(const float* ssqp, int row, int fq) {
    float s = 0.f;
#pragma unroll
    for (int i = 0; i < 4; ++i) s += ssqp[(size_t)(fq * 4 + i) * MROWS + row];
    s += swz_xor<16>(s); s = sum_x32(s);
    return rsqrtf(s * (1.0f / 1024.0f) + RMS_EPS);
}
struct EpiUp {
    static constexpr bool PERM = true, AFTER_DRAIN = false;
    bf16_t* H; const float* sw; const float* ssqp;
    __device__ __forceinline__ void operator()(const f32x4 (&acc)[2][2][4][2], const Unit& u, int wr, int wc, int fr, int fq) const {
        const int b = u.pm >> 5, row0 = u.pm * BM + wr * 64 + fr, c8 = wc * 32 + 8 * fq;
        const float* swp = sw + (size_t)b * 5632 + u.pn * 256 + c8;
        const f32x4 sg0 = *(const f32x4*)(swp), sg1 = *(const f32x4*)(swp + 4), su0 = *(const f32x4*)(swp + 128), su1 = *(const f32x4*)(swp + 132);
        bf16_t* hp = H + (size_t)u.pn * 128 + c8;
        float rsv[2][4]; rows_rstd(ssqp, row0, fq, rsv);
#pragma unroll
        for (int ai = 0; ai < 2; ++ai)
#pragma unroll
            for (int m = 0; m < 4; ++m) {
                const int row = row0 + ai * HALF + m * 16;
                const float rs = rsv[ai][m];
                const f32x4 g0 = acc[ai][0][m][0] * rs + sg0, g1 = acc[ai][0][m][1] * rs + sg1;
                const f32x4 u0 = acc[ai][1][m][0] * rs + su0, u1 = acc[ai][1][m][1] * rs + su1;
                u32x4 w;
                w.x = cvt_pk_bf16(silu_f(g0[0]) * u0[0], silu_f(g0[1]) * u0[1]); w.y = cvt_pk_bf16(silu_f(g0[2]) * u0[2], silu_f(g0[3]) * u0[3]);
                w.z = cvt_pk_bf16(silu_f(g1[0]) * u1[0], silu_f(g1[1]) * u1[1]); w.w = cvt_pk_bf16(silu_f(g1[2]) * u1[2], silu_f(g1[3]) * u1[3]);
                *(u32x4*)(hp + (size_t)row * 2816) = w;
            }
    }
};
struct EpiBias {
    static constexpr bool PERM = true, AFTER_DRAIN = false;
    bf16_t* O; int ldc; const float* sw; int nsw; const float* ssqp;
    __device__ __forceinline__ void operator()(const f32x4 (&acc)[2][2][4][2], const Unit& u, int wr, int wc, int fr, int fq) const {
        const int b = u.pm >> 5, row0 = u.pm * BM + wr * 64 + fr, col0 = u.pn * BM + wc * 32 + 8 * fq;
        f32x4 sv[2][2];
#pragma unroll
        for (int bj = 0; bj < 2; ++bj)
#pragma unroll
            for (int n = 0; n < 2; ++n) sv[bj][n] = *(const f32x4*)(sw + (size_t)b * nsw + col0 + bj * HALF + 4 * n);
        float rsv[2][4]; rows_rstd(ssqp, row0, fq, rsv);
#pragma unroll
        for (int ai = 0; ai < 2; ++ai)
#pragma unroll
            for (int m = 0; m < 4; ++m) {
                const int row = row0 + ai * HALF + m * 16;
                const float rs = rsv[ai][m];
                bf16_t* rowp = O + (size_t)row * ldc + col0;
#pragma unroll
                for (int bj = 0; bj < 2; ++bj) {
                    const f32x4 v0 = acc[ai][bj][m][0] * rs + sv[bj][0], v1 = acc[ai][bj][m][1] * rs + sv[bj][1];
                    u32x4 w; w.x = cvt_pk_bf16(v0[0], v0[1]); w.y = cvt_pk_bf16(v0[2], v0[3]); w.z = cvt_pk_bf16(v1[0], v1[1]); w.w = cvt_pk_bf16(v1[2], v1[3]);
                    *(u32x4*)(rowp + bj * HALF) = w;
                }
            }
    }
};
template <int HALFC> struct EpiResidT {
    static constexpr bool PERM = true, AFTER_DRAIN = false;
    float* x; const float* gate; const float* gsn; bf16_t* xs; float* ssqp;
    __device__ __forceinline__ void operator()(const f32x4 (&acc)[2][2][4][2], const Unit& u, int wr, int wc, int fr, int fq) const {
        const int b = u.pm >> 5, row0 = u.pm * BM + wr * 64 + fr, col0 = u.pn * BM + wc * 32 + 8 * fq;
        constexpr float gcoef = HALFC == 2 ? 0.0f : (HALFC ? 0.5f : 1.0f);
        f32x4 gt[2][2], gs[2][2];
#pragma unroll
        for (int bj = 0; bj < 2; ++bj)
#pragma unroll
            for (int n = 0; n < 2; ++n) {
                gt[bj][n] = *(const f32x4*)(gate + (size_t)b * 9216 + col0 + bj * HALF + 4 * n) * gcoef;
                gs[bj][n] = *(const f32x4*)(gsn + (size_t)b * 1024 + col0 + bj * HALF + 4 * n);
            }
#pragma unroll
        for (int ai = 0; ai < 2; ++ai)
#pragma unroll
        for (int mp = 0; mp < 2; ++mp) {
            f32x4 xv[2][2][2];
#pragma unroll
            for (int mm = 0; mm < 2; ++mm)
#pragma unroll
                for (int bj = 0; bj < 2; ++bj) { const float* xp = x + (size_t)(row0 + ai * HALF + (mp * 2 + mm) * 16) * 1024 + col0 + bj * HALF; xv[mm][bj][0] = *(const f32x4*)xp; xv[mm][bj][1] = *(const f32x4*)(xp + 4); }
#pragma unroll
            for (int mm = 0; mm < 2; ++mm) {
                const int m = mp * 2 + mm, row = row0 + ai * HALF + m * 16;
                float ss = 0.f;
#pragma unroll
                for (int bj = 0; bj < 2; ++bj) {
                    float* xp = x + (size_t)row * 1024 + col0 + bj * HALF;
                    const f32x4 x0 = xv[mm][bj][0] + gt[bj][0] * acc[ai][bj][m][0], x1 = xv[mm][bj][1] + gt[bj][1] * acc[ai][bj][m][1];
                    *(f32x4*)xp = x0; *(f32x4*)(xp + 4) = x1;
                    ss += (x0[0] * x0[0] + x0[1] * x0[1]) + (x0[2] * x0[2] + x0[3] * x0[3]) + (x1[0] * x1[0] + x1[1] * x1[1]) + (x1[2] * x1[2] + x1[3] * x1[3]);
                    const f32x4 y0 = x0 * gs[bj][0], y1 = x1 * gs[bj][1];
                    u32x4 w; w.x = cvt_pk_bf16(y0[0], y0[1]); w.y = cvt_pk_bf16(y0[2], y0[3]); w.z = cvt_pk_bf16(y1[0], y1[1]); w.w = cvt_pk_bf16(y1[2], y1[3]);
                    *(u32x4*)(xs + (size_t)row * 1024 + col0 + bj * HALF) = w;
                }
                ss += swz_xor<16>(ss); ss = sum_x32(ss);
                if (fq == 0) ssqp[(size_t)(u.pn * 4 + wc) * MROWS + row] = ss;
            }
            asm volatile("" ::: "memory");
        }
    }
};
__constant__ float ROPE_INVF[16] = {1.000000000e+00f, 4.403665960e-01f, 1.939227432e-01f, 8.539710194e-02f, 3.760603070e-02f, 1.656044088e-02f, 7.292664610e-03f, 3.211446106e-03f,
                                    1.414213562e-03f, 6.227724371e-04f, 2.742481884e-04f, 1.207697351e-04f, 5.318295734e-05f, 2.341999971e-05f, 1.031338525e-05f, 4.541670478e-06f};
struct EpiRope {
    static constexpr bool PERM = true, AFTER_DRAIN = false;
    bf16_t* QKV; const float* sw; const float* ssqp; const int* pos;
    __device__ __forceinline__ void operator()(const f32x4 (&acc)[2][2][4][2], const Unit& u, int wr, int wc, int fr, int fq) const {
        const int b = u.pm >> 5, row0 = u.pm * BM + wr * 64 + fr, col0 = u.pn * BM + wc * 32 + 8 * fq;
        f32x4 sv[2][2];
#pragma unroll
        for (int bj = 0; bj < 2; ++bj)
#pragma unroll
            for (int n = 0; n < 2; ++n) sv[bj][n] = *(const f32x4*)(sw + (size_t)b * 3072 + col0 + bj * HALF + 4 * n);
        const bool rot = (wc == 0) && (u.pn < 8);
        const bool lower = fq < 2;
        float rsv[2][4]; rows_rstd(ssqp, row0, fq, rsv);
        f32x4 fr4[2] = {{0.f, 0.f, 0.f, 0.f}, {0.f, 0.f, 0.f, 0.f}};
        if (rot) { fr4[0] = *(const f32x4*)(ROPE_INVF + 8 * (fq & 1)); fr4[1] = *(const f32x4*)(ROPE_INVF + 8 * (fq & 1) + 4); }
#pragma unroll
        for (int ai = 0; ai < 2; ++ai)
#pragma unroll
            for (int m = 0; m < 4; ++m) {
                const int row = row0 + ai * HALF + m * 16, srow = row & 8191;
                const float rs = rsv[ai][m];
                f32x4 cs[2] = {{1.f, 1.f, 1.f, 1.f}, {1.f, 1.f, 1.f, 1.f}}, sn[2] = {{0.f, 0.f, 0.f, 0.f}, {0.f, 0.f, 0.f, 0.f}};
                if (rot) {
                    const float p = (float)pos[row];
#pragma unroll
                    for (int n = 0; n < 2; ++n)
#pragma unroll
                        for (int j = 0; j < 4; ++j) {
                            const float a = p * fr4[n][j];
                            const float k = rintf(a * 0.15915494309189535f);
                            float r = fmaf(-k, 6.2831854820251465f, a); r = fmaf(-k, -1.7484555314695172e-07f, r);
                            cs[n][j] = __cosf(r); sn[n][j] = lower ? -__sinf(r) : __sinf(r);
                        }
                }
#pragma unroll
                for (int bj = 0; bj < 2; ++bj) {
                    const int blk = u.pn * 2 + bj, which = blk >> 3, idx = blk & 7;
                    f32x4 v[2] = {acc[ai][bj][m][0] * rs + sv[bj][0], acc[ai][bj][m][1] * rs + sv[bj][1]};
                    if (rot) {
#pragma unroll
                        for (int n = 0; n < 2; ++n)
#pragma unroll
                            for (int j = 0; j < 4; ++j) {
                                const unsigned bits = __float_as_uint(v[n][j]);
                                auto rr = __builtin_amdgcn_permlane32_swap(bits, bits, false, false);
                                const unsigned r0 = rr[0], r1 = rr[1];
                                const float pv = __uint_as_float(lower ? r1 : r0);
                                v[n][j] = v[n][j] * cs[n][j] + pv * sn[n][j];
                            }
                    }
                    bf16_t* dp = QKV + (size_t)which * 16777216 + ((size_t)(b * 8 + idx) * 8192 + srow) * 128 + wc * 32 + 8 * fq;
                    u32x4 w; w.x = cvt_pk_bf16(v[0][0], v[0][1]); w.y = cvt_pk_bf16(v[0][2], v[0][3]); w.z = cvt_pk_bf16(v[1][0], v[1][1]); w.w = cvt_pk_bf16(v[1][2], v[1][3]);
                    *(u32x4*)dp = w;
                }
            }
    }
};
struct EpiGen {
    static constexpr bool PERM = true, AFTER_DRAIN = false;
    int kind; void* p0; const void* p1; const void* p2; const void* p3; void* p4; void* p5;
    __device__ __forceinline__ void operator()(const f32x4 (&acc)[2][2][4][2], const Unit& u, int wr, int wc, int fr, int fq) const {
        if (kind == 0) { EpiUp e{(bf16_t*)p0, (const float*)p1, (const float*)p2}; e(acc, u, wr, wc, fr, fq); }
        else if (kind == 1) { EpiResidT<1> e{(float*)p0, (const float*)p1, (const float*)p2, (bf16_t*)p4, (float*)p5}; e(acc, u, wr, wc, fr, fq); }
        else if (kind == 2) { EpiResidT<0> e{(float*)p0, (const float*)p1, (const float*)p2, (bf16_t*)p4, (float*)p5}; e(acc, u, wr, wc, fr, fq); }
        else if (kind == 3) { EpiBias e{(bf16_t*)p0, 3072, (const float*)p1, 3072, (const float*)p2}; e(acc, u, wr, wc, fr, fq); }
        else if (kind == 5) { EpiResidT<2> e{(float*)p0, (const float*)p1, (const float*)p2, (bf16_t*)p4, (float*)p5}; e(acc, u, wr, wc, fr, fq); }
        else { EpiRope e{(bf16_t*)p0, (const float*)p1, (const float*)p2, (const int*)p3}; e(acc, u, wr, wc, fr, fq); }
    }
};
template <class Epi, class Sched, bool ALIGN_EPI = false, bool SP2 = false>
__device__ __forceinline__ void gemm_phase(PG8_LAS unsigned char* lds, const Gemm g, const Sched& S, const Epi& E, const int tid_in) {
    const int tid = tid_in, wid = __builtin_amdgcn_readfirstlane(tid >> 6), lane = tid & 63, wr = wid >> 2, wc = wid & 3, fr = lane & 15, fq = lane >> 4;
    const int K = g.K, nt = K / BK;
    unsigned voffA[2], voffB[2];
#pragma unroll
    for (int i = 0; i < 2; ++i) { int R, C; stage_rc(tid * 16 + i * 8192, R, C); const int Rb = Epi::PERM ? ((R & ~31) + perm32(R & 31)) : R;
        voffA[i] = (unsigned)(R * K + C) * 2u; voffB[i] = (unsigned)(Rb * K + C) * 2u; }
    const size_t kstep = (size_t)(BK * 2);
    const size_t hstep = (size_t)HALF * K * 2;
    const size_t tstep = 2 * hstep;
    const unsigned ldsw = (unsigned)wid * 1024u;
    const int aoff = lds_byte(wr * 64 + fr, fq * 8), boff = lds_byte(wc * 32 + fr, fq * 8);
#define PG8_SA(b, h) (((b) * 2 + (h)) * HTB)
#define PG8_SB(b, h) ((4 + (b) * 2 + (h)) * HTB)
#define PG8_STAGE(bufoff, gbase, voff) do { _Pragma("unroll") for (int _i = 0; _i < 2; ++_i) \
        __builtin_amdgcn_global_load_lds((const unsigned*)((const char*)(gbase) + (voff)[_i]), (PG8_LAS unsigned*)(lds + (bufoff) + ldsw + _i * 8192), 16, 0, 0); } while (0)
#define PG8_LDA(dst, b, h) do { _Pragma("unroll") for (int m = 0; m < 4; ++m) _Pragma("unroll") for (int k = 0; k < 2; ++k) dst[m][k] = *(const PG8_LAS bf16x8*)(lds + PG8_SA(b, h) + aoff + m * 2048 + k * 1024); } while (0)
#define PG8_LDB(dst, b, h) do { _Pragma("unroll") for (int n = 0; n < 2; ++n) _Pragma("unroll") for (int k = 0; k < 2; ++k) dst[n][k] = *(const PG8_LAS bf16x8*)(lds + PG8_SB(b, h) + boff + n * 2048 + k * 1024); } while (0)
#define PG8_MMA(ai, bj, At, Bt) do { __builtin_amdgcn_s_setprio(1); _Pragma("unroll") for (int m = 0; m < 4; ++m) _Pragma("unroll") for (int n = 0; n < 2; ++n) _Pragma("unroll") for (int k = 0; k < 2; ++k) \
        acc[ai][bj][m][n] = __builtin_amdgcn_mfma_f32_16x16x32_bf16(Bt[n][k], At[m][k], acc[ai][bj][m][n], 0, 0, 0); __builtin_amdgcn_s_setprio(0); } while (0)
#define PG8_WAIT_V(n) asm volatile("s_waitcnt vmcnt(" #n ")" ::: "memory")
#define PG8_WAIT_L(n) asm volatile("s_waitcnt lgkmcnt(" #n ")" ::: "memory")
#define PG8_BAR __builtin_amdgcn_s_barrier()
#define PG8_SCHED __builtin_amdgcn_sched_barrier(0)
    Unit cur, nxt; int ui = 0;
    if (!S.next(0, cur)) return;
    f32x4 acc[2][2][4][2];
#pragma unroll
    for (int a = 0; a < 2; ++a)
#pragma unroll
        for (int b = 0; b < 2; ++b)
#pragma unroll
            for (int m = 0; m < 4; ++m)
#pragma unroll
                for (int n = 0; n < 2; ++n) acc[a][b][m][n] = (f32x4){0.f, 0.f, 0.f, 0.f};
    bf16x8 At[4][2], B0[2][2], B1[2][2];
    const char* cA = (const char*)g.A + (size_t)cur.pm * tstep; const char* cB = (const char*)g.Bt + (size_t)cur.pn * tstep;
    S.a_ready(cur);
    if constexpr (SP2) {
        PG8_STAGE(PG8_SB(0, 0), cB, voffB); PG8_STAGE(PG8_SB(0, 1), cB + hstep, voffB); PG8_STAGE(PG8_SA(0, 0), cA, voffA); PG8_STAGE(PG8_SA(0, 1), cA + hstep, voffA);
        if (wr == 1) PG8_BAR;
        PG8_WAIT_V(2); PG8_BAR;
        PG8_STAGE(PG8_SB(1, 0), cB + kstep, voffB); PG8_STAGE(PG8_SA(1, 0), cA + kstep, voffA); PG8_STAGE(PG8_SB(1, 1), cB + hstep + kstep, voffB);
        PG8_WAIT_V(6); PG8_BAR;
    } else {
        PG8_STAGE(PG8_SB(0, 0), cB, voffB); PG8_STAGE(PG8_SA(0, 0), cA, voffA); PG8_STAGE(PG8_SB(0, 1), cB + hstep, voffB); PG8_STAGE(PG8_SA(0, 1), cA + hstep, voffA);
        if (wr == 1) PG8_BAR;
        PG8_WAIT_V(4); PG8_BAR;
        PG8_STAGE(PG8_SB(1, 0), cB + kstep, voffB); PG8_STAGE(PG8_SA(1, 0), cA + kstep, voffA); PG8_STAGE(PG8_SB(1, 1), cB + hstep + kstep, voffB);
        PG8_WAIT_V(6); PG8_BAR;
    }
    for (;;) {
        const bool has_next = S.next(ui + 1, nxt);
        const char* nA = has_next ? (const char*)g.A + (size_t)nxt.pm * tstep : cA; const char* nB = has_next ? (const char*)g.Bt + (size_t)nxt.pn * tstep : cB;
        for (int t = 0; t < nt; t += 2) {
            const bool last = (t == nt - 2);
            const char* a1 = cA + (size_t)(t + 1) * kstep;
            const char* a2 = last ? nA : cA + (size_t)(t + 2) * kstep; const char* b2 = last ? nB : cB + (size_t)(t + 2) * kstep;
            const char* a3 = a2 + kstep; const char* b3 = b2 + kstep;
            if (last && has_next) S.a_ready(nxt);
            if constexpr (SP2) {
            PG8_LDB(B0, 0, 0); PG8_LDB(B1, 0, 1); PG8_SCHED; PG8_LDA(At, 0, 0); PG8_STAGE(PG8_SA(1, 1), a1 + hstep, voffA);
            PG8_WAIT_V(8); PG8_WAIT_L(0); PG8_BAR; PG8_MMA(0, 0, At, B0); PG8_MMA(0, 1, At, B1); PG8_BAR; PG8_SCHED;
            PG8_LDA(At, 0, 1); PG8_STAGE(PG8_SB(0, 0), b2, voffB); PG8_STAGE(PG8_SB(0, 1), b2 + hstep, voffB); PG8_STAGE(PG8_SA(0, 0), a2, voffA);
            PG8_WAIT_V(8); PG8_WAIT_L(0); PG8_BAR; PG8_MMA(1, 0, At, B0); PG8_MMA(1, 1, At, B1); PG8_BAR; PG8_SCHED;
            PG8_LDB(B0, 1, 0); PG8_LDB(B1, 1, 1); PG8_SCHED; PG8_LDA(At, 1, 0); PG8_STAGE(PG8_SA(0, 1), a2 + hstep, voffA);
            PG8_WAIT_V(8); PG8_WAIT_L(0); PG8_BAR; PG8_MMA(0, 0, At, B0); PG8_MMA(0, 1, At, B1); PG8_BAR; PG8_SCHED;
            PG8_LDA(At, 1, 1); PG8_STAGE(PG8_SB(1, 0), b3, voffB); PG8_STAGE(PG8_SB(1, 1), b3 + hstep, voffB); PG8_STAGE(PG8_SA(1, 0), a3, voffA);
            PG8_WAIT_V(8); PG8_WAIT_L(0); PG8_BAR; PG8_MMA(1, 0, At, B0); PG8_MMA(1, 1, At, B1); PG8_BAR; PG8_SCHED;
            } else {
            PG8_LDB(B0, 0, 0); PG8_SCHED; PG8_LDA(At, 0, 0); PG8_STAGE(PG8_SA(1, 1), a1 + hstep, voffA);
            PG8_WAIT_L(8); PG8_BAR; PG8_WAIT_L(0); PG8_MMA(0, 0, At, B0); PG8_BAR; PG8_SCHED;
            PG8_LDB(B1, 0, 1); PG8_STAGE(PG8_SB(0, 0), b2, voffB);
            PG8_BAR; PG8_WAIT_L(0); PG8_MMA(0, 1, At, B1); PG8_BAR;
            PG8_LDA(At, 0, 1); PG8_STAGE(PG8_SA(0, 0), a2, voffA);
            PG8_BAR; PG8_WAIT_L(0); PG8_MMA(1, 0, At, B0); PG8_BAR; PG8_SCHED;
            PG8_STAGE(PG8_SB(0, 1), b2 + hstep, voffB);
            PG8_WAIT_V(6); PG8_BAR; PG8_MMA(1, 1, At, B1); PG8_BAR;
            PG8_LDB(B0, 1, 0); PG8_SCHED; PG8_LDA(At, 1, 0); PG8_STAGE(PG8_SA(0, 1), a2 + hstep, voffA);
            PG8_WAIT_L(8); PG8_BAR; PG8_WAIT_L(0); PG8_MMA(0, 0, At, B0); PG8_BAR; PG8_SCHED;
            PG8_LDB(B1, 1, 1); PG8_STAGE(PG8_SB(1, 0), b3, voffB);
            PG8_BAR; PG8_WAIT_L(0); PG8_MMA(0, 1, At, B1); PG8_BAR;
            PG8_LDA(At, 1, 1); PG8_STAGE(PG8_SA(1, 0), a3, voffA);
            PG8_BAR; PG8_WAIT_L(0); PG8_MMA(1, 0, At, B0); PG8_BAR; PG8_SCHED;
            PG8_STAGE(PG8_SB(1, 1), b3 + hstep, voffB);
            PG8_WAIT_V(6); PG8_BAR; PG8_MMA(1, 1, At, B1); PG8_BAR;
            }
        }
        if constexpr (ALIGN_EPI) { if (wr == 0) PG8_BAR; }
        if constexpr (!Epi::AFTER_DRAIN) { E(acc, cur, wr, wc, fr, fq); S.done(cur); }
        if (!has_next) break;
#pragma unroll
        for (int a = 0; a < 2; ++a)
#pragma unroll
            for (int b = 0; b < 2; ++b)
#pragma unroll
                for (int m = 0; m < 4; ++m)
#pragma unroll
                    for (int n = 0; n < 2; ++n) acc[a][b][m][n] = (f32x4){0.f, 0.f, 0.f, 0.f};
        cur = nxt; cA = nA; cB = nB; ++ui;
        if constexpr (ALIGN_EPI) { if (wr == 1) PG8_BAR; }
    }
    PG8_WAIT_V(0);
    if constexpr (!ALIGN_EPI) { if (wr == 0) PG8_BAR; }
    PG8_BAR;
    if constexpr (Epi::AFTER_DRAIN) { E.fused(acc, cur, wr, wc, fr, fq, lds, wid, lane); S.done(cur); }
#undef PG8_SA
#undef PG8_SB
#undef PG8_STAGE
#undef PG8_LDA
#undef PG8_LDB
#undef PG8_MMA
#undef PG8_WAIT_V
#undef PG8_WAIT_L
#undef PG8_BAR
#undef PG8_SCHED
}
}
namespace att {
using bf16 = __hip_bfloat16;
constexpr int D = 128; constexpr float THR = 8.f; constexpr bool WSKIP = false;
constexpr float SCALE = 0.08838834764831845f;
constexpr int NW = 8, QBLK = 32, KVBLK = 64, QB = NW * QBLK;
constexpr int SHM_V = KVBLK * D * 2, SHM_K = KVBLK * D * 2;
constexpr int LDS_BYTES = 2 * SHM_V + 2 * SHM_K + NW * 64 * 4;
typedef short bf16x8 __attribute__((ext_vector_type(8)));
typedef short s16x4 __attribute__((ext_vector_type(4)));
typedef float f32x16 __attribute__((ext_vector_type(16)));
typedef float f32x4 __attribute__((ext_vector_type(4)));
typedef unsigned u32x4 __attribute__((ext_vector_type(4)));
template <class A, class Bt> struct same_t { static constexpr bool v = false; };
template <class A> struct same_t<A, A> { static constexpr bool v = true; };

#define KSWZ(row, colB) ((row) * 256 + ((colB) ^ (((row) & 7) << 4)))
#define SBAR() __builtin_amdgcn_sched_barrier(0)
__device__ __forceinline__ int v_st(int k, int c) { const int kk = (k & ~0xC) | ((k & 4) << 1) | ((k & 8) >> 1); return ((kk >> 3) * 4 + (c >> 5)) * 512 + ((kk & 7) * 32 + (c & 31)) * 2; }
__device__ __forceinline__ int v_rd_base(int lane) { return ((lane & 3) << 3) | (((lane >> 2) & 3) << 6) | (((lane >> 4) & 1) << 5) | (((lane >> 5) & 1) << 8); }
constexpr int v_rd_off(int d0, int ks, int half) { return d0 * 512 + ks * 4096 + half * 2048; }
__device__ __forceinline__ int crow(int r, int hi) { return (r & 3) + 8 * (r >> 2) + 4 * hi; }
__device__ __forceinline__ unsigned cvtpk(float lo, float hi) {
    unsigned r; asm volatile("v_cvt_pk_bf16_f32 %0, %1, %2" : "=v"(r) : "v"(lo), "v"(hi)); return r;
}
__device__ __forceinline__ bf16x8 pack8(f32x4 a, f32x4 b) {
    u32x4 w = {cvtpk(a[0], a[1]), cvtpk(a[2], a[3]), cvtpk(b[0], b[1]), cvtpk(b[2], b[3])};
    return *reinterpret_cast<bf16x8*>(&w);
}
template <class T> __device__ __forceinline__ bf16x8 load8(const T* p) {
    if constexpr (same_t<T, float>::v) { return pack8(*(const f32x4*)p, *(const f32x4*)(p + 4)); }
    else { return *reinterpret_cast<const bf16x8*>(p); }
}
__device__ __forceinline__ void mask_tile(f32x16& p0, f32x16& p1, int dq, unsigned W) {
    const float NEG = -__builtin_inff();
#pragma unroll
    for (int r = 0; r < 16; ++r) {
        const int c = (r & 3) + 8 * (r >> 2);
        if ((unsigned)(dq - c) >= W) p0[r] = NEG;
        if ((unsigned)(dq - c - 32) >= W) p1[r] = NEG;
    }
}
__device__ __forceinline__ void partialSM(f32x16& p0, f32x16& p1, float& m_reg, float& mn, float& alpha) {
    float pmax = p0[0]; for (int r = 1; r < 16; ++r) pmax = fmaxf(pmax, p0[r]); for (int r = 0; r < 16; ++r) pmax = fmaxf(pmax, p1[r]);
    { auto rr = __builtin_amdgcn_permlane32_swap(__float_as_uint(pmax), __float_as_uint(pmax), false, false);
      pmax = fmaxf(__uint_as_float(rr[0]), __uint_as_float(rr[1])); }
    constexpr float C2 = 1.4426950408889634f * SCALE;
    if (__builtin_expect(__all((pmax - m_reg) * SCALE <= THR), 1)) { mn = m_reg; alpha = 1.f; }
    else { mn = fmaxf(m_reg, pmax); alpha = __builtin_amdgcn_exp2f((m_reg - mn) * C2); m_reg = mn; }
    const float mnL = -mn * C2;
    for (int r = 0; r < 16; ++r) p0[r] = fmaf(p0[r], C2, mnL); for (int r = 0; r < 16; ++r) p1[r] = fmaf(p1[r], C2, mnL);
    for (int r = 0; r < 16; ++r) p0[r] = __builtin_amdgcn_exp2f(p0[r]);
}
__device__ __forceinline__ void finishSM(f32x16& p0, f32x16& p1, float alpha, float& l_reg, bf16x8& pa0, bf16x8& pa1, bf16x8& pa2, bf16x8& pa3) {
    for (int r = 0; r < 16; ++r) p1[r] = __builtin_amdgcn_exp2f(p1[r]);
    float ps = 0; for (int r = 0; r < 16; ++r) ps += p0[r]; for (int r = 0; r < 16; ++r) ps += p1[r];
    { auto rr = __builtin_amdgcn_permlane32_swap(__float_as_uint(ps), __float_as_uint(ps), false, false);
      ps = __uint_as_float(rr[0]) + __uint_as_float(rr[1]); }
    l_reg = l_reg * alpha + ps;
#define PK4(P, B_, OUT) do { unsigned a0 = cvtpk(P[B_+0], P[B_+1]), a1 = cvtpk(P[B_+2], P[B_+3]);                          \
        unsigned b0 = cvtpk(P[B_+4], P[B_+5]), b1 = cvtpk(P[B_+6], P[B_+7]);                                             \
        auto r0 = __builtin_amdgcn_permlane32_swap(a0, b0, false, false); auto r1 = __builtin_amdgcn_permlane32_swap(a1, b1, false, false); \
        u32x4 w = {r0[0], r1[0], r0[1], r1[1]}; OUT = *reinterpret_cast<bf16x8*>(&w); } while (0)
    PK4(p0, 0, pa0); PK4(p0, 8, pa1); PK4(p1, 0, pa2); PK4(p1, 8, pa3);
#undef PK4
}
template <int KB, bool SK>
__device__ __forceinline__ void qkt(f32x16& p0, f32x16& p1, const char* K_lds, int r32, int hi, const bf16x8* qr, bool act) {
    if (SK && !act) { const float NEG = -__builtin_inff();
#pragma unroll
        for (int r = 0; r < 16; ++r) { p0[r] = NEG; p1[r] = NEG; } return; }
    p0 = f32x16{}; p1 = f32x16{};
    const char* kb[4];
#pragma unroll
    for (int dd = 0; dd < 4; ++dd) kb[dd] = K_lds + KB * SHM_K + KSWZ(r32, (dd * 16 + hi * 8) * 2);
#pragma unroll
    for (int d0 = 0; d0 < 8; ++d0) { const char* a = kb[d0 & 3] + (d0 >> 2) * 128;
        bf16x8 b0 = *reinterpret_cast<const bf16x8*>(a);
        bf16x8 b1 = *reinterpret_cast<const bf16x8*>(a + 32 * 256);
        p0 = __builtin_amdgcn_mfma_f32_32x32x16_bf16(b0, qr[d0], p0, 0, 0, 0);
        p1 = __builtin_amdgcn_mfma_f32_32x32x16_bf16(b1, qr[d0], p1, 0, 0, 0); }
}
template <int VB, bool SK>
__device__ __forceinline__ void pv_tile(f32x16* o, int vb0, bf16x8 pa0, bf16x8 pa1, bf16x8 pa2, bf16x8 pa3, bool act) {
    if (SK && !act) return;
#define TRRD(dst, off) asm volatile("ds_read_b64_tr_b16 %0, %1 offset:%2" : "=&v"(dst) : "v"(vb0), "i"(off) : "memory")
#define PV_D0(d0) do { s16x4 l0, l1, l2, l3, h0, h1, h2, h3; constexpr int b_ = VB * SHM_V + v_rd_off(d0, 0, 0);     \
        TRRD(l0, b_); TRRD(h0, b_ + 2048); TRRD(l1, b_ + 4096); TRRD(h1, b_ + 6144); TRRD(l2, b_ + 8192); TRRD(h2, b_ + 10240); TRRD(l3, b_ + 12288); TRRD(h3, b_ + 14336); \
        asm volatile("s_waitcnt lgkmcnt(0)" ::: "memory"); SBAR();                 \
        o[d0] = __builtin_amdgcn_mfma_f32_32x32x16_bf16(pa0, (bf16x8){l0[0], l0[1], l0[2], l0[3], h0[0], h0[1], h0[2], h0[3]}, o[d0], 0, 0, 0);   \
        o[d0] = __builtin_amdgcn_mfma_f32_32x32x16_bf16(pa1, (bf16x8){l1[0], l1[1], l1[2], l1[3], h1[0], h1[1], h1[2], h1[3]}, o[d0], 0, 0, 0);   \
        o[d0] = __builtin_amdgcn_mfma_f32_32x32x16_bf16(pa2, (bf16x8){l2[0], l2[1], l2[2], l2[3], h2[0], h2[1], h2[2], h2[3]}, o[d0], 0, 0, 0);   \
        o[d0] = __builtin_amdgcn_mfma_f32_32x32x16_bf16(pa3, (bf16x8){l3[0], l3[1], l3[2], l3[3], h3[0], h3[1], h3[2], h3[3]}, o[d0], 0, 0, 0); } while (0)
    PV_D0(0); PV_D0(1); PV_D0(2); PV_D0(3);
#undef PV_D0
#undef TRRD
}

template <class TIn, class TOut> struct BlockRef { const TIn* Q; const TIn* K; const TIn* V; TOut* O; int P0; };
template <class TIn> struct Seam {
    bf16x8 qr[8];
    bf16x8 st_v0, st_v1, st_k0, st_k1; f32x4 sf0, sf1, sf2, sf3;
    f32x4 tq[16];
};
__device__ __forceinline__ int swa_jlo(int P0, int W) { const int lowk = P0 - W + 1; return lowk > 0 ? lowk / KVBLK : 0; }
#define ROW(p, k0, rr) ((p) + (size_t)((k0) + (rr)) * D + sc)
#define VMW() asm volatile("s_waitcnt vmcnt(0)" ::: "memory")
#define VMWN(n) asm volatile("s_waitcnt vmcnt(%0)" :: "i"(n) : "memory")
#define SLOAD_H(Kp, Vp, k0) do { S.st_v0 = load8<TIn>(ROW(Vp, k0, sr)); S.st_v1 = load8<TIn>(ROW(Vp, k0, 32 + sr));              \
                         S.st_k0 = load8<TIn>(ROW(Kp, k0, sr)); S.st_k1 = load8<TIn>(ROW(Kp, k0, 32 + sr)); } while (0)
#define SWRITE_HK(bf) do { *(bf16x8*)(K_lds + (bf) * SHM_K + kws) = S.st_k0; *(bf16x8*)(K_lds + (bf) * SHM_K + kws + 32 * 256) = S.st_k1; } while (0)
#define SWRITE_HV(bf) do { *(bf16x8*)(V_lds + (bf) * SHM_V + vst0) = S.st_v0; *(bf16x8*)(V_lds + (bf) * SHM_V + vst1) = S.st_v1; } while (0)
#define SWRITE_H(bf) do { SWRITE_HV(bf); SWRITE_HK(bf); } while (0)
#define SLOAD_F(p, k0) do { S.sf0 = *(const f32x4*)ROW(p, k0, sr); S.sf1 = *(const f32x4*)(ROW(p, k0, sr) + 4);                \
                            S.sf2 = *(const f32x4*)ROW(p, k0, 32 + sr); S.sf3 = *(const f32x4*)(ROW(p, k0, 32 + sr) + 4); } while (0)
#define SWRITE_KF(bf) do { *(bf16x8*)(K_lds + (bf) * SHM_K + kws) = pack8(S.sf0, S.sf1); *(bf16x8*)(K_lds + (bf) * SHM_K + kws + 32 * 256) = pack8(S.sf2, S.sf3); } while (0)
#define SWRITE_VF(bf) do { *(bf16x8*)(V_lds + (bf) * SHM_V + vst0) = pack8(S.sf0, S.sf1); *(bf16x8*)(V_lds + (bf) * SHM_V + vst1) = pack8(S.sf2, S.sf3); } while (0)
template <class TIn, class TOut>
__device__ __forceinline__ void causal_swa_prime(const BlockRef<TIn, TOut>& cur, int W, char* lds, Seam<TIn>& S, int tid_in) {
    constexpr bool F32 = same_t<TIn, float>::v;
    const int tid = tid_in, wid = __builtin_amdgcn_readfirstlane(tid >> 6), lane = tid & 63, r32 = lane & 31, hi = lane >> 5;
    const int sr = tid >> 4, sc = (tid & 15) * 8, kws = KSWZ(sr, sc * 2); char* K_lds = lds + 2 * SHM_V;
    const int kb0 = swa_jlo(cur.P0, W) * KVBLK;
    for (int d0 = 0; d0 < 8; ++d0) S.qr[d0] = load8<TIn>(cur.Q + (size_t)(wid * QBLK + r32) * D + d0 * 16 + hi * 8);
    if constexpr (F32) { SLOAD_F((const float*)cur.K, kb0); VMW(); SWRITE_KF(0); SBAR(); SLOAD_F((const float*)cur.V, kb0); }
    else { SLOAD_H(cur.K, cur.V, kb0); VMW(); SWRITE_HK(0); }
    __syncthreads();
}
template <class TIn, class TOut>
__device__ __forceinline__ void causal_swa_block(const BlockRef<TIn, TOut>& cur, const BlockRef<TIn, TOut>& nxt, int skv, int W, char* lds, Seam<TIn>& S, int tid_in) {
    constexpr bool F32 = same_t<TIn, float>::v;
    const int tid = tid_in, wid = __builtin_amdgcn_readfirstlane(tid >> 6), lane = tid & 63, r32 = lane & 31, hi = lane >> 5;
    const int j_lo = swa_jlo(cur.P0, W);
    int j_hi = (cur.P0 + QB - 1) / KVBLK + 1; if (j_hi > skv / KVBLK) j_hi = skv / KVBLK;
    const int NT = j_hi - j_lo;
    const int kbn = swa_jlo(nxt.P0, W) * KVBLK;
    const int qlo = cur.P0 + wid * QBLK, qm = qlo + r32 - 4 * hi;
    char* V_lds = lds; char* K_lds = lds + 2 * SHM_V;
    float* ws = (float*)(lds + 2 * SHM_V + 2 * SHM_K) + wid * 64; float* li_l = ws, * al_l = ws + 32;
    float m_reg = -1e30f, l_reg = 0; f32x16 o[4] = {};
    const int sr = tid >> 4, sc = (tid & 15) * 8, vst0 = v_st(sr, sc), vst1 = v_st(32 + sr, sc), kws = KSWZ(sr, sc * 2);
    const int vb0 = (int)(uintptr_t)V_lds + v_rd_base(lane);
    const TIn* Kh = cur.K; const TIn* Vh = cur.V;
#define RESC(a) do { if (__any((a) < 1.f)) { if (hi == 0) al_l[r32] = (a); asm volatile("s_waitcnt lgkmcnt(0)" ::: "memory");              \
                     for (int d_ = 0; d_ < 4; ++d_) for (int r = 0; r < 16; ++r) o[d_][r] *= al_l[crow(r, hi)]; } } while (0)
#define KBASE(t) ((j_lo + (t)) * KVBLK)
#define ACT(t) (KBASE(t) <= qlo + QBLK - 1 && KBASE(t) + KVBLK - 1 >= qlo - W + 1)
#define MASKT(P0_, P1_, t) do { const int kb_ = KBASE(t); if ((!SK || ACT(t)) && (kb_ + KVBLK - 1 > qlo || kb_ <= qlo + QBLK - 1 - W)) mask_tile(P0_, P1_, qm - kb_, (unsigned)W); } while (0)
    constexpr int NQL = F32 ? 16 : 8;
    constexpr bool SK = WSKIP && !F32;
#define SEAM_K0() do { VMWN(NQL); if constexpr (F32) { SWRITE_KF(0); SBAR(); SLOAD_F((const float*)nxt.V, kbn); } else { SWRITE_HK(0); } SBAR(); } while (0)
    f32x16 pA0, pA1, pB0, pB1; float mnA, mnB, alA, alB; bf16x8 pa0, pa1, pa2, pa3;
    if constexpr (F32) { VMW(); SWRITE_VF(0); SBAR(); } else { SWRITE_HV(0); SBAR(); }
    if (NT > 1) { if constexpr (F32) SLOAD_F((const float*)Kh, KBASE(1)); else SLOAD_H(Kh, Vh, KBASE(1)); }
    SBAR(); qkt<0, SK>(pA0, pA1, K_lds, r32, hi, S.qr, ACT(0));
    if constexpr (F32) { if (NT > 1) { VMW(); SWRITE_KF(1); SBAR(); SLOAD_F((const float*)Vh, KBASE(1)); } }
    MASKT(pA0, pA1, 0); partialSM(pA0, pA1, m_reg, mnA, alA);
    if (NT > 1) { VMW(); if constexpr (F32) { SWRITE_VF(1); SBAR(); if (NT > 2) SLOAD_F((const float*)Kh, KBASE(2)); } else SWRITE_H(1); }
    __syncthreads();
#define HALF_STEP(PX0, PX1, mnX, alX, PY0, PY1, alY, t, KB, VB, SB) do {                                                      \
        SBAR(); qkt<KB, SK>(PX0, PX1, K_lds, r32, hi, S.qr, ACT(t));                                             \
        finishSM(PY0, PY1, alY, l_reg, pa0, pa1, pa2, pa3); SBAR();                                                           \
        if ((t) + 1 < NT) { if constexpr (F32) { VMW(); SWRITE_KF(SB); SBAR(); SLOAD_F((const float*)Vh, KBASE((t) + 1)); }  \
                            else { SLOAD_H(Kh, Vh, KBASE((t) + 1)); } SBAR(); }                                               \
        pv_tile<VB, SK>(o, vb0, pa0, pa1, pa2, pa3, ACT((t) - 1)); MASKT(PX0, PX1, (t)); partialSM(PX0, PX1, m_reg, mnX, alX);                                        \
        __syncthreads();                                                                                                      \
        if ((t) + 1 < NT) { VMW(); if constexpr (F32) { SWRITE_VF(SB); SBAR(); if ((t) + 2 < NT) SLOAD_F((const float*)Kh, KBASE((t) + 2)); } \
                            else { SWRITE_H(SB); } }                                                                          \
        RESC(alX); __syncthreads(); } while (0)
    for (int t = 1; t + 1 < NT; t += 2) {
        HALF_STEP(pB0, pB1, mnB, alB, pA0, pA1, alA, t, 1, 0, 0);
        HALF_STEP(pA0, pA1, mnA, alA, pB0, pB1, alB, t + 1, 0, 1, 1);
    }
    const bool even = (NT & 1) == 0;
    if (even) { SBAR(); qkt<1, SK>(pB0, pB1, K_lds, r32, hi, S.qr, ACT(NT - 1)); SBAR(); }
#define QROW(e) (nxt.Q + (size_t)(wid * QBLK + r32) * D + ((e) >> 1) * 16 + hi * 8 + ((e) & 1) * 4)
    if constexpr (F32) { SLOAD_F((const float*)nxt.K, kbn); SBAR();
#pragma unroll
        for (int e = 0; e < 8; ++e) S.tq[e] = *(const f32x4*)QROW(e); }
    else { SLOAD_H(nxt.K, nxt.V, kbn); SBAR();
#pragma unroll
        for (int d0 = 0; d0 < 8; ++d0) S.qr[d0] = load8<TIn>(nxt.Q + (size_t)(wid * QBLK + r32) * D + d0 * 16 + hi * 8); }
    SBAR();
    finishSM(pA0, pA1, alA, l_reg, pa0, pa1, pa2, pa3); SBAR();
    if constexpr (F32) {
#pragma unroll
        for (int e = 8; e < 16; ++e) S.tq[e] = *(const f32x4*)QROW(e); SBAR(); }
#undef QROW
    pv_tile<0, SK>(o, vb0, pa0, pa1, pa2, pa3, ACT(even ? NT - 2 : NT - 1));
    if (even) { MASKT(pB0, pB1, NT - 1); partialSM(pB0, pB1, m_reg, mnB, alB); __syncthreads(); RESC(alB);
        finishSM(pB0, pB1, alB, l_reg, pa0, pa1, pa2, pa3); SBAR(); pv_tile<1, SK>(o, vb0, pa0, pa1, pa2, pa3, ACT(NT - 1)); }
    SBAR(); SEAM_K0();
    if (hi == 0) li_l[r32] = l_reg; asm volatile("s_waitcnt lgkmcnt(0)" ::: "memory");
    float rli[16];
#pragma unroll
    for (int r = 0; r < 16; ++r) rli[r] = __builtin_amdgcn_rcpf(li_l[crow(r, hi)]);
    TOut* Ow = cur.O + (size_t)(wid * QBLK) * D;
    int hi_e = hi; asm volatile("" : "+v"(hi_e));
#pragma unroll
    for (int r = 0; r < 16; ++r) { const int orow = crow(r, hi_e);
#pragma unroll
        for (int d0 = 0; d0 < 4; ++d0) { const float v = o[d0][r] * rli[r];
            if constexpr (same_t<TOut, float>::v) { Ow[(size_t)orow * D + d0 * 32 + r32] = v; }
            else { const float vn = swz_xor<1>(v);
                   if ((r32 & 1) == 0) *(unsigned*)(Ow + (size_t)orow * D + d0 * 32 + r32) = cvtpk(v, vn); } } }
    if constexpr (F32) {
#pragma unroll
        for (int d0 = 0; d0 < 8; ++d0) S.qr[d0] = pack8(S.tq[2 * d0], S.tq[2 * d0 + 1]); }
    __syncthreads();
#undef RESC
#undef KBASE
#undef ACT
#undef MASKT
#undef SEAM_K0
#undef HALF_STEP
}
#undef ROW
#undef VMW
#undef VMWN
#undef SLOAD_H
#undef SWRITE_HK
#undef SWRITE_HV
#undef SWRITE_H
#undef SLOAD_F
#undef SWRITE_KF
#undef SWRITE_VF
#undef SBAR
#undef KSWZ
}
namespace cg = cooperative_groups;
#ifndef MK_DEBUG
#define MK_DEBUG 0
#endif
#define LAS __attribute__((address_space(3)))
typedef unsigned short bf16r;
typedef unsigned v4u __attribute__((ext_vector_type(4)));
typedef unsigned v2u __attribute__((ext_vector_type(2)));
typedef float f32x4 __attribute__((ext_vector_type(4)));
typedef short bf16x8 __attribute__((ext_vector_type(8)));
constexpr int M = 16384, SEQ = 8192, DM = 1024, DFF = 2816, NUP = 5632, NIN = 3072, DEPTH = 4;
constexpr float EPS = 1e-6f;
constexpr size_t MiB = 1u << 20;
constexpr size_t WS_ADA = 1 * MiB, WS_GS = 2 * MiB, WS_SWF = 3 * MiB, WS_SWM = 4 * MiB, WS_SSQP = 5 * MiB, WS_GATES = 6 * MiB, WS_BCUM = 7 * MiB, WS_LOGI = 8 * MiB,
                 WS_SCAL = 9 * MiB, WS_NLOC = 10 * MiB, WS_NST = 11 * MiB, WS_LAM = 12 * MiB;
constexpr size_t WS_W13 = 16 * MiB, WS_W2 = 104 * MiB, WS_WINA = 148 * MiB, WS_WINB = 160 * MiB, WS_WOA = 172 * MiB, WS_WOB = 176 * MiB;
constexpr size_t WS_XS = 180 * MiB, WS_H = 212 * MiB, WS_P = 300 * MiB, WS_Y = 396 * MiB, WS_U = 428 * MiB, WS_CST = 556 * MiB, WS_END = 620 * MiB;
constexpr size_t WS_O = WS_H;
constexpr int LDS_BYTES = 147456;
constexpr int NWAVES = 8;

__device__ __forceinline__ unsigned f2bf(float f) { unsigned u = __builtin_bit_cast(unsigned, f); return (u + 0x7fffu + ((u >> 16) & 1u)) >> 16; }
__device__ __forceinline__ unsigned pk2(float lo, float hi) { return f2bf(lo) | (f2bf(hi) << 16); }
__device__ __forceinline__ float bflo(unsigned w) { return __uint_as_float(w << 16); }
__device__ __forceinline__ float bfhi(unsigned w) { return __uint_as_float(w & 0xffff0000u); }
__device__ __forceinline__ float bf2f(bf16r v) { return __uint_as_float((unsigned)v << 16); }
__device__ __forceinline__ float wave_sum(float v) {
    v += swz_xor<1>(v); v += swz_xor<2>(v); v += swz_xor<4>(v); v += swz_xor<8>(v); v += swz_xor<16>(v); return sum_x32(v);
}
__device__ __forceinline__ float wave_max(float v) {
    v = fmaxf(v, swz_xor<1>(v)); v = fmaxf(v, swz_xor<2>(v)); v = fmaxf(v, swz_xor<4>(v)); v = fmaxf(v, swz_xor<8>(v)); v = fmaxf(v, swz_xor<16>(v)); return max_x32(v);
}
__device__ __forceinline__ float lane_up(float v, int lane, int o) { return __builtin_bit_cast(float, __builtin_amdgcn_ds_bpermute(((lane - o) & 63) << 2, __builtin_bit_cast(int, v))); }
#define LDS_WAIT() asm volatile("s_waitcnt lgkmcnt(0)" ::: "memory")

struct Args { const void* in[19]; float* out; unsigned char* ws; int ph_lo, ph_hi; };
typedef const Args __attribute__((address_space(4)))* KArgs;
struct Ctx { KArgs ka; float* out; unsigned char* ws; int tid, lane, wave, G, wg; };

__device__ __forceinline__ void transpose_item(const float* W, int ldw, int k0, int n0, bf16r* dst  , int Kdst, LAS float* scr, int lane) {
#pragma unroll 8
    for (int i = 0; i < 32; ++i) { const int kk = 2 * i + (lane >> 5); scr[kk * 33 + (lane & 31)] = W[(size_t)(k0 + kk) * ldw + n0 + (lane & 31)]; }
    LDS_WAIT(); asm volatile("" ::: "memory");
    const int c = lane & 7;
#pragma unroll
    for (int j = 0; j < 4; ++j) { const int n = (lane >> 3) + 8 * j; const LAS float* s = scr + (8 * c) * 33 + n;
        v4u o; o.x = pk2(s[0 * 33], s[1 * 33]); o.y = pk2(s[2 * 33], s[3 * 33]); o.z = pk2(s[4 * 33], s[5 * 33]); o.w = pk2(s[6 * 33], s[7 * 33]);
        *(v4u*)(dst + (size_t)n * Kdst + k0 + 8 * c) = o; }
    LDS_WAIT(); asm volatile("" ::: "memory");
}
__device__ __forceinline__ void p0_phase(const Ctx& F, LAS unsigned char* lds) {
#if MK_DEBUG
    if (F.wg == 0 && F.tid == 1) *(unsigned*)(F.ws + 64) = 0u;
#endif
    {
        LAS float* red = (LAS float*)lds;
        float* ADA = (float*)(F.ws + WS_ADA);
        const int l32 = F.tid & 31, kg = F.tid >> 5;
        for (int task = F.wg; task < 4 * 72; task += F.G) {
            const int l = task / 72, col0 = (task % 72) * 128;
            f32x4 a0 = {0.f, 0.f, 0.f, 0.f}, a1 = {0.f, 0.f, 0.f, 0.f};
            const float* wp = ((const float*)F.ka->in[3]) + ((size_t)l * 1024 + kg * 64) * 9216 + col0 + l32 * 4;
#pragma unroll 8
            for (int kk = 0; kk < 64; ++kk) {
                const f32x4 w = *(const f32x4*)(wp + (size_t)kk * 9216);
                const float c0 = ((const float*)F.ka->in[1])[kg * 64 + kk], c1 = ((const float*)F.ka->in[1])[1024 + kg * 64 + kk];
                a0 += w * pg8::silu_f(c0); a1 += w * pg8::silu_f(c1);
            }
            *(LAS f32x4*)(red + (kg * 2 + 0) * 128 + l32 * 4) = a0; *(LAS f32x4*)(red + (kg * 2 + 1) * 128 + l32 * 4) = a1;
            __syncthreads();
            if (F.tid < 256) { const int b = F.tid >> 7, col = F.tid & 127; float s = 0.f;
#pragma unroll
                for (int g = 0; g < 16; ++g) s += red[(g * 2 + b) * 128 + col];
                ADA[(size_t)(l * 2 + b) * 9216 + col0 + col] = s + ((const float*)F.ka->in[4])[(size_t)l * 9216 + col0 + col]; }
            __syncthreads();
        }
    }
    {
        LAS float* scr = (LAS float*)(lds + 16384 + F.wave * 8448);
        const int gw = F.wg * NWAVES + F.wave, NGW = F.G * NWAVES;
        constexpr int I13 = 16 * 176, I2 = 44 * 32, IIN = 16 * 96, IOUT = 16 * 32;
        constexpr int T0 = 8 * I13, T1 = T0 + 8 * I2, T2 = T1 + 2 * IIN, T3 = T2 + 2 * IIN, T4 = T3 + 2 * IOUT, T5 = T4 + 2 * IOUT;
        for (int it = gw; it < T5; it += NGW) {
            if (it < T0) { const int mat = it / I13, r = it % I13, kb = r / 176, n0 = (r % 176) * 32;
                const int drow = n0 < 2816 ? (n0 >> 7) * 256 + (n0 & 127) : ((n0 - 2816) >> 7) * 256 + 128 + ((n0 - 2816) & 127);
                transpose_item(((const float*)F.ka->in[6]) + (size_t)mat * 1024 * 5632, 5632, kb * 64, n0, (bf16r*)(F.ws + WS_W13) + ((size_t)mat * 5632 + drow) * 1024, 1024, scr, F.lane); }
            else if (it < T1) { const int q = it - T0, mat = q / I2, r = q % I2, kb = r / 32, n0 = (r % 32) * 32;
                transpose_item(((const float*)F.ka->in[7]) + (size_t)mat * 2816 * 1024, 1024, kb * 64, n0, (bf16r*)(F.ws + WS_W2) + ((size_t)mat * 1024 + n0) * 2816, 2816, scr, F.lane); }
            else if (it < T2) { const int q = it - T1, mat = q / IIN, r = q % IIN, kb = r / 96, n0 = (r % 96) * 32;
                transpose_item(((const float*)F.ka->in[8]) + (size_t)mat * 1024 * 3080, 3080, kb * 64, n0, (bf16r*)(F.ws + WS_WINA) + ((size_t)mat * 3072 + n0) * 1024, 1024, scr, F.lane); }
            else if (it < T3) { const int q = it - T2, mat = q / IIN, r = q % IIN, kb = r / 96, n0 = (r % 96) * 32;
                transpose_item(((const float*)F.ka->in[14]) + (size_t)mat * 1024 * 3072, 3072, kb * 64, n0, (bf16r*)(F.ws + WS_WINB) + ((size_t)mat * 3072 + n0) * 1024, 1024, scr, F.lane); }
            else if (it < T4) { const int q = it - T3, mat = q / IOUT, r = q % IOUT, kb = r / 32, n0 = (r % 32) * 32;
                transpose_item(((const float*)F.ka->in[13]) + (size_t)mat * 1024 * 1024, 1024, kb * 64, n0, (bf16r*)(F.ws + WS_WOA) + ((size_t)mat * 1024 + n0) * 1024, 1024, scr, F.lane); }
            else { const int q = it - T4, mat = q / IOUT, r = q % IOUT, kb = r / 32, n0 = (r % 32) * 32;
                transpose_item(((const float*)F.ka->in[17]) + (size_t)mat * 1024 * 1024, 1024, kb * 64, n0, (bf16r*)(F.ws + WS_WOB) + ((size_t)mat * 1024 + n0) * 1024, 1024, scr, F.lane); }
        }
    }
}
__device__ __forceinline__ void p1_phase(const Ctx& F) {
    const float* ADA = (const float*)(F.ws + WS_ADA);
    float* GS = (float*)(F.ws + WS_GS);
    const int gw = F.wg * NWAVES + F.wave, NGW = F.G * NWAVES;
    for (int i = F.wg * 512 + F.tid; i < 4 * 3 * 2 * 1024; i += F.G * 512) {
        const int d = i & 1023, b = (i >> 10) & 1, ls = i >> 11, l = ls / 3, sub = ls % 3;
        GS[i] = ((const float*)F.ka->in[5])[(size_t)ls * 1024 + d] * (1.0f + ADA[(size_t)(l * 2 + b) * 9216 + sub * 3072 + 1024 + d]);
    }
    if (F.wg == 0 && F.tid < 2) {
        const float* lm = ((const float*)F.ka->in[15]) + F.tid * 512; float s1 = 0.f, s2 = 0.f;
        for (int k = 0; k < 128; ++k) { s1 += lm[k] * lm[128 + k]; s2 += lm[256 + k] * lm[384 + k]; }
        const float lam_init = F.tid == 0 ? 0.35550906759096934f : 0.5560582041556406f;
        ((float*)(F.ws + WS_LAM))[F.tid] = expf(s1) - expf(s2) + lam_init;
    }
    {
        float* ssqp = (float*)(F.ws + WS_SSQP); bf16r* XS = (bf16r*)(F.ws + WS_XS);
        for (int m = gw; m < M; m += NGW) {
            const int b = m >> 13;
            const f32x4* xr = (const f32x4*)(((const float*)F.ka->in[0]) + (size_t)m * 1024) + F.lane;
            f32x4* orow = (f32x4*)(F.out + (size_t)m * 1024) + F.lane;
            v2u* xsr = (v2u*)(XS + (size_t)m * 1024) + F.lane;
            float ss = 0.f;
#pragma unroll
            for (int j = 0; j < 4; ++j) {
                const f32x4 v = xr[64 * j]; orow[64 * j] = v;
                ss += (v[0] * v[0] + v[1] * v[1]) + (v[2] * v[2] + v[3] * v[3]);
                const int col = 4 * F.lane + 256 * j;
                const f32x4 ng = *(const f32x4*)(((const float*)F.ka->in[5]) + col);
                const f32x4 sc = *(const f32x4*)(ADA + (size_t)b * 9216 + 1024 + col);
                const f32x4 y = v * ng * (sc + 1.0f);
                v2u w; w.x = pk2(y[0], y[1]); w.y = pk2(y[2], y[3]); xsr[64 * j] = w;
            }
            ss = wave_sum(ss);
            if (F.lane < 16) ssqp[(size_t)F.lane * M + m] = F.lane == 0 ? ss : 0.f;
        }
    }
    {
        float* SWF = (float*)(F.ws + WS_SWF); float* SWM = (float*)(F.ws + WS_SWM);
        constexpr int RF = 8 * 5632, RT = RF + 4 * 3072;
        for (int r = gw; r < RT; r += NGW) {
            const bf16r* wt; const float* sh; float* o; int ostride;
            if (r < RF) { const int q = r / 5632, n = r % 5632, l = q >> 1, f = q & 1;
                wt = (const bf16r*)(F.ws + WS_W13) + (size_t)r * 1024; sh = ADA + (size_t)l * 2 * 9216 + (f ? 2 : 0) * 3072; o = SWF + (size_t)q * 2 * 5632 + n; ostride = 5632; }
            else { const int rr = r - RF, l = rr / 3072, n = rr % 3072;
                wt = (const bf16r*)(F.ws + ((l & 1) ? WS_WINB : WS_WINA)) + ((size_t)(l >> 1) * 3072 + n) * 1024; sh = ADA + (size_t)l * 2 * 9216 + 3072; o = SWM + (size_t)l * 2 * 3072 + n; ostride = 3072; }
            const v4u w0 = *(const v4u*)(wt + F.lane * 16), w1 = *(const v4u*)(wt + F.lane * 16 + 8);
            float wv[16] = {bflo(w0.x), bfhi(w0.x), bflo(w0.y), bfhi(w0.y), bflo(w0.z), bfhi(w0.z), bflo(w0.w), bfhi(w0.w),
                            bflo(w1.x), bfhi(w1.x), bflo(w1.y), bfhi(w1.y), bflo(w1.z), bfhi(w1.z), bflo(w1.w), bfhi(w1.w)};
            float s0 = 0.f, s1 = 0.f;
#pragma unroll
            for (int j = 0; j < 4; ++j) {
                const f32x4 h0 = *(const f32x4*)(sh + F.lane * 16 + 4 * j), h1 = *(const f32x4*)(sh + 9216 + F.lane * 16 + 4 * j);
#pragma unroll
                for (int e = 0; e < 4; ++e) { s0 += wv[4 * j + e] * h0[e]; s1 += wv[4 * j + e] * h1[e]; }
            }
            s0 = wave_sum(s0); s1 = wave_sum(s1);
            if (F.lane == 0) { o[0] = s0; o[ostride] = s1; }
        }
    }
}
__device__ __forceinline__ void gates_phase(const Ctx& F, LAS unsigned char* lds, int l) {
    const int j = l >> 1;
    LAS float* wg = (LAS float*)lds;
    LAS float* swg = (LAS float*)(lds + 32768);
    const float* ADA = (const float*)(F.ws + WS_ADA); const float* ssqp = (const float*)(F.ws + WS_SSQP);
    const bf16r* XS = (const bf16r*)(F.ws + WS_XS); float* GT = (float*)(F.ws + WS_GATES);
    const float* src = ((const float*)F.ka->in[8]) + (size_t)j * 1024 * 3080 + 3072;
    for (int ch = F.wg; ch < 256; ch += F.G) {
        const int b = ch >> 7, m0 = ch * 64;
        for (int i = F.tid; i < 8192; i += 512) { const int k = i >> 3, g = i & 7; wg[g * 1024 + k] = src[(size_t)k * 3080 + g]; }
        __syncthreads();
        { const float* sh = ADA + (size_t)(l * 2 + b) * 9216 + 3072; float s = 0.f;
#pragma unroll
          for (int q = 0; q < 16; ++q) s += sh[q * 64 + F.lane] * wg[F.wave * 1024 + q * 64 + F.lane];
          s = wave_sum(s); if (F.lane == 0) swg[F.wave] = s; }
        __syncthreads();
        for (int i = 0; i < 8; ++i) {
            const int row = m0 + F.wave * 8 + i;
            float a[8] = {0.f, 0.f, 0.f, 0.f, 0.f, 0.f, 0.f, 0.f};
#pragma unroll
            for (int q = 0; q < 16; ++q) { const float xv = bf2f(XS[(size_t)row * 1024 + q * 64 + F.lane]);
#pragma unroll
                for (int g = 0; g < 8; ++g) a[g] += xv * wg[g * 1024 + q * 64 + F.lane]; }
            float ss = F.lane < 16 ? ssqp[(size_t)F.lane * M + row] : 0.f; ss = wave_sum(ss);
            const float rs = rsqrtf(ss * (1.0f / 1024.0f) + EPS);
#pragma unroll
            for (int g = 0; g < 8; ++g) { const float s = wave_sum(a[g]); if (F.lane == g) GT[(size_t)row * 8 + g] = s * rs + swg[g]; }
        }
        __syncthreads();
    }
}
__device__ __forceinline__ bf16x8 ldfrag(const LAS bf16r* base, int row0, int stride, int k0, int lane) {
    return *(const LAS bf16x8*)(base + (row0 + (lane & 15)) * stride + k0 + (lane >> 4) * 8);
}
__device__ __forceinline__ void conv8(const bf16r* P, size_t mrow, int ps, int ch0, const float* cw, const float* cb, float scale, float (&o)[8]) {
    float acc[8];
    { const f32x4 b0 = *(const f32x4*)(cb + ch0), b1 = *(const f32x4*)(cb + ch0 + 4); acc[0] = b0[0]; acc[1] = b0[1]; acc[2] = b0[2]; acc[3] = b0[3]; acc[4] = b1[0]; acc[5] = b1[1]; acc[6] = b1[2]; acc[7] = b1[3]; }
#pragma unroll
    for (int jt = 0; jt < 4; ++jt) {
        if (ps - 3 + jt >= 0) {
            const v4u w = *(const v4u*)(P + (mrow - 3 + jt) * 3072 + ch0);
            const f32x4 c0 = *(const f32x4*)(cw + jt * 1024 + ch0), c1 = *(const f32x4*)(cw + jt * 1024 + ch0 + 4);
            acc[0] += bflo(w.x) * c0[0]; acc[1] += bfhi(w.x) * c0[1]; acc[2] += bflo(w.y) * c0[2]; acc[3] += bfhi(w.y) * c0[3];
            acc[4] += bflo(w.z) * c1[0]; acc[5] += bfhi(w.z) * c1[1]; acc[6] += bflo(w.w) * c1[2]; acc[7] += bfhi(w.w) * c1[3];
        }
    }
#pragma unroll
    for (int e = 0; e < 8; ++e) o[e] = pg8::silu_f(acc[e]) * scale;
}
__device__ __forceinline__ void conv_load(const bf16r* P, size_t mrow, int ps, int ch0, v4u (&raw)[4]) {
#pragma unroll
    for (int jt = 0; jt < 4; ++jt) raw[jt] = (ps - 3 + jt >= 0) ? *(const v4u*)(P + (mrow - 3 + jt) * 3072 + ch0) : (v4u){0u, 0u, 0u, 0u};
}
__device__ __forceinline__ void conv_apply(const v4u (&raw)[4], const f32x4 (&cwv)[4][2], const f32x4 (&cbv)[2], float scale, float (&o)[8]) {
    float acc[8] = {cbv[0][0], cbv[0][1], cbv[0][2], cbv[0][3], cbv[1][0], cbv[1][1], cbv[1][2], cbv[1][3]};
#pragma unroll
    for (int jt = 0; jt < 4; ++jt) { const v4u w = raw[jt]; const f32x4 c0 = cwv[jt][0], c1 = cwv[jt][1];
        acc[0] += bflo(w.x) * c0[0]; acc[1] += bfhi(w.x) * c0[1]; acc[2] += bflo(w.y) * c0[2]; acc[3] += bfhi(w.y) * c0[3];
        acc[4] += bflo(w.z) * c1[0]; acc[5] += bfhi(w.z) * c1[1]; acc[6] += bflo(w.w) * c1[2]; acc[7] += bfhi(w.w) * c1[3]; }
#pragma unroll
    for (int e = 0; e < 8; ++e) o[e] = pg8::silu_f(acc[e]) * scale;
}
__device__ __forceinline__ void conv_weights(const float* cw, const float* cb, int ch0, f32x4 (&cwv)[4][2], f32x4 (&cbv)[2]) {
#pragma unroll
    for (int jt = 0; jt < 4; ++jt) { cwv[jt][0] = *(const f32x4*)(cw + jt * 1024 + ch0); cwv[jt][1] = *(const f32x4*)(cw + jt * 1024 + ch0 + 4); }
    cbv[0] = *(const f32x4*)(cb + ch0); cbv[1] = *(const f32x4*)(cb + ch0 + 4);
}
__device__ __forceinline__ void vt_scatter(LAS bf16r* d, const v4u w) {
    d[0] = (bf16r)(w.x & 0xffffu); d[72] = (bf16r)(w.x >> 16); d[2 * 72] = (bf16r)(w.y & 0xffffu); d[3 * 72] = (bf16r)(w.y >> 16);
    d[4 * 72] = (bf16r)(w.z & 0xffffu); d[5 * 72] = (bf16r)(w.z >> 16); d[6 * 72] = (bf16r)(w.w & 0xffffu); d[7 * 72] = (bf16r)(w.w >> 16);
}
constexpr int VT_STRIDE = 72, QK_STRIDE = 136;
__device__ __forceinline__ void s1_phase(const Ctx& F, LAS unsigned char* lds, int l) {
    const int j = l >> 1;
    LAS bf16r* VT = (LAS bf16r*)lds;
    LAS bf16r* KT = (LAS bf16r*)(lds + 36864);
    LAS float* wS = (LAS float*)(lds + 36864 + 18432);
    const bf16r* P = (const bf16r*)(F.ws + WS_P); const float* GT = (const float*)(F.ws + WS_GATES);
    float* BCUM = (float*)(F.ws + WS_BCUM); float* LOGI = (float*)(F.ws + WS_LOGI); float* BLAST = (float*)(F.ws + WS_SCAL); float* MLOC = BLAST + 16384;
    float* NLOC = (float*)(F.ws + WS_NLOC); bf16r* U = (bf16r*)(F.ws + WS_U);
    const float* cw = ((const float*)F.ka->in[9]) + (size_t)j * 4096; const float* cb = ((const float*)F.ka->in[10]) + (size_t)j * 1024; const float* bif = ((const float*)F.ka->in[11]) + j * 8;
    for (int u = F.wg; u < 1024; u += F.G) {
        const int b = u >> 9, h = (u >> 7) & 3, c = u & 127, bh = b * 4 + h;
        const size_t m0 = (size_t)b * 8192 + c * 64;
        if (F.wave == 0) {
            const int s = F.lane;
            const float gi = GT[(m0 + s) * 8 + h] + bif[h], gf = GT[(m0 + s) * 8 + 4 + h] + bif[4 + h];
            const float lf = fminf(gf, 0.f) - log1pf(expf(-fabsf(gf)));
            float bc = lf;
#pragma unroll
            for (int o = 1; o < 64; o <<= 1) { const float t = lane_up(bc, s, o); if (s >= o) bc += t; }
            const float blast = __builtin_bit_cast(float, __builtin_amdgcn_readlane(__builtin_bit_cast(int, bc), 63));
            const float wl = blast - bc + gi;
            const float mloc = wave_max(wl);
            wS[s] = expf(wl - mloc);
            BCUM[(size_t)bh * 8192 + c * 64 + s] = bc; LOGI[(size_t)bh * 8192 + c * 64 + s] = gi;
            if (s == 0) { BLAST[bh * 128 + c] = blast; MLOC[bh * 128 + c] = mloc; }
        }
        __syncthreads();
        {
            const int cg = F.tid & 15, s0 = F.tid >> 4, vg = F.tid & 31, sv0 = F.tid >> 5, kch = 512 + h * 128 + cg * 8;
            v4u rk[2][4], rv[4];
#pragma unroll
            for (int i = 0; i < 2; ++i) conv_load(P, m0 + s0 + 32 * i, c * 64 + s0 + 32 * i, kch, rk[i]);
#pragma unroll
            for (int i = 0; i < 4; ++i) rv[i] = *(const v4u*)(P + (m0 + sv0 + 16 * i) * 3072 + 1024 + h * 256 + vg * 8);
            f32x4 cwv[4][2], cbv[2]; conv_weights(cw, cb, kch, cwv, cbv);
#pragma unroll
            for (int i = 0; i < 2; ++i) { const int s = s0 + 32 * i; float kv[8]; conv_apply(rk[i], cwv, cbv, 0.08838834764831845f, kv);
                const float w = wS[s];
#pragma unroll
                for (int e2 = 0; e2 < 8; ++e2) KT[(cg * 8 + e2) * VT_STRIDE + s] = (bf16r)f2bf(kv[e2] * w); }
#pragma unroll
            for (int i = 0; i < 4; ++i) vt_scatter(VT + (vg * 8) * VT_STRIDE + sv0 + 16 * i, rv[i]);
        }
        __syncthreads();
        { const int d = F.tid >> 2, q4 = F.tid & 3; float s = 0.f;
#pragma unroll
          for (int e = 0; e < 16; ++e) s += bf2f(KT[d * VT_STRIDE + q4 * 16 + e]);
          s += swz_xor<1>(s); s += swz_xor<2>(s);
          if (q4 == 0) NLOC[(size_t)u * 128 + d] = s; }
        {
            f32x4 acc[2][8];
#pragma unroll
            for (int mt = 0; mt < 2; ++mt)
#pragma unroll
                for (int nt = 0; nt < 8; ++nt) acc[mt][nt] = (f32x4){0.f, 0.f, 0.f, 0.f};
#pragma unroll
            for (int ks = 0; ks < 2; ++ks) {
                bf16x8 av[2];
#pragma unroll
                for (int mt = 0; mt < 2; ++mt) av[mt] = ldfrag(VT, 32 * F.wave + 16 * mt, VT_STRIDE, ks * 32, F.lane);
#pragma unroll
                for (int nt = 0; nt < 8; ++nt) { const bf16x8 bk = ldfrag(KT, 16 * nt, VT_STRIDE, ks * 32, F.lane);
#pragma unroll
                    for (int mt = 0; mt < 2; ++mt) acc[mt][nt] = __builtin_amdgcn_mfma_f32_16x16x32_bf16(bk, av[mt], acc[mt][nt], 0, 0, 0); }
            }
            bf16r* up = U + (size_t)u * 32768;
#pragma unroll
            for (int mt = 0; mt < 2; ++mt)
#pragma unroll
                for (int nt = 0; nt < 8; ++nt) { v2u w; w.x = pk2(acc[mt][nt][0], acc[mt][nt][1]); w.y = pk2(acc[mt][nt][2], acc[mt][nt][3]);
                    *(v2u*)(up + (size_t)(32 * F.wave + 16 * mt + (F.lane & 15)) * 128 + 16 * nt + 4 * (F.lane >> 4)) = w; }
        }
        __syncthreads();
    }
}
__device__ __forceinline__ void s2_phase(const Ctx& F) {
    const float* BLAST = (const float*)(F.ws + WS_SCAL); const float* MLOC = BLAST + 16384; float* MST = (float*)(F.ws + WS_SCAL) + 32768;
    const bf16r* U = (const bf16r*)(F.ws + WS_U); const float* NLOC = (const float*)(F.ws + WS_NLOC); float* NST = (float*)(F.ws + WS_NST); bf16r* CST = (bf16r*)(F.ws + WS_CST);
    constexpr int QPB = 8192 + 32;
    for (int q = F.wg * 512 + F.tid; q < 8 * QPB; q += F.G * 512) {
        const int bh = q / QPB, e = q % QPB; const bool isn = e >= 8192;
        f32x4 S = {0.f, 0.f, 0.f, 0.f}; float m = 0.f;
        for (int c0 = 0; c0 < 128; c0 += 8) {
            f32x4 uv[8];
#pragma unroll
            for (int i = 0; i < 8; ++i) { const size_t unit = (size_t)bh * 128 + c0 + i;
                if (isn) uv[i] = *(const f32x4*)(NLOC + unit * 128 + (e - 8192) * 4);
                else { const v2u w = *(const v2u*)(U + unit * 32768 + (size_t)e * 4); uv[i] = (f32x4){bflo(w.x), bfhi(w.x), bflo(w.y), bfhi(w.y)}; } }
#pragma unroll
            for (int i = 0; i < 8; ++i) { const int c = c0 + i; const size_t unit = (size_t)bh * 128 + c;
                if (isn) *(f32x4*)(NST + unit * 128 + (e - 8192) * 4) = S;
                else { v2u w; w.x = pk2(S[0], S[1]); w.y = pk2(S[2], S[3]); *(v2u*)(CST + unit * 32768 + (size_t)e * 4) = w; }
                if (e == 0) MST[unit] = m;
                const float bl = BLAST[unit], ml = MLOC[unit];
                const float mn = fmaxf(bl + m, ml);
                const float dec = expf(bl + m - mn), gain = expf(ml - mn);
                S = S * dec + uv[i] * gain; m = mn; }
        }
    }
}
__device__ __forceinline__ void s3_phase(const Ctx& F, LAS unsigned char* lds, int l) {
    const int j = l >> 1;
    LAS bf16r* VT = (LAS bf16r*)lds;
    LAS bf16r* Qs = (LAS bf16r*)(lds + 36864);
    LAS bf16r* Ks = (LAS bf16r*)(lds + 36864 + 17408);
    LAS bf16r* Sw = (LAS bf16r*)(lds + 36864 + 34816);
    LAS float* fa = (LAS float*)(lds + 36864 + 34816 + 9216);
    LAS float* bS = fa, *zS = fa + 64, *mtS = fa + 128, *inS = fa + 192, *dnS = fa + 256, *nS = fa + 320  , *sqS = fa + 448  ;
    const bf16r* P = (const bf16r*)(F.ws + WS_P);
    const float* BCUM = (const float*)(F.ws + WS_BCUM); const float* LOGI = (const float*)(F.ws + WS_LOGI); const float* MST = (const float*)(F.ws + WS_SCAL) + 32768;
    const float* NST = (const float*)(F.ws + WS_NST); const bf16r* CST = (const bf16r*)(F.ws + WS_CST); bf16r* Y = (bf16r*)(F.ws + WS_Y);
    const float* cw = ((const float*)F.ka->in[9]) + (size_t)j * 4096; const float* cb = ((const float*)F.ka->in[10]) + (size_t)j * 1024; const float* ng = ((const float*)F.ka->in[12]) + (size_t)j * 1024;
    const int lane = F.lane, w = F.wave, fr = lane & 15, fq = lane >> 4;
    for (int u = F.wg; u < 1024; u += F.G) {
        const int b = u >> 9, h = (u >> 7) & 3, c = u & 127, bh = b * 4 + h;
        const size_t m0 = (size_t)b * 8192 + c * 64;
        bf16x8 cf[2][4];
#pragma unroll
        for (int nt = 0; nt < 2; ++nt)
#pragma unroll
            for (int ks = 0; ks < 4; ++ks) cf[nt][ks] = *(const bf16x8*)(CST + (size_t)u * 32768 + (size_t)(32 * w + 16 * nt + fr) * 128 + ks * 32 + fq * 8);
        if (w == 0) {
            const int s = lane;
            const float bs = BCUM[(size_t)bh * 8192 + c * 64 + s], li = LOGI[(size_t)bh * 8192 + c * 64 + s], mc = MST[bh * 128 + c];
            const float a = bs + mc, z = li - bs;
            float pm = z;
#pragma unroll
            for (int o = 1; o < 64; o <<= 1) { const float t = lane_up(pm, s, o); if (s >= o) pm = fmaxf(pm, t); }
            const float mt = fmaxf(a, bs + pm);
            bS[s] = bs; zS[s] = z; mtS[s] = mt; inS[s] = expf(a - mt);
        } else if (w <= 2) { const int d = (w - 1) * 64 + lane; nS[d] = NST[(size_t)u * 128 + d]; }
        {
            const int cg = F.tid & 15, s0 = F.tid >> 4, vg = F.tid & 31, sv0 = F.tid >> 5, qch = h * 128 + cg * 8, kch = 512 + qch;
            v4u rq[2][4], rk[2][4], rv[4];
#pragma unroll
            for (int i = 0; i < 2; ++i) { conv_load(P, m0 + s0 + 32 * i, c * 64 + s0 + 32 * i, qch, rq[i]); conv_load(P, m0 + s0 + 32 * i, c * 64 + s0 + 32 * i, kch, rk[i]); }
#pragma unroll
            for (int i = 0; i < 4; ++i) rv[i] = *(const v4u*)(P + (m0 + sv0 + 16 * i) * 3072 + 1024 + h * 256 + vg * 8);
            { f32x4 cwv[4][2], cbv[2]; conv_weights(cw, cb, qch, cwv, cbv);
#pragma unroll
              for (int i = 0; i < 2; ++i) { float kv[8]; conv_apply(rq[i], cwv, cbv, 1.0f, kv);
                  v4u o; o.x = pk2(kv[0], kv[1]); o.y = pk2(kv[2], kv[3]); o.z = pk2(kv[4], kv[5]); o.w = pk2(kv[6], kv[7]); *(LAS v4u*)(Qs + (s0 + 32 * i) * QK_STRIDE + cg * 8) = o; } }
            { f32x4 cwv[4][2], cbv[2]; conv_weights(cw, cb, kch, cwv, cbv);
#pragma unroll
              for (int i = 0; i < 2; ++i) { float kv[8]; conv_apply(rk[i], cwv, cbv, 0.08838834764831845f, kv);
                  v4u o; o.x = pk2(kv[0], kv[1]); o.y = pk2(kv[2], kv[3]); o.z = pk2(kv[4], kv[5]); o.w = pk2(kv[6], kv[7]); *(LAS v4u*)(Ks + (s0 + 32 * i) * QK_STRIDE + cg * 8) = o; } }
#pragma unroll
            for (int i = 0; i < 4; ++i) vt_scatter(VT + (vg * 8) * VT_STRIDE + sv0 + 16 * i, rv[i]);
        }
        __syncthreads();
        {
            const int tt = w >> 1;
            const int t = 16 * tt + fr; const float bt = bS[t], mt = mtS[t];
#pragma unroll
            for (int i = 0; i < 2; ++i) {
                const int st = 2 * (w & 1) + i;
                f32x4 acc = {0.f, 0.f, 0.f, 0.f};
                if (st <= tt) {
#pragma unroll
                    for (int ks = 0; ks < 4; ++ks) acc = __builtin_amdgcn_mfma_f32_16x16x32_bf16(ldfrag(Ks, 16 * st, QK_STRIDE, ks * 32, lane), ldfrag(Qs, 16 * tt, QK_STRIDE, ks * 32, lane), acc, 0, 0, 0);
                }
                float o[4];
#pragma unroll
                for (int e = 0; e < 4; ++e) { const int s = 16 * st + 4 * fq + e; o[e] = (s <= t) ? acc[e] * expf(bt + zS[s] - mt) : 0.f; }
                v2u pw; pw.x = pk2(o[0], o[1]); pw.y = pk2(o[2], o[3]);
                *(LAS v2u*)(Sw + t * VT_STRIDE + 16 * st + 4 * fq) = pw;
            }
        }
        __syncthreads();
        { const int t = F.tid >> 3, part = F.tid & 7; float rsum = 0.f, qn = 0.f;
#pragma unroll
          for (int e = 0; e < 8; ++e) rsum += bf2f(Sw[t * VT_STRIDE + part * 8 + e]);
#pragma unroll
          for (int e = 0; e < 16; ++e) qn += bf2f(Qs[t * QK_STRIDE + part * 16 + e]) * nS[part * 16 + e];
          rsum += swz_xor<1>(rsum); rsum += swz_xor<2>(rsum); rsum += swz_xor<4>(rsum);
          qn += swz_xor<1>(qn); qn += swz_xor<2>(qn); qn += swz_xor<4>(qn);
          if (part == 0) { const float den = inS[t] * qn + rsum; dnS[t] = 1.0f / fmaxf(fabsf(den), expf(-mtS[t])); } }
        f32x4 a1[4][2], a2[4][2];
#pragma unroll
        for (int mt = 0; mt < 4; ++mt)
#pragma unroll
            for (int nt = 0; nt < 2; ++nt) { a1[mt][nt] = (f32x4){0.f, 0.f, 0.f, 0.f}; a2[mt][nt] = (f32x4){0.f, 0.f, 0.f, 0.f}; }
#pragma unroll
        for (int ks = 0; ks < 4; ++ks)
#pragma unroll
            for (int mt = 0; mt < 4; ++mt) { const bf16x8 qf = ldfrag(Qs, 16 * mt, QK_STRIDE, ks * 32, lane);
#pragma unroll
                for (int nt = 0; nt < 2; ++nt) a1[mt][nt] = __builtin_amdgcn_mfma_f32_16x16x32_bf16(cf[nt][ks], qf, a1[mt][nt], 0, 0, 0); }
#pragma unroll
        for (int ks = 0; ks < 2; ++ks) {
            bf16x8 vf[2];
#pragma unroll
            for (int nt = 0; nt < 2; ++nt) vf[nt] = ldfrag(VT, 32 * w + 16 * nt, VT_STRIDE, ks * 32, lane);
#pragma unroll
            for (int mt = 0; mt < 4; ++mt) { const bf16x8 sf = ldfrag(Sw, 16 * mt, VT_STRIDE, ks * 32, lane);
#pragma unroll
                for (int nt = 0; nt < 2; ++nt) a2[mt][nt] = __builtin_amdgcn_mfma_f32_16x16x32_bf16(vf[nt], sf, a2[mt][nt], 0, 0, 0); }
        }
        __syncthreads();
#pragma unroll
        for (int mt = 0; mt < 4; ++mt) {
            const int t = 16 * mt + fr; const float it = inS[t], dn = dnS[t]; float ss = 0.f;
#pragma unroll
            for (int nt = 0; nt < 2; ++nt) { a1[mt][nt] = (a1[mt][nt] * it + a2[mt][nt]) * dn;
                ss += (a1[mt][nt][0] * a1[mt][nt][0] + a1[mt][nt][1] * a1[mt][nt][1]) + (a1[mt][nt][2] * a1[mt][nt][2] + a1[mt][nt][3] * a1[mt][nt][3]); }
            ss += swz_xor<16>(ss); ss = sum_x32(ss);
            if (fq == 0) sqS[w * 64 + t] = ss;
        }
        __syncthreads();
#pragma unroll
        for (int mt = 0; mt < 4; ++mt) {
            const int t = 16 * mt + fr; float tot = 0.f;
#pragma unroll
            for (int ww = 0; ww < 8; ++ww) tot += sqS[ww * 64 + t];
            const float r = rsqrtf(tot * (1.0f / 256.0f) + EPS);
#pragma unroll
            for (int nt = 0; nt < 2; ++nt) {
                const int vv = 32 * w + 16 * nt + 4 * fq;
                const v2u ow = *(const v2u*)(P + (m0 + t) * 3072 + 2048 + h * 256 + vv);
                const f32x4 g = *(const f32x4*)(ng + h * 256 + vv);
                const float o0 = bflo(ow.x), o1 = bfhi(ow.x), o2 = bflo(ow.y), o3 = bfhi(ow.y);
                const f32x4 hv = a1[mt][nt] * r * g;
                v2u yw; yw.x = pk2(hv[0] * __builtin_amdgcn_rcpf(1.0f + __expf(-o0)), hv[1] * __builtin_amdgcn_rcpf(1.0f + __expf(-o1)));
                yw.y = pk2(hv[2] * __builtin_amdgcn_rcpf(1.0f + __expf(-o2)), hv[3] * __builtin_amdgcn_rcpf(1.0f + __expf(-o3)));
                *(v2u*)(Y + (m0 + t) * 1024 + h * 256 + vv) = yw;
            }
        }
        __syncthreads();
    }
}
__device__ __forceinline__ att::BlockRef<att::bf16, att::bf16> attn_ref(int item, int grp, int pass, const att::bf16* Qb, const att::bf16* Kb, const att::bf16* Vb, att::bf16* Ob) {
    const int pc = item & 3, y = item >> 2, qb = pass ? 31 - y : y;
    const int b = grp >> 2, h = grp & 3, c = pc >> 1, vh = pc & 1, hd = ((b * 4 + h) * 2 + c) * 2 + vh;
    att::BlockRef<att::bf16, att::bf16> r;
    r.Q = Qb + ((size_t)(b * 8 + h * 2 + c) * 8192 + (size_t)qb * 256) * 128;
    r.K = Kb + (size_t)(b * 8 + h * 2 + c) * 8192 * 128;
    r.V = Vb + (size_t)(b * 8 + h * 2 + vh) * 8192 * 128;
    r.O = Ob + ((size_t)hd * 8192 + (size_t)qb * 256) * 128;
    r.P0 = qb * 256;
    return r;
}
__device__ __forceinline__ void attn_phase(const Ctx& F, char* lds) {
    const att::bf16* Qb = (const att::bf16*)(F.ws + WS_P); const att::bf16* Kb = Qb + 16777216; const att::bf16* Vb = Kb + 16777216; att::bf16* Ob = (att::bf16*)(F.ws + WS_O);
    constexpr int total = 512; const int stride = F.G;
    int L = F.wg; if (L >= total) return;
    int pass = 0;
#define ATT_ITEM(L_) (((L_) >> 3) & 63)
#define ATT_GRP(L_) ((L_) & 7)
    att::BlockRef<att::bf16, att::bf16> cur = attn_ref(ATT_ITEM(L), ATT_GRP(L), 0, Qb, Kb, Vb, Ob);
    att::Seam<att::bf16> S;
    att::causal_swa_prime<att::bf16, att::bf16>(cur, 8192, lds, S, F.tid);
    for (;;) {
        const bool more_pass = pass == 0, more_item = L + stride < total, last = !more_pass && !more_item;
        int passn = pass + 1, Ln = L;
        if (!more_pass) { passn = 0; Ln = more_item ? L + stride : L; }
        const att::BlockRef<att::bf16, att::bf16> nxt = last ? cur : attn_ref(ATT_ITEM(Ln), ATT_GRP(Ln), passn, Qb, Kb, Vb, Ob);
        att::causal_swa_block<att::bf16, att::bf16>(cur, nxt, 8192, 8192, lds, S, F.tid);
        if (last) break;
        cur = nxt; pass = passn; L = Ln;
    }
#undef ATT_ITEM
#undef ATT_GRP
}
__device__ __forceinline__ void combine_phase(const Ctx& F, int l) {
    const int j = l >> 1;
    const bf16r* Ob = (const bf16r*)(F.ws + WS_O); bf16r* Y = (bf16r*)(F.ws + WS_Y);
    const float lam = ((const float*)(F.ws + WS_LAM))[j];
    const float omi = 1.0f - (j == 0 ? 0.35550906759096934f : 0.5560582041556406f);
    const float* ng = ((const float*)F.ka->in[16]) + j * 256;
    const int gw = F.wg * NWAVES + F.wave, NGW = F.G * NWAVES;
    const int vv = F.lane * 4, vh = vv >> 7, dd = vv & 127;
    const f32x4 g = *(const f32x4*)(ng + vv);
    for (int task = gw; task < M * 4; task += NGW) {
        const int m = task >> 2, h = task & 3, b = m >> 13, s = m & 8191;
        const int hd0 = ((b * 4 + h) * 2 + 0) * 2 + vh, hd1 = hd0 + 2;
        const v2u w0 = *(const v2u*)(Ob + ((size_t)hd0 * 8192 + s) * 128 + dd), w1 = *(const v2u*)(Ob + ((size_t)hd1 * 8192 + s) * 128 + dd);
        f32x4 o = {bflo(w0.x) - lam * bflo(w1.x), bfhi(w0.x) - lam * bfhi(w1.x), bflo(w0.y) - lam * bflo(w1.y), bfhi(w0.y) - lam * bfhi(w1.y)};
        const float ss = wave_sum((o[0] * o[0] + o[1] * o[1]) + (o[2] * o[2] + o[3] * o[3]));
        const float r = rsqrtf(ss * (1.0f / 256.0f) + EPS) * omi;
        o = o * r * g;
        v2u yw; yw.x = pk2(o[0], o[1]); yw.y = pk2(o[2], o[3]);
        *(v2u*)(Y + (size_t)m * 1024 + h * 256 + vv) = yw;
    }
}
__device__ __forceinline__ void final_phase(const Ctx& F) {
    const float* ssqp = (const float*)(F.ws + WS_SSQP);
    const int gw = F.wg * NWAVES + F.wave, NGW = F.G * NWAVES;
    for (int m = gw; m < M; m += NGW) {
        float ss = F.lane < 16 ? ssqp[(size_t)F.lane * M + m] : 0.f; ss = wave_sum(ss);
        const float rs = rsqrtf(ss * (1.0f / 1024.0f) + EPS);
        f32x4* orow = (f32x4*)(F.out + (size_t)m * 1024) + F.lane;
#pragma unroll
        for (int jj = 0; jj < 4; ++jj) { const f32x4 g = *(const f32x4*)(((const float*)F.ka->in[18]) + 4 * F.lane + 256 * jj); orow[64 * jj] = orow[64 * jj] * rs * g; }
    }
}

#if MK_DEBUG
#ifndef DBG_SET
#define DBG_SET 0
#endif
__device__ __forceinline__ void dbg_flag(const Ctx& F, bool bad, unsigned code) {
    int bit = -1;
    switch (code) { case 30: bit = 0; break; case 8: case 31: case 9: bit = 1; break; case 10: bit = 2; break; case 11: bit = 3; break; case 13: case 14: case 15: bit = 4; break;
                    case 16: case 17: bit = 5; break; case 18: bit = 6; break; case 19: bit = 7; break; case 20: bit = 8; break; case 21: bit = 9; break; case 23: bit = 10; break; default: break; }
    if (bad && bit >= 0) atomicOr((unsigned*)(F.ws + 64), 1u << bit);
}
__device__ __forceinline__ bool dbg_ne(float got, float ref) { return !(fabsf(got - ref) <= 0.03f * fabsf(ref) + 0.03f); }
__device__ __forceinline__ unsigned dbg_hash(unsigned i) { i = i * 2654435761u + 12345u; i ^= i >> 15; i *= 2246822519u; i ^= i >> 13; i *= 3266489917u; i ^= i >> 16; return i; }
__device__ __forceinline__ float dbg_rstd(const Ctx& F, int m) { const float* ssqp = (const float*)(F.ws + WS_SSQP); float s = 0.f; for (int p = 0; p < 16; ++p) s += ssqp[(size_t)p * M + m]; return rsqrtf(s * (1.0f / 1024.0f) + EPS); }
__device__ __forceinline__ float dbg_silu(float g) { return g / (1.0f + expf(-g)); }
__device__ __forceinline__ void dbg_check_p0(const Ctx& F) {
    if (F.wg != 0) return;
    const unsigned r = dbg_hash(F.tid);
    const float* ADA = (const float*)(F.ws + WS_ADA);
    { const float t = wave_sum((float)(F.lane + 1)), t2 = wave_max((float)((F.lane * 37) & 63)); dbg_flag(F, t != 2080.0f || t2 != 63.0f, 30); }
    { const int l = r % 4, b = (r >> 2) & 1, j = (r >> 3) % 9216; float ref = ((const float*)F.ka->in[4])[(size_t)l * 9216 + j];
      for (int k = 0; k < 1024; ++k) ref += dbg_silu(((const float*)F.ka->in[1])[b * 1024 + k]) * ((const float*)F.ka->in[3])[((size_t)l * 1024 + k) * 9216 + j];
      dbg_flag(F, dbg_ne(ADA[(size_t)(l * 2 + b) * 9216 + j], ref), 1); }
    { const int mat = r % 8, k = (r >> 3) % 1024, n = (r >> 13) % 5632; const float src = ((const float*)F.ka->in[6])[((size_t)mat * 1024 + k) * 5632 + n];
      const int drow = n < 2816 ? (n >> 7) * 256 + (n & 127) : ((n - 2816) >> 7) * 256 + 128 + ((n - 2816) & 127);
      dbg_flag(F, dbg_ne(bf2f(((const bf16r*)(F.ws + WS_W13))[((size_t)mat * 5632 + drow) * 1024 + k]), src), 2); }
    { const int mat = r % 8, k = (r >> 3) % 2816, n = (r >> 15) % 1024; const float src = ((const float*)F.ka->in[7])[((size_t)mat * 2816 + k) * 1024 + n];
      dbg_flag(F, dbg_ne(bf2f(((const bf16r*)(F.ws + WS_W2))[((size_t)mat * 1024 + n) * 2816 + k]), src), 3); }
    { const int mat = r % 2, k = (r >> 1) % 1024, n = (r >> 11) % 3072; const float src = ((const float*)F.ka->in[8])[((size_t)mat * 1024 + k) * 3080 + n];
      dbg_flag(F, dbg_ne(bf2f(((const bf16r*)(F.ws + WS_WINA))[((size_t)mat * 3072 + n) * 1024 + k]), src), 4); }
    { const int mat = r % 2, k = (r >> 1) % 1024, n = (r >> 11) % 3072; const float src = ((const float*)F.ka->in[14])[((size_t)mat * 1024 + k) * 3072 + n];
      dbg_flag(F, dbg_ne(bf2f(((const bf16r*)(F.ws + WS_WINB))[((size_t)mat * 3072 + n) * 1024 + k]), src), 5); }
    { const int mat = r % 2, k = (r >> 1) % 1024, n = (r >> 11) % 1024; const float sa = ((const float*)F.ka->in[13])[((size_t)mat * 1024 + k) * 1024 + n], sb = ((const float*)F.ka->in[17])[((size_t)mat * 1024 + k) * 1024 + n];
      dbg_flag(F, dbg_ne(bf2f(((const bf16r*)(F.ws + WS_WOA))[((size_t)mat * 1024 + n) * 1024 + k]), sa) || dbg_ne(bf2f(((const bf16r*)(F.ws + WS_WOB))[((size_t)mat * 1024 + n) * 1024 + k]), sb), 6); }
}
__device__ __forceinline__ void dbg_check_p1(const Ctx& F) {
    if (F.wg != 0) return;
    const unsigned r = dbg_hash(F.tid + 1000);
    const float* ADA = (const float*)(F.ws + WS_ADA);
    { const int m = r % 16384, col = (r >> 14) % 1024, b = m >> 13;
      const float ref = ((const float*)F.ka->in[0])[(size_t)m * 1024 + col] * ((const float*)F.ka->in[5])[col] * (1.0f + ADA[(size_t)b * 9216 + 1024 + col]);
      dbg_flag(F, dbg_ne(bf2f(((const bf16r*)(F.ws + WS_XS))[(size_t)m * 1024 + col]), ref) || dbg_ne(F.out[(size_t)m * 1024 + col], ((const float*)F.ka->in[0])[(size_t)m * 1024 + col]), 7); }
    { const int q = r % 8, b = (r >> 3) & 1, n = (r >> 4) % 5632, l = q >> 1, f = q & 1; float ref = 0.f;
      for (int k = 0; k < 1024; ++k) ref += ADA[(size_t)(l * 2 + b) * 9216 + (f ? 2 : 0) * 3072 + k] * bf2f(((const bf16r*)(F.ws + WS_W13))[((size_t)q * 5632 + n) * 1024 + k]);
      dbg_flag(F, dbg_ne(((const float*)(F.ws + WS_SWF))[(size_t)(q * 2 + b) * 5632 + n], ref), b ? 31 : 8); }
    { const int l = r % 4, b = (r >> 2) & 1, n = (r >> 3) % 3072; const bf16r* W = (const bf16r*)(F.ws + ((l & 1) ? WS_WINB : WS_WINA)) + ((size_t)(l >> 1) * 3072 + n) * 1024; float ref = 0.f;
      for (int k = 0; k < 1024; ++k) ref += ADA[(size_t)(l * 2 + b) * 9216 + 3072 + k] * bf2f(W[k]);
      dbg_flag(F, dbg_ne(((const float*)(F.ws + WS_SWM))[(size_t)(l * 2 + b) * 3072 + n], ref), 9); }
    { const int m = r % 16384; float s = 0.f; for (int k = 0; k < 1024; ++k) { const float v = ((const float*)F.ka->in[0])[(size_t)m * 1024 + k]; s += v * v; }
      const float rs = rsqrtf(s * (1.0f / 1024.0f) + EPS); dbg_flag(F, fabsf(dbg_rstd(F, m) - rs) > 1e-3f * rs, 10); }
}
__device__ __forceinline__ void dbg_check_up(const Ctx& F) {
    if (F.wg != 0) return;
    const unsigned r = dbg_hash(F.tid + 2000);
    const int m = r % 16384, n = (r >> 14) % 2816, b = m >> 13, grow = (n >> 7) * 256 + (n & 127), urow = grow + 128;
    const float rs = dbg_rstd(F, m); const bf16r* XS = (const bf16r*)(F.ws + WS_XS) + (size_t)m * 1024; const bf16r* W = (const bf16r*)(F.ws + WS_W13);
    float g = 0.f, u = 0.f;
    for (int k = 0; k < 1024; ++k) { const float xv = bf2f(XS[k]); g += xv * bf2f(W[(size_t)grow * 1024 + k]); u += xv * bf2f(W[(size_t)urow * 1024 + k]); }
    const float* SWF = (const float*)(F.ws + WS_SWF) + (size_t)b * 5632;
    g = g * rs + SWF[grow]; u = u * rs + SWF[urow];
    dbg_flag(F, dbg_ne(bf2f(((const bf16r*)(F.ws + WS_H))[(size_t)m * 2816 + n]), dbg_silu(g) * u), 11);
}
__device__ __forceinline__ void dbg_check_down(const Ctx& F) {
    if (F.wg != 0) return;
    const unsigned r = dbg_hash(F.tid + 3000);
    const int m = r % 16384, n = (r >> 14) % 1024, b = m >> 13;
    const bf16r* H = (const bf16r*)(F.ws + WS_H) + (size_t)m * 2816; const bf16r* W = (const bf16r*)(F.ws + WS_W2) + (size_t)n * 2816;
    float d = 0.f; for (int k = 0; k < 2816; ++k) d += bf2f(H[k]) * bf2f(W[k]);
    const float* ADA = (const float*)(F.ws + WS_ADA);
    const float ref = ((const float*)F.ka->in[0])[(size_t)m * 1024 + n] + 0.5f * ADA[(size_t)b * 9216 + 2048 + n] * d, got = F.out[(size_t)m * 1024 + n];
    dbg_flag(F, dbg_ne(got, ref), 13);
    dbg_flag(F, dbg_ne(bf2f(((const bf16r*)(F.ws + WS_XS))[(size_t)m * 1024 + n]), got * ((const float*)(F.ws + WS_GS))[(size_t)(0 * 3 + 1) * 2048 + b * 1024 + n]), 14);
    float s = 0.f; for (int k = 0; k < 1024; ++k) { const float v = F.out[(size_t)m * 1024 + k]; s += v * v; }
    const float rs = rsqrtf(s * (1.0f / 1024.0f) + EPS); dbg_flag(F, fabsf(dbg_rstd(F, m) - rs) > 1e-3f * rs, 15);
}
__device__ __forceinline__ float dbg_inproj(const Ctx& F, int l, int m, int n) {
    const int b = m >> 13; const float rs = dbg_rstd(F, m);
    const bf16r* XS = (const bf16r*)(F.ws + WS_XS) + (size_t)m * 1024; const bf16r* W = (const bf16r*)(F.ws + ((l & 1) ? WS_WINB : WS_WINA)) + ((size_t)(l >> 1) * 3072 + n) * 1024;
    float a = 0.f; for (int k = 0; k < 1024; ++k) a += bf2f(XS[k]) * bf2f(W[k]);
    return a * rs + ((const float*)(F.ws + WS_SWM))[(size_t)(l * 2 + b) * 3072 + n];
}
__device__ __forceinline__ void dbg_check_inproj0(const Ctx& F) {
    if (F.wg != 0) return;
    const unsigned r = dbg_hash(F.tid + 4000);
    const int m = r % 16384, n = (r >> 14) % 3072, b = m >> 13;
    dbg_flag(F, dbg_ne(bf2f(((const bf16r*)(F.ws + WS_P))[(size_t)m * 3072 + n]), dbg_inproj(F, 0, m, n)), 16);
    const int g = n & 7; const float rs = dbg_rstd(F, m); const bf16r* XS = (const bf16r*)(F.ws + WS_XS) + (size_t)m * 1024; const float* ADA = (const float*)(F.ws + WS_ADA);
    float a = 0.f, sgw = 0.f; for (int k = 0; k < 1024; ++k) { const float w = ((const float*)F.ka->in[8])[(size_t)k * 3080 + 3072 + g]; a += bf2f(XS[k]) * w; sgw += ADA[(size_t)b * 9216 + 3072 + k] * w; }
    dbg_flag(F, dbg_ne(((const float*)(F.ws + WS_GATES))[(size_t)m * 8 + g], a * rs + sgw), 17);
}
__device__ __forceinline__ void dbg_check_inproj1(const Ctx& F) {
    if (F.wg != 0) return;
    const unsigned r = dbg_hash(F.tid + 5000);
    const int m = r % 16384, n = (r >> 14) % 3072, b = m >> 13, s = m & 8191, blk = n >> 7, d = n & 127, which = blk >> 3, idx = blk & 7;
    float ref = dbg_inproj(F, 1, m, n);
    if (which < 2 && d < 32) {
        const int fi = d & 15; const float other = dbg_inproj(F, 1, m, d < 16 ? n + 16 : n - 16);
        const float a = (float)((const int*)F.ka->in[2])[m] * pg8::ROPE_INVF[fi];
        const float kk = rintf(a * 0.15915494309189535f); float rr = fmaf(-kk, 6.2831854820251465f, a); rr = fmaf(-kk, -1.7484555314695172e-07f, rr);
        const float c = __cosf(rr), sn = __sinf(rr);
        ref = d < 16 ? ref * c - other * sn : ref * c + other * sn;
    }
    dbg_flag(F, dbg_ne(bf2f(((const bf16r*)(F.ws + WS_P))[(size_t)which * 16777216 + ((size_t)(b * 8 + idx) * 8192 + s) * 128 + d]), ref), 20);
}
__device__ __forceinline__ void dbg_check_mlstm(const Ctx& F, LAS unsigned char* lds) {
    if (F.wg != 0) return;
    LAS float* C = (LAS float*)lds;
    LAS float* qs = C + 32768, *ks = qs + 128, *vs = ks + 128, *nn = vs + 256, *hv = nn + 128, *red = hv + 256;
    const int h = 1, tid = F.tid;
    const bf16r* P = (const bf16r*)(F.ws + WS_P); const float* GT = (const float*)(F.ws + WS_GATES); const bf16r* Y = (const bf16r*)(F.ws + WS_Y);
    const float* cw = (const float*)F.ka->in[9]; const float* cb = (const float*)F.ka->in[10]; const float* bif = (const float*)F.ka->in[11]; const float* ng = (const float*)F.ka->in[12];
    for (int i = tid; i < 32768; i += 512) C[i] = 0.f;
    if (tid < 128) nn[tid] = 0.f;
    float mstate = 0.f;
    __syncthreads();
    for (int t = 0; t < 160; ++t) {
        if (tid < 256) { const int isk = tid >> 7, d = tid & 127, ch = isk * 512 + h * 128 + d; float a = cb[ch];
            for (int jt = 0; jt < 4; ++jt) if (t - 3 + jt >= 0) a += cw[jt * 1024 + ch] * bf2f(P[(size_t)(t - 3 + jt) * 3072 + ch]);
            a = dbg_silu(a); if (isk) ks[d] = a * 0.08838834764831845f; else qs[d] = a; }
        else { const int v = tid - 256; vs[v] = bf2f(P[(size_t)t * 3072 + 1024 + h * 256 + v]); }
        __syncthreads();
        const float li = GT[(size_t)t * 8 + h] + bif[h], gf = GT[(size_t)t * 8 + 4 + h] + bif[4 + h];
        const float lf = fminf(gf, 0.f) - log1pf(expf(-fabsf(gf)));
        const float mn = fmaxf(lf + mstate, li), fd = expf(lf + mstate - mn), ig = expf(li - mn);
        for (int i = tid; i < 32768; i += 512) { const int v = i >> 7, d = i & 127; C[i] = fd * C[i] + ig * vs[v] * ks[d]; }
        if (tid < 128) nn[tid] = fd * nn[tid] + ig * ks[tid];
        mstate = mn;
        __syncthreads();
        float den = 0.f; for (int d = 0; d < 128; ++d) den += nn[d] * qs[d];
        const float dn = 1.0f / fmaxf(fabsf(den), expf(-mn));
        { const int v = tid >> 1, half = tid & 1; float a = 0.f; for (int d = 0; d < 64; ++d) a += C[v * 128 + half * 64 + d] * qs[half * 64 + d];
          a += swz_xor<1>(a); if (half == 0) hv[v] = a * dn; }
        __syncthreads();
        float ss = 0.f; for (int v = 0; v < 256; ++v) ss += hv[v] * hv[v];
        const float rr = rsqrtf(ss * (1.0f / 256.0f) + EPS);
        if (tid < 256) { const int v = tid; const float o = bf2f(P[(size_t)t * 3072 + 2048 + h * 256 + v]);
            const float ref = hv[v] * rr * ng[h * 256 + v] / (1.0f + expf(-o));
            dbg_flag(F, dbg_ne(bf2f(Y[(size_t)t * 1024 + h * 256 + v]), ref), t < 64 ? 18 : 19); }
        __syncthreads();
    }
}
__device__ __forceinline__ void dbg_check_attn(const Ctx& F) {
    if (F.wg >= 8) return;
    const bf16r* Qb = (const bf16r*)(F.ws + WS_P); const bf16r* Kb = Qb + 16777216; const bf16r* Vb = Kb + 16777216; const bf16r* Ob = (const bf16r*)(F.ws + WS_O);
    const unsigned r = dbg_hash(F.wg * 8 + F.wave + 6000);
    const int hd = r % 32, row = (F.wave == 0) ? (int)((r >> 5) % 300) : (int)((r >> 5) % 8192);
    const int b = hd >> 4, h = (hd >> 2) & 3, c = (hd >> 1) & 1, vh = hd & 1, lane = F.lane;
    const bf16r* q = Qb + ((size_t)(b * 8 + h * 2 + c) * 8192 + row) * 128; const bf16r* K = Kb + (size_t)(b * 8 + h * 2 + c) * 8192 * 128; const bf16r* V = Vb + (size_t)(b * 8 + h * 2 + vh) * 8192 * 128;
    const float q0 = bf2f(q[lane * 2]), q1 = bf2f(q[lane * 2 + 1]);
    float mx = -1e30f, l = 0.f, o0 = 0.f, o1 = 0.f;
    for (int jk = 0; jk <= row; ++jk) {
        float sc = q0 * bf2f(K[(size_t)jk * 128 + lane * 2]) + q1 * bf2f(K[(size_t)jk * 128 + lane * 2 + 1]); sc = wave_sum(sc) * 0.08838834764831845f;
        const float mn = fmaxf(mx, sc), al = expf(mx - mn), p = expf(sc - mn);
        l = l * al + p; o0 = o0 * al + p * bf2f(V[(size_t)jk * 128 + lane * 2]); o1 = o1 * al + p * bf2f(V[(size_t)jk * 128 + lane * 2 + 1]); mx = mn;
    }
    const bf16r* O = Ob + ((size_t)hd * 8192 + row) * 128;
    dbg_flag(F, dbg_ne(bf2f(O[lane * 2]), o0 / l) || dbg_ne(bf2f(O[lane * 2 + 1]), o1 / l), 21);
}
__device__ __forceinline__ void dbg_check_combine(const Ctx& F) {
    if (F.wg != 0) return;
    const unsigned r = dbg_hash(F.tid + 7000);
    const int m = r % 16384, h = (r >> 14) & 3, vv = (r >> 16) & 255, b = m >> 13, s = m & 8191;
    const bf16r* Ob = (const bf16r*)(F.ws + WS_O); const float lam = ((const float*)(F.ws + WS_LAM))[0];
    float ss = 0.f, mine = 0.f;
    for (int v = 0; v < 256; ++v) { const int hd0 = ((b * 4 + h) * 2) * 2 + (v >> 7);
        const float o = bf2f(Ob[((size_t)hd0 * 8192 + s) * 128 + (v & 127)]) - lam * bf2f(Ob[((size_t)(hd0 + 2) * 8192 + s) * 128 + (v & 127)]); ss += o * o; if (v == vv) mine = o; }
    const float ref = mine * rsqrtf(ss * (1.0f / 256.0f) + EPS) * ((const float*)F.ka->in[16])[vv] * (1.0f - 0.35550906759096934f);
    dbg_flag(F, dbg_ne(bf2f(((const bf16r*)(F.ws + WS_Y))[(size_t)m * 1024 + h * 256 + vv]), ref), 23);
}
#endif

constexpr int N_PHASES = 2 + 9 * DEPTH + 1;
constexpr int PH_ATT1 = 2 + 9 * 1 + 3, PH_ATT3 = 2 + 9 * 3 + 3;
#ifndef DBL_MASK
#define DBL_MASK 0
#endif
#ifndef MK_ONE_LAUNCH
#define MK_ONE_LAUNCH 1
#endif
__device__ __forceinline__ Ctx make_ctx(int wave_s) {
    KArgs ka = (KArgs)__builtin_amdgcn_kernarg_segment_ptr();
    asm volatile("" : "+s"(ka));
    Ctx F; F.ka = ka; F.out = ka->out; F.ws = ka->ws;
    { unsigned z0 = 0u; asm volatile("" : "+v"(z0)); const int t0 = wave_s * 64 + (int)__builtin_amdgcn_mbcnt_hi(~0u, __builtin_amdgcn_mbcnt_lo(~0u, z0)); F.tid = t0 & 511; }
    F.lane = F.tid & 63; F.wave = __builtin_amdgcn_readfirstlane(F.tid >> 6);
    { int g0 = gridDim.x, w0 = blockIdx.x; asm volatile("" : "+s"(g0), "+s"(w0)); F.G = g0; F.wg = w0; }
    return F;
}
template <bool FIRST> __device__ __forceinline__ void grid_seam(const Ctx& F, int& epoch) {
    if (FIRST && epoch == 0) {
        if (F.wg == 0 && F.tid == 0) __hip_atomic_store((unsigned*)F.ws, 0u, __ATOMIC_RELAXED, __HIP_MEMORY_SCOPE_AGENT);
        __threadfence(); cg::this_grid().sync(); epoch = 1; return;
    }
    asm volatile("s_waitcnt vmcnt(0) lgkmcnt(0)" ::: "memory");
    __syncthreads();
    if (F.tid == 0) {
        unsigned* cnt = (unsigned*)F.ws;
        __builtin_amdgcn_fence(__ATOMIC_RELEASE, "agent");
        asm volatile("s_waitcnt vmcnt(0)" ::: "memory");
        __hip_atomic_fetch_add(cnt, 1u, __ATOMIC_RELAXED, __HIP_MEMORY_SCOPE_AGENT);
        const unsigned target = (unsigned)epoch * (unsigned)F.G;
        while (__hip_atomic_load(cnt, __ATOMIC_RELAXED, __HIP_MEMORY_SCOPE_AGENT) < target) __builtin_amdgcn_s_sleep(2);
        __builtin_amdgcn_fence(__ATOMIC_ACQUIRE, "agent");
        asm volatile("s_waitcnt vmcnt(0)" ::: "memory");
    }
    __syncthreads();
    epoch += 1;
}
template <int PH, bool DRY = false> __device__ __forceinline__ void do_phase(int lo, int hi, int wave_s, LAS unsigned char* lds, unsigned char* lds_raw, int& epoch) {
    if (!(lo <= PH && PH < hi)) return;
    const Ctx F = make_ctx(wave_s);
    unsigned char* ws = F.ws;
    const float* ADA = (const float*)(ws + WS_ADA); const float* GS = (const float*)(ws + WS_GS); float* SSQP = (float*)(ws + WS_SSQP);
    bf16r* XS = (bf16r*)(ws + WS_XS); bf16r* H = (bf16r*)(ws + WS_H); bf16r* P = (bf16r*)(ws + WS_P); bf16r* Y = (bf16r*)(ws + WS_Y);
    constexpr bool is_layer = PH >= 2 && PH < N_PHASES - 1;
    constexpr int l = is_layer ? (PH - 2) / 9 : 0, s = is_layer ? (PH - 2) % 9 : -1, isattn = l & 1, j = l >> 1;
    constexpr bool empty = is_layer && s == 5 && isattn;
#if MK_DEBUG
    if constexpr (PH == 1) dbg_check_p0(F); else if constexpr (PH == 2) dbg_check_p1(F); else if constexpr (PH == 3) dbg_check_up(F); else if constexpr (PH == 4) dbg_check_down(F);
    else if constexpr (PH == 5) dbg_check_inproj0(F); else if constexpr (PH == 8) dbg_check_mlstm(F, lds); else if constexpr (PH == 14) dbg_check_inproj1(F);
    else if constexpr (PH == 15) dbg_check_attn(F); else if constexpr (PH == 17) dbg_check_combine(F);
    __syncthreads();
#endif
    if constexpr (PH == 0) p0_phase(F, lds);
    else if constexpr (PH == 1) p1_phase(F);
    else if constexpr (PH == N_PHASES - 1) { final_phase(F);
#if MK_DEBUG
        if (F.wg == 0) { asm volatile("s_waitcnt vmcnt(0)" ::: "memory"); __syncthreads(); const unsigned code = *(const unsigned*)(F.ws + 64); if (code) { float v = (float)(10 + (code % 90)) * 100.0f; for (unsigned q = 0; q < code / 90; ++q) v *= 10.0f; F.out[F.tid] = v; } }
#endif
    }
    else if constexpr (s == 0 || s == 7) {
        constexpr int f = s == 0 ? 0 : 1;
        pg8::Gemm g{XS, (const bf16r*)(ws + WS_W13) + (size_t)(l * 2 + f) * NUP * 1024, M, NUP, 1024};
        pg8::EpiGen E{0, H, (const float*)(ws + WS_SWF) + (size_t)(l * 2 + f) * 2 * NUP, SSQP, nullptr, nullptr, nullptr};
        pg8::StaticOrder S; S.init(M, NUP, F.G, F.wg);
        pg8::gemm_phase<pg8::EpiGen, pg8::StaticOrder, true, true>(lds, g, S, E, F.tid);
    } else if constexpr (s == 1 || s == 8) {
        constexpr int f = s == 1 ? 0 : 1, sub = f ? 2 : 0;
        pg8::Gemm g{H, (const bf16r*)(ws + WS_W2) + (size_t)(l * 2 + f) * 1024 * DFF, M, 1024, DFF};
        const float* gsn = f == 0 ? GS + (size_t)(l * 3 + 1) * 2048 : GS + (size_t)((l + 1 < DEPTH ? l + 1 : 0) * 3) * 2048;
        pg8::EpiGen E{DRY ? 5 : 1, F.out, ADA + (size_t)l * 2 * 9216 + sub * 3072 + 2048, gsn, nullptr, XS, SSQP};
        pg8::StaticOrder S; S.init(M, 1024, F.G, F.wg);
        pg8::gemm_phase<pg8::EpiGen, pg8::StaticOrder, true, true>(lds, g, S, E, F.tid);
    } else if constexpr (s == 2) {
        pg8::Gemm g{XS, (const bf16r*)(ws + (isattn ? WS_WINB : WS_WINA)) + (size_t)j * NIN * 1024, M, NIN, 1024};
        pg8::EpiGen E{isattn ? 4 : 3, P, (const float*)(ws + WS_SWM) + (size_t)l * 2 * NIN, SSQP, ((const int*)F.ka->in[2]), nullptr, nullptr};
        pg8::StaticOrder S; S.init(M, NIN, F.G, F.wg);
        pg8::gemm_phase<pg8::EpiGen, pg8::StaticOrder, true, true>(lds, g, S, E, F.tid);
        if constexpr (!isattn) { __syncthreads(); gates_phase(F, lds, l); }
    } else if constexpr (s == 6) {
        pg8::Gemm g{Y, (const bf16r*)(ws + (isattn ? WS_WOB : WS_WOA)) + (size_t)j * 1024 * 1024, M, 1024, 1024};
        pg8::EpiGen E{DRY ? 5 : 2, F.out, ADA + (size_t)l * 2 * 9216 + 3072 + 2048, GS + (size_t)(l * 3 + 2) * 2048, nullptr, XS, SSQP};
        pg8::StaticOrder S; S.init(M, 1024, F.G, F.wg);
        pg8::gemm_phase<pg8::EpiGen, pg8::StaticOrder, true, true>(lds, g, S, E, F.tid);
    }
    else if constexpr (s == 3) { if constexpr (isattn) attn_phase(F, (char*)lds_raw); else s1_phase(F, lds, l); }
    else if constexpr (s == 4) { if constexpr (isattn) combine_phase(F, l); else s2_phase(F); }
    else if constexpr (s == 5) { if constexpr (!isattn) s3_phase(F, lds, l); }
    if (PH + 1 < hi && !empty) grid_seam<PH == 0>(F, epoch);
}
template <int PH> __device__ __forceinline__ void do_twice(int lo, int hi, int wave_s, LAS unsigned char* lds, unsigned char* lds_raw, int& epoch) {
    constexpr bool is_layer = PH >= 2 && PH < N_PHASES - 1;
    constexpr int l = is_layer ? (PH - 2) / 9 : 0, s = is_layer ? (PH - 2) % 9 : -1, isattn = l & 1;
    constexpr bool dbl = ((DBL_MASK & 1) && (PH == 0 || PH == 1)) || ((DBL_MASK & 2) && is_layer && !isattn && (s == 3 || s == 4 || s == 5)) || ((DBL_MASK & 4) && is_layer && isattn && s == 3)
                      || ((DBL_MASK & 8) && is_layer && (s == 0 || s == 7)) || ((DBL_MASK & 16) && is_layer && s == 2) || ((DBL_MASK & 32) && is_layer && isattn && s == 4) || ((DBL_MASK & 256) && is_layer && !isattn && s == 3) || ((DBL_MASK & 512) && is_layer && !isattn && s == 4) || ((DBL_MASK & 1024) && is_layer && !isattn && s == 5) || ((DBL_MASK & 2048) && PH == 0) || ((DBL_MASK & 4096) && PH == 1);
    constexpr bool dry = ((DBL_MASK & 64) && is_layer && (s == 1 || s == 8)) || ((DBL_MASK & 128) && is_layer && s == 6);
    if constexpr (dry) do_phase<PH, true>(lo, hi, wave_s, lds, lds_raw, epoch);
    do_phase<PH>(lo, hi, wave_s, lds, lds_raw, epoch);
    if constexpr (dbl) do_phase<PH>(lo, hi, wave_s, lds, lds_raw, epoch);
}
template <int... I> __device__ __forceinline__ void all_phases(std::integer_sequence<int, I...>, int lo, int hi, int wave_s, LAS unsigned char* lds, unsigned char* lds_raw, int& epoch) {
    (do_twice<I>(lo, hi, wave_s, lds, lds_raw, epoch), ...);
}
__global__ void __launch_bounds__(NWAVES * 64, 2) mk_fwd(Args args) {
    extern __shared__ __attribute__((aligned(16))) unsigned char lds_raw[];
    LAS unsigned char* lds = (LAS unsigned char*)lds_raw;
    const int ph_lo = args.ph_lo, ph_hi = args.ph_hi;
    const int wave_s = __builtin_amdgcn_readfirstlane(threadIdx.x >> 6);
    if (ph_lo != 0 && ph_hi - ph_lo > 1) return;
    int epoch = 0;
    all_phases(std::make_integer_sequence<int, N_PHASES>{}, ph_lo, ph_hi, wave_s, lds, lds_raw, epoch);
}

extern "C" void kernel_launch(void* const* d_in, const int* in_sizes, int n_in, void* d_out, int out_size, void* d_ws, size_t ws_size, hipStream_t stream) {
    static int grid = 0;
    if (grid == 0) {
        if (n_in != 19 || out_size != M * DM || ws_size < WS_END) { fprintf(stderr, "kernel_launch: unexpected shapes (n_in %d out %d ws %zu)\n", n_in, out_size, ws_size); grid = -1; return; }
        int dev = 0, cus = 0, per_cu = 0;
        (void)hipGetDevice(&dev); (void)hipDeviceGetAttribute(&cus, hipDeviceAttributeMultiprocessorCount, dev);
        if (hipFuncSetAttribute((const void*)mk_fwd, hipFuncAttributeMaxDynamicSharedMemorySize, LDS_BYTES) != hipSuccess) { fprintf(stderr, "kernel_launch: hipFuncSetAttribute failed\n"); grid = -1; return; }
        if (hipOccupancyMaxActiveBlocksPerMultiprocessor(&per_cu, (const void*)mk_fwd, NWAVES * 64, LDS_BYTES) != hipSuccess || per_cu < 1) { fprintf(stderr, "kernel_launch: occupancy query gave %d\n", per_cu); per_cu = 1; }
        (void)hipGetLastError();
        grid = cus > 0 ? cus : 256;
    }
    if (grid < 0) return;
    Args a{};
    for (int i = 0; i < 19; ++i) a.in[i] = d_in[i];
    a.out = (float*)d_out; a.ws = (unsigned char*)d_ws;
#if MK_ONE_LAUNCH
    a.ph_lo = 0; a.ph_hi = N_PHASES;
    void* kargs[] = {&a};
    hipError_t e = hipLaunchCooperativeKernel((const void*)mk_fwd, dim3(grid), dim3(NWAVES * 64), kargs, LDS_BYTES, stream);
    if (e != hipSuccess) fprintf(stderr, "kernel_launch: cooperative launch failed: %s (grid %d)\n", hipGetErrorString(e), grid);
#else
    for (int ph = 0; ph < N_PHASES; ++ph) {
        if (ph >= 2 && ph < N_PHASES - 1 && ((ph - 2) / 9 & 1) && ((ph - 2) % 9 == 5)) continue;
        a.ph_lo = ph; a.ph_hi = ph + 1;
        hipLaunchKernelGGL(mk_fwd, dim3(grid), dim3(NWAVES * 64), LDS_BYTES, stream, a);
    }
#endif
}
```

```cpp
#include <hip/hip_runtime.h>
#include <hip/hip_bf16.h>
#include <hip/hip_cooperative_groups.h>
#include <cstdio>
#include <cstdint>
#include <cmath>
#include <utility>
template <int MASK> __device__ __forceinline__ float swz_xor(float v) { return __builtin_bit_cast(float, __builtin_amdgcn_ds_swizzle(__builtin_bit_cast(int, v), (MASK << 10) | 0x1f)); }
__device__ __forceinline__ float sum_x32(float v) { const unsigned u = __float_as_uint(v); auto rr = __builtin_amdgcn_permlane32_swap(u, u, false, false); const unsigned r0 = rr[0], r1 = rr[1]; return __uint_as_float(r0) + __uint_as_float(r1); }
__device__ __forceinline__ float max_x32(float v) { const unsigned u = __float_as_uint(v); auto rr = __builtin_amdgcn_permlane32_swap(u, u, false, false); const unsigned r0 = rr[0], r1 = rr[1]; return fmaxf(__uint_as_float(r0), __uint_as_float(r1)); }
namespace pg8 {
#define PG8_LAS __attribute__((address_space(3)))
typedef unsigned short bf16_t;
typedef short bf16x8 __attribute__((ext_vector_type(8)));
typedef float f32x4 __attribute__((ext_vector_type(4)));
typedef unsigned u32x4 __attribute__((ext_vector_type(4)));
constexpr int BM = 256, BK = 64, HALF = 128, HTB = HALF * BK * 2  , STAGE_BYTES = 8 * HTB, NXCD = 8, WGM = 8;

__host__ __device__ __forceinline__ int lds_byte(int r, int c) { const int st = (r >> 4) * 2 + (c >> 5), rr = r & 15, cc = c & 31, ob = rr * 64 + cc * 2; return st * 1024 + (ob ^ (((ob >> 9) & 1) << 5)); }
__host__ __device__ __forceinline__ void stage_rc(int b, int& R, int& C) { const int st = b / 1024, sb = b % 1024, swz = sb ^ (((sb >> 9) & 1) << 5); R = (st >> 1) * 16 + swz / 64; C = (st & 1) * 32 + (swz % 64) / 2; }
__host__ __device__ __forceinline__ int perm32(int rho) { const int n = rho >> 4, i = rho & 15; return 8 * (i >> 2) + 4 * n + (i & 3); }

struct Unit { int pm, pn; };
struct Gemm { const bf16_t* A; const bf16_t* Bt; int M, N, K; };

struct StaticOrder {
    int nM, nN, nwg, G, c;
    __host__ __device__ void init(int M, int N, int G_, int c_) { nM = M / BM; nN = N / BM; nwg = nM * nN; G = G_; c = c_; }
    __host__ __device__ bool next(int i, Unit& u) const {
        const long L = (long)i * G + c; if (L >= nwg) return false;
        int wgid = (int)L; { const int q = nwg / NXCD, r = nwg % NXCD, xcd = wgid % NXCD, off = wgid / NXCD; wgid = (xcd < r ? xcd * (q + 1) : r * (q + 1) + (xcd - r) * q) + off; }
        const int nig = WGM * nN, gid = wgid / nig, fm = gid * WGM, gsz = (nM - fm) < WGM ? (nM - fm) : WGM;
        u.pm = fm + ((wgid % nig) % gsz); u.pn = (wgid % nig) / gsz; return true;
    }
    __device__ __forceinline__ void a_ready(const Unit&) const {}
    __device__ __forceinline__ void done(const Unit&) const {}
};
__device__ __forceinline__ unsigned cvt_pk_bf16(float lo, float hi) { unsigned r; asm volatile("v_cvt_pk_bf16_f32 %0, %1, %2" : "=v"(r) : "v"(lo), "v"(hi)); return r; }
constexpr int MROWS = 16384;
constexpr float RMS_EPS = 1e-6f;
__device__ __forceinline__ float silu_f(float g) { return g * __builtin_amdgcn_rcpf(1.0f + __expf(-g)); }
__device__ __forceinline__ void rows_rstd(const float* ssqp, int row0, int fq, float (&rs)[2][4]) {
    float s[2][4];
#pragma unroll
    for (int ai = 0; ai < 2; ++ai)
#pragma unroll
        for (int m = 0; m < 4; ++m) { const float* p = ssqp + (size_t)(fq * 4) * MROWS + row0 + ai * HALF + m * 16;
            s[ai][m] = (p[0] + p[MROWS]) + (p[2 * MROWS] + p[3 * MROWS]); }
#pragma unroll
    for (int ai = 0; ai < 2; ++ai)
#pragma unroll
        for (int m = 0; m < 4; ++m) { float t = s[ai][m]; t += swz_xor<16>(t); t = sum_x32(t); rs[ai][m] = rsqrtf(t * (1.0f / 1024.0f) + RMS_EPS); }
}
__device__ __forceinline__ float row_rstd(const float* ssqp, int row, int fq) {
    float s = 0.f;
#pragma unroll
    for (int i = 0; i < 4; ++i) s += ssqp[(size_t)(fq * 4 + i) * MROWS + row];
    s += swz_xor<16>(s); s = sum_x32(s);
    return rsqrtf(s * (1.0f / 1024.0f) + RMS_EPS);
}
struct EpiUp {
    static constexpr bool PERM = true, AFTER_DRAIN = false;
    bf16_t* H; const float* sw; const float* ssqp;
    __device__ __forceinline__ void operator()(const f32x4 (&acc)[2][2][4][2], const Unit& u, int wr, int wc, int fr, int fq) const {
        const int b = u.pm >> 5, row0 = u.pm * BM + wr * 64 + fr, c8 = wc * 32 + 8 * fq;
        const float* swp = sw + (size_t)b * 5632 + u.pn * 256 + c8;
        const f32x4 sg0 = *(const f32x4*)(swp), sg1 = *(const f32x4*)(swp + 4), su0 = *(const f32x4*)(swp + 128), su1 = *(const f32x4*)(swp + 132);
        bf16_t* hp = H + (size_t)u.pn * 128 + c8;
        float rsv[2][4]; rows_rstd(ssqp, row0, fq, rsv);
#pragma unroll
        for (int ai = 0; ai < 2; ++ai)
#pragma unroll
            for (int m = 0; m < 4; ++m) {
                const int row = row0 + ai * HALF + m * 16;
                const float rs = rsv[ai][m];
                const f32x4 g0 = acc[ai][0][m][0] * rs + sg0, g1 = acc[ai][0][m][1] * rs + sg1;
                const f32x4 u0 = acc[ai][1][m][0] * rs + su0, u1 = acc[ai][1][m][1] * rs + su1;
                u32x4 w;
                w.x = cvt_pk_bf16(silu_f(g0[0]) * u0[0], silu_f(g0[1]) * u0[1]); w.y = cvt_pk_bf16(silu_f(g0[2]) * u0[2], silu_f(g0[3]) * u0[3]);
                w.z = cvt_pk_bf16(silu_f(g1[0]) * u1[0], silu_f(g1[1]) * u1[1]); w.w = cvt_pk_bf16(silu_f(g1[2]) * u1[2], silu_f(g1[3]) * u1[3]);
                *(u32x4*)(hp + (size_t)row * 2816) = w;
            }
    }
};
struct EpiBias {
    static constexpr bool PERM = true, AFTER_DRAIN = false;
    bf16_t* O; int ldc; const float* sw; int nsw; const float* ssqp;
    __device__ __forceinline__ void operator()(const f32x4 (&acc)[2][2][4][2], const Unit& u, int wr, int wc, int fr, int fq) const {
        const int b = u.pm >> 5, row0 = u.pm * BM + wr * 64 + fr, col0 = u.pn * BM + wc * 32 + 8 * fq;
        f32x4 sv[2][2];
#pragma unroll
        for (int bj = 0; bj < 2; ++bj)
#pragma unroll
            for (int n = 0; n < 2; ++n) sv[bj][n] = *(const f32x4*)(sw + (size_t)b * nsw + col0 + bj * HALF + 4 * n);
        float rsv[2][4]; rows_rstd(ssqp, row0, fq, rsv);
#pragma unroll
        for (int ai = 0; ai < 2; ++ai)
#pragma unroll
            for (int m = 0; m < 4; ++m) {
                const int row = row0 + ai * HALF + m * 16;
                const float rs = rsv[ai][m];
                bf16_t* rowp = O + (size_t)row * ldc + col0;
#pragma unroll
                for (int bj = 0; bj < 2; ++bj) {
                    const f32x4 v0 = acc[ai][bj][m][0] * rs + sv[bj][0], v1 = acc[ai][bj][m][1] * rs + sv[bj][1];
                    u32x4 w; w.x = cvt_pk_bf16(v0[0], v0[1]); w.y = cvt_pk_bf16(v0[2], v0[3]); w.z = cvt_pk_bf16(v1[0], v1[1]); w.w = cvt_pk_bf16(v1[2], v1[3]);
                    *(u32x4*)(rowp + bj * HALF) = w;
                }
            }
    }
};
template <int HALFC> struct EpiResidT {
    static constexpr bool PERM = true, AFTER_DRAIN = false;
    float* x; const float* gate; const float* gsn; bf16_t* xs; float* ssqp;
    __device__ __forceinline__ void operator()(const f32x4 (&acc)[2][2][4][2], const Unit& u, int wr, int wc, int fr, int fq) const {
        const int b = u.pm >> 5, row0 = u.pm * BM + wr * 64 + fr, col0 = u.pn * BM + wc * 32 + 8 * fq;
        constexpr float gcoef = HALFC == 2 ? 0.0f : (HALFC ? 0.5f : 1.0f);
        f32x4 gt[2][2], gs[2][2];
#pragma unroll
        for (int bj = 0; bj < 2; ++bj)
#pragma unroll
            for (int n = 0; n < 2; ++n) {
                gt[bj][n] = *(const f32x4*)(gate + (size_t)b * 9216 + col0 + bj * HALF + 4 * n) * gcoef;
                gs[bj][n] = *(const f32x4*)(gsn + (size_t)b * 1024 + col0 + bj * HALF + 4 * n);
            }
#pragma unroll
        for (int ai = 0; ai < 2; ++ai)
#pragma unroll
        for (int mp = 0; mp < 2; ++mp) {
            f32x4 xv[2][2][2];
#pragma unroll
            for (int mm = 0; mm < 2; ++mm)
#pragma unroll
                for (int bj = 0; bj < 2; ++bj) { const float* xp = x + (size_t)(row0 + ai * HALF + (mp * 2 + mm) * 16) * 1024 + col0 + bj * HALF; xv[mm][bj][0] = *(const f32x4*)xp; xv[mm][bj][1] = *(const f32x4*)(xp + 4); }
#pragma unroll
            for (int mm = 0; mm < 2; ++mm) {
                const int m = mp * 2 + mm, row = row0 + ai * HALF + m * 16;
                float ss = 0.f;
#pragma unroll
                for (int bj = 0; bj < 2; ++bj) {
                    float* xp = x + (size_t)row * 1024 + col0 + bj * HALF;
                    const f32x4 x0 = xv[mm][bj][0] + gt[bj][0] * acc[ai][bj][m][0], x1 = xv[mm][bj][1] + gt[bj][1] * acc[ai][bj][m][1];
                    *(f32x4*)xp = x0; *(f32x4*)(xp + 4) = x1;
                    ss += (x0[0] * x0[0] + x0[1] * x0[1]) + (x0[2] * x0[2] + x0[3] * x0[3]) + (x1[0] * x1[0] + x1[1] * x1[1]) + (x1[2] * x1[2] + x1[3] * x1[3]);
                    const f32x4 y0 = x0 * gs[bj][0], y1 = x1 * gs[bj][1];
                    u32x4 w; w.x = cvt_pk_bf16(y0[0], y0[1]); w.y = cvt_pk_bf16(y0[2], y0[3]); w.z = cvt_pk_bf16(y1[0], y1[1]); w.w = cvt_pk_bf16(y1[2], y1[3]);
                    *(u32x4*)(xs + (size_t)row * 1024 + col0 + bj * HALF) = w;
                }
                ss += swz_xor<16>(ss); ss = sum_x32(ss);
                if (fq == 0) ssqp[(size_t)(u.pn * 4 + wc) * MROWS + row] = ss;
            }
            asm volatile("" ::: "memory");
        }
    }
};
__constant__ float ROPE_INVF[16] = {1.000000000e+00f, 4.403665960e-01f, 1.939227432e-01f, 8.539710194e-02f, 3.760603070e-02f, 1.656044088e-02f, 7.292664610e-03f, 3.211446106e-03f,
                                    1.414213562e-03f, 6.227724371e-04f, 2.742481884e-04f, 1.207697351e-04f, 5.318295734e-05f, 2.341999971e-05f, 1.031338525e-05f, 4.541670478e-06f};
struct EpiRope {
    static constexpr bool PERM = true, AFTER_DRAIN = false;
    bf16_t* QKV; const float* sw; const float* ssqp; const int* pos;
    __device__ __forceinline__ void operator()(const f32x4 (&acc)[2][2][4][2], const Unit& u, int wr, int wc, int fr, int fq) const {
        const int b = u.pm >> 5, row0 = u.pm * BM + wr * 64 + fr, col0 = u.pn * BM + wc * 32 + 8 * fq;
        f32x4 sv[2][2];
#pragma unroll
        for (int bj = 0; bj < 2; ++bj)
#pragma unroll
            for (int n = 0; n < 2; ++n) sv[bj][n] = *(const f32x4*)(sw + (size_t)b * 3072 + col0 + bj * HALF + 4 * n);
        const bool rot = (wc == 0) && (u.pn < 8);
        const bool lower = fq < 2;
        float rsv[2][4]; rows_rstd(ssqp, row0, fq, rsv);
        f32x4 fr4[2] = {{0.f, 0.f, 0.f, 0.f}, {0.f, 0.f, 0.f, 0.f}};
        if (rot) { fr4[0] = *(const f32x4*)(ROPE_INVF + 8 * (fq & 1)); fr4[1] = *(const f32x4*)(ROPE_INVF + 8 * (fq & 1) + 4); }
#pragma unroll
        for (int ai = 0; ai < 2; ++ai)
#pragma unroll
            for (int m = 0; m < 4; ++m) {
                const int row = row0 + ai * HALF + m * 16, srow = row & 8191;
                const float rs = rsv[ai][m];
                f32x4 cs[2] = {{1.f, 1.f, 1.f, 1.f}, {1.f, 1.f, 1.f, 1.f}}, sn[2] = {{0.f, 0.f, 0.f, 0.f}, {0.f, 0.f, 0.f, 0.f}};
                if (rot) {
                    const float p = (float)pos[row];
#pragma unroll
                    for (int n = 0; n < 2; ++n)
#pragma unroll
                        for (int j = 0; j < 4; ++j) {
                            const float a = p * fr4[n][j];
                            const float k = rintf(a * 0.15915494309189535f);
                            float r = fmaf(-k, 6.2831854820251465f, a); r = fmaf(-k, -1.7484555314695172e-07f, r);
                            cs[n][j] = __cosf(r); sn[n][j] = lower ? -__sinf(r) : __sinf(r);
                        }
                }
#pragma unroll
                for (int bj = 0; bj < 2; ++bj) {
                    const int blk = u.pn * 2 + bj, which = blk >> 3, idx = blk & 7;
                    f32x4 v[2] = {acc[ai][bj][m][0] * rs + sv[bj][0], acc[ai][bj][m][1] * rs + sv[bj][1]};
                    if (rot) {
#pragma unroll
                        for (int n = 0; n < 2; ++n)
#pragma unroll
                            for (int j = 0; j < 4; ++j) {
                                const unsigned bits = __float_as_uint(v[n][j]);
                                auto rr = __builtin_amdgcn_permlane32_swap(bits, bits, false, false);
                                const unsigned r0 = rr[0], r1 = rr[1];
                                const float pv = __uint_as_float(lower ? r1 : r0);
                                v[n][j] = v[n][j] * cs[n][j] + pv * sn[n][j];
                            }
                    }
                    bf16_t* dp = QKV + (size_t)which * 16777216 + ((size_t)(b * 8 + idx) * 8192 + srow) * 128 + wc * 32 + 8 * fq;
                    u32x4 w; w.x = cvt_pk_bf16(v[0][0], v[0][1]); w.y = cvt_pk_bf16(v[0][2], v[0][3]); w.z = cvt_pk_bf16(v[1][0], v[1][1]); w.w = cvt_pk_bf16(v[1][2], v[1][3]);
                    *(u32x4*)dp = w;
                }
            }
    }
};
struct EpiGen {
    static constexpr bool PERM = true, AFTER_DRAIN = false;
    int kind; void* p0; const void* p1; const void* p2; const void* p3; void* p4; void* p5;
    __device__ __forceinline__ void operator()(const f32x4 (&acc)[2][2][4][2], const Unit& u, int wr, int wc, int fr, int fq) const {
        if (kind == 0) { EpiUp e{(bf16_t*)p0, (const float*)p1, (const float*)p2}; e(acc, u, wr, wc, fr, fq); }
        else if (kind == 1) { EpiResidT<1> e{(float*)p0, (const float*)p1, (const float*)p2, (bf16_t*)p4, (float*)p5}; e(acc, u, wr, wc, fr, fq); }
        else if (kind == 2) { EpiResidT<0> e{(float*)p0, (const float*)p1, (const float*)p2, (bf16_t*)p4, (float*)p5}; e(acc, u, wr, wc, fr, fq); }
        else if (kind == 3) { EpiBias e{(bf16_t*)p0, 3072, (const float*)p1, 3072, (const float*)p2}; e(acc, u, wr, wc, fr, fq); }
        else if (kind == 5) { EpiResidT<2> e{(float*)p0, (const float*)p1, (const float*)p2, (bf16_t*)p4, (float*)p5}; e(acc, u, wr, wc, fr, fq); }
        else { EpiRope e{(bf16_t*)p0, (const float*)p1, (const float*)p2, (const int*)p3}; e(acc, u, wr, wc, fr, fq); }
    }
};
template <class Epi, class Sched, bool ALIGN_EPI = false, bool SP2 = false>
__device__ __forceinline__ void gemm_phase(PG8_LAS unsigned char* lds, const Gemm g, const Sched& S, const Epi& E, const int tid_in) {
    const int tid = tid_in, wid = __builtin_amdgcn_readfirstlane(tid >> 6), lane = tid & 63, wr = wid >> 2, wc = wid & 3, fr = lane & 15, fq = lane >> 4;
    const int K = g.K, nt = K / BK;
    unsigned voffA[2], voffB[2];
#pragma unroll
    for (int i = 0; i < 2; ++i) { int R, C; stage_rc(tid * 16 + i * 8192, R, C); const int Rb = Epi::PERM ? ((R & ~31) + perm32(R & 31)) : R;
        voffA[i] = (unsigned)(R * K + C) * 2u; voffB[i] = (unsigned)(Rb * K + C) * 2u; }
    const size_t kstep = (size_t)(BK * 2);
    const size_t hstep = (size_t)HALF * K * 2;
    const size_t tstep = 2 * hstep;
    const unsigned ldsw = (unsigned)wid * 1024u;
    const int aoff = lds_byte(wr * 64 + fr, fq * 8), boff = lds_byte(wc * 32 + fr, fq * 8);
#define PG8_SA(b, h) (((b) * 2 + (h)) * HTB)
#define PG8_SB(b, h) ((4 + (b) * 2 + (h)) * HTB)
#define PG8_STAGE(bufoff, gbase, voff) do { _Pragma("unroll") for (int _i = 0; _i < 2; ++_i) \
        __builtin_amdgcn_global_load_lds((const unsigned*)((const char*)(gbase) + (voff)[_i]), (PG8_LAS unsigned*)(lds + (bufoff) + ldsw + _i * 8192), 16, 0, 0); } while (0)
#define PG8_LDA(dst, b, h) do { _Pragma("unroll") for (int m = 0; m < 4; ++m) _Pragma("unroll") for (int k = 0; k < 2; ++k) dst[m][k] = *(const PG8_LAS bf16x8*)(lds + PG8_SA(b, h) + aoff + m * 2048 + k * 1024); } while (0)
#define PG8_LDB(dst, b, h) do { _Pragma("unroll") for (int n = 0; n < 2; ++n) _Pragma("unroll") for (int k = 0; k < 2; ++k) dst[n][k] = *(const PG8_LAS bf16x8*)(lds + PG8_SB(b, h) + boff + n * 2048 + k * 1024); } while (0)
#define PG8_MMA(ai, bj, At, Bt) do { __builtin_amdgcn_s_setprio(1); _Pragma("unroll") for (int m = 0; m < 4; ++m) _Pragma("unroll") for (int n = 0; n < 2; ++n) _Pragma("unroll") for (int k = 0; k < 2; ++k) \
        acc[ai][bj][m][n] = __builtin_amdgcn_mfma_f32_16x16x32_bf16(Bt[n][k], At[m][k], acc[ai][bj][m][n], 0, 0, 0); __builtin_amdgcn_s_setprio(0); } while (0)
#define PG8_WAIT_V(n) asm volatile("s_waitcnt vmcnt(" #n ")" ::: "memory")
#define PG8_WAIT_L(n) asm volatile("s_waitcnt lgkmcnt(" #n ")" ::: "memory")
#define PG8_BAR __builtin_amdgcn_s_barrier()
#define PG8_SCHED __builtin_amdgcn_sched_barrier(0)
    Unit cur, nxt; int ui = 0;
    if (!S.next(0, cur)) return;
    f32x4 acc[2][2][4][2];
#pragma unroll
    for (int a = 0; a < 2; ++a)
#pragma unroll
        for (int b = 0; b < 2; ++b)
#pragma unroll
            for (int m = 0; m < 4; ++m)
#pragma unroll
                for (int n = 0; n < 2; ++n) acc[a][b][m][n] = (f32x4){0.f, 0.f, 0.f, 0.f};
    bf16x8 At[4][2], B0[2][2], B1[2][2];
    const char* cA = (const char*)g.A + (size_t)cur.pm * tstep; const char* cB = (const char*)g.Bt + (size_t)cur.pn * tstep;
    S.a_ready(cur);
    if constexpr (SP2) {
        PG8_STAGE(PG8_SB(0, 0), cB, voffB); PG8_STAGE(PG8_SB(0, 1), cB + hstep, voffB); PG8_STAGE(PG8_SA(0, 0), cA, voffA); PG8_STAGE(PG8_SA(0, 1), cA + hstep, voffA);
        if (wr == 1) PG8_BAR;
        PG8_WAIT_V(2); PG8_BAR;
        PG8_STAGE(PG8_SB(1, 0), cB + kstep, voffB); PG8_STAGE(PG8_SA(1, 0), cA + kstep, voffA); PG8_STAGE(PG8_SB(1, 1), cB + hstep + kstep, voffB);
        PG8_WAIT_V(6); PG8_BAR;
    } else {
        PG8_STAGE(PG8_SB(0, 0), cB, voffB); PG8_STAGE(PG8_SA(0, 0), cA, voffA); PG8_STAGE(PG8_SB(0, 1), cB + hstep, voffB); PG8_STAGE(PG8_SA(0, 1), cA + hstep, voffA);
        if (wr == 1) PG8_BAR;
        PG8_WAIT_V(4); PG8_BAR;
        PG8_STAGE(PG8_SB(1, 0), cB + kstep, voffB); PG8_STAGE(PG8_SA(1, 0), cA + kstep, voffA); PG8_STAGE(PG8_SB(1, 1), cB + hstep + kstep, voffB);
        PG8_WAIT_V(6); PG8_BAR;
    }
    for (;;) {
        const bool has_next = S.next(ui + 1, nxt);
        const char* nA = has_next ? (const char*)g.A + (size_t)nxt.pm * tstep : cA; const char* nB = has_next ? (const char*)g.Bt + (size_t)nxt.pn * tstep : cB;
        for (int t = 0; t < nt; t += 2) {
            const bool last = (t == nt - 2);
            const char* a1 = cA + (size_t)(t + 1) * kstep;
            const char* a2 = last ? nA : cA + (size_t)(t + 2) * kstep; const char* b2 = last ? nB : cB + (size_t)(t + 2) * kstep;
            const char* a3 = a2 + kstep; const char* b3 = b2 + kstep;
            if (last && has_next) S.a_ready(nxt);
            if constexpr (SP2) {
            PG8_LDB(B0, 0, 0); PG8_LDB(B1, 0, 1); PG8_SCHED; PG8_LDA(At, 0, 0); PG8_STAGE(PG8_SA(1, 1), a1 + hstep, voffA);
            PG8_WAIT_V(8); PG8_WAIT_L(0); PG8_BAR; PG8_MMA(0, 0, At, B0); PG8_MMA(0, 1, At, B1); PG8_BAR; PG8_SCHED;
            PG8_LDA(At, 0, 1); PG8_STAGE(PG8_SB(0, 0), b2, voffB); PG8_STAGE(PG8_SB(0, 1), b2 + hstep, voffB); PG8_STAGE(PG8_SA(0, 0), a2, voffA);
            PG8_WAIT_V(8); PG8_WAIT_L(0); PG8_BAR; PG8_MMA(1, 0, At, B0); PG8_MMA(1, 1, At, B1); PG8_BAR; PG8_SCHED;
            PG8_LDB(B0, 1, 0); PG8_LDB(B1, 1, 1); PG8_SCHED; PG8_LDA(At, 1, 0); PG8_STAGE(PG8_SA(0, 1), a2 + hstep, voffA);
            PG8_WAIT_V(8); PG8_WAIT_L(0); PG8_BAR; PG8_MMA(0, 0, At, B0); PG8_MMA(0, 1, At, B1); PG8_BAR; PG8_SCHED;
            PG8_LDA(At, 1, 1); PG8_STAGE(PG8_SB(1, 0), b3, voffB); PG8_STAGE(PG8_SB(1, 1), b3 + hstep, voffB); PG8_STAGE(PG8_SA(1, 0), a3, voffA);
            PG8_WAIT_V(8); PG8_WAIT_L(0); PG8_BAR; PG8_MMA(1, 0, At, B0); PG8_MMA(1, 1, At, B1); PG8_BAR; PG8_SCHED;
            } else {
            PG8_LDB(B0, 0, 0); PG8_SCHED; PG8_LDA(At, 0, 0); PG8_STAGE(PG8_SA(1, 1), a1 + hstep, voffA);
            PG8_WAIT_L(8); PG8_BAR; PG8_WAIT_L(0); PG8_MMA(0, 0, At, B0); PG8_BAR; PG8_SCHED;
            PG8_LDB(B1, 0, 1); PG8_STAGE(PG8_SB(0, 0), b2, voffB);
            PG8_BAR; PG8_WAIT_L(0); PG8_MMA(0, 1, At, B1); PG8_BAR;
            PG8_LDA(At, 0, 1); PG8_STAGE(PG8_SA(0, 0), a2, voffA);
            PG8_BAR; PG8_WAIT_L(0); PG8_MMA(1, 0, At, B0); PG8_BAR; PG8_SCHED;
            PG8_STAGE(PG8_SB(0, 1), b2 + hstep, voffB);
            PG8_WAIT_V(6); PG8_BAR; PG8_MMA(1, 1, At, B1); PG8_BAR;
            PG8_LDB(B0, 1, 0); PG8_SCHED; PG8_LDA(At, 1, 0); PG8_STAGE(PG8_SA(0, 1), a2 + hstep, voffA);
            PG8_WAIT_L(8); PG8_BAR; PG8_WAIT_L(0); PG8_MMA(0, 0, At, B0); PG8_BAR; PG8_SCHED;
            PG8_LDB(B1, 1, 1); PG8_STAGE(PG8_SB(1, 0), b3, voffB);
            PG8_BAR; PG8_WAIT_L(0); PG8_MMA(0, 1, At, B1); PG8_BAR;
            PG8_LDA(At, 1, 1); PG8_STAGE(PG8_SA(1, 0), a3, voffA);
            PG8_BAR; PG8_WAIT_L(0); PG8_MMA(1, 0, At, B0); PG8_BAR; PG8_SCHED;
            PG8_STAGE(PG8_SB(1, 1), b3 + hstep, voffB);
            PG8_WAIT_V(6); PG8_BAR; PG8_MMA(1, 1, At, B1); PG8_BAR;
            }
        }
        if constexpr (ALIGN_EPI) { if (wr == 0) PG8_BAR; }
        if constexpr (!Epi::AFTER_DRAIN) { E(acc, cur, wr, wc, fr, fq); S.done(cur); }
        if (!has_next) break;
#pragma unroll
        for (int a = 0; a < 2; ++a)
#pragma unroll
            for (int b = 0; b < 2; ++b)
#pragma unroll
                for (int m = 0; m < 4; ++m)
#pragma unroll
                    for (int n = 0; n < 2; ++n) acc[a][b][m][n] = (f32x4){0.f, 0.f, 0.f, 0.f};
        cur = nxt; cA = nA; cB = nB; ++ui;
        if constexpr (ALIGN_EPI) { if (wr == 1) PG8_BAR; }
    }
    PG8_WAIT_V(0);
    if constexpr (!ALIGN_EPI) { if (wr == 0) PG8_BAR; }
    PG8_BAR;
    if constexpr (Epi::AFTER_DRAIN) { E.fused(acc, cur, wr, wc, fr, fq, lds, wid, lane); S.done(cur); }
#undef PG8_SA
#undef PG8_SB
#undef PG8_STAGE
#undef PG8_LDA
#undef PG8_LDB
#undef PG8_MMA
#undef PG8_WAIT_V
#undef PG8_WAIT_L
#undef PG8_BAR
#undef PG8_SCHED
}
}
namespace att {
using bf16 = __hip_bfloat16;
constexpr int D = 128; constexpr float THR = 8.f; constexpr bool WSKIP = false;
constexpr float SCALE = 0.08838834764831845f;
constexpr int NW = 8, QBLK = 32, KVBLK = 64, QB = NW * QBLK;
constexpr int SHM_V = KVBLK * D * 2, SHM_K = KVBLK * D * 2;
constexpr int LDS_BYTES = 2 * SHM_V + 2 * SHM_K + NW * 64 * 4;
typedef short bf16x8 __attribute__((ext_vector_type(8)));
typedef short s16x4 __attribute__((ext_vector_type(4)));
typedef float f32x16 __attribute__((ext_vector_type(16)));
typedef float f32x4 __attribute__((ext_vector_type(4)));
typedef unsigned u32x4 __attribute__((ext_vector_type(4)));
template <class A, class Bt> struct same_t { static constexpr bool v = false; };
template <class A> struct same_t<A, A> { static constexpr bool v = true; };

#define KSWZ(row, colB) ((row) * 256 + ((colB) ^ (((row) & 7) << 4)))
#define SBAR() __builtin_amdgcn_sched_barrier(0)
__device__ __forceinline__ int v_st(int k, int c) { const int kk = (k & ~0xC) | ((k & 4) << 1) | ((k & 8) >> 1); return ((kk >> 3) * 4 + (c >> 5)) * 512 + ((kk & 7) * 32 + (c & 31)) * 2; }
__device__ __forceinline__ int v_rd_base(int lane) { return ((lane & 3) << 3) | (((lane >> 2) & 3) << 6) | (((lane >> 4) & 1) << 5) | (((lane >> 5) & 1) << 8); }
constexpr int v_rd_off(int d0, int ks, int half) { return d0 * 512 + ks * 4096 + half * 2048; }
__device__ __forceinline__ int crow(int r, int hi) { return (r & 3) + 8 * (r >> 2) + 4 * hi; }
__device__ __forceinline__ unsigned cvtpk(float lo, float hi) {
    unsigned r; asm volatile("v_cvt_pk_bf16_f32 %0, %1, %2" : "=v"(r) : "v"(lo), "v"(hi)); return r;
}
__device__ __forceinline__ bf16x8 pack8(f32x4 a, f32x4 b) {
    u32x4 w = {cvtpk(a[0], a[1]), cvtpk(a[2], a[3]), cvtpk(b[0], b[1]), cvtpk(b[2], b[3])};
    return *reinterpret_cast<bf16x8*>(&w);
}
template <class T> __device__ __forceinline__ bf16x8 load8(const T* p) {
    if constexpr (same_t<T, float>::v) { return pack8(*(const f32x4*)p, *(const f32x4*)(p + 4)); }
    else { return *reinterpret_cast<const bf16x8*>(p); }
}
__device__ __forceinline__ void mask_tile(f32x16& p0, f32x16& p1, int dq, unsigned W) {
    const float NEG = -__builtin_inff();
#pragma unroll
    for (int r = 0; r < 16; ++r) {
        const int c = (r & 3) + 8 * (r >> 2);
        if ((unsigned)(dq - c) >= W) p0[r] = NEG;
        if ((unsigned)(dq - c - 32) >= W) p1[r] = NEG;
    }
}
__device__ __forceinline__ void partialSM(f32x16& p0, f32x16& p1, float& m_reg, float& mn, float& alpha) {
    float pmax = p0[0]; for (int r = 1; r < 16; ++r) pmax = fmaxf(pmax, p0[r]); for (int r = 0; r < 16; ++r) pmax = fmaxf(pmax, p1[r]);
    { auto rr = __builtin_amdgcn_permlane32_swap(__float_as_uint(pmax), __float_as_uint(pmax), false, false);
      pmax = fmaxf(__uint_as_float(rr[0]), __uint_as_float(rr[1])); }
    constexpr float C2 = 1.4426950408889634f * SCALE;
    if (__builtin_expect(__all((pmax - m_reg) * SCALE <= THR), 1)) { mn = m_reg; alpha = 1.f; }
    else { mn = fmaxf(m_reg, pmax); alpha = __builtin_amdgcn_exp2f((m_reg - mn) * C2); m_reg = mn; }
    const float mnL = -mn * C2;
    for (int r = 0; r < 16; ++r) p0[r] = fmaf(p0[r], C2, mnL); for (int r = 0; r < 16; ++r) p1[r] = fmaf(p1[r], C2, mnL);
    for (int r = 0; r < 16; ++r) p0[r] = __builtin_amdgcn_exp2f(p0[r]);
}
__device__ __forceinline__ void finishSM(f32x16& p0, f32x16& p1, float alpha, float& l_reg, bf16x8& pa0, bf16x8& pa1, bf16x8& pa2, bf16x8& pa3) {
    for (int r = 0; r < 16; ++r) p1[r] = __builtin_amdgcn_exp2f(p1[r]);
    float ps = 0; for (int r = 0; r < 16; ++r) ps += p0[r]; for (int r = 0; r < 16; ++r) ps += p1[r];
    { auto rr = __builtin_amdgcn_permlane32_swap(__float_as_uint(ps), __float_as_uint(ps), false, false);
      ps = __uint_as_float(rr[0]) + __uint_as_float(rr[1]); }
    l_reg = l_reg * alpha + ps;
#define PK4(P, B_, OUT) do { unsigned a0 = cvtpk(P[B_+0], P[B_+1]), a1 = cvtpk(P[B_+2], P[B_+3]);                          \
        unsigned b0 = cvtpk(P[B_+4], P[B_+5]), b1 = cvtpk(P[B_+6], P[B_+7]);                                             \
        auto r0 = __builtin_amdgcn_permlane32_swap(a0, b0, false, false); auto r1 = __builtin_amdgcn_permlane32_swap(a1, b1, false, false); \
        u32x4 w = {r0[0], r1[0], r0[1], r1[1]}; OUT = *reinterpret_cast<bf16x8*>(&w); } while (0)
    PK4(p0, 0, pa0); PK4(p0, 8, pa1); PK4(p1, 0, pa2); PK4(p1, 8, pa3);
#undef PK4
}
template <int KB, bool SK>
__device__ __forceinline__ void qkt(f32x16& p0, f32x16& p1, const char* K_lds, int r32, int hi, const bf16x8* qr, bool act) {
    if (SK && !act) { const float NEG = -__builtin_inff();
#pragma unroll
        for (int r = 0; r < 16; ++r) { p0[r] = NEG; p1[r] = NEG; } return; }
    p0 = f32x16{}; p1 = f32x16{};
    const char* kb[4];
#pragma unroll
    for (int dd = 0; dd < 4; ++dd) kb[dd] = K_lds + KB * SHM_K + KSWZ(r32, (dd * 16 + hi * 8) * 2);
#pragma unroll
    for (int d0 = 0; d0 < 8; ++d0) { const char* a = kb[d0 & 3] + (d0 >> 2) * 128;
        bf16x8 b0 = *reinterpret_cast<const bf16x8*>(a);
        bf16x8 b1 = *reinterpret_cast<const bf16x8*>(a + 32 * 256);
        p0 = __builtin_amdgcn_mfma_f32_32x32x16_bf16(b0, qr[d0], p0, 0, 0, 0);
        p1 = __builtin_amdgcn_mfma_f32_32x32x16_bf16(b1, qr[d0], p1, 0, 0, 0); }
}
template <int VB, bool SK>
__device__ __forceinline__ void pv_tile(f32x16* o, int vb0, bf16x8 pa0, bf16x8 pa1, bf16x8 pa2, bf16x8 pa3, bool act) {
    if (SK && !act) return;
#define TRRD(dst, off) asm volatile("ds_read_b64_tr_b16 %0, %1 offset:%2" : "=&v"(dst) : "v"(vb0), "i"(off) : "memory")
#define PV_D0(d0) do { s16x4 l0, l1, l2, l3, h0, h1, h2, h3; constexpr int b_ = VB * SHM_V + v_rd_off(d0, 0, 0);     \
        TRRD(l0, b_); TRRD(h0, b_ + 2048); TRRD(l1, b_ + 4096); TRRD(h1, b_ + 6144); TRRD(l2, b_ + 8192); TRRD(h2, b_ + 10240); TRRD(l3, b_ + 12288); TRRD(h3, b_ + 14336); \
        asm volatile("s_waitcnt lgkmcnt(0)" ::: "memory"); SBAR();                 \
        o[d0] = __builtin_amdgcn_mfma_f32_32x32x16_bf16(pa0, (bf16x8){l0[0], l0[1], l0[2], l0[3], h0[0], h0[1], h0[2], h0[3]}, o[d0], 0, 0, 0);   \
        o[d0] = __builtin_amdgcn_mfma_f32_32x32x16_bf16(pa1, (bf16x8){l1[0], l1[1], l1[2], l1[3], h1[0], h1[1], h1[2], h1[3]}, o[d0], 0, 0, 0);   \
        o[d0] = __builtin_amdgcn_mfma_f32_32x32x16_bf16(pa2, (bf16x8){l2[0], l2[1], l2[2], l2[3], h2[0], h2[1], h2[2], h2[3]}, o[d0], 0, 0, 0);   \
        o[d0] = __builtin_amdgcn_mfma_f32_32x32x16_bf16(pa3, (bf16x8){l3[0], l3[1], l3[2], l3[3], h3[0], h3[1], h3[2], h3[3]}, o[d0], 0, 0, 0); } while (0)
    PV_D0(0); PV_D0(1); PV_D0(2); PV_D0(3);
#undef PV_D0
#undef TRRD
}

template <class TIn, class TOut> struct BlockRef { const TIn* Q; const TIn* K; const TIn* V; TOut* O; int P0; };
template <class TIn> struct Seam {
    bf16x8 qr[8];
    bf16x8 st_v0, st_v1, st_k0, st_k1; f32x4 sf0, sf1, sf2, sf3;
    f32x4 tq[16];
};
__device__ __forceinline__ int swa_jlo(int P0, int W) { const int lowk = P0 - W + 1; return lowk > 0 ? lowk / KVBLK : 0; }
#define ROW(p, k0, rr) ((p) + (size_t)((k0) + (rr)) * D + sc)
#define VMW() asm volatile("s_waitcnt vmcnt(0)" ::: "memory")
#define VMWN(n) asm volatile("s_waitcnt vmcnt(%0)" :: "i"(n) : "memory")
#define SLOAD_H(Kp, Vp, k0) do { S.st_v0 = load8<TIn>(ROW(Vp, k0, sr)); S.st_v1 = load8<TIn>(ROW(Vp, k0, 32 + sr));              \
                         S.st_k0 = load8<TIn>(ROW(Kp, k0, sr)); S.st_k1 = load8<TIn>(ROW(Kp, k0, 32 + sr)); } while (0)
#define SWRITE_HK(bf) do { *(bf16x8*)(K_lds + (bf) * SHM_K + kws) = S.st_k0; *(bf16x8*)(K_lds + (bf) * SHM_K + kws + 32 * 256) = S.st_k1; } while (0)
#define SWRITE_HV(bf) do { *(bf16x8*)(V_lds + (bf) * SHM_V + vst0) = S.st_v0; *(bf16x8*)(V_lds + (bf) * SHM_V + vst1) = S.st_v1; } while (0)
#define SWRITE_H(bf) do { SWRITE_HV(bf); SWRITE_HK(bf); } while (0)
#define SLOAD_F(p, k0) do { S.sf0 = *(const f32x4*)ROW(p, k0, sr); S.sf1 = *(const f32x4*)(ROW(p, k0, sr) + 4);                \
                            S.sf2 = *(const f32x4*)ROW(p, k0, 32 + sr); S.sf3 = *(const f32x4*)(ROW(p, k0, 32 + sr) + 4); } while (0)
#define SWRITE_KF(bf) do { *(bf16x8*)(K_lds + (bf) * SHM_K + kws) = pack8(S.sf0, S.sf1); *(bf16x8*)(K_lds + (bf) * SHM_K + kws + 32 * 256) = pack8(S.sf2, S.sf3); } while (0)
#define SWRITE_VF(bf) do { *(bf16x8*)(V_lds + (bf) * SHM_V + vst0) = pack8(S.sf0, S.sf1); *(bf16x8*)(V_lds + (bf) * SHM_V + vst1) = pack8(S.sf2, S.sf3); } while (0)
template <class TIn, class TOut>
__device__ __forceinline__ void causal_swa_prime(const BlockRef<TIn, TOut>& cur, int W, char* lds, Seam<TIn>& S, int tid_in) {
    constexpr bool F32 = same_t<TIn, float>::v;
    const int tid = tid_in, wid = __builtin_amdgcn_readfirstlane(tid >> 6), lane = tid & 63, r32 = lane & 31, hi = lane >> 5;
    const int sr = tid >> 4, sc = (tid & 15) * 8, kws = KSWZ(sr, sc * 2); char* K_lds = lds + 2 * SHM_V;
    const int kb0 = swa_jlo(cur.P0, W) * KVBLK;
    for (int d0 = 0; d0 < 8; ++d0) S.qr[d0] = load8<TIn>(cur.Q + (size_t)(wid * QBLK + r32) * D + d0 * 16 + hi * 8);
    if constexpr (F32) { SLOAD_F((const float*)cur.K, kb0); VMW(); SWRITE_KF(0); SBAR(); SLOAD_F((const float*)cur.V, kb0); }
    else { SLOAD_H(cur.K, cur.V, kb0); VMW(); SWRITE_HK(0); }
    __syncthreads();
}
template <class TIn, class TOut>
__device__ __forceinline__ void causal_swa_block(const BlockRef<TIn, TOut>& cur, const BlockRef<TIn, TOut>& nxt, int skv, int W, char* lds, Seam<TIn>& S, int tid_in) {
    constexpr bool F32 = same_t<TIn, float>::v;
    const int tid = tid_in, wid = __builtin_amdgcn_readfirstlane(tid >> 6), lane = tid & 63, r32 = lane & 31, hi = lane >> 5;
    const int j_lo = swa_jlo(cur.P0, W);
    int j_hi = (cur.P0 + QB - 1) / KVBLK + 1; if (j_hi > skv / KVBLK) j_hi = skv / KVBLK;
    const int NT = j_hi - j_lo;
    const int kbn = swa_jlo(nxt.P0, W) * KVBLK;
    const int qlo = cur.P0 + wid * QBLK, qm = qlo + r32 - 4 * hi;
    char* V_lds = lds; char* K_lds = lds + 2 * SHM_V;
    float* ws = (float*)(lds + 2 * SHM_V + 2 * SHM_K) + wid * 64; float* li_l = ws, * al_l = ws + 32;
    float m_reg = -1e30f, l_reg = 0; f32x16 o[4] = {};
    const int sr = tid >> 4, sc = (tid & 15) * 8, vst0 = v_st(sr, sc), vst1 = v_st(32 + sr, sc), kws = KSWZ(sr, sc * 2);
    const int vb0 = (int)(uintptr_t)V_lds + v_rd_base(lane);
    const TIn* Kh = cur.K; const TIn* Vh = cur.V;
#define RESC(a) do { if (__any((a) < 1.f)) { if (hi == 0) al_l[r32] = (a); asm volatile("s_waitcnt lgkmcnt(0)" ::: "memory");              \
                     for (int d_ = 0; d_ < 4; ++d_) for (int r = 0; r < 16; ++r) o[d_][r] *= al_l[crow(r, hi)]; } } while (0)
#define KBASE(t) ((j_lo + (t)) * KVBLK)
#define ACT(t) (KBASE(t) <= qlo + QBLK - 1 && KBASE(t) + KVBLK - 1 >= qlo - W + 1)
#define MASKT(P0_, P1_, t) do { const int kb_ = KBASE(t); if ((!SK || ACT(t)) && (kb_ + KVBLK - 1 > qlo || kb_ <= qlo + QBLK - 1 - W)) mask_tile(P0_, P1_, qm - kb_, (unsigned)W); } while (0)
    constexpr int NQL = F32 ? 16 : 8;
    constexpr bool SK = WSKIP && !F32;
#define SEAM_K0() do { VMWN(NQL); if constexpr (F32) { SWRITE_KF(0); SBAR(); SLOAD_F((const float*)nxt.V, kbn); } else { SWRITE_HK(0); } SBAR(); } while (0)
    f32x16 pA0, pA1, pB0, pB1; float mnA, mnB, alA, alB; bf16x8 pa0, pa1, pa2, pa3;
    if constexpr (F32) { VMW(); SWRITE_VF(0); SBAR(); } else { SWRITE_HV(0); SBAR(); }
    if (NT > 1) { if constexpr (F32) SLOAD_F((const float*)Kh, KBASE(1)); else SLOAD_H(Kh, Vh, KBASE(1)); }
    SBAR(); qkt<0, SK>(pA0, pA1, K_lds, r32, hi, S.qr, ACT(0));
    if constexpr (F32) { if (NT > 1) { VMW(); SWRITE_KF(1); SBAR(); SLOAD_F((const float*)Vh, KBASE(1)); } }
    MASKT(pA0, pA1, 0); partialSM(pA0, pA1, m_reg, mnA, alA);
    if (NT > 1) { VMW(); if constexpr (F32) { SWRITE_VF(1); SBAR(); if (NT > 2) SLOAD_F((const float*)Kh, KBASE(2)); } else SWRITE_H(1); }
    __syncthreads();
#define HALF_STEP(PX0, PX1, mnX, alX, PY0, PY1, alY, t, KB, VB, SB) do {                                                      \
        SBAR(); qkt<KB, SK>(PX0, PX1, K_lds, r32, hi, S.qr, ACT(t));                                             \
        finishSM(PY0, PY1, alY, l_reg, pa0, pa1, pa2, pa3); SBAR();                                                           \
        if ((t) + 1 < NT) { if constexpr (F32) { VMW(); SWRITE_KF(SB); SBAR(); SLOAD_F((const float*)Vh, KBASE((t) + 1)); }  \
                            else { SLOAD_H(Kh, Vh, KBASE((t) + 1)); } SBAR(); }                                               \
        pv_tile<VB, SK>(o, vb0, pa0, pa1, pa2, pa3, ACT((t) - 1)); MASKT(PX0, PX1, (t)); partialSM(PX0, PX1, m_reg, mnX, alX);                                        \
        __syncthreads();                                                                                                      \
        if ((t) + 1 < NT) { VMW(); if constexpr (F32) { SWRITE_VF(SB); SBAR(); if ((t) + 2 < NT) SLOAD_F((const float*)Kh, KBASE((t) + 2)); } \
                            else { SWRITE_H(SB); } }                                                                          \
        RESC(alX); __syncthreads(); } while (0)
    for (int t = 1; t + 1 < NT; t += 2) {
        HALF_STEP(pB0, pB1, mnB, alB, pA0, pA1, alA, t, 1, 0, 0);
        HALF_STEP(pA0, pA1, mnA, alA, pB0, pB1, alB, t + 1, 0, 1, 1);
    }
    const bool even = (NT & 1) == 0;
    if (even) { SBAR(); qkt<1, SK>(pB0, pB1, K_lds, r32, hi, S.qr, ACT(NT - 1)); SBAR(); }
#define QROW(e) (nxt.Q + (size_t)(wid * QBLK + r32) * D + ((e) >> 1) * 16 + hi * 8 + ((e) & 1) * 4)
    if constexpr (F32) { SLOAD_F((const float*)nxt.K, kbn); SBAR();
#pragma unroll
        for (int e = 0; e < 8; ++e) S.tq[e] = *(const f32x4*)QROW(e); }
    else { SLOAD_H(nxt.K, nxt.V, kbn); SBAR();
#pragma unroll
        for (int d0 = 0; d0 < 8; ++d0) S.qr[d0] = load8<TIn>(nxt.Q + (size_t)(wid * QBLK + r32) * D + d0 * 16 + hi * 8); }
    SBAR();
    finishSM(pA0, pA1, alA, l_reg, pa0, pa1, pa2, pa3); SBAR();
    if constexpr (F32) {
#pragma unroll
        for (int e = 8; e < 16; ++e) S.tq[e] = *(const f32x4*)QROW(e); SBAR(); }
#undef QROW
    pv_tile<0, SK>(o, vb0, pa0, pa1, pa2, pa3, ACT(even ? NT - 2 : NT - 1));
    if (even) { MASKT(pB0, pB1, NT - 1); partialSM(pB0, pB1, m_reg, mnB, alB); __syncthreads(); RESC(alB);
        finishSM(pB0, pB1, alB, l_reg, pa0, pa1, pa2, pa3); SBAR(); pv_tile<1, SK>(o, vb0, pa0, pa1, pa2, pa3, ACT(NT - 1)); }
    SBAR(); SEAM_K0();
    if (hi == 0) li_l[r32] = l_reg; asm volatile("s_waitcnt lgkmcnt(0)" ::: "memory");
    float rli[16];
#pragma unroll
    for (int r = 0; r < 16; ++r) rli[r] = __builtin_amdgcn_rcpf(li_l[crow(r, hi)]);
    TOut* Ow = cur.O + (size_t)(wid * QBLK) * D;
    int hi_e = hi; asm volatile("" : "+v"(hi_e));
#pragma unroll
    for (int r = 0; r < 16; ++r) { const int orow = crow(r, hi_e);
#pragma unroll
        for (int d0 = 0; d0 < 4; ++d0) { const float v = o[d0][r] * rli[r];
            if constexpr (same_t<TOut, float>::v) { Ow[(size_t)orow * D + d0 * 32 + r32] = v; }
            else { const float vn = swz_xor<1>(v);
                   if ((r32 & 1) == 0) *(unsigned*)(Ow + (size_t)orow * D + d0 * 32 + r32) = cvtpk(v, vn); } } }
    if constexpr (F32) {
#pragma unroll
        for (int d0 = 0; d0 < 8; ++d0) S.qr[d0] = pack8(S.tq[2 * d0], S.tq[2 * d0 + 1]); }
    __syncthreads();
#undef RESC
#undef KBASE
#undef ACT
#undef MASKT
#undef SEAM_K0
#undef HALF_STEP
}
#undef ROW
#undef VMW
#undef VMWN
#undef SLOAD_H
#undef SWRITE_HK
#undef SWRITE_HV
#undef SWRITE_H
#undef SLOAD_F
#undef SWRITE_KF
#undef SWRITE_VF
#undef SBAR
#undef KSWZ
}
namespace cg = cooperative_groups;
#ifndef S3_REP
#define S3_REP 1
#endif
#ifndef MK_DEBUG
#define MK_DEBUG 0
#endif
#define LAS __attribute__((address_space(3)))
typedef unsigned short bf16r;
typedef unsigned v4u __attribute__((ext_vector_type(4)));
typedef unsigned v2u __attribute__((ext_vector_type(2)));
typedef float f32x4 __attribute__((ext_vector_type(4)));
typedef short bf16x8 __attribute__((ext_vector_type(8)));
constexpr int M = 16384, SEQ = 8192, DM = 1024, DFF = 2816, NUP = 5632, NIN = 3072, DEPTH = 4;
constexpr float EPS = 1e-6f;
constexpr size_t MiB = 1u << 20;
constexpr size_t WS_ADA = 1 * MiB, WS_GS = 2 * MiB, WS_SWF = 3 * MiB, WS_SWM = 4 * MiB, WS_SSQP = 5 * MiB, WS_GATES = 6 * MiB, WS_BCUM = 7 * MiB, WS_LOGI = 8 * MiB,
                 WS_SCAL = 9 * MiB, WS_NLOC = 10 * MiB, WS_NST = 11 * MiB, WS_LAM = 12 * MiB, WS_WGT = 13 * MiB, WS_SWG = 14 * MiB;
constexpr size_t WS_W13 = 16 * MiB, WS_W2 = 104 * MiB, WS_WINA = 148 * MiB, WS_WINB = 160 * MiB, WS_WOA = 172 * MiB, WS_WOB = 176 * MiB;
constexpr size_t WS_XS = 180 * MiB, WS_H = 212 * MiB, WS_P = 300 * MiB, WS_Y = 396 * MiB, WS_U = 428 * MiB, WS_CST = 556 * MiB, WS_END = 620 * MiB;
constexpr size_t WS_O = WS_H;
constexpr int LDS_BYTES = 147456;
constexpr int NWAVES = 8;

typedef float f32x2_t __attribute__((ext_vector_type(2))); typedef __bf16 bf16x2_t __attribute__((ext_vector_type(2)));
__device__ __forceinline__ unsigned pk2(float lo, float hi) { f32x2_t v = {lo, hi}; bf16x2_t b = __builtin_convertvector(v, bf16x2_t); return __builtin_bit_cast(unsigned, b); }
__device__ __forceinline__ unsigned f2bf(float f) { return pk2(f, f) & 0xffffu; }
__device__ __forceinline__ float bflo(unsigned w) { return __uint_as_float(w << 16); }
__device__ __forceinline__ float bfhi(unsigned w) { return __uint_as_float(w & 0xffff0000u); }
__device__ __forceinline__ float bf2f(bf16r v) { return __uint_as_float((unsigned)v << 16); }
__device__ __forceinline__ float wave_sum(float v) {
    v += swz_xor<1>(v); v += swz_xor<2>(v); v += swz_xor<4>(v); v += swz_xor<8>(v); v += swz_xor<16>(v); return sum_x32(v);
}
__device__ __forceinline__ float wave_max(float v) {
    v = fmaxf(v, swz_xor<1>(v)); v = fmaxf(v, swz_xor<2>(v)); v = fmaxf(v, swz_xor<4>(v)); v = fmaxf(v, swz_xor<8>(v)); v = fmaxf(v, swz_xor<16>(v)); return max_x32(v);
}
__device__ __forceinline__ float lane_up(float v, int lane, int o) { return __builtin_bit_cast(float, __builtin_amdgcn_ds_bpermute(((lane - o) & 63) << 2, __builtin_bit_cast(int, v))); }
#define LDS_WAIT() asm volatile("s_waitcnt lgkmcnt(0)" ::: "memory")

struct Args { const void* in[19]; float* out; unsigned char* ws; int ph_lo, ph_hi; };
typedef const Args __attribute__((address_space(4)))* KArgs;
struct Ctx { KArgs ka; float* out; unsigned char* ws; int tid, lane, wave, G, wg; };

__device__ __forceinline__ void transpose_item(const float* W, int ldw, int k0, int n0, bf16r* dst  , int Kdst, LAS float* scr, int lane) {
#pragma unroll 8
    for (int i = 0; i < 32; ++i) { const int kk = 2 * i + (lane >> 5); scr[kk * 33 + (lane & 31)] = W[(size_t)(k0 + kk) * ldw + n0 + (lane & 31)]; }
    LDS_WAIT(); asm volatile("" ::: "memory");
    const int c = lane & 7;
#pragma unroll
    for (int j = 0; j < 4; ++j) { const int n = (lane >> 3) + 8 * j; const LAS float* s = scr + (8 * c) * 33 + n;
        v4u o; o.x = pk2(s[0 * 33], s[1 * 33]); o.y = pk2(s[2 * 33], s[3 * 33]); o.z = pk2(s[4 * 33], s[5 * 33]); o.w = pk2(s[6 * 33], s[7 * 33]);
        *(v4u*)(dst + (size_t)n * Kdst + k0 + 8 * c) = o; }
    LDS_WAIT(); asm volatile("" ::: "memory");
}
__device__ __forceinline__ void p0_phase(const Ctx& F, LAS unsigned char* lds) {
#if MK_DEBUG
    if (F.wg == 0 && F.tid == 1) *(unsigned*)(F.ws + 64) = 0u;
#endif
    {
        LAS float* red = (LAS float*)lds;
        float* ADA = (float*)(F.ws + WS_ADA);
        const int l32 = F.tid & 31, kg = F.tid >> 5;
        for (int task = F.wg; task < 4 * 72; task += F.G) {
            const int l = task / 72, col0 = (task % 72) * 128;
            f32x4 a0 = {0.f, 0.f, 0.f, 0.f}, a1 = {0.f, 0.f, 0.f, 0.f};
            const float* wp = ((const float*)F.ka->in[3]) + ((size_t)l * 1024 + kg * 64) * 9216 + col0 + l32 * 4;
#pragma unroll 8
            for (int kk = 0; kk < 64; ++kk) {
                const f32x4 w = *(const f32x4*)(wp + (size_t)kk * 9216);
                const float c0 = ((const float*)F.ka->in[1])[kg * 64 + kk], c1 = ((const float*)F.ka->in[1])[1024 + kg * 64 + kk];
                a0 += w * pg8::silu_f(c0); a1 += w * pg8::silu_f(c1);
            }
            *(LAS f32x4*)(red + (kg * 2 + 0) * 128 + l32 * 4) = a0; *(LAS f32x4*)(red + (kg * 2 + 1) * 128 + l32 * 4) = a1;
            __syncthreads();
            if (F.tid < 256) { const int b = F.tid >> 7, col = F.tid & 127; float s = 0.f;
#pragma unroll
                for (int g = 0; g < 16; ++g) s += red[(g * 2 + b) * 128 + col];
                ADA[(size_t)(l * 2 + b) * 9216 + col0 + col] = s + ((const float*)F.ka->in[4])[(size_t)l * 9216 + col0 + col]; }
            __syncthreads();
        }
    }
    for (int i = F.wg * 512 + F.tid; i < 2 * 8 * 1024; i += F.G * 512) { const int jj = i >> 13, g = (i >> 10) & 7, k = i & 1023;
        ((float*)(F.ws + WS_WGT))[i] = ((const float*)F.ka->in[8])[((size_t)jj * 1024 + k) * 3080 + 3072 + g]; }
    {
        LAS float* scr = (LAS float*)(lds + 16384 + F.wave * 8448);
        const int gw = F.wg * NWAVES + F.wave, NGW = F.G * NWAVES;
        constexpr int I13 = 16 * 176, I2 = 44 * 32, IIN = 16 * 96, IOUT = 16 * 32;
        constexpr int T0 = 8 * I13, T1 = T0 + 8 * I2, T2 = T1 + 2 * IIN, T3 = T2 + 2 * IIN, T4 = T3 + 2 * IOUT, T5 = T4 + 2 * IOUT;
        for (int it = gw; it < T5; it += NGW) {
            if (it < T0) { const int mat = it / I13, r = it % I13, kb = r / 176, n0 = (r % 176) * 32;
                const int drow = n0 < 2816 ? (n0 >> 7) * 256 + (n0 & 127) : ((n0 - 2816) >> 7) * 256 + 128 + ((n0 - 2816) & 127);
                transpose_item(((const float*)F.ka->in[6]) + (size_t)mat * 1024 * 5632, 5632, kb * 64, n0, (bf16r*)(F.ws + WS_W13) + ((size_t)mat * 5632 + drow) * 1024, 1024, scr, F.lane); }
            else if (it < T1) { const int q = it - T0, mat = q / I2, r = q % I2, kb = r / 32, n0 = (r % 32) * 32;
                transpose_item(((const float*)F.ka->in[7]) + (size_t)mat * 2816 * 1024, 1024, kb * 64, n0, (bf16r*)(F.ws + WS_W2) + ((size_t)mat * 1024 + n0) * 2816, 2816, scr, F.lane); }
            else if (it < T2) { const int q = it - T1, mat = q / IIN, r = q % IIN, kb = r / 96, n0 = (r % 96) * 32;
                transpose_item(((const float*)F.ka->in[8]) + (size_t)mat * 1024 * 3080, 3080, kb * 64, n0, (bf16r*)(F.ws + WS_WINA) + ((size_t)mat * 3072 + n0) * 1024, 1024, scr, F.lane); }
            else if (it < T3) { const int q = it - T2, mat = q / IIN, r = q % IIN, kb = r / 96, n0 = (r % 96) * 32;
                transpose_item(((const float*)F.ka->in[14]) + (size_t)mat * 1024 * 3072, 3072, kb * 64, n0, (bf16r*)(F.ws + WS_WINB) + ((size_t)mat * 3072 + n0) * 1024, 1024, scr, F.lane); }
            else if (it < T4) { const int q = it - T3, mat = q / IOUT, r = q % IOUT, kb = r / 32, n0 = (r % 32) * 32;
                transpose_item(((const float*)F.ka->in[13]) + (size_t)mat * 1024 * 1024, 1024, kb * 64, n0, (bf16r*)(F.ws + WS_WOA) + ((size_t)mat * 1024 + n0) * 1024, 1024, scr, F.lane); }
            else { const int q = it - T4, mat = q / IOUT, r = q % IOUT, kb = r / 32, n0 = (r % 32) * 32;
                transpose_item(((const float*)F.ka->in[17]) + (size_t)mat * 1024 * 1024, 1024, kb * 64, n0, (bf16r*)(F.ws + WS_WOB) + ((size_t)mat * 1024 + n0) * 1024, 1024, scr, F.lane); }
        }
    }
}
__device__ __forceinline__ void p1_phase(const Ctx& F) {
    const float* ADA = (const float*)(F.ws + WS_ADA);
    float* GS = (float*)(F.ws + WS_GS);
    const int gw = F.wg * NWAVES + F.wave, NGW = F.G * NWAVES;
    for (int i = F.wg * 512 + F.tid; i < 4 * 3 * 2 * 1024; i += F.G * 512) {
        const int d = i & 1023, b = (i >> 10) & 1, ls = i >> 11, l = ls / 3, sub = ls % 3;
        GS[i] = ((const float*)F.ka->in[5])[(size_t)ls * 1024 + d] * (1.0f + ADA[(size_t)(l * 2 + b) * 9216 + sub * 3072 + 1024 + d]);
    }
    if (F.wg == 0 && F.tid < 2) {
        const float* lm = ((const float*)F.ka->in[15]) + F.tid * 512; float s1 = 0.f, s2 = 0.f;
        for (int k = 0; k < 128; ++k) { s1 += lm[k] * lm[128 + k]; s2 += lm[256 + k] * lm[384 + k]; }
        const float lam_init = F.tid == 0 ? 0.35550906759096934f : 0.5560582041556406f;
        ((float*)(F.ws + WS_LAM))[F.tid] = expf(s1) - expf(s2) + lam_init;
    }
    if (gw < 32) { const int jj = gw >> 4, b = (gw >> 3) & 1, g = gw & 7, l = jj * 2; const float* sh = ADA + (size_t)(l * 2 + b) * 9216 + 3072; const float* w = (const float*)(F.ws + WS_WGT) + (size_t)(jj * 8 + g) * 1024;
        float s = 0.f;
#pragma unroll
        for (int q = 0; q < 16; ++q) s += sh[q * 64 + F.lane] * w[q * 64 + F.lane];
        s = wave_sum(s); if (F.lane == 0) ((float*)(F.ws + WS_SWG))[gw] = s; }
    {
        float* ssqp = (float*)(F.ws + WS_SSQP); bf16r* XS = (bf16r*)(F.ws + WS_XS);
        for (int m = gw; m < M; m += NGW) {
            const int b = m >> 13;
            const f32x4* xr = (const f32x4*)(((const float*)F.ka->in[0]) + (size_t)m * 1024) + F.lane;
            f32x4* orow = (f32x4*)(F.out + (size_t)m * 1024) + F.lane;
            v2u* xsr = (v2u*)(XS + (size_t)m * 1024) + F.lane;
            float ss = 0.f;
#pragma unroll
            for (int j = 0; j < 4; ++j) {
                const f32x4 v = xr[64 * j]; orow[64 * j] = v;
                ss += (v[0] * v[0] + v[1] * v[1]) + (v[2] * v[2] + v[3] * v[3]);
                const int col = 4 * F.lane + 256 * j;
                const f32x4 ng = *(const f32x4*)(((const float*)F.ka->in[5]) + col);
                const f32x4 sc = *(const f32x4*)(ADA + (size_t)b * 9216 + 1024 + col);
                const f32x4 y = v * ng * (sc + 1.0f);
                v2u w; w.x = pk2(y[0], y[1]); w.y = pk2(y[2], y[3]); xsr[64 * j] = w;
            }
            ss = wave_sum(ss);
            if (F.lane < 16) ssqp[(size_t)F.lane * M + m] = F.lane == 0 ? ss : 0.f;
        }
    }
    {
        float* SWF = (float*)(F.ws + WS_SWF); float* SWM = (float*)(F.ws + WS_SWM);
        constexpr int RF = 8 * 5632, RT = RF + 4 * 3072;
        for (int r = gw; r < RT; r += NGW) {
            const bf16r* wt; const float* sh; float* o; int ostride;
            if (r < RF) { const int q = r / 5632, n = r % 5632, l = q >> 1, f = q & 1;
                wt = (const bf16r*)(F.ws + WS_W13) + (size_t)r * 1024; sh = ADA + (size_t)l * 2 * 9216 + (f ? 2 : 0) * 3072; o = SWF + (size_t)q * 2 * 5632 + n; ostride = 5632; }
            else { const int rr = r - RF, l = rr / 3072, n = rr % 3072;
                wt = (const bf16r*)(F.ws + ((l & 1) ? WS_WINB : WS_WINA)) + ((size_t)(l >> 1) * 3072 + n) * 1024; sh = ADA + (size_t)l * 2 * 9216 + 3072; o = SWM + (size_t)l * 2 * 3072 + n; ostride = 3072; }
            const v4u w0 = *(const v4u*)(wt + F.lane * 16), w1 = *(const v4u*)(wt + F.lane * 16 + 8);
            float wv[16] = {bflo(w0.x), bfhi(w0.x), bflo(w0.y), bfhi(w0.y), bflo(w0.z), bfhi(w0.z), bflo(w0.w), bfhi(w0.w),
                            bflo(w1.x), bfhi(w1.x), bflo(w1.y), bfhi(w1.y), bflo(w1.z), bfhi(w1.z), bflo(w1.w), bfhi(w1.w)};
            float s0 = 0.f, s1 = 0.f;
#pragma unroll
            for (int j = 0; j < 4; ++j) {
                const f32x4 h0 = *(const f32x4*)(sh + F.lane * 16 + 4 * j), h1 = *(const f32x4*)(sh + 9216 + F.lane * 16 + 4 * j);
#pragma unroll
                for (int e = 0; e < 4; ++e) { s0 += wv[4 * j + e] * h0[e]; s1 += wv[4 * j + e] * h1[e]; }
            }
            s0 = wave_sum(s0); s1 = wave_sum(s1);
            if (F.lane == 0) { o[0] = s0; o[ostride] = s1; }
        }
    }
}
__device__ __forceinline__ void gates_phase(const Ctx& F, LAS unsigned char* lds, int l) {
    const int j = l >> 1;
    const float* ssqp = (const float*)(F.ws + WS_SSQP); const bf16r* XS = (const bf16r*)(F.ws + WS_XS); float* GT = (float*)(F.ws + WS_GATES);
    const float* WGT = (const float*)(F.ws + WS_WGT) + (size_t)j * 8192; const float* SWG = (const float*)(F.ws + WS_SWG) + j * 16;
    for (int ch = F.wg; ch < 256; ch += F.G) {
        const int b = ch >> 7, m0 = ch * 64;
        f32x4 w[8][2][2];
#pragma unroll
        for (int g = 0; g < 8; ++g)
#pragma unroll
            for (int jj = 0; jj < 2; ++jj) { const float* p = WGT + g * 1024 + jj * 512 + F.lane * 8; w[g][jj][0] = *(const f32x4*)p; w[g][jj][1] = *(const f32x4*)(p + 4); }
        const float swg = F.lane < 8 ? SWG[b * 8 + F.lane] : 0.f;
#pragma unroll
        for (int half = 0; half < 2; ++half) {
            v4u xr[4][2]; float ssv[4];
#pragma unroll
            for (int i = 0; i < 4; ++i) { const int row = m0 + F.wave * 8 + half * 4 + i;
                xr[i][0] = *(const v4u*)(XS + (size_t)row * 1024 + F.lane * 8); xr[i][1] = *(const v4u*)(XS + (size_t)row * 1024 + 512 + F.lane * 8);
                ssv[i] = F.lane < 16 ? ssqp[(size_t)F.lane * M + row] : 0.f; }
#pragma unroll
            for (int i = 0; i < 4; ++i) { const int row = m0 + F.wave * 8 + half * 4 + i;
                const float rs = rsqrtf(wave_sum(ssv[i]) * (1.0f / 1024.0f) + EPS);
                float mine = 0.f;
#pragma unroll
                for (int g = 0; g < 8; ++g) { float a = 0.f;
#pragma unroll
                    for (int jj = 0; jj < 2; ++jj) { const v4u x = xr[i][jj]; const f32x4 w0 = w[g][jj][0], w1 = w[g][jj][1];
                        a += bflo(x.x) * w0[0] + bfhi(x.x) * w0[1] + bflo(x.y) * w0[2] + bfhi(x.y) * w0[3] + bflo(x.z) * w1[0] + bfhi(x.z) * w1[1] + bflo(x.w) * w1[2] + bfhi(x.w) * w1[3]; }
                    a = wave_sum(a); if (F.lane == g) mine = a; }
                if (F.lane < 8) GT[(size_t)row * 8 + F.lane] = mine * rs + swg; }
        }
    }
}
__device__ __forceinline__ bf16x8 ldfrag(const LAS bf16r* base, int row0, int stride, int k0, int lane) {
    return *(const LAS bf16x8*)(base + (row0 + (lane & 15)) * stride + k0 + (lane >> 4) * 8);
}
__device__ __forceinline__ void conv8(const bf16r* P, size_t mrow, int ps, int ch0, const float* cw, const float* cb, float scale, float (&o)[8]) {
    float acc[8];
    { const f32x4 b0 = *(const f32x4*)(cb + ch0), b1 = *(const f32x4*)(cb + ch0 + 4); acc[0] = b0[0]; acc[1] = b0[1]; acc[2] = b0[2]; acc[3] = b0[3]; acc[4] = b1[0]; acc[5] = b1[1]; acc[6] = b1[2]; acc[7] = b1[3]; }
#pragma unroll
    for (int jt = 0; jt < 4; ++jt) {
        if (ps - 3 + jt >= 0) {
            const v4u w = *(const v4u*)(P + (mrow - 3 + jt) * 3072 + ch0);
            const f32x4 c0 = *(const f32x4*)(cw + jt * 1024 + ch0), c1 = *(const f32x4*)(cw + jt * 1024 + ch0 + 4);
            acc[0] += bflo(w.x) * c0[0]; acc[1] += bfhi(w.x) * c0[1]; acc[2] += bflo(w.y) * c0[2]; acc[3] += bfhi(w.y) * c0[3];
            acc[4] += bflo(w.z) * c1[0]; acc[5] += bfhi(w.z) * c1[1]; acc[6] += bflo(w.w) * c1[2]; acc[7] += bfhi(w.w) * c1[3];
        }
    }
#pragma unroll
    for (int e = 0; e < 8; ++e) o[e] = pg8::silu_f(acc[e]) * scale;
}
__device__ __forceinline__ void conv_load(const bf16r* P, size_t mrow, int ps, int ch0, v4u (&raw)[4]) {
#pragma unroll
    for (int jt = 0; jt < 4; ++jt) raw[jt] = (ps - 3 + jt >= 0) ? *(const v4u*)(P + (mrow - 3 + jt) * 3072 + ch0) : (v4u){0u, 0u, 0u, 0u};
}
__device__ __forceinline__ void conv_apply(const v4u (&raw)[4], const f32x4 (&cwv)[4][2], const f32x4 (&cbv)[2], float scale, float (&o)[8]) {
    float acc[8] = {cbv[0][0], cbv[0][1], cbv[0][2], cbv[0][3], cbv[1][0], cbv[1][1], cbv[1][2], cbv[1][3]};
#pragma unroll
    for (int jt = 0; jt < 4; ++jt) { const v4u w = raw[jt]; const f32x4 c0 = cwv[jt][0], c1 = cwv[jt][1];
        acc[0] += bflo(w.x) * c0[0]; acc[1] += bfhi(w.x) * c0[1]; acc[2] += bflo(w.y) * c0[2]; acc[3] += bfhi(w.y) * c0[3];
        acc[4] += bflo(w.z) * c1[0]; acc[5] += bfhi(w.z) * c1[1]; acc[6] += bflo(w.w) * c1[2]; acc[7] += bfhi(w.w) * c1[3]; }
#pragma unroll
    for (int e = 0; e < 8; ++e) o[e] = pg8::silu_f(acc[e]) * scale;
}
__device__ __forceinline__ void conv_weights(const float* cw, const float* cb, int ch0, f32x4 (&cwv)[4][2], f32x4 (&cbv)[2]) {
#pragma unroll
    for (int jt = 0; jt < 4; ++jt) { cwv[jt][0] = *(const f32x4*)(cw + jt * 1024 + ch0); cwv[jt][1] = *(const f32x4*)(cw + jt * 1024 + ch0 + 4); }
    cbv[0] = *(const f32x4*)(cb + ch0); cbv[1] = *(const f32x4*)(cb + ch0 + 4);
}
__device__ __forceinline__ int vt_idx(int r, int s) { return r * 72 + ((((s >> 3) ^ (r >> 3)) & 7) << 3) + (s & 7); }
__device__ __forceinline__ void vt_scatter(LAS bf16r* T, int r0  , int s, const v4u w) {
    LAS bf16r* d = T + vt_idx(r0, s);
    d[0] = (bf16r)(w.x & 0xffffu); d[72] = (bf16r)(w.x >> 16); d[2 * 72] = (bf16r)(w.y & 0xffffu); d[3 * 72] = (bf16r)(w.y >> 16);
    d[4 * 72] = (bf16r)(w.z & 0xffffu); d[5 * 72] = (bf16r)(w.z >> 16); d[6 * 72] = (bf16r)(w.w & 0xffffu); d[7 * 72] = (bf16r)(w.w >> 16);
}
__device__ __forceinline__ bf16x8 ldfrag_sw(const LAS bf16r* base, int row0, int k0, int lane) {
    const int r = row0 + (lane & 15);
    return *(const LAS bf16x8*)(base + r * 72 + (((((k0 >> 3) + (lane >> 4)) ^ (r >> 3)) & 7) << 3));
}
constexpr int VT_STRIDE = 72, QK_STRIDE = 136;
__device__ __forceinline__ void s1_phase(const Ctx& F, LAS unsigned char* lds, int l) {
    const int j = l >> 1;
    LAS bf16r* VT = (LAS bf16r*)lds;
    LAS bf16r* KT = (LAS bf16r*)(lds + 36864);
    LAS float* wS = (LAS float*)(lds + 36864 + 18432);
    const bf16r* P = (const bf16r*)(F.ws + WS_P); const float* GT = (const float*)(F.ws + WS_GATES);
    float* BCUM = (float*)(F.ws + WS_BCUM); float* LOGI = (float*)(F.ws + WS_LOGI); float* BLAST = (float*)(F.ws + WS_SCAL); float* MLOC = BLAST + 16384;
    float* NLOC = (float*)(F.ws + WS_NLOC); bf16r* U = (bf16r*)(F.ws + WS_U);
    const float* cw = ((const float*)F.ka->in[9]) + (size_t)j * 4096; const float* cb = ((const float*)F.ka->in[10]) + (size_t)j * 1024; const float* bif = ((const float*)F.ka->in[11]) + j * 8;
    for (int u = F.wg; u < 1024; u += F.G) {
        const int b = u >> 9, h = (u >> 7) & 3, c = u & 127, bh = b * 4 + h;
        const size_t m0 = (size_t)b * 8192 + c * 64;
        if (F.wave == 0) {
            const int s = F.lane;
            const float gi = GT[(m0 + s) * 8 + h] + bif[h], gf = GT[(m0 + s) * 8 + 4 + h] + bif[4 + h];
            const float lf = fminf(gf, 0.f) - log1pf(expf(-fabsf(gf)));
            float bc = lf;
#pragma unroll
            for (int o = 1; o < 64; o <<= 1) { const float t = lane_up(bc, s, o); if (s >= o) bc += t; }
            const float blast = __builtin_bit_cast(float, __builtin_amdgcn_readlane(__builtin_bit_cast(int, bc), 63));
            const float wl = blast - bc + gi;
            const float mloc = wave_max(wl);
            wS[s] = __expf(wl - mloc);
            BCUM[(size_t)bh * 8192 + c * 64 + s] = bc; LOGI[(size_t)bh * 8192 + c * 64 + s] = gi;
            if (s == 0) { BLAST[bh * 128 + c] = blast; MLOC[bh * 128 + c] = mloc; }
        }
        __syncthreads();
        {
            const int cg = F.tid & 15, s0 = F.tid >> 4, vg = F.tid & 31, sv0 = F.tid >> 5, kch = 512 + h * 128 + cg * 8;
            v4u rk[2][4], rv[4];
#pragma unroll
            for (int i = 0; i < 2; ++i) conv_load(P, m0 + s0 + 32 * i, c * 64 + s0 + 32 * i, kch, rk[i]);
#pragma unroll
            for (int i = 0; i < 4; ++i) rv[i] = *(const v4u*)(P + (m0 + sv0 + 16 * i) * 3072 + 1024 + h * 256 + vg * 8);
            f32x4 cwv[4][2], cbv[2]; conv_weights(cw, cb, kch, cwv, cbv);
#pragma unroll
            for (int i = 0; i < 2; ++i) { const int s = s0 + 32 * i; float kv[8]; conv_apply(rk[i], cwv, cbv, 0.08838834764831845f, kv);
                const float w = wS[s];
#pragma unroll
                for (int e2 = 0; e2 < 8; ++e2) KT[vt_idx(cg * 8, s) + e2 * 72] = (bf16r)f2bf(kv[e2] * w); }
#pragma unroll
            for (int i = 0; i < 4; ++i) vt_scatter(VT, vg * 8, sv0 + 16 * i, rv[i]);
        }
        __syncthreads();
        { const int d = F.tid >> 2, q4 = F.tid & 3; float s = 0.f;
#pragma unroll
          for (int e = 0; e < 16; ++e) s += bf2f(KT[vt_idx(d, q4 * 16 + e)]);
          s += swz_xor<1>(s); s += swz_xor<2>(s);
          if (q4 == 0) NLOC[(size_t)u * 128 + d] = s; }
        {
            f32x4 acc[2][8];
#pragma unroll
            for (int mt = 0; mt < 2; ++mt)
#pragma unroll
                for (int nt = 0; nt < 8; ++nt) acc[mt][nt] = (f32x4){0.f, 0.f, 0.f, 0.f};
#pragma unroll
            for (int ks = 0; ks < 2; ++ks) {
                bf16x8 av[2];
#pragma unroll
                for (int mt = 0; mt < 2; ++mt) av[mt] = ldfrag_sw(VT, 32 * F.wave + 16 * mt, ks * 32, F.lane);
#pragma unroll
                for (int nt = 0; nt < 8; ++nt) { const bf16x8 bk = ldfrag_sw(KT, 16 * nt, ks * 32, F.lane);
#pragma unroll
                    for (int mt = 0; mt < 2; ++mt) acc[mt][nt] = __builtin_amdgcn_mfma_f32_16x16x32_bf16(bk, av[mt], acc[mt][nt], 0, 0, 0); }
            }
            bf16r* up = U + (size_t)u * 32768;
#pragma unroll
            for (int mt = 0; mt < 2; ++mt)
#pragma unroll
                for (int nt = 0; nt < 8; ++nt) { v2u w; w.x = pk2(acc[mt][nt][0], acc[mt][nt][1]); w.y = pk2(acc[mt][nt][2], acc[mt][nt][3]);
                    *(v2u*)(up + (size_t)(32 * F.wave + 16 * mt + (F.lane & 15)) * 128 + 16 * nt + 4 * (F.lane >> 4)) = w; }
        }
        __syncthreads();
    }
}
__device__ __forceinline__ void s2_phase(const Ctx& F, LAS unsigned char* lds) {
    const float* BLAST = (const float*)(F.ws + WS_SCAL); const float* MLOC = BLAST + 16384; float* MST = (float*)(F.ws + WS_SCAL) + 32768;
    const bf16r* U = (const bf16r*)(F.ws + WS_U); const float* NLOC = (const float*)(F.ws + WS_NLOC); float* NST = (float*)(F.ws + WS_NST); bf16r* CST = (bf16r*)(F.ws + WS_CST);
    LAS float* decS = (LAS float*)lds; LAS float* gainS = decS + 128;
    for (int w = F.wg; w < 256; w += F.G) {
        const int bh = w >> 5, slice = w & 31;
        if (F.tid == 0) { float m = 0.f;
            for (int c = 0; c < 128; ++c) { const int unit = bh * 128 + c; const float bl = BLAST[unit], ml = MLOC[unit], mn = fmaxf(bl + m, ml);
                decS[c] = expf(bl + m - mn); gainS[c] = expf(ml - mn); if (slice == 0) MST[unit] = m; m = mn; } }
        __syncthreads();
        const size_t e2 = (size_t)slice * 1024 + F.tid * 2;
        float s0 = 0.f, s1 = 0.f;
        for (int c0 = 0; c0 < 128; c0 += 16) {
            unsigned uv[16];
#pragma unroll
            for (int i = 0; i < 16; ++i) uv[i] = *(const unsigned*)(U + (size_t)(bh * 128 + c0 + i) * 32768 + e2);
#pragma unroll
            for (int i = 0; i < 16; ++i) { const int c = c0 + i;
                *(unsigned*)(CST + (size_t)(bh * 128 + c) * 32768 + e2) = pk2(s0, s1);
                const float dec = decS[c], gain = gainS[c];
                s0 = s0 * dec + bflo(uv[i]) * gain; s1 = s1 * dec + bfhi(uv[i]) * gain; }
        }
        if (slice == 0 && F.tid < 128) { float s = 0.f;
            for (int c0 = 0; c0 < 128; c0 += 16) { float nv[16];
#pragma unroll
                for (int i = 0; i < 16; ++i) nv[i] = NLOC[(size_t)(bh * 128 + c0 + i) * 128 + F.tid];
#pragma unroll
                for (int i = 0; i < 16; ++i) { const int c = c0 + i; NST[(size_t)(bh * 128 + c) * 128 + F.tid] = s; s = s * decS[c] + nv[i] * gainS[c]; } } }
        __syncthreads();
    }
}
__device__ __forceinline__ void s3_phase(const Ctx& F, LAS unsigned char* lds, int l) {
    const int j = l >> 1;
    LAS bf16r* VT = (LAS bf16r*)lds;
    LAS bf16r* Qs = (LAS bf16r*)(lds + 36864);
    LAS bf16r* Ks = (LAS bf16r*)(lds + 36864 + 17408);
    LAS bf16r* Sw = (LAS bf16r*)(lds + 36864 + 34816);
    LAS float* fa = (LAS float*)(lds + 36864 + 34816 + 9216);
    LAS float* bS = fa, *zS = fa + 64, *mtS = fa + 128, *inS = fa + 192, *dnS = fa + 256, *nS = fa + 320  , *sqS = fa + 448  ;
    const bf16r* P = (const bf16r*)(F.ws + WS_P);
    const float* BCUM = (const float*)(F.ws + WS_BCUM); const float* LOGI = (const float*)(F.ws + WS_LOGI); const float* MST = (const float*)(F.ws + WS_SCAL) + 32768;
    const float* NST = (const float*)(F.ws + WS_NST); const bf16r* CST = (const bf16r*)(F.ws + WS_CST); bf16r* Y = (bf16r*)(F.ws + WS_Y);
    const float* cw = ((const float*)F.ka->in[9]) + (size_t)j * 4096; const float* cb = ((const float*)F.ka->in[10]) + (size_t)j * 1024; const float* ng = ((const float*)F.ka->in[12]) + (size_t)j * 1024;
    const int lane = F.lane, w = F.wave, fr = lane & 15, fq = lane >> 4;
    for (int u = F.wg; u < 1024; u += F.G) {
        const int b = u >> 9, h = (u >> 7) & 3, c = u & 127, bh = b * 4 + h;
        const size_t m0 = (size_t)b * 8192 + c * 64;
        bf16x8 cf[2][4];
#pragma unroll
        for (int nt = 0; nt < 2; ++nt)
#pragma unroll
            for (int ks = 0; ks < 4; ++ks) cf[nt][ks] = *(const bf16x8*)(CST + (size_t)u * 32768 + (size_t)(32 * w + 16 * nt + fr) * 128 + ks * 32 + fq * 8);
        if (w == 0) {
            const int s = lane;
            const float bs = BCUM[(size_t)bh * 8192 + c * 64 + s], li = LOGI[(size_t)bh * 8192 + c * 64 + s], mc = MST[bh * 128 + c];
            const float a = bs + mc, z = li - bs;
            float pm = z;
#pragma unroll
            for (int o = 1; o < 64; o <<= 1) { const float t = lane_up(pm, s, o); if (s >= o) pm = fmaxf(pm, t); }
            const float mt = fmaxf(a, bs + pm);
            bS[s] = bs; zS[s] = z; mtS[s] = mt; inS[s] = __expf(a - mt);
        } else if (w <= 2) { const int d = (w - 1) * 64 + lane; nS[d] = NST[(size_t)u * 128 + d]; }
        {
            const int cg = F.tid & 15, s0 = F.tid >> 4, vg = F.tid & 31, sv0 = F.tid >> 5, qch = h * 128 + cg * 8, kch = 512 + qch;
            v4u rq[2][4], rk[2][4], rv[4];
#pragma unroll
            for (int i = 0; i < 2; ++i) { conv_load(P, m0 + s0 + 32 * i, c * 64 + s0 + 32 * i, qch, rq[i]); conv_load(P, m0 + s0 + 32 * i, c * 64 + s0 + 32 * i, kch, rk[i]); }
#pragma unroll
            for (int i = 0; i < 4; ++i) rv[i] = *(const v4u*)(P + (m0 + sv0 + 16 * i) * 3072 + 1024 + h * 256 + vg * 8);
            { f32x4 cwv[4][2], cbv[2]; conv_weights(cw, cb, qch, cwv, cbv);
#pragma unroll
              for (int i = 0; i < 2; ++i) { float kv[8]; conv_apply(rq[i], cwv, cbv, 1.0f, kv);
                  v4u o; o.x = pk2(kv[0], kv[1]); o.y = pk2(kv[2], kv[3]); o.z = pk2(kv[4], kv[5]); o.w = pk2(kv[6], kv[7]); *(LAS v4u*)(Qs + (s0 + 32 * i) * QK_STRIDE + cg * 8) = o; } }
            { f32x4 cwv[4][2], cbv[2]; conv_weights(cw, cb, kch, cwv, cbv);
#pragma unroll
              for (int i = 0; i < 2; ++i) { float kv[8]; conv_apply(rk[i], cwv, cbv, 0.08838834764831845f, kv);
                  v4u o; o.x = pk2(kv[0], kv[1]); o.y = pk2(kv[2], kv[3]); o.z = pk2(kv[4], kv[5]); o.w = pk2(kv[6], kv[7]); *(LAS v4u*)(Ks + (s0 + 32 * i) * QK_STRIDE + cg * 8) = o; } }
#pragma unroll
            for (int i = 0; i < 4; ++i) vt_scatter(VT, vg * 8, sv0 + 16 * i, rv[i]);
        }
#if S3_REP > 1
        __syncthreads();
        {
            const int cg = F.tid & 15, s0 = F.tid >> 4, vg = F.tid & 31, sv0 = F.tid >> 5, qch = h * 128 + cg * 8, kch = 512 + qch;
            v4u rq[2][4], rk[2][4], rv[4];
#pragma unroll
            for (int i = 0; i < 2; ++i) { conv_load(P, m0 + s0 + 32 * i, c * 64 + s0 + 32 * i, qch, rq[i]); conv_load(P, m0 + s0 + 32 * i, c * 64 + s0 + 32 * i, kch, rk[i]); }
#pragma unroll
            for (int i = 0; i < 4; ++i) rv[i] = *(const v4u*)(P + (m0 + sv0 + 16 * i) * 3072 + 1024 + h * 256 + vg * 8);
            { f32x4 cwv[4][2], cbv[2]; conv_weights(cw, cb, qch, cwv, cbv);
#pragma unroll
              for (int i = 0; i < 2; ++i) { float kv[8]; conv_apply(rq[i], cwv, cbv, 1.0f, kv);
                  v4u o; o.x = pk2(kv[0], kv[1]); o.y = pk2(kv[2], kv[3]); o.z = pk2(kv[4], kv[5]); o.w = pk2(kv[6], kv[7]); *(LAS v4u*)(Qs + (s0 + 32 * i) * QK_STRIDE + cg * 8) = o; } }
            { f32x4 cwv[4][2], cbv[2]; conv_weights(cw, cb, kch, cwv, cbv);
#pragma unroll
              for (int i = 0; i < 2; ++i) { float kv[8]; conv_apply(rk[i], cwv, cbv, 0.08838834764831845f, kv);
                  v4u o; o.x = pk2(kv[0], kv[1]); o.y = pk2(kv[2], kv[3]); o.z = pk2(kv[4], kv[5]); o.w = pk2(kv[6], kv[7]); *(LAS v4u*)(Ks + (s0 + 32 * i) * QK_STRIDE + cg * 8) = o; } }
#pragma unroll
            for (int i = 0; i < 4; ++i) vt_scatter(VT, vg * 8, sv0 + 16 * i, rv[i]);
        }
#endif
        __syncthreads();
        {
            const int tt = w >> 1;
            const int t = 16 * tt + fr; const float bt = bS[t], mt = mtS[t];
#pragma unroll
            for (int i = 0; i < 2; ++i) {
                const int st = 2 * (w & 1) + i;
                f32x4 acc = {0.f, 0.f, 0.f, 0.f};
                if (st <= tt) {
#pragma unroll
                    for (int ks = 0; ks < 4; ++ks) acc = __builtin_amdgcn_mfma_f32_16x16x32_bf16(ldfrag(Ks, 16 * st, QK_STRIDE, ks * 32, lane), ldfrag(Qs, 16 * tt, QK_STRIDE, ks * 32, lane), acc, 0, 0, 0);
                }
                float o[4];
#pragma unroll
                for (int e = 0; e < 4; ++e) { const int s = 16 * st + 4 * fq + e; o[e] = (s <= t) ? acc[e] * __expf(bt + zS[s] - mt) : 0.f; }
                v2u pw; pw.x = pk2(o[0], o[1]); pw.y = pk2(o[2], o[3]);
                *(LAS v2u*)(Sw + t * VT_STRIDE + 16 * st + 4 * fq) = pw;
            }
        }
        __syncthreads();
        { const int t = F.tid >> 3, part = F.tid & 7; float rsum = 0.f, qn = 0.f;
#pragma unroll
          for (int e = 0; e < 8; ++e) rsum += bf2f(Sw[t * VT_STRIDE + part * 8 + e]);
#pragma unroll
          for (int e = 0; e < 16; ++e) qn += bf2f(Qs[t * QK_STRIDE + part * 16 + e]) * nS[part * 16 + e];
          rsum += swz_xor<1>(rsum); rsum += swz_xor<2>(rsum); rsum += swz_xor<4>(rsum);
          qn += swz_xor<1>(qn); qn += swz_xor<2>(qn); qn += swz_xor<4>(qn);
          if (part == 0) { const float den = inS[t] * qn + rsum; dnS[t] = __builtin_amdgcn_rcpf(fmaxf(fabsf(den), __expf(-mtS[t]))); } }
        f32x4 a1[4][2], a2[4][2];
#pragma unroll
        for (int mt = 0; mt < 4; ++mt)
#pragma unroll
            for (int nt = 0; nt < 2; ++nt) { a1[mt][nt] = (f32x4){0.f, 0.f, 0.f, 0.f}; a2[mt][nt] = (f32x4){0.f, 0.f, 0.f, 0.f}; }
#pragma unroll
        for (int ks = 0; ks < 4; ++ks)
#pragma unroll
            for (int mt = 0; mt < 4; ++mt) { const bf16x8 qf = ldfrag(Qs, 16 * mt, QK_STRIDE, ks * 32, lane);
#pragma unroll
                for (int nt = 0; nt < 2; ++nt) a1[mt][nt] = __builtin_amdgcn_mfma_f32_16x16x32_bf16(cf[nt][ks], qf, a1[mt][nt], 0, 0, 0); }
#pragma unroll
        for (int ks = 0; ks < 2; ++ks) {
            bf16x8 vf[2];
#pragma unroll
            for (int nt = 0; nt < 2; ++nt) vf[nt] = ldfrag_sw(VT, 32 * w + 16 * nt, ks * 32, lane);
#pragma unroll
            for (int mt = 0; mt < 4; ++mt) { const bf16x8 sf = ldfrag(Sw, 16 * mt, VT_STRIDE, ks * 32, lane);
#pragma unroll
                for (int nt = 0; nt < 2; ++nt) a2[mt][nt] = __builtin_amdgcn_mfma_f32_16x16x32_bf16(vf[nt], sf, a2[mt][nt], 0, 0, 0); }
        }
        __syncthreads();
#pragma unroll
        for (int mt = 0; mt < 4; ++mt) {
            const int t = 16 * mt + fr; const float it = inS[t], dn = dnS[t]; float ss = 0.f;
#pragma unroll
            for (int nt = 0; nt < 2; ++nt) { a1[mt][nt] = (a1[mt][nt] * it + a2[mt][nt]) * dn;
                ss += (a1[mt][nt][0] * a1[mt][nt][0] + a1[mt][nt][1] * a1[mt][nt][1]) + (a1[mt][nt][2] * a1[mt][nt][2] + a1[mt][nt][3] * a1[mt][nt][3]); }
            ss += swz_xor<16>(ss); ss = sum_x32(ss);
            if (fq == 0) sqS[w * 64 + t] = ss;
        }
        __syncthreads();
#pragma unroll
        for (int mt = 0; mt < 4; ++mt) {
            const int t = 16 * mt + fr; float tot = 0.f;
#pragma unroll
            for (int ww = 0; ww < 8; ++ww) tot += sqS[ww * 64 + t];
            const float r = rsqrtf(tot * (1.0f / 256.0f) + EPS);
#pragma unroll
            for (int nt = 0; nt < 2; ++nt) {
                const int vv = 32 * w + 16 * nt + 4 * fq;
                const v2u ow = *(const v2u*)(P + (m0 + t) * 3072 + 2048 + h * 256 + vv);
                const f32x4 g = *(const f32x4*)(ng + h * 256 + vv);
                const float o0 = bflo(ow.x), o1 = bfhi(ow.x), o2 = bflo(ow.y), o3 = bfhi(ow.y);
                const f32x4 hv = a1[mt][nt] * r * g;
                v2u yw; yw.x = pk2(hv[0] * __builtin_amdgcn_rcpf(1.0f + __expf(-o0)), hv[1] * __builtin_amdgcn_rcpf(1.0f + __expf(-o1)));
                yw.y = pk2(hv[2] * __builtin_amdgcn_rcpf(1.0f + __expf(-o2)), hv[3] * __builtin_amdgcn_rcpf(1.0f + __expf(-o3)));
                *(v2u*)(Y + (m0 + t) * 1024 + h * 256 + vv) = yw;
            }
        }
        __syncthreads();
    }
}
__device__ __forceinline__ att::BlockRef<att::bf16, att::bf16> attn_ref(int item, int grp, int pass, const att::bf16* Qb, const att::bf16* Kb, const att::bf16* Vb, att::bf16* Ob) {
    const int pc = item & 3, y = item >> 2, qb = pass ? 31 - y : y;
    const int b = grp >> 2, h = grp & 3, c = pc >> 1, vh = pc & 1, hd = ((b * 4 + h) * 2 + c) * 2 + vh;
    att::BlockRef<att::bf16, att::bf16> r;
    r.Q = Qb + ((size_t)(b * 8 + h * 2 + c) * 8192 + (size_t)qb * 256) * 128;
    r.K = Kb + (size_t)(b * 8 + h * 2 + c) * 8192 * 128;
    r.V = Vb + (size_t)(b * 8 + h * 2 + vh) * 8192 * 128;
    r.O = Ob + ((size_t)hd * 8192 + (size_t)qb * 256) * 128;
    r.P0 = qb * 256;
    return r;
}
__device__ __forceinline__ void attn_phase(const Ctx& F, char* lds) {
    const att::bf16* Qb = (const att::bf16*)(F.ws + WS_P); const att::bf16* Kb = Qb + 16777216; const att::bf16* Vb = Kb + 16777216; att::bf16* Ob = (att::bf16*)(F.ws + WS_O);
    constexpr int total = 512; const int stride = F.G;
    int L = F.wg; if (L >= total) return;
    int pass = 0;
#define ATT_ITEM(L_) (((L_) >> 3) & 63)
#define ATT_GRP(L_) ((L_) & 7)
    att::BlockRef<att::bf16, att::bf16> cur = attn_ref(ATT_ITEM(L), ATT_GRP(L), 0, Qb, Kb, Vb, Ob);
    att::Seam<att::bf16> S;
    att::causal_swa_prime<att::bf16, att::bf16>(cur, 8192, lds, S, F.tid);
    for (;;) {
        const bool more_pass = pass == 0, more_item = L + stride < total, last = !more_pass && !more_item;
        int passn = pass + 1, Ln = L;
        if (!more_pass) { passn = 0; Ln = more_item ? L + stride : L; }
        const att::BlockRef<att::bf16, att::bf16> nxt = last ? cur : attn_ref(ATT_ITEM(Ln), ATT_GRP(Ln), passn, Qb, Kb, Vb, Ob);
        att::causal_swa_block<att::bf16, att::bf16>(cur, nxt, 8192, 8192, lds, S, F.tid);
        if (last) break;
        cur = nxt; pass = passn; L = Ln;
    }
#undef ATT_ITEM
#undef ATT_GRP
}
__device__ __forceinline__ void combine_phase(const Ctx& F, int l) {
    const int j = l >> 1;
    const bf16r* Ob = (const bf16r*)(F.ws + WS_O); bf16r* Y = (bf16r*)(F.ws + WS_Y);
    const float lam = ((const float*)(F.ws + WS_LAM))[j];
    const float omi = 1.0f - (j == 0 ? 0.35550906759096934f : 0.5560582041556406f);
    const float* ng = ((const float*)F.ka->in[16]) + j * 256;
    const int gw = F.wg * NWAVES + F.wave, NGW = F.G * NWAVES;
    const int vv = F.lane * 4, vh = vv >> 7, dd = vv & 127;
    const f32x4 g = *(const f32x4*)(ng + vv);
    for (int task = gw; task < M * 4; task += NGW) {
        const int m = task >> 2, h = task & 3, b = m >> 13, s = m & 8191;
        const int hd0 = ((b * 4 + h) * 2 + 0) * 2 + vh, hd1 = hd0 + 2;
        const v2u w0 = *(const v2u*)(Ob + ((size_t)hd0 * 8192 + s) * 128 + dd), w1 = *(const v2u*)(Ob + ((size_t)hd1 * 8192 + s) * 128 + dd);
        f32x4 o = {bflo(w0.x) - lam * bflo(w1.x), bfhi(w0.x) - lam * bfhi(w1.x), bflo(w0.y) - lam * bflo(w1.y), bfhi(w0.y) - lam * bfhi(w1.y)};
        const float ss = wave_sum((o[0] * o[0] + o[1] * o[1]) + (o[2] * o[2] + o[3] * o[3]));
        const float r = rsqrtf(ss * (1.0f / 256.0f) + EPS) * omi;
        o = o * r * g;
        v2u yw; yw.x = pk2(o[0], o[1]); yw.y = pk2(o[2], o[3]);
        *(v2u*)(Y + (size_t)m * 1024 + h * 256 + vv) = yw;
    }
}
__device__ __forceinline__ void final_phase(const Ctx& F) {
    const float* ssqp = (const float*)(F.ws + WS_SSQP);
    const int gw = F.wg * NWAVES + F.wave, NGW = F.G * NWAVES;
    for (int m = gw; m < M; m += NGW) {
        float ss = F.lane < 16 ? ssqp[(size_t)F.lane * M + m] : 0.f; ss = wave_sum(ss);
        const float rs = rsqrtf(ss * (1.0f / 1024.0f) + EPS);
        f32x4* orow = (f32x4*)(F.out + (size_t)m * 1024) + F.lane;
#pragma unroll
        for (int jj = 0; jj < 4; ++jj) { const f32x4 g = *(const f32x4*)(((const float*)F.ka->in[18]) + 4 * F.lane + 256 * jj); orow[64 * jj] = orow[64 * jj] * rs * g; }
    }
}

#if MK_DEBUG
#ifndef DBG_SET
#define DBG_SET 0
#endif
__device__ __forceinline__ void dbg_flag(const Ctx& F, bool bad, unsigned code) {
    int bit = -1;
    switch (code) { case 30: bit = 0; break; case 8: case 31: case 9: bit = 1; break; case 10: bit = 2; break; case 11: bit = 3; break; case 13: case 14: case 15: bit = 4; break;
                    case 16: case 17: bit = 5; break; case 18: bit = 6; break; case 19: bit = 7; break; case 20: bit = 8; break; case 21: bit = 9; break; case 23: bit = 10; break; default: break; }
    if (bad && bit >= 0) atomicOr((unsigned*)(F.ws + 64), 1u << bit);
}
__device__ __forceinline__ bool dbg_ne(float got, float ref) { return !(fabsf(got - ref) <= 0.03f * fabsf(ref) + 0.03f); }
__device__ __forceinline__ unsigned dbg_hash(unsigned i) { i = i * 2654435761u + 12345u; i ^= i >> 15; i *= 2246822519u; i ^= i >> 13; i *= 3266489917u; i ^= i >> 16; return i; }
__device__ __forceinline__ float dbg_rstd(const Ctx& F, int m) { const float* ssqp = (const float*)(F.ws + WS_SSQP); float s = 0.f; for (int p = 0; p < 16; ++p) s += ssqp[(size_t)p * M + m]; return rsqrtf(s * (1.0f / 1024.0f) + EPS); }
__device__ __forceinline__ float dbg_silu(float g) { return g / (1.0f + expf(-g)); }
__device__ __forceinline__ void dbg_check_p0(const Ctx& F) {
    if (F.wg != 0) return;
    const unsigned r = dbg_hash(F.tid);
    const float* ADA = (const float*)(F.ws + WS_ADA);
    { const float t = wave_sum((float)(F.lane + 1)), t2 = wave_max((float)((F.lane * 37) & 63)); dbg_flag(F, t != 2080.0f || t2 != 63.0f, 30); }
    { const int l = r % 4, b = (r >> 2) & 1, j = (r >> 3) % 9216; float ref = ((const float*)F.ka->in[4])[(size_t)l * 9216 + j];
      for (int k = 0; k < 1024; ++k) ref += dbg_silu(((const float*)F.ka->in[1])[b * 1024 + k]) * ((const float*)F.ka->in[3])[((size_t)l * 1024 + k) * 9216 + j];
      dbg_flag(F, dbg_ne(ADA[(size_t)(l * 2 + b) * 9216 + j], ref), 1); }
    { const int mat = r % 8, k = (r >> 3) % 1024, n = (r >> 13) % 5632; const float src = ((const float*)F.ka->in[6])[((size_t)mat * 1024 + k) * 5632 + n];
      const int drow = n < 2816 ? (n >> 7) * 256 + (n & 127) : ((n - 2816) >> 7) * 256 + 128 + ((n - 2816) & 127);
      dbg_flag(F, dbg_ne(bf2f(((const bf16r*)(F.ws + WS_W13))[((size_t)mat * 5632 + drow) * 1024 + k]), src), 2); }
    { const int mat = r % 8, k = (r >> 3) % 2816, n = (r >> 15) % 1024; const float src = ((const float*)F.ka->in[7])[((size_t)mat * 2816 + k) * 1024 + n];
      dbg_flag(F, dbg_ne(bf2f(((const bf16r*)(F.ws + WS_W2))[((size_t)mat * 1024 + n) * 2816 + k]), src), 3); }
    { const int mat = r % 2, k = (r >> 1) % 1024, n = (r >> 11) % 3072; const float src = ((const float*)F.ka->in[8])[((size_t)mat * 1024 + k) * 3080 + n];
      dbg_flag(F, dbg_ne(bf2f(((const bf16r*)(F.ws + WS_WINA))[((size_t)mat * 3072 + n) * 1024 + k]), src), 4); }
    { const int mat = r % 2, k = (r >> 1) % 1024, n = (r >> 11) % 3072; const float src = ((const float*)F.ka->in[14])[((size_t)mat * 1024 + k) * 3072 + n];
      dbg_flag(F, dbg_ne(bf2f(((const bf16r*)(F.ws + WS_WINB))[((size_t)mat * 3072 + n) * 1024 + k]), src), 5); }
    { const int mat = r % 2, k = (r >> 1) % 1024, n = (r >> 11) % 1024; const float sa = ((const float*)F.ka->in[13])[((size_t)mat * 1024 + k) * 1024 + n], sb = ((const float*)F.ka->in[17])[((size_t)mat * 1024 + k) * 1024 + n];
      dbg_flag(F, dbg_ne(bf2f(((const bf16r*)(F.ws + WS_WOA))[((size_t)mat * 1024 + n) * 1024 + k]), sa) || dbg_ne(bf2f(((const bf16r*)(F.ws + WS_WOB))[((size_t)mat * 1024 + n) * 1024 + k]), sb), 6); }
}
__device__ __forceinline__ void dbg_check_p1(const Ctx& F) {
    if (F.wg != 0) return;
    const unsigned r = dbg_hash(F.tid + 1000);
    const float* ADA = (const float*)(F.ws + WS_ADA);
    { const int m = r % 16384, col = (r >> 14) % 1024, b = m >> 13;
      const float ref = ((const float*)F.ka->in[0])[(size_t)m * 1024 + col] * ((const float*)F.ka->in[5])[col] * (1.0f + ADA[(size_t)b * 9216 + 1024 + col]);
      dbg_flag(F, dbg_ne(bf2f(((const bf16r*)(F.ws + WS_XS))[(size_t)m * 1024 + col]), ref) || dbg_ne(F.out[(size_t)m * 1024 + col], ((const float*)F.ka->in[0])[(size_t)m * 1024 + col]), 7); }
    { const int q = r % 8, b = (r >> 3) & 1, n = (r >> 4) % 5632, l = q >> 1, f = q & 1; float ref = 0.f;
      for (int k = 0; k < 1024; ++k) ref += ADA[(size_t)(l * 2 + b) * 9216 + (f ? 2 : 0) * 3072 + k] * bf2f(((const bf16r*)(F.ws + WS_W13))[((size_t)q * 5632 + n) * 1024 + k]);
      dbg_flag(F, dbg_ne(((const float*)(F.ws + WS_SWF))[(size_t)(q * 2 + b) * 5632 + n], ref), b ? 31 : 8); }
    { const int l = r % 4, b = (r >> 2) & 1, n = (r >> 3) % 3072; const bf16r* W = (const bf16r*)(F.ws + ((l & 1) ? WS_WINB : WS_WINA)) + ((size_t)(l >> 1) * 3072 + n) * 1024; float ref = 0.f;
      for (int k = 0; k < 1024; ++k) ref += ADA[(size_t)(l * 2 + b) * 9216 + 3072 + k] * bf2f(W[k]);
      dbg_flag(F, dbg_ne(((const float*)(F.ws + WS_SWM))[(size_t)(l * 2 + b) * 3072 + n], ref), 9); }
    { const int m = r % 16384; float s = 0.f; for (int k = 0; k < 1024; ++k) { const float v = ((const float*)F.ka->in[0])[(size_t)m * 1024 + k]; s += v * v; }
      const float rs = rsqrtf(s * (1.0f / 1024.0f) + EPS); dbg_flag(F, fabsf(dbg_rstd(F, m) - rs) > 1e-3f * rs, 10); }
}
__device__ __forceinline__ void dbg_check_up(const Ctx& F) {
    if (F.wg != 0) return;
    const unsigned r = dbg_hash(F.tid + 2000);
    const int m = r % 16384, n = (r >> 14) % 2816, b = m >> 13, grow = (n >> 7) * 256 + (n & 127), urow = grow + 128;
    const float rs = dbg_rstd(F, m); const bf16r* XS = (const bf16r*)(F.ws + WS_XS) + (size_t)m * 1024; const bf16r* W = (const bf16r*)(F.ws + WS_W13);
    float g = 0.f, u = 0.f;
    for (int k = 0; k < 1024; ++k) { const float xv = bf2f(XS[k]); g += xv * bf2f(W[(size_t)grow * 1024 + k]); u += xv * bf2f(W[(size_t)urow * 1024 + k]); }
    const float* SWF = (const float*)(F.ws + WS_SWF) + (size_t)b * 5632;
    g = g * rs + SWF[grow]; u = u * rs + SWF[urow];
    dbg_flag(F, dbg_ne(bf2f(((const bf16r*)(F.ws + WS_H))[(size_t)m * 2816 + n]), dbg_silu(g) * u), 11);
}
__device__ __forceinline__ void dbg_check_down(const Ctx& F) {
    if (F.wg != 0) return;
    const unsigned r = dbg_hash(F.tid + 3000);
    const int m = r % 16384, n = (r >> 14) % 1024, b = m >> 13;
    const bf16r* H = (const bf16r*)(F.ws + WS_H) + (size_t)m * 2816; const bf16r* W = (const bf16r*)(F.ws + WS_W2) + (size_t)n * 2816;
    float d = 0.f; for (int k = 0; k < 2816; ++k) d += bf2f(H[k]) * bf2f(W[k]);
    const float* ADA = (const float*)(F.ws + WS_ADA);
    const float ref = ((const float*)F.ka->in[0])[(size_t)m * 1024 + n] + 0.5f * ADA[(size_t)b * 9216 + 2048 + n] * d, got = F.out[(size_t)m * 1024 + n];
    dbg_flag(F, dbg_ne(got, ref), 13);
    dbg_flag(F, dbg_ne(bf2f(((const bf16r*)(F.ws + WS_XS))[(size_t)m * 1024 + n]), got * ((const float*)(F.ws + WS_GS))[(size_t)(0 * 3 + 1) * 2048 + b * 1024 + n]), 14);
    float s = 0.f; for (int k = 0; k < 1024; ++k) { const float v = F.out[(size_t)m * 1024 + k]; s += v * v; }
    const float rs = rsqrtf(s * (1.0f / 1024.0f) + EPS); dbg_flag(F, fabsf(dbg_rstd(F, m) - rs) > 1e-3f * rs, 15);
}
__device__ __forceinline__ float dbg_inproj(const Ctx& F, int l, int m, int n) {
    const int b = m >> 13; const float rs = dbg_rstd(F, m);
    const bf16r* XS = (const bf16r*)(F.ws + WS_XS) + (size_t)m * 1024; const bf16r* W = (const bf16r*)(F.ws + ((l & 1) ? WS_WINB : WS_WINA)) + ((size_t)(l >> 1) * 3072 + n) * 1024;
    float a = 0.f; for (int k = 0; k < 1024; ++k) a += bf2f(XS[k]) * bf2f(W[k]);
    return a * rs + ((const float*)(F.ws + WS_SWM))[(size_t)(l * 2 + b) * 3072 + n];
}
__device__ __forceinline__ void dbg_check_inproj0(const Ctx& F) {
    if (F.wg != 0) return;
    const unsigned r = dbg_hash(F.tid + 4000);
    const int m = r % 16384, n = (r >> 14) % 3072, b = m >> 13;
    dbg_flag(F, dbg_ne(bf2f(((const bf16r*)(F.ws + WS_P))[(size_t)m * 3072 + n]), dbg_inproj(F, 0, m, n)), 16);
    const int g = n & 7; const float rs = dbg_rstd(F, m); const bf16r* XS = (const bf16r*)(F.ws + WS_XS) + (size_t)m * 1024; const float* ADA = (const float*)(F.ws + WS_ADA);
    float a = 0.f, sgw = 0.f; for (int k = 0; k < 1024; ++k) { const float w = ((const float*)F.ka->in[8])[(size_t)k * 3080 + 3072 + g]; a += bf2f(XS[k]) * w; sgw += ADA[(size_t)b * 9216 + 3072 + k] * w; }
    dbg_flag(F, dbg_ne(((const float*)(F.ws + WS_GATES))[(size_t)m * 8 + g], a * rs + sgw), 17);
}
__device__ __forceinline__ void dbg_check_inproj1(const Ctx& F) {
    if (F.wg != 0) return;
    const unsigned r = dbg_hash(F.tid + 5000);
    const int m = r % 16384, n = (r >> 14) % 3072, b = m >> 13, s = m & 8191, blk = n >> 7, d = n & 127, which = blk >> 3, idx = blk & 7;
    float ref = dbg_inproj(F, 1, m, n);
    if (which < 2 && d < 32) {
        const int fi = d & 15; const float other = dbg_inproj(F, 1, m, d < 16 ? n + 16 : n - 16);
        const float a = (float)((const int*)F.ka->in[2])[m] * pg8::ROPE_INVF[fi];
        const float kk = rintf(a * 0.15915494309189535f); float rr = fmaf(-kk, 6.2831854820251465f, a); rr = fmaf(-kk, -1.7484555314695172e-07f, rr);
        const float c = __cosf(rr), sn = __sinf(rr);
        ref = d < 16 ? ref * c - other * sn : ref * c + other * sn;
    }
    dbg_flag(F, dbg_ne(bf2f(((const bf16r*)(F.ws + WS_P))[(size_t)which * 16777216 + ((size_t)(b * 8 + idx) * 8192 + s) * 128 + d]), ref), 20);
}
__device__ __forceinline__ void dbg_check_mlstm(const Ctx& F, LAS unsigned char* lds) {
    if (F.wg != 0) return;
    LAS float* C = (LAS float*)lds;
    LAS float* qs = C + 32768, *ks = qs + 128, *vs = ks + 128, *nn = vs + 256, *hv = nn + 128, *red = hv + 256;
    const int h = 1, tid = F.tid;
    const bf16r* P = (const bf16r*)(F.ws + WS_P); const float* GT = (const float*)(F.ws + WS_GATES); const bf16r* Y = (const bf16r*)(F.ws + WS_Y);
    const float* cw = (const float*)F.ka->in[9]; const float* cb = (const float*)F.ka->in[10]; const float* bif = (const float*)F.ka->in[11]; const float* ng = (const float*)F.ka->in[12];
    for (int i = tid; i < 32768; i += 512) C[i] = 0.f;
    if (tid < 128) nn[tid] = 0.f;
    float mstate = 0.f;
    __syncthreads();
    for (int t = 0; t < 160; ++t) {
        if (tid < 256) { const int isk = tid >> 7, d = tid & 127, ch = isk * 512 + h * 128 + d; float a = cb[ch];
            for (int jt = 0; jt < 4; ++jt) if (t - 3 + jt >= 0) a += cw[jt * 1024 + ch] * bf2f(P[(size_t)(t - 3 + jt) * 3072 + ch]);
            a = dbg_silu(a); if (isk) ks[d] = a * 0.08838834764831845f; else qs[d] = a; }
        else { const int v = tid - 256; vs[v] = bf2f(P[(size_t)t * 3072 + 1024 + h * 256 + v]); }
        __syncthreads();
        const float li = GT[(size_t)t * 8 + h] + bif[h], gf = GT[(size_t)t * 8 + 4 + h] + bif[4 + h];
        const float lf = fminf(gf, 0.f) - log1pf(expf(-fabsf(gf)));
        const float mn = fmaxf(lf + mstate, li), fd = expf(lf + mstate - mn), ig = expf(li - mn);
        for (int i = tid; i < 32768; i += 512) { const int v = i >> 7, d = i & 127; C[i] = fd * C[i] + ig * vs[v] * ks[d]; }
        if (tid < 128) nn[tid] = fd * nn[tid] + ig * ks[tid];
        mstate = mn;
        __syncthreads();
        float den = 0.f; for (int d = 0; d < 128; ++d) den += nn[d] * qs[d];
        const float dn = 1.0f / fmaxf(fabsf(den), expf(-mn));
        { const int v = tid >> 1, half = tid & 1; float a = 0.f; for (int d = 0; d < 64; ++d) a += C[v * 128 + half * 64 + d] * qs[half * 64 + d];
          a += swz_xor<1>(a); if (half == 0) hv[v] = a * dn; }
        __syncthreads();
        float ss = 0.f; for (int v = 0; v < 256; ++v) ss += hv[v] * hv[v];
        const float rr = rsqrtf(ss * (1.0f / 256.0f) + EPS);
        if (tid < 256) { const int v = tid; const float o = bf2f(P[(size_t)t * 3072 + 2048 + h * 256 + v]);
            const float ref = hv[v] * rr * ng[h * 256 + v] / (1.0f + expf(-o));
            dbg_flag(F, dbg_ne(bf2f(Y[(size_t)t * 1024 + h * 256 + v]), ref), t < 64 ? 18 : 19); }
        __syncthreads();
    }
}
__device__ __forceinline__ void dbg_check_attn(const Ctx& F) {
    if (F.wg >= 8) return;
    const bf16r* Qb = (const bf16r*)(F.ws + WS_P); const bf16r* Kb = Qb + 16777216; const bf16r* Vb = Kb + 16777216; const bf16r* Ob = (const bf16r*)(F.ws + WS_O);
    const unsigned r = dbg_hash(F.wg * 8 + F.wave + 6000);
    const int hd = r % 32, row = (F.wave == 0) ? (int)((r >> 5) % 300) : (int)((r >> 5) % 8192);
    const int b = hd >> 4, h = (hd >> 2) & 3, c = (hd >> 1) & 1, vh = hd & 1, lane = F.lane;
    const bf16r* q = Qb + ((size_t)(b * 8 + h * 2 + c) * 8192 + row) * 128; const bf16r* K = Kb + (size_t)(b * 8 + h * 2 + c) * 8192 * 128; const bf16r* V = Vb + (size_t)(b * 8 + h * 2 + vh) * 8192 * 128;
    const float q0 = bf2f(q[lane * 2]), q1 = bf2f(q[lane * 2 + 1]);
    float mx = -1e30f, l = 0.f, o0 = 0.f, o1 = 0.f;
    for (int jk = 0; jk <= row; ++jk) {
        float sc = q0 * bf2f(K[(size_t)jk * 128 + lane * 2]) + q1 * bf2f(K[(size_t)jk * 128 + lane * 2 + 1]); sc = wave_sum(sc) * 0.08838834764831845f;
        const float mn = fmaxf(mx, sc), al = expf(mx - mn), p = expf(sc - mn);
        l = l * al + p; o0 = o0 * al + p * bf2f(V[(size_t)jk * 128 + lane * 2]); o1 = o1 * al + p * bf2f(V[(size_t)jk * 128 + lane * 2 + 1]); mx = mn;
    }
    const bf16r* O = Ob + ((size_t)hd * 8192 + row) * 128;
    dbg_flag(F, dbg_ne(bf2f(O[lane * 2]), o0 / l) || dbg_ne(bf2f(O[lane * 2 + 1]), o1 / l), 21);
}
__device__ __forceinline__ void dbg_check_combine(const Ctx& F) {
    if (F.wg != 0) return;
    const unsigned r = dbg_hash(F.tid + 7000);
    const int m = r % 16384, h = (r >> 14) & 3, vv = (r >> 16) & 255, b = m >> 13, s = m & 8191;
    const bf16r* Ob = (const bf16r*)(F.ws + WS_O); const float lam = ((const float*)(F.ws + WS_LAM))[0];
    float ss = 0.f, mine = 0.f;
    for (int v = 0; v < 256; ++v) { const int hd0 = ((b * 4 + h) * 2) * 2 + (v >> 7);
        const float o = bf2f(Ob[((size_t)hd0 * 8192 + s) * 128 + (v & 127)]) - lam * bf2f(Ob[((size_t)(hd0 + 2) * 8192 + s) * 128 + (v & 127)]); ss += o * o; if (v == vv) mine = o; }
    const float ref = mine * rsqrtf(ss * (1.0f / 256.0f) + EPS) * ((const float*)F.ka->in[16])[vv] * (1.0f - 0.35550906759096934f);
    dbg_flag(F, dbg_ne(bf2f(((const bf16r*)(F.ws + WS_Y))[(size_t)m * 1024 + h * 256 + vv]), ref), 23);
}
#endif

constexpr int N_PHASES = 2 + 9 * DEPTH + 1;
constexpr int PH_ATT1 = 2 + 9 * 1 + 3, PH_ATT3 = 2 + 9 * 3 + 3;
#ifndef DBL_MASK
#define DBL_MASK 0
#endif
#ifndef MK_ONE_LAUNCH
#define MK_ONE_LAUNCH 1
#endif
__device__ __forceinline__ Ctx make_ctx(int wave_s) {
    KArgs ka = (KArgs)__builtin_amdgcn_kernarg_segment_ptr();
    asm volatile("" : "+s"(ka));
    Ctx F; F.ka = ka; F.out = ka->out; F.ws = ka->ws;
    { unsigned z0 = 0u; asm volatile("" : "+v"(z0)); const int t0 = wave_s * 64 + (int)__builtin_amdgcn_mbcnt_hi(~0u, __builtin_amdgcn_mbcnt_lo(~0u, z0)); F.tid = t0 & 511; }
    F.lane = F.tid & 63; F.wave = __builtin_amdgcn_readfirstlane(F.tid >> 6);
    { int g0 = gridDim.x, w0 = blockIdx.x; asm volatile("" : "+s"(g0), "+s"(w0)); F.G = g0; F.wg = w0; }
    return F;
}
template <bool FIRST> __device__ __forceinline__ void grid_seam(const Ctx& F, int& epoch) {
    if (FIRST && epoch == 0) {
        if (F.wg == 0 && F.tid == 0) __hip_atomic_store((unsigned*)F.ws, 0u, __ATOMIC_RELAXED, __HIP_MEMORY_SCOPE_AGENT);
        __threadfence(); cg::this_grid().sync(); epoch = 1; return;
    }
    asm volatile("s_waitcnt vmcnt(0) lgkmcnt(0)" ::: "memory");
    __syncthreads();
    if (F.tid == 0) {
        unsigned* cnt = (unsigned*)F.ws;
        __builtin_amdgcn_fence(__ATOMIC_RELEASE, "agent");
        asm volatile("s_waitcnt vmcnt(0)" ::: "memory");
        __hip_atomic_fetch_add(cnt, 1u, __ATOMIC_RELAXED, __HIP_MEMORY_SCOPE_AGENT);
        const unsigned target = (unsigned)epoch * (unsigned)F.G;
        while (__hip_atomic_load(cnt, __ATOMIC_RELAXED, __HIP_MEMORY_SCOPE_AGENT) < target) __builtin_amdgcn_s_sleep(2);
        __builtin_amdgcn_fence(__ATOMIC_ACQUIRE, "agent");
        asm volatile("s_waitcnt vmcnt(0)" ::: "memory");
    }
    __syncthreads();
    epoch += 1;
}
template <int PH, bool DRY = false> __device__ __forceinline__ void do_phase(int lo, int hi, int wave_s, LAS unsigned char* lds, unsigned char* lds_raw, int& epoch) {
    if (!(lo <= PH && PH < hi)) return;
    const Ctx F = make_ctx(wave_s);
    unsigned char* ws = F.ws;
    const float* ADA = (const float*)(ws + WS_ADA); const float* GS = (const float*)(ws + WS_GS); float* SSQP = (float*)(ws + WS_SSQP);
    bf16r* XS = (bf16r*)(ws + WS_XS); bf16r* H = (bf16r*)(ws + WS_H); bf16r* P = (bf16r*)(ws + WS_P); bf16r* Y = (bf16r*)(ws + WS_Y);
    constexpr bool is_layer = PH >= 2 && PH < N_PHASES - 1;
    constexpr int l = is_layer ? (PH - 2) / 9 : 0, s = is_layer ? (PH - 2) % 9 : -1, isattn = l & 1, j = l >> 1;
    constexpr bool empty = is_layer && s == 5 && isattn;
#if MK_DEBUG
    if constexpr (PH == 1) dbg_check_p0(F); else if constexpr (PH == 2) dbg_check_p1(F); else if constexpr (PH == 3) dbg_check_up(F); else if constexpr (PH == 4) dbg_check_down(F);
    else if constexpr (PH == 5) dbg_check_inproj0(F); else if constexpr (PH == 8) dbg_check_mlstm(F, lds); else if constexpr (PH == 14) dbg_check_inproj1(F);
    else if constexpr (PH == 15) dbg_check_attn(F); else if constexpr (PH == 17) dbg_check_combine(F);
    __syncthreads();
#endif
    if constexpr (PH == 0) p0_phase(F, lds);
    else if constexpr (PH == 1) p1_phase(F);
    else if constexpr (PH == N_PHASES - 1) { final_phase(F);
#if MK_DEBUG
        if (F.wg == 0) { asm volatile("s_waitcnt vmcnt(0)" ::: "memory"); __syncthreads(); const unsigned code = *(const unsigned*)(F.ws + 64); if (code) { float v = (float)(10 + (code % 90)) * 100.0f; for (unsigned q = 0; q < code / 90; ++q) v *= 10.0f; F.out[F.tid] = v; } }
#endif
    }
    else if constexpr (s == 0 || s == 7) {
        constexpr int f = s == 0 ? 0 : 1;
        pg8::Gemm g{XS, (const bf16r*)(ws + WS_W13) + (size_t)(l * 2 + f) * NUP * 1024, M, NUP, 1024};
        pg8::EpiGen E{0, H, (const float*)(ws + WS_SWF) + (size_t)(l * 2 + f) * 2 * NUP, SSQP, nullptr, nullptr, nullptr};
        pg8::StaticOrder S; S.init(M, NUP, F.G, F.wg);
        pg8::gemm_phase<pg8::EpiGen, pg8::StaticOrder, true, true>(lds, g, S, E, F.tid);
    } else if constexpr (s == 1 || s == 8) {
        constexpr int f = s == 1 ? 0 : 1, sub = f ? 2 : 0;
        pg8::Gemm g{H, (const bf16r*)(ws + WS_W2) + (size_t)(l * 2 + f) * 1024 * DFF, M, 1024, DFF};
        const float* gsn = f == 0 ? GS + (size_t)(l * 3 + 1) * 2048 : GS + (size_t)((l + 1 < DEPTH ? l + 1 : 0) * 3) * 2048;
        pg8::EpiGen E{DRY ? 5 : 1, F.out, ADA + (size_t)l * 2 * 9216 + sub * 3072 + 2048, gsn, nullptr, XS, SSQP};
        pg8::StaticOrder S; S.init(M, 1024, F.G, F.wg);
        pg8::gemm_phase<pg8::EpiGen, pg8::StaticOrder, true, true>(lds, g, S, E, F.tid);
    } else if constexpr (s == 2) {
        pg8::Gemm g{XS, (const bf16r*)(ws + (isattn ? WS_WINB : WS_WINA)) + (size_t)j * NIN * 1024, M, NIN, 1024};
        pg8::EpiGen E{isattn ? 4 : 3, P, (const float*)(ws + WS_SWM) + (size_t)l * 2 * NIN, SSQP, ((const int*)F.ka->in[2]), nullptr, nullptr};
        pg8::StaticOrder S; S.init(M, NIN, F.G, F.wg);
        pg8::gemm_phase<pg8::EpiGen, pg8::StaticOrder, true, true>(lds, g, S, E, F.tid);
        if constexpr (!isattn) { __syncthreads(); gates_phase(F, lds, l); }
    } else if constexpr (s == 6) {
        pg8::Gemm g{Y, (const bf16r*)(ws + (isattn ? WS_WOB : WS_WOA)) + (size_t)j * 1024 * 1024, M, 1024, 1024};
        pg8::EpiGen E{DRY ? 5 : 2, F.out, ADA + (size_t)l * 2 * 9216 + 3072 + 2048, GS + (size_t)(l * 3 + 2) * 2048, nullptr, XS, SSQP};
        pg8::StaticOrder S; S.init(M, 1024, F.G, F.wg);
        pg8::gemm_phase<pg8::EpiGen, pg8::StaticOrder, true, true>(lds, g, S, E, F.tid);
    }
    else if constexpr (s == 3) { if constexpr (isattn) attn_phase(F, (char*)lds_raw); else s1_phase(F, lds, l); }
    else if constexpr (s == 4) { if constexpr (isattn) combine_phase(F, l); else s2_phase(F, lds); }
    else if constexpr (s == 5) { if constexpr (!isattn) s3_phase(F, lds, l); }
    if (PH + 1 < hi && !empty) grid_seam<PH == 0>(F, epoch);
}
template <int PH> __device__ __forceinline__ void do_twice(int lo, int hi, int wave_s, LAS unsigned char* lds, unsigned char* lds_raw, int& epoch) {
    constexpr bool is_layer = PH >= 2 && PH < N_PHASES - 1;
    constexpr int l = is_layer ? (PH - 2) / 9 : 0, s = is_layer ? (PH - 2) % 9 : -1, isattn = l & 1;
    constexpr bool dbl = ((DBL_MASK & 1) && (PH == 0 || PH == 1)) || ((DBL_MASK & 2) && is_layer && !isattn && (s == 3 || s == 4 || s == 5)) || ((DBL_MASK & 4) && is_layer && isattn && s == 3)
                      || ((DBL_MASK & 8) && is_layer && (s == 0 || s == 7)) || ((DBL_MASK & 16) && is_layer && s == 2) || ((DBL_MASK & 32) && is_layer && isattn && s == 4) || ((DBL_MASK & 256) && is_layer && !isattn && s == 3) || ((DBL_MASK & 512) && is_layer && !isattn && s == 4) || ((DBL_MASK & 1024) && is_layer && !isattn && s == 5) || ((DBL_MASK & 2048) && PH == 0) || ((DBL_MASK & 4096) && PH == 1);
    constexpr bool dry = ((DBL_MASK & 64) && is_layer && (s == 1 || s == 8)) || ((DBL_MASK & 128) && is_layer && s == 6);
    if constexpr (dry) do_phase<PH, true>(lo, hi, wave_s, lds, lds_raw, epoch);
    do_phase<PH>(lo, hi, wave_s, lds, lds_raw, epoch);
    if constexpr (dbl) do_phase<PH>(lo, hi, wave_s, lds, lds_raw, epoch);
}
template <int... I> __device__ __forceinline__ void all_phases(std::integer_sequence<int, I...>, int lo, int hi, int wave_s, LAS unsigned char* lds, unsigned char* lds_raw, int& epoch) {
    (do_twice<I>(lo, hi, wave_s, lds, lds_raw, epoch), ...);
}
__global__ void __launch_bounds__(NWAVES * 64, 2) mk_fwd(Args args) {
    extern __shared__ __attribute__((aligned(16))) unsigned char lds_raw[];
    LAS unsigned char* lds = (LAS unsigned char*)lds_raw;
    const int ph_lo = args.ph_lo, ph_hi = args.ph_hi;
    const int wave_s = __builtin_amdgcn_readfirstlane(threadIdx.x >> 6);
    if (ph_lo != 0 && ph_hi - ph_lo > 1) return;
    int epoch = 0;
    all_phases(std::make_integer_sequence<int, N_PHASES>{}, ph_lo, ph_hi, wave_s, lds, lds_raw, epoch);
}

extern "C" void kernel_launch(void* const* d_in, const int* in_sizes, int n_in, void* d_out, int out_size, void* d_ws, size_t ws_size, hipStream_t stream) {
    static int grid = 0;
    if (grid == 0) {
        if (n_in != 19 || out_size != M * DM || ws_size < WS_END) { fprintf(stderr, "kernel_launch: unexpected shapes (n_in %d out %d ws %zu)\n", n_in, out_size, ws_size); grid = -1; return; }
        int dev = 0, cus = 0, per_cu = 0;
        (void)hipGetDevice(&dev); (void)hipDeviceGetAttribute(&cus, hipDeviceAttributeMultiprocessorCount, dev);
        if (hipFuncSetAttribute((const void*)mk_fwd, hipFuncAttributeMaxDynamicSharedMemorySize, LDS_BYTES) != hipSuccess) { fprintf(stderr, "kernel_launch: hipFuncSetAttribute failed\n"); grid = -1; return; }
        if (hipOccupancyMaxActiveBlocksPerMultiprocessor(&per_cu, (const void*)mk_fwd, NWAVES * 64, LDS_BYTES) != hipSuccess || per_cu < 1) { fprintf(stderr, "kernel_launch: occupancy query gave %d\n", per_cu); per_cu = 1; }
        (void)hipGetLastError();
        grid = cus > 0 ? cus : 256;
    }
    if (grid < 0) return;
    Args a{};
    for (int i = 0; i < 19; ++i) a.in[i] = d_in[i];
    a.out = (float*)d_out; a.ws = (unsigned char*)d_ws;
#if MK_ONE_LAUNCH
    a.ph_lo = 0; a.ph_hi = N_PHASES;
    void* kargs[] = {&a};
    hipError_t e = hipLaunchCooperativeKernel((const void*)mk_fwd, dim3(grid), dim3(NWAVES * 64), kargs, LDS_BYTES, stream);
    if (e != hipSuccess) fprintf(stderr, "kernel_launch: cooperative launch failed: %s (grid %d)\n", hipGetErrorString(e), grid);
#else
    for (int ph = 0; ph < N_PHASES; ++ph) {
        if (ph >= 2 && ph < N_PHASES - 1 && ((ph - 2) / 9 & 1) && ((ph - 2) % 9 == 5)) continue;
        a.ph_lo = ph; a.ph_hi = ph + 1;
        hipLaunchKernelGGL(mk_fwd, dim3(grid), dim3(NWAVES * 64), LDS_BYTES, stream, a);
    }
#endif
}
```

```cpp
#include <hip/hip_runtime.h>
#include <hip/hip_bf16.h>
#include <hip/hip_cooperative_groups.h>
#include <cstdio>
#include <cstdint>
#include <cmath>
#include <utility>
template <int MASK> __device__ __forceinline__ float swz_xor(float v) { return __builtin_bit_cast(float, __builtin_amdgcn_ds_swizzle(__builtin_bit_cast(int, v), (MASK << 10) | 0x1f)); }
__device__ __forceinline__ float sum_x32(float v) { const unsigned u = __float_as_uint(v); auto rr = __builtin_amdgcn_permlane32_swap(u, u, false, false); const unsigned r0 = rr[0], r1 = rr[1]; return __uint_as_float(r0) + __uint_as_float(r1); }
__device__ __forceinline__ float max_x32(float v) { const unsigned u = __float_as_uint(v); auto rr = __builtin_amdgcn_permlane32_swap(u, u, false, false); const unsigned r0 = rr[0], r1 = rr[1]; return fmaxf(__uint_as_float(r0), __uint_as_float(r1)); }
namespace pg8 {
#define PG8_LAS __attribute__((address_space(3)))
typedef unsigned short bf16_t;
typedef short bf16x8 __attribute__((ext_vector_type(8)));
typedef float f32x4 __attribute__((ext_vector_type(4)));
typedef unsigned u32x4 __attribute__((ext_vector_type(4)));
constexpr int BM = 256, BK = 64, HALF = 128, HTB = HALF * BK * 2  , STAGE_BYTES = 8 * HTB, NXCD = 8, WGM = 8;

__host__ __device__ __forceinline__ int lds_byte(int r, int c) { const int st = (r >> 4) * 2 + (c >> 5), rr = r & 15, cc = c & 31, ob = rr * 64 + cc * 2; return st * 1024 + (ob ^ (((ob >> 9) & 1) << 5)); }
__host__ __device__ __forceinline__ void stage_rc(int b, int& R, int& C) { const int st = b / 1024, sb = b % 1024, swz = sb ^ (((sb >> 9) & 1) << 5); R = (st >> 1) * 16 + swz / 64; C = (st & 1) * 32 + (swz % 64) / 2; }
__host__ __device__ __forceinline__ int perm32(int rho) { const int n = rho >> 4, i = rho & 15; return 8 * (i >> 2) + 4 * n + (i & 3); }

struct Unit { int pm, pn; };
struct Gemm { const bf16_t* A; const bf16_t* Bt; int M, N, K; };

struct StaticOrder {
    int nM, nN, nwg, G, c;
    __host__ __device__ void init(int M, int N, int G_, int c_) { nM = M / BM; nN = N / BM; nwg = nM * nN; G = G_; c = c_; }
    __host__ __device__ bool next(int i, Unit& u) const {
        const long L = (long)i * G + c; if (L >= nwg) return false;
        int wgid = (int)L; { const int q = nwg / NXCD, r = nwg % NXCD, xcd = wgid % NXCD, off = wgid / NXCD; wgid = (xcd < r ? xcd * (q + 1) : r * (q + 1) + (xcd - r) * q) + off; }
        const int nig = WGM * nN, gid = wgid / nig, fm = gid * WGM, gsz = (nM - fm) < WGM ? (nM - fm) : WGM;
        u.pm = fm + ((wgid % nig) % gsz); u.pn = (wgid % nig) / gsz; return true;
    }
    __device__ __forceinline__ void a_ready(const Unit&) const {}
    __device__ __forceinline__ void done(const Unit&) const {}
};
__device__ __forceinline__ unsigned cvt_pk_bf16(float lo, float hi) { unsigned r; asm volatile("v_cvt_pk_bf16_f32 %0, %1, %2" : "=v"(r) : "v"(lo), "v"(hi)); return r; }
constexpr int MROWS = 16384;
constexpr float RMS_EPS = 1e-6f;
__device__ __forceinline__ float silu_f(float g) { return g * __builtin_amdgcn_rcpf(1.0f + __expf(-g)); }
__device__ __forceinline__ void rows_rstd(const float* ssqp, int row0, int fq, float (&rs)[2][4]) {
    float s[2][4];
#pragma unroll
    for (int ai = 0; ai < 2; ++ai)
#pragma unroll
        for (int m = 0; m < 4; ++m) { const float* p = ssqp + (size_t)(fq * 4) * MROWS + row0 + ai * HALF + m * 16;
            s[ai][m] = (p[0] + p[MROWS]) + (p[2 * MROWS] + p[3 * MROWS]); }
#pragma unroll
    for (int ai = 0; ai < 2; ++ai)
#pragma unroll
        for (int m = 0; m < 4; ++m) { float t = s[ai][m]; t += swz_xor<16>(t); t = sum_x32(t); rs[ai][m] = rsqrtf(t * (1.0f / 1024.0f) + RMS_EPS); }
}
__device__ __forceinline__ float row_rstd(const float* ssqp, int row, int fq) {
    float s = 0.f;
#pragma unroll
    for (int i = 0; i < 4; ++i) s += ssqp[(size_t)(fq * 4 + i) * MROWS + row];
    s += swz_xor<16>(s); s = sum_x32(s);
    return rsqrtf(s * (1.0f / 1024.0f) + RMS_EPS);
}
struct EpiUp {
    static constexpr bool PERM = true, AFTER_DRAIN = false;
    bf16_t* H; const float* sw; const float* ssqp;
    __device__ __forceinline__ void operator()(const f32x4 (&acc)[2][2][4][2], const Unit& u, int wr, int wc, int fr, int fq) const {
        const int b = u.pm >> 5, row0 = u.pm * BM + wr * 64 + fr, c8 = wc * 32 + 8 * fq;
        const float* swp = sw + (size_t)b * 5632 + u.pn * 256 + c8;
        const f32x4 sg0 = *(const f32x4*)(swp), sg1 = *(const f32x4*)(swp + 4), su0 = *(const f32x4*)(swp + 128), su1 = *(const f32x4*)(swp + 132);
        bf16_t* hp = H + (size_t)u.pn * 128 + c8;
        float rsv[2][4]; rows_rstd(ssqp, row0, fq, rsv);
#pragma unroll
        for (int ai = 0; ai < 2; ++ai)
#pragma unroll
            for (int m = 0; m < 4; ++m) {
                const int row = row0 + ai * HALF + m * 16;
                const float rs = rsv[ai][m];
                const f32x4 g0 = acc[ai][0][m][0] * rs + sg0, g1 = acc[ai][0][m][1] * rs + sg1;
                const f32x4 u0 = acc[ai][1][m][0] * rs + su0, u1 = acc[ai][1][m][1] * rs + su1;
                u32x4 w;
                w.x = cvt_pk_bf16(silu_f(g0[0]) * u0[0], silu_f(g0[1]) * u0[1]); w.y = cvt_pk_bf16(silu_f(g0[2]) * u0[2], silu_f(g0[3]) * u0[3]);
                w.z = cvt_pk_bf16(silu_f(g1[0]) * u1[0], silu_f(g1[1]) * u1[1]); w.w = cvt_pk_bf16(silu_f(g1[2]) * u1[2], silu_f(g1[3]) * u1[3]);
                *(u32x4*)(hp + (size_t)row * 2816) = w;
            }
    }
};
struct EpiBias {
    static constexpr bool PERM = true, AFTER_DRAIN = false;
    bf16_t* O; int ldc; const float* sw; int nsw; const float* ssqp;
    __device__ __forceinline__ void operator()(const f32x4 (&acc)[2][2][4][2], const Unit& u, int wr, int wc, int fr, int fq) const {
        const int b = u.pm >> 5, row0 = u.pm * BM + wr * 64 + fr, col0 = u.pn * BM + wc * 32 + 8 * fq;
        f32x4 sv[2][2];
#pragma unroll
        for (int bj = 0; bj < 2; ++bj)
#pragma unroll
            for (int n = 0; n < 2; ++n) sv[bj][n] = *(const f32x4*)(sw + (size_t)b * nsw + col0 + bj * HALF + 4 * n);
        float rsv[2][4]; rows_rstd(ssqp, row0, fq, rsv);
#pragma unroll
        for (int ai = 0; ai < 2; ++ai)
#pragma unroll
            for (int m = 0; m < 4; ++m) {
                const int row = row0 + ai * HALF + m * 16;
                const float rs = rsv[ai][m];
                bf16_t* rowp = O + (size_t)row * ldc + col0;
#pragma unroll
                for (int bj = 0; bj < 2; ++bj) {
                    const f32x4 v0 = acc[ai][bj][m][0] * rs + sv[bj][0], v1 = acc[ai][bj][m][1] * rs + sv[bj][1];
                    u32x4 w; w.x = cvt_pk_bf16(v0[0], v0[1]); w.y = cvt_pk_bf16(v0[2], v0[3]); w.z = cvt_pk_bf16(v1[0], v1[1]); w.w = cvt_pk_bf16(v1[2], v1[3]);
                    *(u32x4*)(rowp + bj * HALF) = w;
                }
            }
    }
};
template <int HALFC> struct EpiResidT {
    static constexpr bool PERM = true, AFTER_DRAIN = false;
    float* x; const float* xin; const float* gate; const float* gsn; bf16_t* xs; float* ssqp;
    __device__ __forceinline__ void operator()(const f32x4 (&acc)[2][2][4][2], const Unit& u, int wr, int wc, int fr, int fq) const {
        const int b = u.pm >> 5, row0 = u.pm * BM + wr * 64 + fr, col0 = u.pn * BM + wc * 32 + 8 * fq;
        constexpr float gcoef = HALFC == 2 ? 0.0f : (HALFC ? 0.5f : 1.0f);
        f32x4 gt[2][2], gs[2][2];
#pragma unroll
        for (int bj = 0; bj < 2; ++bj)
#pragma unroll
            for (int n = 0; n < 2; ++n) {
                gt[bj][n] = *(const f32x4*)(gate + (size_t)b * 9216 + col0 + bj * HALF + 4 * n) * gcoef;
                gs[bj][n] = *(const f32x4*)(gsn + (size_t)b * 1024 + col0 + bj * HALF + 4 * n);
            }
#pragma unroll
        for (int ai = 0; ai < 2; ++ai)
#pragma unroll
        for (int mp = 0; mp < 2; ++mp) {
            f32x4 xv[2][2][2];
#pragma unroll
            for (int mm = 0; mm < 2; ++mm)
#pragma unroll
                for (int bj = 0; bj < 2; ++bj) { const float* xp = xin + (size_t)(row0 + ai * HALF + (mp * 2 + mm) * 16) * 1024 + col0 + bj * HALF; xv[mm][bj][0] = *(const f32x4*)xp; xv[mm][bj][1] = *(const f32x4*)(xp + 4); }
#pragma unroll
            for (int mm = 0; mm < 2; ++mm) {
                const int m = mp * 2 + mm, row = row0 + ai * HALF + m * 16;
                float ss = 0.f;
#pragma unroll
                for (int bj = 0; bj < 2; ++bj) {
                    float* xp = x + (size_t)row * 1024 + col0 + bj * HALF;
                    const f32x4 x0 = xv[mm][bj][0] + gt[bj][0] * acc[ai][bj][m][0], x1 = xv[mm][bj][1] + gt[bj][1] * acc[ai][bj][m][1];
                    *(f32x4*)xp = x0; *(f32x4*)(xp + 4) = x1;
                    ss += (x0[0] * x0[0] + x0[1] * x0[1]) + (x0[2] * x0[2] + x0[3] * x0[3]) + (x1[0] * x1[0] + x1[1] * x1[1]) + (x1[2] * x1[2] + x1[3] * x1[3]);
                    const f32x4 y0 = x0 * gs[bj][0], y1 = x1 * gs[bj][1];
                    u32x4 w; w.x = cvt_pk_bf16(y0[0], y0[1]); w.y = cvt_pk_bf16(y0[2], y0[3]); w.z = cvt_pk_bf16(y1[0], y1[1]); w.w = cvt_pk_bf16(y1[2], y1[3]);
                    *(u32x4*)(xs + (size_t)row * 1024 + col0 + bj * HALF) = w;
                }
                ss += swz_xor<16>(ss); ss = sum_x32(ss);
                if (fq == 0) ssqp[(size_t)(u.pn * 4 + wc) * MROWS + row] = ss;
            }
            asm volatile("" ::: "memory");
        }
    }
};
__constant__ float ROPE_INVF[16] = {1.000000000e+00f, 4.403665960e-01f, 1.939227432e-01f, 8.539710194e-02f, 3.760603070e-02f, 1.656044088e-02f, 7.292664610e-03f, 3.211446106e-03f,
                                    1.414213562e-03f, 6.227724371e-04f, 2.742481884e-04f, 1.207697351e-04f, 5.318295734e-05f, 2.341999971e-05f, 1.031338525e-05f, 4.541670478e-06f};
struct EpiRope {
    static constexpr bool PERM = true, AFTER_DRAIN = false;
    bf16_t* QKV; const float* sw; const float* ssqp; const int* pos;
    __device__ __forceinline__ void operator()(const f32x4 (&acc)[2][2][4][2], const Unit& u, int wr, int wc, int fr, int fq) const {
        const int b = u.pm >> 5, row0 = u.pm * BM + wr * 64 + fr, col0 = u.pn * BM + wc * 32 + 8 * fq;
        f32x4 sv[2][2];
#pragma unroll
        for (int bj = 0; bj < 2; ++bj)
#pragma unroll
            for (int n = 0; n < 2; ++n) sv[bj][n] = *(const f32x4*)(sw + (size_t)b * 3072 + col0 + bj * HALF + 4 * n);
        const bool rot = (wc == 0) && (u.pn < 8);
        const bool lower = fq < 2;
        float rsv[2][4]; rows_rstd(ssqp, row0, fq, rsv);
        f32x4 fr4[2] = {{0.f, 0.f, 0.f, 0.f}, {0.f, 0.f, 0.f, 0.f}};
        if (rot) { fr4[0] = *(const f32x4*)(ROPE_INVF + 8 * (fq & 1)); fr4[1] = *(const f32x4*)(ROPE_INVF + 8 * (fq & 1) + 4); }
#pragma unroll
        for (int ai = 0; ai < 2; ++ai)
#pragma unroll
            for (int m = 0; m < 4; ++m) {
                const int row = row0 + ai * HALF + m * 16, srow = row & 8191;
                const float rs = rsv[ai][m];
                f32x4 cs[2] = {{1.f, 1.f, 1.f, 1.f}, {1.f, 1.f, 1.f, 1.f}}, sn[2] = {{0.f, 0.f, 0.f, 0.f}, {0.f, 0.f, 0.f, 0.f}};
                if (rot) {
                    const float p = (float)pos[row];
#pragma unroll
                    for (int n = 0; n < 2; ++n)
#pragma unroll
                        for (int j = 0; j < 4; ++j) {
                            const float a = p * fr4[n][j];
                            const float k = rintf(a * 0.15915494309189535f);
                            float r = fmaf(-k, 6.2831854820251465f, a); r = fmaf(-k, -1.7484555314695172e-07f, r);
                            cs[n][j] = __cosf(r); sn[n][j] = lower ? -__sinf(r) : __sinf(r);
                        }
                }
#pragma unroll
                for (int bj = 0; bj < 2; ++bj) {
                    const int blk = u.pn * 2 + bj, which = blk >> 3, idx = blk & 7;
                    f32x4 v[2] = {acc[ai][bj][m][0] * rs + sv[bj][0], acc[ai][bj][m][1] * rs + sv[bj][1]};
                    if (rot) {
#pragma unroll
                        for (int n = 0; n < 2; ++n)
#pragma unroll
                            for (int j = 0; j < 4; ++j) {
                                const unsigned bits = __float_as_uint(v[n][j]);
                                auto rr = __builtin_amdgcn_permlane32_swap(bits, bits, false, false);
                                const unsigned r0 = rr[0], r1 = rr[1];
                                const float pv = __uint_as_float(lower ? r1 : r0);
                                v[n][j] = v[n][j] * cs[n][j] + pv * sn[n][j];
                            }
                    }
                    bf16_t* dp = QKV + (size_t)which * 16777216 + ((size_t)(b * 8 + idx) * 8192 + srow) * 128 + wc * 32 + 8 * fq;
                    u32x4 w; w.x = cvt_pk_bf16(v[0][0], v[0][1]); w.y = cvt_pk_bf16(v[0][2], v[0][3]); w.z = cvt_pk_bf16(v[1][0], v[1][1]); w.w = cvt_pk_bf16(v[1][2], v[1][3]);
                    *(u32x4*)dp = w;
                }
            }
    }
};
struct EpiGen {
    static constexpr bool PERM = true, AFTER_DRAIN = false;
    int kind; void* p0; const void* p1; const void* p2; const void* p3; void* p4; void* p5;
    __device__ __forceinline__ void operator()(const f32x4 (&acc)[2][2][4][2], const Unit& u, int wr, int wc, int fr, int fq) const {
        if (kind == 0) { EpiUp e{(bf16_t*)p0, (const float*)p1, (const float*)p2}; e(acc, u, wr, wc, fr, fq); }
        else if (kind == 1) { EpiResidT<1> e{(float*)p0, (const float*)p3, (const float*)p1, (const float*)p2, (bf16_t*)p4, (float*)p5}; e(acc, u, wr, wc, fr, fq); }
        else if (kind == 2) { EpiResidT<0> e{(float*)p0, (const float*)p3, (const float*)p1, (const float*)p2, (bf16_t*)p4, (float*)p5}; e(acc, u, wr, wc, fr, fq); }
        else if (kind == 3) { EpiBias e{(bf16_t*)p0, 3072, (const float*)p1, 3072, (const float*)p2}; e(acc, u, wr, wc, fr, fq); }
        else if (kind == 5) { EpiResidT<2> e{(float*)p0, (const float*)p3, (const float*)p1, (const float*)p2, (bf16_t*)p4, (float*)p5}; e(acc, u, wr, wc, fr, fq); }
        else { EpiRope e{(bf16_t*)p0, (const float*)p1, (const float*)p2, (const int*)p3}; e(acc, u, wr, wc, fr, fq); }
    }
};
template <class Epi, class Sched, bool ALIGN_EPI = false, bool SP2 = false>
__device__ __forceinline__ void gemm_phase(PG8_LAS unsigned char* lds, const Gemm g, const Sched& S, const Epi& E, const int tid_in) {
    const int tid = tid_in, wid = __builtin_amdgcn_readfirstlane(tid >> 6), lane = tid & 63, wr = wid >> 2, wc = wid & 3, fr = lane & 15, fq = lane >> 4;
    const int K = g.K, nt = K / BK;
    unsigned voffA[2], voffB[2];
#pragma unroll
    for (int i = 0; i < 2; ++i) { int R, C; stage_rc(tid * 16 + i * 8192, R, C); const int Rb = Epi::PERM ? ((R & ~31) + perm32(R & 31)) : R;
        voffA[i] = (unsigned)(R * K + C) * 2u; voffB[i] = (unsigned)(Rb * K + C) * 2u; }
    const size_t kstep = (size_t)(BK * 2);
    const size_t hstep = (size_t)HALF * K * 2;
    const size_t tstep = 2 * hstep;
    const unsigned ldsw = (unsigned)wid * 1024u;
    const int aoff = lds_byte(wr * 64 + fr, fq * 8), boff = lds_byte(wc * 32 + fr, fq * 8);
#define PG8_SA(b, h) (((b) * 2 + (h)) * HTB)
#define PG8_SB(b, h) ((4 + (b) * 2 + (h)) * HTB)
#define PG8_STAGE(bufoff, gbase, voff) do { _Pragma("unroll") for (int _i = 0; _i < 2; ++_i) \
        __builtin_amdgcn_global_load_lds((const unsigned*)((const char*)(gbase) + (voff)[_i]), (PG8_LAS unsigned*)(lds + (bufoff) + ldsw + _i * 8192), 16, 0, 0); } while (0)
#define PG8_LDA(dst, b, h) do { _Pragma("unroll") for (int m = 0; m < 4; ++m) _Pragma("unroll") for (int k = 0; k < 2; ++k) dst[m][k] = *(const PG8_LAS bf16x8*)(lds + PG8_SA(b, h) + aoff + m * 2048 + k * 1024); } while (0)
#define PG8_LDB(dst, b, h) do { _Pragma("unroll") for (int n = 0; n < 2; ++n) _Pragma("unroll") for (int k = 0; k < 2; ++k) dst[n][k] = *(const PG8_LAS bf16x8*)(lds + PG8_SB(b, h) + boff + n * 2048 + k * 1024); } while (0)
#define PG8_MMA(ai, bj, At, Bt) do { __builtin_amdgcn_s_setprio(1); _Pragma("unroll") for (int m = 0; m < 4; ++m) _Pragma("unroll") for (int n = 0; n < 2; ++n) _Pragma("unroll") for (int k = 0; k < 2; ++k) \
        acc[ai][bj][m][n] = __builtin_amdgcn_mfma_f32_16x16x32_bf16(Bt[n][k], At[m][k], acc[ai][bj][m][n], 0, 0, 0); __builtin_amdgcn_s_setprio(0); } while (0)
#define PG8_WAIT_V(n) asm volatile("s_waitcnt vmcnt(" #n ")" ::: "memory")
#define PG8_WAIT_L(n) asm volatile("s_waitcnt lgkmcnt(" #n ")" ::: "memory")
#define PG8_BAR __builtin_amdgcn_s_barrier()
#define PG8_SCHED __builtin_amdgcn_sched_barrier(0)
    Unit cur, nxt; int ui = 0;
    if (!S.next(0, cur)) return;
    f32x4 acc[2][2][4][2];
#pragma unroll
    for (int a = 0; a < 2; ++a)
#pragma unroll
        for (int b = 0; b < 2; ++b)
#pragma unroll
            for (int m = 0; m < 4; ++m)
#pragma unroll
                for (int n = 0; n < 2; ++n) acc[a][b][m][n] = (f32x4){0.f, 0.f, 0.f, 0.f};
    bf16x8 At[4][2], B0[2][2], B1[2][2];
    const char* cA = (const char*)g.A + (size_t)cur.pm * tstep; const char* cB = (const char*)g.Bt + (size_t)cur.pn * tstep;
    S.a_ready(cur);
    if constexpr (SP2) {
        PG8_STAGE(PG8_SB(0, 0), cB, voffB); PG8_STAGE(PG8_SB(0, 1), cB + hstep, voffB); PG8_STAGE(PG8_SA(0, 0), cA, voffA); PG8_STAGE(PG8_SA(0, 1), cA + hstep, voffA);
        if (wr == 1) PG8_BAR;
        PG8_WAIT_V(2); PG8_BAR;
        PG8_STAGE(PG8_SB(1, 0), cB + kstep, voffB); PG8_STAGE(PG8_SA(1, 0), cA + kstep, voffA); PG8_STAGE(PG8_SB(1, 1), cB + hstep + kstep, voffB);
        PG8_WAIT_V(6); PG8_BAR;
    } else {
        PG8_STAGE(PG8_SB(0, 0), cB, voffB); PG8_STAGE(PG8_SA(0, 0), cA, voffA); PG8_STAGE(PG8_SB(0, 1), cB + hstep, voffB); PG8_STAGE(PG8_SA(0, 1), cA + hstep, voffA);
        if (wr == 1) PG8_BAR;
        PG8_WAIT_V(4); PG8_BAR;
        PG8_STAGE(PG8_SB(1, 0), cB + kstep, voffB); PG8_STAGE(PG8_SA(1, 0), cA + kstep, voffA); PG8_STAGE(PG8_SB(1, 1), cB + hstep + kstep, voffB);
        PG8_WAIT_V(6); PG8_BAR;
    }
    for (;;) {
        const bool has_next = S.next(ui + 1, nxt);
        const char* nA = has_next ? (const char*)g.A + (size_t)nxt.pm * tstep : cA; const char* nB = has_next ? (const char*)g.Bt + (size_t)nxt.pn * tstep : cB;
        for (int t = 0; t < nt; t += 2) {
            const bool last = (t == nt - 2);
            const char* a1 = cA + (size_t)(t + 1) * kstep;
            const char* a2 = last ? nA : cA + (size_t)(t + 2) * kstep; const char* b2 = last ? nB : cB + (size_t)(t + 2) * kstep;
            const char* a3 = a2 + kstep; const char* b3 = b2 + kstep;
            if (last && has_next) S.a_ready(nxt);
            if constexpr (SP2) {
            PG8_LDB(B0, 0, 0); PG8_LDB(B1, 0, 1); PG8_SCHED; PG8_LDA(At, 0, 0); PG8_STAGE(PG8_SA(1, 1), a1 + hstep, voffA);
            PG8_WAIT_V(8); PG8_WAIT_L(0); PG8_BAR; PG8_MMA(0, 0, At, B0); PG8_MMA(0, 1, At, B1); PG8_BAR; PG8_SCHED;
            PG8_LDA(At, 0, 1); PG8_STAGE(PG8_SB(0, 0), b2, voffB); PG8_STAGE(PG8_SB(0, 1), b2 + hstep, voffB); PG8_STAGE(PG8_SA(0, 0), a2, voffA);
            PG8_WAIT_V(8); PG8_WAIT_L(0); PG8_BAR; PG8_MMA(1, 0, At, B0); PG8_MMA(1, 1, At, B1); PG8_BAR; PG8_SCHED;
            PG8_LDB(B0, 1, 0); PG8_LDB(B1, 1, 1); PG8_SCHED; PG8_LDA(At, 1, 0); PG8_STAGE(PG8_SA(0, 1), a2 + hstep, voffA);
            PG8_WAIT_V(8); PG8_WAIT_L(0); PG8_BAR; PG8_MMA(0, 0, At, B0); PG8_MMA(0, 1, At, B1); PG8_BAR; PG8_SCHED;
            PG8_LDA(At, 1, 1); PG8_STAGE(PG8_SB(1, 0), b3, voffB); PG8_STAGE(PG8_SB(1, 1), b3 + hstep, voffB); PG8_STAGE(PG8_SA(1, 0), a3, voffA);
            PG8_WAIT_V(8); PG8_WAIT_L(0); PG8_BAR; PG8_MMA(1, 0, At, B0); PG8_MMA(1, 1, At, B1); PG8_BAR; PG8_SCHED;
            } else {
            PG8_LDB(B0, 0, 0); PG8_SCHED; PG8_LDA(At, 0, 0); PG8_STAGE(PG8_SA(1, 1), a1 + hstep, voffA);
            PG8_WAIT_L(8); PG8_BAR; PG8_WAIT_L(0); PG8_MMA(0, 0, At, B0); PG8_BAR; PG8_SCHED;
            PG8_LDB(B1, 0, 1); PG8_STAGE(PG8_SB(0, 0), b2, voffB);
            PG8_BAR; PG8_WAIT_L(0); PG8_MMA(0, 1, At, B1); PG8_BAR;
            PG8_LDA(At, 0, 1); PG8_STAGE(PG8_SA(0, 0), a2, voffA);
            PG8_BAR; PG8_WAIT_L(0); PG8_MMA(1, 0, At, B0); PG8_BAR; PG8_SCHED;
            PG8_STAGE(PG8_SB(0, 1), b2 + hstep, voffB);
            PG8_WAIT_V(6); PG8_BAR; PG8_MMA(1, 1, At, B1); PG8_BAR;
            PG8_LDB(B0, 1, 0); PG8_SCHED; PG8_LDA(At, 1, 0); PG8_STAGE(PG8_SA(0, 1), a2 + hstep, voffA);
            PG8_WAIT_L(8); PG8_BAR; PG8_WAIT_L(0); PG8_MMA(0, 0, At, B0); PG8_BAR; PG8_SCHED;
            PG8_LDB(B1, 1, 1); PG8_STAGE(PG8_SB(1, 0), b3, voffB);
            PG8_BAR; PG8_WAIT_L(0); PG8_MMA(0, 1, At, B1); PG8_BAR;
            PG8_LDA(At, 1, 1); PG8_STAGE(PG8_SA(1, 0), a3, voffA);
            PG8_BAR; PG8_WAIT_L(0); PG8_MMA(1, 0, At, B0); PG8_BAR; PG8_SCHED;
            PG8_STAGE(PG8_SB(1, 1), b3 + hstep, voffB);
            PG8_WAIT_V(6); PG8_BAR; PG8_MMA(1, 1, At, B1); PG8_BAR;
            }
        }
        if constexpr (ALIGN_EPI) { if (wr == 0) PG8_BAR; }
        if constexpr (!Epi::AFTER_DRAIN) { E(acc, cur, wr, wc, fr, fq); S.done(cur); }
        if (!has_next) break;
#pragma unroll
        for (int a = 0; a < 2; ++a)
#pragma unroll
            for (int b = 0; b < 2; ++b)
#pragma unroll
                for (int m = 0; m < 4; ++m)
#pragma unroll
                    for (int n = 0; n < 2; ++n) acc[a][b][m][n] = (f32x4){0.f, 0.f, 0.f, 0.f};
        cur = nxt; cA = nA; cB = nB; ++ui;
        if constexpr (ALIGN_EPI) { if (wr == 1) PG8_BAR; }
    }
    PG8_WAIT_V(0);
    if constexpr (!ALIGN_EPI) { if (wr == 0) PG8_BAR; }
    PG8_BAR;
    if constexpr (Epi::AFTER_DRAIN) { E.fused(acc, cur, wr, wc, fr, fq, lds, wid, lane); S.done(cur); }
#undef PG8_SA
#undef PG8_SB
#undef PG8_STAGE
#undef PG8_LDA
#undef PG8_LDB
#undef PG8_MMA
#undef PG8_WAIT_V
#undef PG8_WAIT_L
#undef PG8_BAR
#undef PG8_SCHED
}
}
namespace att {
using bf16 = __hip_bfloat16;
constexpr int D = 128; constexpr float THR = 8.f; constexpr bool WSKIP = false;
constexpr float SCALE = 0.08838834764831845f;
constexpr int NW = 8, QBLK = 32, KVBLK = 64, QB = NW * QBLK;
constexpr int SHM_V = KVBLK * D * 2, SHM_K = KVBLK * D * 2;
constexpr int LDS_BYTES = 2 * SHM_V + 2 * SHM_K + NW * 64 * 4;
typedef short bf16x8 __attribute__((ext_vector_type(8)));
typedef short s16x4 __attribute__((ext_vector_type(4)));
typedef float f32x16 __attribute__((ext_vector_type(16)));
typedef float f32x4 __attribute__((ext_vector_type(4)));
typedef unsigned u32x4 __attribute__((ext_vector_type(4)));
template <class A, class Bt> struct same_t { static constexpr bool v = false; };
template <class A> struct same_t<A, A> { static constexpr bool v = true; };

#define KSWZ(row, colB) ((row) * 256 + ((colB) ^ (((row) & 7) << 4)))
#define SBAR() __builtin_amdgcn_sched_barrier(0)
__device__ __forceinline__ int v_st(int k, int c) { const int kk = (k & ~0xC) | ((k & 4) << 1) | ((k & 8) >> 1); return ((kk >> 3) * 4 + (c >> 5)) * 512 + ((kk & 7) * 32 + (c & 31)) * 2; }
__device__ __forceinline__ int v_rd_base(int lane) { return ((lane & 3) << 3) | (((lane >> 2) & 3) << 6) | (((lane >> 4) & 1) << 5) | (((lane >> 5) & 1) << 8); }
constexpr int v_rd_off(int d0, int ks, int half) { return d0 * 512 + ks * 4096 + half * 2048; }
__device__ __forceinline__ int crow(int r, int hi) { return (r & 3) + 8 * (r >> 2) + 4 * hi; }
__device__ __forceinline__ unsigned cvtpk(float lo, float hi) {
    unsigned r; asm volatile("v_cvt_pk_bf16_f32 %0, %1, %2" : "=v"(r) : "v"(lo), "v"(hi)); return r;
}
__device__ __forceinline__ bf16x8 pack8(f32x4 a, f32x4 b) {
    u32x4 w = {cvtpk(a[0], a[1]), cvtpk(a[2], a[3]), cvtpk(b[0], b[1]), cvtpk(b[2], b[3])};
    return *reinterpret_cast<bf16x8*>(&w);
}
template <class T> __device__ __forceinline__ bf16x8 load8(const T* p) {
    if constexpr (same_t<T, float>::v) { return pack8(*(const f32x4*)p, *(const f32x4*)(p + 4)); }
    else { return *reinterpret_cast<const bf16x8*>(p); }
}
__device__ __forceinline__ void mask_tile(f32x16& p0, f32x16& p1, int dq, unsigned W) {
    const float NEG = -__builtin_inff();
#pragma unroll
    for (int r = 0; r < 16; ++r) {
        const int c = (r & 3) + 8 * (r >> 2);
        if ((unsigned)(dq - c) >= W) p0[r] = NEG;
        if ((unsigned)(dq - c - 32) >= W) p1[r] = NEG;
    }
}
__device__ __forceinline__ void partialSM(f32x16& p0, f32x16& p1, float& m_reg, float& mn, float& alpha) {
    float pmax = p0[0]; for (int r = 1; r < 16; ++r) pmax = fmaxf(pmax, p0[r]); for (int r = 0; r < 16; ++r) pmax = fmaxf(pmax, p1[r]);
    { auto rr = __builtin_amdgcn_permlane32_swap(__float_as_uint(pmax), __float_as_uint(pmax), false, false);
      pmax = fmaxf(__uint_as_float(rr[0]), __uint_as_float(rr[1])); }
    constexpr float C2 = 1.4426950408889634f * SCALE;
    if (__builtin_expect(__all((pmax - m_reg) * SCALE <= THR), 1)) { mn = m_reg; alpha = 1.f; }
    else { mn = fmaxf(m_reg, pmax); alpha = __builtin_amdgcn_exp2f((m_reg - mn) * C2); m_reg = mn; }
    const float mnL = -mn * C2;
    for (int r = 0; r < 16; ++r) p0[r] = fmaf(p0[r], C2, mnL); for (int r = 0; r < 16; ++r) p1[r] = fmaf(p1[r], C2, mnL);
    for (int r = 0; r < 16; ++r) p0[r] = __builtin_amdgcn_exp2f(p0[r]);
}
__device__ __forceinline__ void finishSM(f32x16& p0, f32x16& p1, float alpha, float& l_reg, bf16x8& pa0, bf16x8& pa1, bf16x8& pa2, bf16x8& pa3) {
    for (int r = 0; r < 16; ++r) p1[r] = __builtin_amdgcn_exp2f(p1[r]);
    float ps = 0; for (int r = 0; r < 16; ++r) ps += p0[r]; for (int r = 0; r < 16; ++r) ps += p1[r];
    { auto rr = __builtin_amdgcn_permlane32_swap(__float_as_uint(ps), __float_as_uint(ps), false, false);
      ps = __uint_as_float(rr[0]) + __uint_as_float(rr[1]); }
    l_reg = l_reg * alpha + ps;
#define PK4(P, B_, OUT) do { unsigned a0 = cvtpk(P[B_+0], P[B_+1]), a1 = cvtpk(P[B_+2], P[B_+3]);                          \
        unsigned b0 = cvtpk(P[B_+4], P[B_+5]), b1 = cvtpk(P[B_+6], P[B_+7]);                                             \
        auto r0 = __builtin_amdgcn_permlane32_swap(a0, b0, false, false); auto r1 = __builtin_amdgcn_permlane32_swap(a1, b1, false, false); \
        u32x4 w = {r0[0], r1[0], r0[1], r1[1]}; OUT = *reinterpret_cast<bf16x8*>(&w); } while (0)
    PK4(p0, 0, pa0); PK4(p0, 8, pa1); PK4(p1, 0, pa2); PK4(p1, 8, pa3);
#undef PK4
}
template <int KB, bool SK>
__device__ __forceinline__ void qkt(f32x16& p0, f32x16& p1, const char* K_lds, int r32, int hi, const bf16x8* qr, bool act) {
    if (SK && !act) { const float NEG = -__builtin_inff();
#pragma unroll
        for (int r = 0; r < 16; ++r) { p0[r] = NEG; p1[r] = NEG; } return; }
    p0 = f32x16{}; p1 = f32x16{};
    const char* kb[4];
#pragma unroll
    for (int dd = 0; dd < 4; ++dd) kb[dd] = K_lds + KB * SHM_K + KSWZ(r32, (dd * 16 + hi * 8) * 2);
#pragma unroll
    for (int d0 = 0; d0 < 8; ++d0) { const char* a = kb[d0 & 3] + (d0 >> 2) * 128;
        bf16x8 b0 = *reinterpret_cast<const bf16x8*>(a);
        bf16x8 b1 = *reinterpret_cast<const bf16x8*>(a + 32 * 256);
        p0 = __builtin_amdgcn_mfma_f32_32x32x16_bf16(b0, qr[d0], p0, 0, 0, 0);
        p1 = __builtin_amdgcn_mfma_f32_32x32x16_bf16(b1, qr[d0], p1, 0, 0, 0); }
}
template <int VB, bool SK>
__device__ __forceinline__ void pv_tile(f32x16* o, int vb0, bf16x8 pa0, bf16x8 pa1, bf16x8 pa2, bf16x8 pa3, bool act) {
    if (SK && !act) return;
#define TRRD(dst, off) asm volatile("ds_read_b64_tr_b16 %0, %1 offset:%2" : "=&v"(dst) : "v"(vb0), "i"(off) : "memory")
#define PV_D0(d0) do { s16x4 l0, l1, l2, l3, h0, h1, h2, h3; constexpr int b_ = VB * SHM_V + v_rd_off(d0, 0, 0);     \
        TRRD(l0, b_); TRRD(h0, b_ + 2048); TRRD(l1, b_ + 4096); TRRD(h1, b_ + 6144); TRRD(l2, b_ + 8192); TRRD(h2, b_ + 10240); TRRD(l3, b_ + 12288); TRRD(h3, b_ + 14336); \
        asm volatile("s_waitcnt lgkmcnt(0)" ::: "memory"); SBAR();                 \
        o[d0] = __builtin_amdgcn_mfma_f32_32x32x16_bf16(pa0, (bf16x8){l0[0], l0[1], l0[2], l0[3], h0[0], h0[1], h0[2], h0[3]}, o[d0], 0, 0, 0);   \
        o[d0] = __builtin_amdgcn_mfma_f32_32x32x16_bf16(pa1, (bf16x8){l1[0], l1[1], l1[2], l1[3], h1[0], h1[1], h1[2], h1[3]}, o[d0], 0, 0, 0);   \
        o[d0] = __builtin_amdgcn_mfma_f32_32x32x16_bf16(pa2, (bf16x8){l2[0], l2[1], l2[2], l2[3], h2[0], h2[1], h2[2], h2[3]}, o[d0], 0, 0, 0);   \
        o[d0] = __builtin_amdgcn_mfma_f32_32x32x16_bf16(pa3, (bf16x8){l3[0], l3[1], l3[2], l3[3], h3[0], h3[1], h3[2], h3[3]}, o[d0], 0, 0, 0); } while (0)
    PV_D0(0); PV_D0(1); PV_D0(2); PV_D0(3);
#undef PV_D0
#undef TRRD
}

template <class TIn, class TOut> struct BlockRef { const TIn* Q; const TIn* K; const TIn* V; TOut* O; int P0; };
template <class TIn> struct Seam {
    bf16x8 qr[8];
    bf16x8 st_v0, st_v1, st_k0, st_k1; f32x4 sf0, sf1, sf2, sf3;
    f32x4 tq[16];
};
__device__ __forceinline__ int swa_jlo(int P0, int W) { const int lowk = P0 - W + 1; return lowk > 0 ? lowk / KVBLK : 0; }
#define ROW(p, k0, rr) ((p) + (size_t)((k0) + (rr)) * D + sc)
#define VMW() asm volatile("s_waitcnt vmcnt(0)" ::: "memory")
#define VMWN(n) asm volatile("s_waitcnt vmcnt(%0)" :: "i"(n) : "memory")
#define SLOAD_H(Kp, Vp, k0) do { S.st_v0 = load8<TIn>(ROW(Vp, k0, sr)); S.st_v1 = load8<TIn>(ROW(Vp, k0, 32 + sr));              \
                         S.st_k0 = load8<TIn>(ROW(Kp, k0, sr)); S.st_k1 = load8<TIn>(ROW(Kp, k0, 32 + sr)); } while (0)
#define SWRITE_HK(bf) do { *(bf16x8*)(K_lds + (bf) * SHM_K + kws) = S.st_k0; *(bf16x8*)(K_lds + (bf) * SHM_K + kws + 32 * 256) = S.st_k1; } while (0)
#define SWRITE_HV(bf) do { *(bf16x8*)(V_lds + (bf) * SHM_V + vst0) = S.st_v0; *(bf16x8*)(V_lds + (bf) * SHM_V + vst1) = S.st_v1; } while (0)
#define SWRITE_H(bf) do { SWRITE_HV(bf); SWRITE_HK(bf); } while (0)
#define SLOAD_F(p, k0) do { S.sf0 = *(const f32x4*)ROW(p, k0, sr); S.sf1 = *(const f32x4*)(ROW(p, k0, sr) + 4);                \
                            S.sf2 = *(const f32x4*)ROW(p, k0, 32 + sr); S.sf3 = *(const f32x4*)(ROW(p, k0, 32 + sr) + 4); } while (0)
#define SWRITE_KF(bf) do { *(bf16x8*)(K_lds + (bf) * SHM_K + kws) = pack8(S.sf0, S.sf1); *(bf16x8*)(K_lds + (bf) * SHM_K + kws + 32 * 256) = pack8(S.sf2, S.sf3); } while (0)
#define SWRITE_VF(bf) do { *(bf16x8*)(V_lds + (bf) * SHM_V + vst0) = pack8(S.sf0, S.sf1); *(bf16x8*)(V_lds + (bf) * SHM_V + vst1) = pack8(S.sf2, S.sf3); } while (0)
template <class TIn, class TOut>
__device__ __forceinline__ void causal_swa_prime(const BlockRef<TIn, TOut>& cur, int W, char* lds, Seam<TIn>& S, int tid_in) {
    constexpr bool F32 = same_t<TIn, float>::v;
    const int tid = tid_in, wid = __builtin_amdgcn_readfirstlane(tid >> 6), lane = tid & 63, r32 = lane & 31, hi = lane >> 5;
    const int sr = tid >> 4, sc = (tid & 15) * 8, kws = KSWZ(sr, sc * 2); char* K_lds = lds + 2 * SHM_V;
    const int kb0 = swa_jlo(cur.P0, W) * KVBLK;
    for (int d0 = 0; d0 < 8; ++d0) S.qr[d0] = load8<TIn>(cur.Q + (size_t)(wid * QBLK + r32) * D + d0 * 16 + hi * 8);
    if constexpr (F32) { SLOAD_F((const float*)cur.K, kb0); VMW(); SWRITE_KF(0); SBAR(); SLOAD_F((const float*)cur.V, kb0); }
    else { SLOAD_H(cur.K, cur.V, kb0); VMW(); SWRITE_HK(0); }
    __syncthreads();
}
template <class TIn, class TOut>
__device__ __forceinline__ void causal_swa_block(const BlockRef<TIn, TOut>& cur, const BlockRef<TIn, TOut>& nxt, int skv, int W, char* lds, Seam<TIn>& S, int tid_in) {
    constexpr bool F32 = same_t<TIn, float>::v;
    const int tid = tid_in, wid = __builtin_amdgcn_readfirstlane(tid >> 6), lane = tid & 63, r32 = lane & 31, hi = lane >> 5;
    const int j_lo = swa_jlo(cur.P0, W);
    int j_hi = (cur.P0 + QB - 1) / KVBLK + 1; if (j_hi > skv / KVBLK) j_hi = skv / KVBLK;
    const int NT = j_hi - j_lo;
    const int kbn = swa_jlo(nxt.P0, W) * KVBLK;
    const int qlo = cur.P0 + wid * QBLK, qm = qlo + r32 - 4 * hi;
    char* V_lds = lds; char* K_lds = lds + 2 * SHM_V;
    float* ws = (float*)(lds + 2 * SHM_V + 2 * SHM_K) + wid * 64; float* li_l = ws, * al_l = ws + 32;
    float m_reg = -1e30f, l_reg = 0; f32x16 o[4] = {};
    const int sr = tid >> 4, sc = (tid & 15) * 8, vst0 = v_st(sr, sc), vst1 = v_st(32 + sr, sc), kws = KSWZ(sr, sc * 2);
    const int vb0 = (int)(uintptr_t)V_lds + v_rd_base(lane);
    const TIn* Kh = cur.K; const TIn* Vh = cur.V;
#define RESC(a) do { if (__any((a) < 1.f)) { if (hi == 0) al_l[r32] = (a); asm volatile("s_waitcnt lgkmcnt(0)" ::: "memory");              \
                     for (int d_ = 0; d_ < 4; ++d_) for (int r = 0; r < 16; ++r) o[d_][r] *= al_l[crow(r, hi)]; } } while (0)
#define KBASE(t) ((j_lo + (t)) * KVBLK)
#define ACT(t) (KBASE(t) <= qlo + QBLK - 1 && KBASE(t) + KVBLK - 1 >= qlo - W + 1)
#define MASKT(P0_, P1_, t) do { const int kb_ = KBASE(t); if ((!SK || ACT(t)) && (kb_ + KVBLK - 1 > qlo || kb_ <= qlo + QBLK - 1 - W)) mask_tile(P0_, P1_, qm - kb_, (unsigned)W); } while (0)
    constexpr int NQL = F32 ? 16 : 8;
    constexpr bool SK = WSKIP && !F32;
#define SEAM_K0() do { VMWN(NQL); if constexpr (F32) { SWRITE_KF(0); SBAR(); SLOAD_F((const float*)nxt.V, kbn); } else { SWRITE_HK(0); } SBAR(); } while (0)
    f32x16 pA0, pA1, pB0, pB1; float mnA, mnB, alA, alB; bf16x8 pa0, pa1, pa2, pa3;
    if constexpr (F32) { VMW(); SWRITE_VF(0); SBAR(); } else { SWRITE_HV(0); SBAR(); }
    if (NT > 1) { if constexpr (F32) SLOAD_F((const float*)Kh, KBASE(1)); else SLOAD_H(Kh, Vh, KBASE(1)); }
    SBAR(); qkt<0, SK>(pA0, pA1, K_lds, r32, hi, S.qr, ACT(0));
    if constexpr (F32) { if (NT > 1) { VMW(); SWRITE_KF(1); SBAR(); SLOAD_F((const float*)Vh, KBASE(1)); } }
    MASKT(pA0, pA1, 0); partialSM(pA0, pA1, m_reg, mnA, alA);
    if (NT > 1) { VMW(); if constexpr (F32) { SWRITE_VF(1); SBAR(); if (NT > 2) SLOAD_F((const float*)Kh, KBASE(2)); } else SWRITE_H(1); }
    __syncthreads();
#define HALF_STEP(PX0, PX1, mnX, alX, PY0, PY1, alY, t, KB, VB, SB) do {                                                      \
        SBAR(); qkt<KB, SK>(PX0, PX1, K_lds, r32, hi, S.qr, ACT(t));                                             \
        finishSM(PY0, PY1, alY, l_reg, pa0, pa1, pa2, pa3); SBAR();                                                           \
        if ((t) + 1 < NT) { if constexpr (F32) { VMW(); SWRITE_KF(SB); SBAR(); SLOAD_F((const float*)Vh, KBASE((t) + 1)); }  \
                            else { SLOAD_H(Kh, Vh, KBASE((t) + 1)); } SBAR(); }                                               \
        pv_tile<VB, SK>(o, vb0, pa0, pa1, pa2, pa3, ACT((t) - 1)); MASKT(PX0, PX1, (t)); partialSM(PX0, PX1, m_reg, mnX, alX);                                        \
        __syncthreads();                                                                                                      \
        if ((t) + 1 < NT) { VMW(); if constexpr (F32) { SWRITE_VF(SB); SBAR(); if ((t) + 2 < NT) SLOAD_F((const float*)Kh, KBASE((t) + 2)); } \
                            else { SWRITE_H(SB); } }                                                                          \
        RESC(alX); __syncthreads(); } while (0)
    for (int t = 1; t + 1 < NT; t += 2) {
        HALF_STEP(pB0, pB1, mnB, alB, pA0, pA1, alA, t, 1, 0, 0);
        HALF_STEP(pA0, pA1, mnA, alA, pB0, pB1, alB, t + 1, 0, 1, 1);
    }
    const bool even = (NT & 1) == 0;
    if (even) { SBAR(); qkt<1, SK>(pB0, pB1, K_lds, r32, hi, S.qr, ACT(NT - 1)); SBAR(); }
#define QROW(e) (nxt.Q + (size_t)(wid * QBLK + r32) * D + ((e) >> 1) * 16 + hi * 8 + ((e) & 1) * 4)
    if constexpr (F32) { SLOAD_F((const float*)nxt.K, kbn); SBAR();
#pragma unroll
        for (int e = 0; e < 8; ++e) S.tq[e] = *(const f32x4*)QROW(e); }
    else { SLOAD_H(nxt.K, nxt.V, kbn); SBAR();
#pragma unroll
        for (int d0 = 0; d0 < 8; ++d0) S.qr[d0] = load8<TIn>(nxt.Q + (size_t)(wid * QBLK + r32) * D + d0 * 16 + hi * 8); }
    SBAR();
    finishSM(pA0, pA1, alA, l_reg, pa0, pa1, pa2, pa3); SBAR();
    if constexpr (F32) {
#pragma unroll
        for (int e = 8; e < 16; ++e) S.tq[e] = *(const f32x4*)QROW(e); SBAR(); }
#undef QROW
    pv_tile<0, SK>(o, vb0, pa0, pa1, pa2, pa3, ACT(even ? NT - 2 : NT - 1));
    if (even) { MASKT(pB0, pB1, NT - 1); partialSM(pB0, pB1, m_reg, mnB, alB); __syncthreads(); RESC(alB);
        finishSM(pB0, pB1, alB, l_reg, pa0, pa1, pa2, pa3); SBAR(); pv_tile<1, SK>(o, vb0, pa0, pa1, pa2, pa3, ACT(NT - 1)); }
    SBAR(); SEAM_K0();
    if (hi == 0) li_l[r32] = l_reg; asm volatile("s_waitcnt lgkmcnt(0)" ::: "memory");
    float rli[16];
#pragma unroll
    for (int r = 0; r < 16; ++r) rli[r] = __builtin_amdgcn_rcpf(li_l[crow(r, hi)]);
    TOut* Ow = cur.O + (size_t)(wid * QBLK) * D;
    int hi_e = hi; asm volatile("" : "+v"(hi_e));
#pragma unroll
    for (int r = 0; r < 16; ++r) { const int orow = crow(r, hi_e);
#pragma unroll
        for (int d0 = 0; d0 < 4; ++d0) { const float v = o[d0][r] * rli[r];
            if constexpr (same_t<TOut, float>::v) { Ow[(size_t)orow * D + d0 * 32 + r32] = v; }
            else { const float vn = swz_xor<1>(v);
                   if ((r32 & 1) == 0) *(unsigned*)(Ow + (size_t)orow * D + d0 * 32 + r32) = cvtpk(v, vn); } } }
    if constexpr (F32) {
#pragma unroll
        for (int d0 = 0; d0 < 8; ++d0) S.qr[d0] = pack8(S.tq[2 * d0], S.tq[2 * d0 + 1]); }
    __syncthreads();
#undef RESC
#undef KBASE
#undef ACT
#undef MASKT
#undef SEAM_K0
#undef HALF_STEP
}
#undef ROW
#undef VMW
#undef VMWN
#undef SLOAD_H
#undef SWRITE_HK
#undef SWRITE_HV
#undef SWRITE_H
#undef SLOAD_F
#undef SWRITE_KF
#undef SWRITE_VF
#undef SBAR
#undef KSWZ
}
namespace cg = cooperative_groups;
#ifndef S3_REP
#define S3_REP 1
#endif
#ifndef MK_DEBUG
#define MK_DEBUG 0
#endif
#define LAS __attribute__((address_space(3)))
typedef unsigned short bf16r;
typedef unsigned v4u __attribute__((ext_vector_type(4)));
typedef unsigned v2u __attribute__((ext_vector_type(2)));
typedef float f32x4 __attribute__((ext_vector_type(4)));
typedef short bf16x8 __attribute__((ext_vector_type(8)));
constexpr int M = 16384, SEQ = 8192, DM = 1024, DFF = 2816, NUP = 5632, NIN = 3072, DEPTH = 4;
constexpr float EPS = 1e-6f;
constexpr size_t MiB = 1u << 20;
constexpr size_t WS_ADA = 1 * MiB, WS_GS = 2 * MiB, WS_SWF = 3 * MiB, WS_SWM = 4 * MiB, WS_SSQP = 5 * MiB, WS_GATES = 6 * MiB, WS_BCUM = 7 * MiB, WS_LOGI = 8 * MiB,
                 WS_SCAL = 9 * MiB, WS_NLOC = 10 * MiB, WS_NST = 11 * MiB, WS_LAM = 12 * MiB, WS_WGT = 13 * MiB, WS_SWG = 14 * MiB;
constexpr size_t WS_W13 = 16 * MiB, WS_W2 = 104 * MiB, WS_WINA = 148 * MiB, WS_WINB = 160 * MiB, WS_WOA = 172 * MiB, WS_WOB = 176 * MiB;
constexpr size_t WS_XS = 180 * MiB, WS_H = 212 * MiB, WS_P = 300 * MiB, WS_Y = 396 * MiB, WS_U = 428 * MiB, WS_CST = 556 * MiB, WS_END = 620 * MiB;
constexpr size_t WS_O = WS_H;
constexpr int LDS_BYTES = 147456;
constexpr int NWAVES = 8;

typedef float f32x2_t __attribute__((ext_vector_type(2))); typedef __bf16 bf16x2_t __attribute__((ext_vector_type(2)));
__device__ __forceinline__ unsigned pk2(float lo, float hi) { f32x2_t v = {lo, hi}; bf16x2_t b = __builtin_convertvector(v, bf16x2_t); return __builtin_bit_cast(unsigned, b); }
__device__ __forceinline__ unsigned f2bf(float f) { return pk2(f, f) & 0xffffu; }
__device__ __forceinline__ float bflo(unsigned w) { return __uint_as_float(w << 16); }
__device__ __forceinline__ float bfhi(unsigned w) { return __uint_as_float(w & 0xffff0000u); }
__device__ __forceinline__ float bf2f(bf16r v) { return __uint_as_float((unsigned)v << 16); }
__device__ __forceinline__ float wave_sum(float v) {
    v += swz_xor<1>(v); v += swz_xor<2>(v); v += swz_xor<4>(v); v += swz_xor<8>(v); v += swz_xor<16>(v); return sum_x32(v);
}
__device__ __forceinline__ float wave_max(float v) {
    v = fmaxf(v, swz_xor<1>(v)); v = fmaxf(v, swz_xor<2>(v)); v = fmaxf(v, swz_xor<4>(v)); v = fmaxf(v, swz_xor<8>(v)); v = fmaxf(v, swz_xor<16>(v)); return max_x32(v);
}
__device__ __forceinline__ float lane_up(float v, int lane, int o) { return __builtin_bit_cast(float, __builtin_amdgcn_ds_bpermute(((lane - o) & 63) << 2, __builtin_bit_cast(int, v))); }
#define LDS_WAIT() asm volatile("s_waitcnt lgkmcnt(0)" ::: "memory")

struct Args { const void* in[19]; float* out; unsigned char* ws; int ph_lo, ph_hi; };
typedef const Args __attribute__((address_space(4)))* KArgs;
struct Ctx { KArgs ka; float* out; unsigned char* ws; int tid, lane, wave, G, wg; };

__device__ __forceinline__ void transpose_item(const float* W, int ldw, int k0, int n0, bf16r* dst  , int Kdst, LAS float* scr, int lane) {
#pragma unroll 8
    for (int i = 0; i < 32; ++i) { const int kk = 2 * i + (lane >> 5); scr[kk * 33 + (lane & 31)] = W[(size_t)(k0 + kk) * ldw + n0 + (lane & 31)]; }
    LDS_WAIT(); asm volatile("" ::: "memory");
    const int c = lane & 7;
#pragma unroll
    for (int j = 0; j < 4; ++j) { const int n = (lane >> 3) + 8 * j; const LAS float* s = scr + (8 * c) * 33 + n;
        v4u o; o.x = pk2(s[0 * 33], s[1 * 33]); o.y = pk2(s[2 * 33], s[3 * 33]); o.z = pk2(s[4 * 33], s[5 * 33]); o.w = pk2(s[6 * 33], s[7 * 33]);
        *(v4u*)(dst + (size_t)n * Kdst + k0 + 8 * c) = o; }
    LDS_WAIT(); asm volatile("" ::: "memory");
}
__device__ __forceinline__ void p0_phase(const Ctx& F, LAS unsigned char* lds) {
#if MK_DEBUG
    if (F.wg == 0 && F.tid == 1) *(unsigned*)(F.ws + 64) = 0u;
#endif
    {
        LAS float* red = (LAS float*)lds;
        float* ADA = (float*)(F.ws + WS_ADA);
        const int l32 = F.tid & 31, kg = F.tid >> 5;
        for (int task = F.wg; task < 4 * 72; task += F.G) {
            const int l = task / 72, col0 = (task % 72) * 128;
            f32x4 a0 = {0.f, 0.f, 0.f, 0.f}, a1 = {0.f, 0.f, 0.f, 0.f};
            const float* wp = ((const float*)F.ka->in[3]) + ((size_t)l * 1024 + kg * 64) * 9216 + col0 + l32 * 4;
#pragma unroll 8
            for (int kk = 0; kk < 64; ++kk) {
                const f32x4 w = *(const f32x4*)(wp + (size_t)kk * 9216);
                const float c0 = ((const float*)F.ka->in[1])[kg * 64 + kk], c1 = ((const float*)F.ka->in[1])[1024 + kg * 64 + kk];
                a0 += w * pg8::silu_f(c0); a1 += w * pg8::silu_f(c1);
            }
            *(LAS f32x4*)(red + (kg * 2 + 0) * 128 + l32 * 4) = a0; *(LAS f32x4*)(red + (kg * 2 + 1) * 128 + l32 * 4) = a1;
            __syncthreads();
            if (F.tid < 256) { const int b = F.tid >> 7, col = F.tid & 127; float s = 0.f;
#pragma unroll
                for (int g = 0; g < 16; ++g) s += red[(g * 2 + b) * 128 + col];
                ADA[(size_t)(l * 2 + b) * 9216 + col0 + col] = s + ((const float*)F.ka->in[4])[(size_t)l * 9216 + col0 + col]; }
            __syncthreads();
        }
    }
    for (int i = F.wg * 512 + F.tid; i < 2 * 8 * 1024; i += F.G * 512) { const int jj = i >> 13, g = (i >> 10) & 7, k = i & 1023;
        ((float*)(F.ws + WS_WGT))[i] = ((const float*)F.ka->in[8])[((size_t)jj * 1024 + k) * 3080 + 3072 + g]; }
    {
        LAS float* scr = (LAS float*)(lds + 16384 + F.wave * 8448);
        const int gw = F.wg * NWAVES + F.wave, NGW = F.G * NWAVES;
        constexpr int I13 = 16 * 176, I2 = 44 * 32, IIN = 16 * 96, IOUT = 16 * 32;
        constexpr int T0 = 8 * I13, T1 = T0 + 8 * I2, T2 = T1 + 2 * IIN, T3 = T2 + 2 * IIN, T4 = T3 + 2 * IOUT, T5 = T4 + 2 * IOUT;
        for (int it = gw; it < T5; it += NGW) {
            if (it < T0) { const int mat = it / I13, r = it % I13, kb = r / 176, n0 = (r % 176) * 32;
                const int drow = n0 < 2816 ? (n0 >> 7) * 256 + (n0 & 127) : ((n0 - 2816) >> 7) * 256 + 128 + ((n0 - 2816) & 127);
                transpose_item(((const float*)F.ka->in[6]) + (size_t)mat * 1024 * 5632, 5632, kb * 64, n0, (bf16r*)(F.ws + WS_W13) + ((size_t)mat * 5632 + drow) * 1024, 1024, scr, F.lane); }
            else if (it < T1) { const int q = it - T0, mat = q / I2, r = q % I2, kb = r / 32, n0 = (r % 32) * 32;
                transpose_item(((const float*)F.ka->in[7]) + (size_t)mat * 2816 * 1024, 1024, kb * 64, n0, (bf16r*)(F.ws + WS_W2) + ((size_t)mat * 1024 + n0) * 2816, 2816, scr, F.lane); }
            else if (it < T2) { const int q = it - T1, mat = q / IIN, r = q % IIN, kb = r / 96, n0 = (r % 96) * 32;
                transpose_item(((const float*)F.ka->in[8]) + (size_t)mat * 1024 * 3080, 3080, kb * 64, n0, (bf16r*)(F.ws + WS_WINA) + ((size_t)mat * 3072 + n0) * 1024, 1024, scr, F.lane); }
            else if (it < T3) { const int q = it - T2, mat = q / IIN, r = q % IIN, kb = r / 96, n0 = (r % 96) * 32;
                transpose_item(((const float*)F.ka->in[14]) + (size_t)mat * 1024 * 3072, 3072, kb * 64, n0, (bf16r*)(F.ws + WS_WINB) + ((size_t)mat * 3072 + n0) * 1024, 1024, scr, F.lane); }
            else if (it < T4) { const int q = it - T3, mat = q / IOUT, r = q % IOUT, kb = r / 32, n0 = (r % 32) * 32;
                transpose_item(((const float*)F.ka->in[13]) + (size_t)mat * 1024 * 1024, 1024, kb * 64, n0, (bf16r*)(F.ws + WS_WOA) + ((size_t)mat * 1024 + n0) * 1024, 1024, scr, F.lane); }
            else { const int q = it - T4, mat = q / IOUT, r = q % IOUT, kb = r / 32, n0 = (r % 32) * 32;
                transpose_item(((const float*)F.ka->in[17]) + (size_t)mat * 1024 * 1024, 1024, kb * 64, n0, (bf16r*)(F.ws + WS_WOB) + ((size_t)mat * 1024 + n0) * 1024, 1024, scr, F.lane); }
        }
    }
}
__device__ __forceinline__ void p1_phase(const Ctx& F) {
    const float* ADA = (const float*)(F.ws + WS_ADA);
    float* GS = (float*)(F.ws + WS_GS);
    const int gw = F.wg * NWAVES + F.wave, NGW = F.G * NWAVES;
    for (int i = F.wg * 512 + F.tid; i < 4 * 3 * 2 * 1024; i += F.G * 512) {
        const int d = i & 1023, b = (i >> 10) & 1, ls = i >> 11, l = ls / 3, sub = ls % 3;
        GS[i] = ((const float*)F.ka->in[5])[(size_t)ls * 1024 + d] * (1.0f + ADA[(size_t)(l * 2 + b) * 9216 + sub * 3072 + 1024 + d]);
    }
    if (F.wg == 0 && F.tid < 2) {
        const float* lm = ((const float*)F.ka->in[15]) + F.tid * 512; float s1 = 0.f, s2 = 0.f;
        for (int k = 0; k < 128; ++k) { s1 += lm[k] * lm[128 + k]; s2 += lm[256 + k] * lm[384 + k]; }
        const float lam_init = F.tid == 0 ? 0.35550906759096934f : 0.5560582041556406f;
        ((float*)(F.ws + WS_LAM))[F.tid] = expf(s1) - expf(s2) + lam_init;
    }
    if (gw < 32) { const int jj = gw >> 4, b = (gw >> 3) & 1, g = gw & 7, l = jj * 2; const float* sh = ADA + (size_t)(l * 2 + b) * 9216 + 3072; const float* w = (const float*)(F.ws + WS_WGT) + (size_t)(jj * 8 + g) * 1024;
        float s = 0.f;
#pragma unroll
        for (int q = 0; q < 16; ++q) s += sh[q * 64 + F.lane] * w[q * 64 + F.lane];
        s = wave_sum(s); if (F.lane == 0) ((float*)(F.ws + WS_SWG))[gw] = s; }
    {
        float* ssqp = (float*)(F.ws + WS_SSQP); bf16r* XS = (bf16r*)(F.ws + WS_XS);
        for (int m = gw; m < M; m += NGW) {
            const int b = m >> 13;
            const f32x4* xr = (const f32x4*)(((const float*)F.ka->in[0]) + (size_t)m * 1024) + F.lane;
            v2u* xsr = (v2u*)(XS + (size_t)m * 1024) + F.lane;
            float ss = 0.f;
#pragma unroll
            for (int j = 0; j < 4; ++j) {
                const f32x4 v = xr[64 * j];
                ss += (v[0] * v[0] + v[1] * v[1]) + (v[2] * v[2] + v[3] * v[3]);
                const int col = 4 * F.lane + 256 * j;
                const f32x4 ng = *(const f32x4*)(((const float*)F.ka->in[5]) + col);
                const f32x4 sc = *(const f32x4*)(ADA + (size_t)b * 9216 + 1024 + col);
                const f32x4 y = v * ng * (sc + 1.0f);
                v2u w; w.x = pk2(y[0], y[1]); w.y = pk2(y[2], y[3]); xsr[64 * j] = w;
            }
            ss = wave_sum(ss);
            if (F.lane < 16) ssqp[(size_t)F.lane * M + m] = F.lane == 0 ? ss : 0.f;
        }
    }
    {
        float* SWF = (float*)(F.ws + WS_SWF); float* SWM = (float*)(F.ws + WS_SWM);
        constexpr int RF = 8 * 5632, RT = RF + 4 * 3072;
        for (int r = gw; r < RT; r += NGW) {
            const bf16r* wt; const float* sh; float* o; int ostride;
            if (r < RF) { const int q = r / 5632, n = r % 5632, l = q >> 1, f = q & 1;
                wt = (const bf16r*)(F.ws + WS_W13) + (size_t)r * 1024; sh = ADA + (size_t)l * 2 * 9216 + (f ? 2 : 0) * 3072; o = SWF + (size_t)q * 2 * 5632 + n; ostride = 5632; }
            else { const int rr = r - RF, l = rr / 3072, n = rr % 3072;
                wt = (const bf16r*)(F.ws + ((l & 1) ? WS_WINB : WS_WINA)) + ((size_t)(l >> 1) * 3072 + n) * 1024; sh = ADA + (size_t)l * 2 * 9216 + 3072; o = SWM + (size_t)l * 2 * 3072 + n; ostride = 3072; }
            const v4u w0 = *(const v4u*)(wt + F.lane * 16), w1 = *(const v4u*)(wt + F.lane * 16 + 8);
            float wv[16] = {bflo(w0.x), bfhi(w0.x), bflo(w0.y), bfhi(w0.y), bflo(w0.z), bfhi(w0.z), bflo(w0.w), bfhi(w0.w),
                            bflo(w1.x), bfhi(w1.x), bflo(w1.y), bfhi(w1.y), bflo(w1.z), bfhi(w1.z), bflo(w1.w), bfhi(w1.w)};
            float s0 = 0.f, s1 = 0.f;
#pragma unroll
            for (int j = 0; j < 4; ++j) {
                const f32x4 h0 = *(const f32x4*)(sh + F.lane * 16 + 4 * j), h1 = *(const f32x4*)(sh + 9216 + F.lane * 16 + 4 * j);
#pragma unroll
                for (int e = 0; e < 4; ++e) { s0 += wv[4 * j + e] * h0[e]; s1 += wv[4 * j + e] * h1[e]; }
            }
            s0 = wave_sum(s0); s1 = wave_sum(s1);
            if (F.lane == 0) { o[0] = s0; o[ostride] = s1; }
        }
    }
}
__device__ __forceinline__ void gates_phase(const Ctx& F, LAS unsigned char* lds, int l) {
    const int j = l >> 1;
    const float* ssqp = (const float*)(F.ws + WS_SSQP); const bf16r* XS = (const bf16r*)(F.ws + WS_XS); float* GT = (float*)(F.ws + WS_GATES);
    const float* WGT = (const float*)(F.ws + WS_WGT) + (size_t)j * 8192; const float* SWG = (const float*)(F.ws + WS_SWG) + j * 16;
    for (int ch = F.wg; ch < 256; ch += F.G) {
        const int b = ch >> 7, m0 = ch * 64;
        f32x4 w[8][2][2];
#pragma unroll
        for (int g = 0; g < 8; ++g)
#pragma unroll
            for (int jj = 0; jj < 2; ++jj) { const float* p = WGT + g * 1024 + jj * 512 + F.lane * 8; w[g][jj][0] = *(const f32x4*)p; w[g][jj][1] = *(const f32x4*)(p + 4); }
        const float swg = F.lane < 8 ? SWG[b * 8 + F.lane] : 0.f;
#pragma unroll
        for (int half = 0; half < 2; ++half) {
            v4u xr[4][2]; float ssv[4];
#pragma unroll
            for (int i = 0; i < 4; ++i) { const int row = m0 + F.wave * 8 + half * 4 + i;
                xr[i][0] = *(const v4u*)(XS + (size_t)row * 1024 + F.lane * 8); xr[i][1] = *(const v4u*)(XS + (size_t)row * 1024 + 512 + F.lane * 8);
                ssv[i] = F.lane < 16 ? ssqp[(size_t)F.lane * M + row] : 0.f; }
#pragma unroll
            for (int i = 0; i < 4; ++i) { const int row = m0 + F.wave * 8 + half * 4 + i;
                const float rs = rsqrtf(wave_sum(ssv[i]) * (1.0f / 1024.0f) + EPS);
                float mine = 0.f;
#pragma unroll
                for (int g = 0; g < 8; ++g) { float a = 0.f;
#pragma unroll
                    for (int jj = 0; jj < 2; ++jj) { const v4u x = xr[i][jj]; const f32x4 w0 = w[g][jj][0], w1 = w[g][jj][1];
                        a += bflo(x.x) * w0[0] + bfhi(x.x) * w0[1] + bflo(x.y) * w0[2] + bfhi(x.y) * w0[3] + bflo(x.z) * w1[0] + bfhi(x.z) * w1[1] + bflo(x.w) * w1[2] + bfhi(x.w) * w1[3]; }
                    a = wave_sum(a); if (F.lane == g) mine = a; }
                if (F.lane < 8) GT[(size_t)row * 8 + F.lane] = mine * rs + swg; }
        }
    }
}
__device__ __forceinline__ bf16x8 ldfrag(const LAS bf16r* base, int row0, int stride, int k0, int lane) {
    return *(const LAS bf16x8*)(base + (row0 + (lane & 15)) * stride + k0 + (lane >> 4) * 8);
}
__device__ __forceinline__ void conv8(const bf16r* P, size_t mrow, int ps, int ch0, const float* cw, const float* cb, float scale, float (&o)[8]) {
    float acc[8];
    { const f32x4 b0 = *(const f32x4*)(cb + ch0), b1 = *(const f32x4*)(cb + ch0 + 4); acc[0] = b0[0]; acc[1] = b0[1]; acc[2] = b0[2]; acc[3] = b0[3]; acc[4] = b1[0]; acc[5] = b1[1]; acc[6] = b1[2]; acc[7] = b1[3]; }
#pragma unroll
    for (int jt = 0; jt < 4; ++jt) {
        if (ps - 3 + jt >= 0) {
            const v4u w = *(const v4u*)(P + (mrow - 3 + jt) * 3072 + ch0);
            const f32x4 c0 = *(const f32x4*)(cw + jt * 1024 + ch0), c1 = *(const f32x4*)(cw + jt * 1024 + ch0 + 4);
            acc[0] += bflo(w.x) * c0[0]; acc[1] += bfhi(w.x) * c0[1]; acc[2] += bflo(w.y) * c0[2]; acc[3] += bfhi(w.y) * c0[3];
            acc[4] += bflo(w.z) * c1[0]; acc[5] += bfhi(w.z) * c1[1]; acc[6] += bflo(w.w) * c1[2]; acc[7] += bfhi(w.w) * c1[3];
        }
    }
#pragma unroll
    for (int e = 0; e < 8; ++e) o[e] = pg8::silu_f(acc[e]) * scale;
}
__device__ __forceinline__ void conv_load(const bf16r* P, size_t mrow, int ps, int ch0, v4u (&raw)[4]) {
#pragma unroll
    for (int jt = 0; jt < 4; ++jt) raw[jt] = (ps - 3 + jt >= 0) ? *(const v4u*)(P + (mrow - 3 + jt) * 3072 + ch0) : (v4u){0u, 0u, 0u, 0u};
}
__device__ __forceinline__ void conv_apply(const v4u (&raw)[4], const f32x4 (&cwv)[4][2], const f32x4 (&cbv)[2], float scale, float (&o)[8]) {
    float acc[8] = {cbv[0][0], cbv[0][1], cbv[0][2], cbv[0][3], cbv[1][0], cbv[1][1], cbv[1][2], cbv[1][3]};
#pragma unroll
    for (int jt = 0; jt < 4; ++jt) { const v4u w = raw[jt]; const f32x4 c0 = cwv[jt][0], c1 = cwv[jt][1];
        acc[0] += bflo(w.x) * c0[0]; acc[1] += bfhi(w.x) * c0[1]; acc[2] += bflo(w.y) * c0[2]; acc[3] += bfhi(w.y) * c0[3];
        acc[4] += bflo(w.z) * c1[0]; acc[5] += bfhi(w.z) * c1[1]; acc[6] += bflo(w.w) * c1[2]; acc[7] += bfhi(w.w) * c1[3]; }
#pragma unroll
    for (int e = 0; e < 8; ++e) o[e] = pg8::silu_f(acc[e]) * scale;
}
__device__ __forceinline__ void conv_weights(const float* cw, const float* cb, int ch0, f32x4 (&cwv)[4][2], f32x4 (&cbv)[2]) {
#pragma unroll
    for (int jt = 0; jt < 4; ++jt) { cwv[jt][0] = *(const f32x4*)(cw + jt * 1024 + ch0); cwv[jt][1] = *(const f32x4*)(cw + jt * 1024 + ch0 + 4); }
    cbv[0] = *(const f32x4*)(cb + ch0); cbv[1] = *(const f32x4*)(cb + ch0 + 4);
}
__device__ __forceinline__ int vt_idx(int r, int s) { return r * 72 + ((((s >> 3) ^ (r >> 3)) & 7) << 3) + (s & 7); }
__device__ __forceinline__ void vt_scatter(LAS bf16r* T, int r0  , int s, const v4u w) {
    LAS bf16r* d = T + vt_idx(r0, s);
    d[0] = (bf16r)(w.x & 0xffffu); d[72] = (bf16r)(w.x >> 16); d[2 * 72] = (bf16r)(w.y & 0xffffu); d[3 * 72] = (bf16r)(w.y >> 16);
    d[4 * 72] = (bf16r)(w.z & 0xffffu); d[5 * 72] = (bf16r)(w.z >> 16); d[6 * 72] = (bf16r)(w.w & 0xffffu); d[7 * 72] = (bf16r)(w.w >> 16);
}
__device__ __forceinline__ bf16x8 ldfrag_sw(const LAS bf16r* base, int row0, int k0, int lane) {
    const int r = row0 + (lane & 15);
    return *(const LAS bf16x8*)(base + r * 72 + (((((k0 >> 3) + (lane >> 4)) ^ (r >> 3)) & 7) << 3));
}
constexpr int VT_STRIDE = 72, QK_STRIDE = 136;
__device__ __forceinline__ void s1_phase(const Ctx& F, LAS unsigned char* lds, int l) {
    const int j = l >> 1;
    LAS bf16r* VT = (LAS bf16r*)lds;
    LAS bf16r* KT = (LAS bf16r*)(lds + 36864);
    LAS float* wS = (LAS float*)(lds + 36864 + 18432);
    const bf16r* P = (const bf16r*)(F.ws + WS_P); const float* GT = (const float*)(F.ws + WS_GATES);
    float* BCUM = (float*)(F.ws + WS_BCUM); float* LOGI = (float*)(F.ws + WS_LOGI); float* BLAST = (float*)(F.ws + WS_SCAL); float* MLOC = BLAST + 16384;
    float* NLOC = (float*)(F.ws + WS_NLOC); bf16r* U = (bf16r*)(F.ws + WS_U);
    const float* cw = ((const float*)F.ka->in[9]) + (size_t)j * 4096; const float* cb = ((const float*)F.ka->in[10]) + (size_t)j * 1024; const float* bif = ((const float*)F.ka->in[11]) + j * 8;
    for (int u = F.wg; u < 1024; u += F.G) {
        const int b = u >> 9, h = (u >> 7) & 3, c = u & 127, bh = b * 4 + h;
        const size_t m0 = (size_t)b * 8192 + c * 64;
        if (F.wave == 0) {
            const int s = F.lane;
            const float gi = GT[(m0 + s) * 8 + h] + bif[h], gf = GT[(m0 + s) * 8 + 4 + h] + bif[4 + h];
            const float lf = fminf(gf, 0.f) - log1pf(expf(-fabsf(gf)));
            float bc = lf;
#pragma unroll
            for (int o = 1; o < 64; o <<= 1) { const float t = lane_up(bc, s, o); if (s >= o) bc += t; }
            const float blast = __builtin_bit_cast(float, __builtin_amdgcn_readlane(__builtin_bit_cast(int, bc), 63));
            const float wl = blast - bc + gi;
            const float mloc = wave_max(wl);
            wS[s] = __expf(wl - mloc);
            BCUM[(size_t)bh * 8192 + c * 64 + s] = bc; LOGI[(size_t)bh * 8192 + c * 64 + s] = gi;
            if (s == 0) { BLAST[bh * 128 + c] = blast; MLOC[bh * 128 + c] = mloc; }
        }
        __syncthreads();
        {
            const int cg = F.tid & 15, s0 = F.tid >> 4, vg = F.tid & 31, sv0 = F.tid >> 5, kch = 512 + h * 128 + cg * 8;
            v4u rk[2][4], rv[4];
#pragma unroll
            for (int i = 0; i < 2; ++i) conv_load(P, m0 + s0 + 32 * i, c * 64 + s0 + 32 * i, kch, rk[i]);
#pragma unroll
            for (int i = 0; i < 4; ++i) rv[i] = *(const v4u*)(P + (m0 + sv0 + 16 * i) * 3072 + 1024 + h * 256 + vg * 8);
            f32x4 cwv[4][2], cbv[2]; conv_weights(cw, cb, kch, cwv, cbv);
#pragma unroll
            for (int i = 0; i < 2; ++i) { const int s = s0 + 32 * i; float kv[8]; conv_apply(rk[i], cwv, cbv, 0.08838834764831845f, kv);
                const float w = wS[s];
#pragma unroll
                for (int e2 = 0; e2 < 8; ++e2) KT[vt_idx(cg * 8, s) + e2 * 72] = (bf16r)f2bf(kv[e2] * w); }
#pragma unroll
            for (int i = 0; i < 4; ++i) vt_scatter(VT, vg * 8, sv0 + 16 * i, rv[i]);
        }
        __syncthreads();
        { const int d = F.tid >> 2, q4 = F.tid & 3; float s = 0.f;
#pragma unroll
          for (int e = 0; e < 16; ++e) s += bf2f(KT[vt_idx(d, q4 * 16 + e)]);
          s += swz_xor<1>(s); s += swz_xor<2>(s);
          if (q4 == 0) NLOC[(size_t)u * 128 + d] = s; }
        {
            f32x4 acc[2][8];
#pragma unroll
            for (int mt = 0; mt < 2; ++mt)
#pragma unroll
                for (int nt = 0; nt < 8; ++nt) acc[mt][nt] = (f32x4){0.f, 0.f, 0.f, 0.f};
#pragma unroll
            for (int ks = 0; ks < 2; ++ks) {
                bf16x8 av[2];
#pragma unroll
                for (int mt = 0; mt < 2; ++mt) av[mt] = ldfrag_sw(VT, 32 * F.wave + 16 * mt, ks * 32, F.lane);
#pragma unroll
                for (int nt = 0; nt < 8; ++nt) { const bf16x8 bk = ldfrag_sw(KT, 16 * nt, ks * 32, F.lane);
#pragma unroll
                    for (int mt = 0; mt < 2; ++mt) acc[mt][nt] = __builtin_amdgcn_mfma_f32_16x16x32_bf16(bk, av[mt], acc[mt][nt], 0, 0, 0); }
            }
            bf16r* up = U + (size_t)u * 32768;
#pragma unroll
            for (int mt = 0; mt < 2; ++mt)
#pragma unroll
                for (int nt = 0; nt < 8; ++nt) { v2u w; w.x = pk2(acc[mt][nt][0], acc[mt][nt][1]); w.y = pk2(acc[mt][nt][2], acc[mt][nt][3]);
                    *(v2u*)(up + (size_t)(32 * F.wave + 16 * mt + (F.lane & 15)) * 128 + 16 * nt + 4 * (F.lane >> 4)) = w; }
        }
        __syncthreads();
    }
}
__device__ __forceinline__ void s2_phase(const Ctx& F, LAS unsigned char* lds) {
    const float* BLAST = (const float*)(F.ws + WS_SCAL); const float* MLOC = BLAST + 16384; float* MST = (float*)(F.ws + WS_SCAL) + 32768;
    const bf16r* U = (const bf16r*)(F.ws + WS_U); const float* NLOC = (const float*)(F.ws + WS_NLOC); float* NST = (float*)(F.ws + WS_NST); bf16r* CST = (bf16r*)(F.ws + WS_CST);
    LAS float* decS = (LAS float*)lds; LAS float* gainS = decS + 128;
    for (int w = F.wg; w < 256; w += F.G) {
        const int bh = w >> 5, slice = w & 31;
        if (F.tid == 0) { float m = 0.f;
            for (int c = 0; c < 128; ++c) { const int unit = bh * 128 + c; const float bl = BLAST[unit], ml = MLOC[unit], mn = fmaxf(bl + m, ml);
                decS[c] = expf(bl + m - mn); gainS[c] = expf(ml - mn); if (slice == 0) MST[unit] = m; m = mn; } }
        __syncthreads();
        const size_t e2 = (size_t)slice * 1024 + F.tid * 2;
        float s0 = 0.f, s1 = 0.f;
        for (int c0 = 0; c0 < 128; c0 += 16) {
            unsigned uv[16];
#pragma unroll
            for (int i = 0; i < 16; ++i) uv[i] = *(const unsigned*)(U + (size_t)(bh * 128 + c0 + i) * 32768 + e2);
#pragma unroll
            for (int i = 0; i < 16; ++i) { const int c = c0 + i;
                *(unsigned*)(CST + (size_t)(bh * 128 + c) * 32768 + e2) = pk2(s0, s1);
                const float dec = decS[c], gain = gainS[c];
                s0 = s0 * dec + bflo(uv[i]) * gain; s1 = s1 * dec + bfhi(uv[i]) * gain; }
        }
        if (slice == 0 && F.tid < 128) { float s = 0.f;
            for (int c0 = 0; c0 < 128; c0 += 16) { float nv[16];
#pragma unroll
                for (int i = 0; i < 16; ++i) nv[i] = NLOC[(size_t)(bh * 128 + c0 + i) * 128 + F.tid];
#pragma unroll
                for (int i = 0; i < 16; ++i) { const int c = c0 + i; NST[(size_t)(bh * 128 + c) * 128 + F.tid] = s; s = s * decS[c] + nv[i] * gainS[c]; } } }
        __syncthreads();
    }
}
__device__ __forceinline__ void s3_phase(const Ctx& F, LAS unsigned char* lds, int l) {
    const int j = l >> 1;
    LAS bf16r* VT = (LAS bf16r*)lds;
    LAS bf16r* Qs = (LAS bf16r*)(lds + 36864);
    LAS bf16r* Ks = (LAS bf16r*)(lds + 36864 + 17408);
    LAS bf16r* Sw = (LAS bf16r*)(lds + 36864 + 34816);
    LAS float* fa = (LAS float*)(lds + 36864 + 34816 + 9216);
    LAS float* bS = fa, *zS = fa + 64, *mtS = fa + 128, *inS = fa + 192, *dnS = fa + 256, *nS = fa + 320  , *sqS = fa + 448  ;
    const bf16r* P = (const bf16r*)(F.ws + WS_P);
    const float* BCUM = (const float*)(F.ws + WS_BCUM); const float* LOGI = (const float*)(F.ws + WS_LOGI); const float* MST = (const float*)(F.ws + WS_SCAL) + 32768;
    const float* NST = (const float*)(F.ws + WS_NST); const bf16r* CST = (const bf16r*)(F.ws + WS_CST); bf16r* Y = (bf16r*)(F.ws + WS_Y);
    const float* cw = ((const float*)F.ka->in[9]) + (size_t)j * 4096; const float* cb = ((const float*)F.ka->in[10]) + (size_t)j * 1024; const float* ng = ((const float*)F.ka->in[12]) + (size_t)j * 1024;
    const int lane = F.lane, w = F.wave, fr = lane & 15, fq = lane >> 4;
    for (int u = F.wg; u < 1024; u += F.G) {
        const int b = u >> 9, h = (u >> 7) & 3, c = u & 127, bh = b * 4 + h;
        const size_t m0 = (size_t)b * 8192 + c * 64;
        bf16x8 cf[2][4];
#pragma unroll
        for (int nt = 0; nt < 2; ++nt)
#pragma unroll
            for (int ks = 0; ks < 4; ++ks) cf[nt][ks] = *(const bf16x8*)(CST + (size_t)u * 32768 + (size_t)(32 * w + 16 * nt + fr) * 128 + ks * 32 + fq * 8);
        if (w == 0) {
            const int s = lane;
            const float bs = BCUM[(size_t)bh * 8192 + c * 64 + s], li = LOGI[(size_t)bh * 8192 + c * 64 + s], mc = MST[bh * 128 + c];
            const float a = bs + mc, z = li - bs;
            float pm = z;
#pragma unroll
            for (int o = 1; o < 64; o <<= 1) { const float t = lane_up(pm, s, o); if (s >= o) pm = fmaxf(pm, t); }
            const float mt = fmaxf(a, bs + pm);
            bS[s] = bs; zS[s] = z; mtS[s] = mt; inS[s] = __expf(a - mt);
        } else if (w <= 2) { const int d = (w - 1) * 64 + lane; nS[d] = NST[(size_t)u * 128 + d]; }
        {
            const int cg = F.tid & 15, s0 = F.tid >> 4, vg = F.tid & 31, sv0 = F.tid >> 5, qch = h * 128 + cg * 8, kch = 512 + qch;
            v4u rq[2][4], rk[2][4], rv[4];
#pragma unroll
            for (int i = 0; i < 2; ++i) { conv_load(P, m0 + s0 + 32 * i, c * 64 + s0 + 32 * i, qch, rq[i]); conv_load(P, m0 + s0 + 32 * i, c * 64 + s0 + 32 * i, kch, rk[i]); }
#pragma unroll
            for (int i = 0; i < 4; ++i) rv[i] = *(const v4u*)(P + (m0 + sv0 + 16 * i) * 3072 + 1024 + h * 256 + vg * 8);
            { f32x4 cwv[4][2], cbv[2]; conv_weights(cw, cb, qch, cwv, cbv);
#pragma unroll
              for (int i = 0; i < 2; ++i) { float kv[8]; conv_apply(rq[i], cwv, cbv, 1.0f, kv);
                  v4u o; o.x = pk2(kv[0], kv[1]); o.y = pk2(kv[2], kv[3]); o.z = pk2(kv[4], kv[5]); o.w = pk2(kv[6], kv[7]); *(LAS v4u*)(Qs + (s0 + 32 * i) * QK_STRIDE + cg * 8) = o; } }
            { f32x4 cwv[4][2], cbv[2]; conv_weights(cw, cb, kch, cwv, cbv);
#pragma unroll
              for (int i = 0; i < 2; ++i) { float kv[8]; conv_apply(rk[i], cwv, cbv, 0.08838834764831845f, kv);
                  v4u o; o.x = pk2(kv[0], kv[1]); o.y = pk2(kv[2], kv[3]); o.z = pk2(kv[4], kv[5]); o.w = pk2(kv[6], kv[7]); *(LAS v4u*)(Ks + (s0 + 32 * i) * QK_STRIDE + cg * 8) = o; } }
#pragma unroll
            for (int i = 0; i < 4; ++i) vt_scatter(VT, vg * 8, sv0 + 16 * i, rv[i]);
        }
#if S3_REP > 1
        __syncthreads();
        {
            const int cg = F.tid & 15, s0 = F.tid >> 4, vg = F.tid & 31, sv0 = F.tid >> 5, qch = h * 128 + cg * 8, kch = 512 + qch;
            v4u rq[2][4], rk[2][4], rv[4];
#pragma unroll
            for (int i = 0; i < 2; ++i) { conv_load(P, m0 + s0 + 32 * i, c * 64 + s0 + 32 * i, qch, rq[i]); conv_load(P, m0 + s0 + 32 * i, c * 64 + s0 + 32 * i, kch, rk[i]); }
#pragma unroll
            for (int i = 0; i < 4; ++i) rv[i] = *(const v4u*)(P + (m0 + sv0 + 16 * i) * 3072 + 1024 + h * 256 + vg * 8);
            { f32x4 cwv[4][2], cbv[2]; conv_weights(cw, cb, qch, cwv, cbv);
#pragma unroll
              for (int i = 0; i < 2; ++i) { float kv[8]; conv_apply(rq[i], cwv, cbv, 1.0f, kv);
                  v4u o; o.x = pk2(kv[0], kv[1]); o.y = pk2(kv[2], kv[3]); o.z = pk2(kv[4], kv[5]); o.w = pk2(kv[6], kv[7]); *(LAS v4u*)(Qs + (s0 + 32 * i) * QK_STRIDE + cg * 8) = o; } }
            { f32x4 cwv[4][2], cbv[2]; conv_weights(cw, cb, kch, cwv, cbv);
#pragma unroll
              for (int i = 0; i < 2; ++i) { float kv[8]; conv_apply(rk[i], cwv, cbv, 0.08838834764831845f, kv);
                  v4u o; o.x = pk2(kv[0], kv[1]); o.y = pk2(kv[2], kv[3]); o.z = pk2(kv[4], kv[5]); o.w = pk2(kv[6], kv[7]); *(LAS v4u*)(Ks + (s0 + 32 * i) * QK_STRIDE + cg * 8) = o; } }
#pragma unroll
            for (int i = 0; i < 4; ++i) vt_scatter(VT, vg * 8, sv0 + 16 * i, rv[i]);
        }
#endif
        __syncthreads();
        {
            const int tt = w >> 1;
            const int t = 16 * tt + fr; const float bt = bS[t], mt = mtS[t];
#pragma unroll
            for (int i = 0; i < 2; ++i) {
                const int st = 2 * (w & 1) + i;
                f32x4 acc = {0.f, 0.f, 0.f, 0.f};
                if (st <= tt) {
#pragma unroll
                    for (int ks = 0; ks < 4; ++ks) acc = __builtin_amdgcn_mfma_f32_16x16x32_bf16(ldfrag(Ks, 16 * st, QK_STRIDE, ks * 32, lane), ldfrag(Qs, 16 * tt, QK_STRIDE, ks * 32, lane), acc, 0, 0, 0);
                }
                float o[4];
#pragma unroll
                for (int e = 0; e < 4; ++e) { const int s = 16 * st + 4 * fq + e; o[e] = (s <= t) ? acc[e] * __expf(bt + zS[s] - mt) : 0.f; }
                v2u pw; pw.x = pk2(o[0], o[1]); pw.y = pk2(o[2], o[3]);
                *(LAS v2u*)(Sw + t * VT_STRIDE + 16 * st + 4 * fq) = pw;
            }
        }
        __syncthreads();
        { const int t = F.tid >> 3, part = F.tid & 7; float rsum = 0.f, qn = 0.f;
#pragma unroll
          for (int e = 0; e < 8; ++e) rsum += bf2f(Sw[t * VT_STRIDE + part * 8 + e]);
#pragma unroll
          for (int e = 0; e < 16; ++e) qn += bf2f(Qs[t * QK_STRIDE + part * 16 + e]) * nS[part * 16 + e];
          rsum += swz_xor<1>(rsum); rsum += swz_xor<2>(rsum); rsum += swz_xor<4>(rsum);
          qn += swz_xor<1>(qn); qn += swz_xor<2>(qn); qn += swz_xor<4>(qn);
          if (part == 0) { const float den = inS[t] * qn + rsum; dnS[t] = __builtin_amdgcn_rcpf(fmaxf(fabsf(den), __expf(-mtS[t]))); } }
        f32x4 a1[4][2], a2[4][2];
#pragma unroll
        for (int mt = 0; mt < 4; ++mt)
#pragma unroll
            for (int nt = 0; nt < 2; ++nt) { a1[mt][nt] = (f32x4){0.f, 0.f, 0.f, 0.f}; a2[mt][nt] = (f32x4){0.f, 0.f, 0.f, 0.f}; }
#pragma unroll
        for (int ks = 0; ks < 4; ++ks)
#pragma unroll
            for (int mt = 0; mt < 4; ++mt) { const bf16x8 qf = ldfrag(Qs, 16 * mt, QK_STRIDE, ks * 32, lane);
#pragma unroll
                for (int nt = 0; nt < 2; ++nt) a1[mt][nt] = __builtin_amdgcn_mfma_f32_16x16x32_bf16(cf[nt][ks], qf, a1[mt][nt], 0, 0, 0); }
#pragma unroll
        for (int ks = 0; ks < 2; ++ks) {
            bf16x8 vf[2];
#pragma unroll
            for (int nt = 0; nt < 2; ++nt) vf[nt] = ldfrag_sw(VT, 32 * w + 16 * nt, ks * 32, lane);
#pragma unroll
            for (int mt = 0; mt < 4; ++mt) { const bf16x8 sf = ldfrag(Sw, 16 * mt, VT_STRIDE, ks * 32, lane);
#pragma unroll
                for (int nt = 0; nt < 2; ++nt) a2[mt][nt] = __builtin_amdgcn_mfma_f32_16x16x32_bf16(vf[nt], sf, a2[mt][nt], 0, 0, 0); }
        }
        v2u owv[4][2]; f32x4 gv[2];
#pragma unroll
        for (int mt = 0; mt < 4; ++mt)
#pragma unroll
            for (int nt = 0; nt < 2; ++nt) owv[mt][nt] = *(const v2u*)(P + (m0 + 16 * mt + fr) * 3072 + 2048 + h * 256 + 32 * w + 16 * nt + 4 * fq);
#pragma unroll
        for (int nt = 0; nt < 2; ++nt) gv[nt] = *(const f32x4*)(ng + h * 256 + 32 * w + 16 * nt + 4 * fq);
        __syncthreads();
#pragma unroll
        for (int mt = 0; mt < 4; ++mt) {
            const int t = 16 * mt + fr; const float it = inS[t], dn = dnS[t]; float ss = 0.f;
#pragma unroll
            for (int nt = 0; nt < 2; ++nt) { a1[mt][nt] = (a1[mt][nt] * it + a2[mt][nt]) * dn;
                ss += (a1[mt][nt][0] * a1[mt][nt][0] + a1[mt][nt][1] * a1[mt][nt][1]) + (a1[mt][nt][2] * a1[mt][nt][2] + a1[mt][nt][3] * a1[mt][nt][3]); }
            ss += swz_xor<16>(ss); ss = sum_x32(ss);
            if (fq == 0) sqS[w * 64 + t] = ss;
        }
        __syncthreads();
#pragma unroll
        for (int mt = 0; mt < 4; ++mt) {
            const int t = 16 * mt + fr; float tot = 0.f;
#pragma unroll
            for (int ww = 0; ww < 8; ++ww) tot += sqS[ww * 64 + t];
            const float r = rsqrtf(tot * (1.0f / 256.0f) + EPS);
#pragma unroll
            for (int nt = 0; nt < 2; ++nt) {
                const int vv = 32 * w + 16 * nt + 4 * fq;
                const v2u ow = owv[mt][nt];
                const f32x4 g = gv[nt];
                const float o0 = bflo(ow.x), o1 = bfhi(ow.x), o2 = bflo(ow.y), o3 = bfhi(ow.y);
                const f32x4 hv = a1[mt][nt] * r * g;
                v2u yw; yw.x = pk2(hv[0] * __builtin_amdgcn_rcpf(1.0f + __expf(-o0)), hv[1] * __builtin_amdgcn_rcpf(1.0f + __expf(-o1)));
                yw.y = pk2(hv[2] * __builtin_amdgcn_rcpf(1.0f + __expf(-o2)), hv[3] * __builtin_amdgcn_rcpf(1.0f + __expf(-o3)));
                *(v2u*)(Y + (m0 + t) * 1024 + h * 256 + vv) = yw;
            }
        }
        __syncthreads();
    }
}
__device__ __forceinline__ att::BlockRef<att::bf16, att::bf16> attn_ref(int item, int grp, int pass, const att::bf16* Qb, const att::bf16* Kb, const att::bf16* Vb, att::bf16* Ob) {
    const int pc = item & 3, y = item >> 2, qb = pass ? 31 - y : y;
    const int b = grp >> 2, h = grp & 3, c = pc >> 1, vh = pc & 1, hd = ((b * 4 + h) * 2 + c) * 2 + vh;
    att::BlockRef<att::bf16, att::bf16> r;
    r.Q = Qb + ((size_t)(b * 8 + h * 2 + c) * 8192 + (size_t)qb * 256) * 128;
    r.K = Kb + (size_t)(b * 8 + h * 2 + c) * 8192 * 128;
    r.V = Vb + (size_t)(b * 8 + h * 2 + vh) * 8192 * 128;
    r.O = Ob + ((size_t)hd * 8192 + (size_t)qb * 256) * 128;
    r.P0 = qb * 256;
    return r;
}
__device__ __forceinline__ void attn_phase(const Ctx& F, char* lds) {
    const att::bf16* Qb = (const att::bf16*)(F.ws + WS_P); const att::bf16* Kb = Qb + 16777216; const att::bf16* Vb = Kb + 16777216; att::bf16* Ob = (att::bf16*)(F.ws + WS_O);
    constexpr int total = 512; const int stride = F.G;
    int L = F.wg; if (L >= total) return;
    int pass = 0;
#define ATT_ITEM(L_) (((L_) >> 3) & 63)
#define ATT_GRP(L_) ((L_) & 7)
    att::BlockRef<att::bf16, att::bf16> cur = attn_ref(ATT_ITEM(L), ATT_GRP(L), 0, Qb, Kb, Vb, Ob);
    att::Seam<att::bf16> S;
    att::causal_swa_prime<att::bf16, att::bf16>(cur, 8192, lds, S, F.tid);
    for (;;) {
        const bool more_pass = pass == 0, more_item = L + stride < total, last = !more_pass && !more_item;
        int passn = pass + 1, Ln = L;
        if (!more_pass) { passn = 0; Ln = more_item ? L + stride : L; }
        const att::BlockRef<att::bf16, att::bf16> nxt = last ? cur : attn_ref(ATT_ITEM(Ln), ATT_GRP(Ln), passn, Qb, Kb, Vb, Ob);
        att::causal_swa_block<att::bf16, att::bf16>(cur, nxt, 8192, 8192, lds, S, F.tid);
        if (last) break;
        cur = nxt; pass = passn; L = Ln;
    }
#undef ATT_ITEM
#undef ATT_GRP
}
__device__ __forceinline__ void combine_phase(const Ctx& F, int l) {
    const int j = l >> 1;
    const bf16r* Ob = (const bf16r*)(F.ws + WS_O); bf16r* Y = (bf16r*)(F.ws + WS_Y);
    const float lam = ((const float*)(F.ws + WS_LAM))[j];
    const float omi = 1.0f - (j == 0 ? 0.35550906759096934f : 0.5560582041556406f);
    const float* ng = ((const float*)F.ka->in[16]) + j * 256;
    const int gw = F.wg * NWAVES + F.wave, NGW = F.G * NWAVES;
    const int vv = F.lane * 4, vh = vv >> 7, dd = vv & 127;
    const f32x4 g = *(const f32x4*)(ng + vv);
    for (int task = gw; task < M * 4; task += NGW) {
        const int m = task >> 2, h = task & 3, b = m >> 13, s = m & 8191;
        const int hd0 = ((b * 4 + h) * 2 + 0) * 2 + vh, hd1 = hd0 + 2;
        const v2u w0 = *(const v2u*)(Ob + ((size_t)hd0 * 8192 + s) * 128 + dd), w1 = *(const v2u*)(Ob + ((size_t)hd1 * 8192 + s) * 128 + dd);
        f32x4 o = {bflo(w0.x) - lam * bflo(w1.x), bfhi(w0.x) - lam * bfhi(w1.x), bflo(w0.y) - lam * bflo(w1.y), bfhi(w0.y) - lam * bfhi(w1.y)};
        const float ss = wave_sum((o[0] * o[0] + o[1] * o[1]) + (o[2] * o[2] + o[3] * o[3]));
        const float r = rsqrtf(ss * (1.0f / 256.0f) + EPS) * omi;
        o = o * r * g;
        v2u yw; yw.x = pk2(o[0], o[1]); yw.y = pk2(o[2], o[3]);
        *(v2u*)(Y + (size_t)m * 1024 + h * 256 + vv) = yw;
    }
}
__device__ __forceinline__ void final_phase(const Ctx& F) {
    const float* ssqp = (const float*)(F.ws + WS_SSQP);
    const int gw = F.wg * NWAVES + F.wave, NGW = F.G * NWAVES;
    for (int m = gw; m < M; m += NGW) {
        float ss = F.lane < 16 ? ssqp[(size_t)F.lane * M + m] : 0.f; ss = wave_sum(ss);
        const float rs = rsqrtf(ss * (1.0f / 1024.0f) + EPS);
        f32x4* orow = (f32x4*)(F.out + (size_t)m * 1024) + F.lane;
#pragma unroll
        for (int jj = 0; jj < 4; ++jj) { const f32x4 g = *(const f32x4*)(((const float*)F.ka->in[18]) + 4 * F.lane + 256 * jj); orow[64 * jj] = orow[64 * jj] * rs * g; }
    }
}

#if MK_DEBUG
#ifndef DBG_SET
#define DBG_SET 0
#endif
__device__ __forceinline__ void dbg_flag(const Ctx& F, bool bad, unsigned code) {
    int bit = -1;
    switch (code) { case 30: bit = 0; break; case 8: case 31: case 9: bit = 1; break; case 10: bit = 2; break; case 11: bit = 3; break; case 13: case 14: case 15: bit = 4; break;
                    case 16: case 17: bit = 5; break; case 18: bit = 6; break; case 19: bit = 7; break; case 20: bit = 8; break; case 21: bit = 9; break; case 23: bit = 10; break; default: break; }
    if (bad && bit >= 0) atomicOr((unsigned*)(F.ws + 64), 1u << bit);
}
__device__ __forceinline__ bool dbg_ne(float got, float ref) { return !(fabsf(got - ref) <= 0.03f * fabsf(ref) + 0.03f); }
__device__ __forceinline__ unsigned dbg_hash(unsigned i) { i = i * 2654435761u + 12345u; i ^= i >> 15; i *= 2246822519u; i ^= i >> 13; i *= 3266489917u; i ^= i >> 16; return i; }
__device__ __forceinline__ float dbg_rstd(const Ctx& F, int m) { const float* ssqp = (const float*)(F.ws + WS_SSQP); float s = 0.f; for (int p = 0; p < 16; ++p) s += ssqp[(size_t)p * M + m]; return rsqrtf(s * (1.0f / 1024.0f) + EPS); }
__device__ __forceinline__ float dbg_silu(float g) { return g / (1.0f + expf(-g)); }
__device__ __forceinline__ void dbg_check_p0(const Ctx& F) {
    if (F.wg != 0) return;
    const unsigned r = dbg_hash(F.tid);
    const float* ADA = (const float*)(F.ws + WS_ADA);
    { const float t = wave_sum((float)(F.lane + 1)), t2 = wave_max((float)((F.lane * 37) & 63)); dbg_flag(F, t != 2080.0f || t2 != 63.0f, 30); }
    { const int l = r % 4, b = (r >> 2) & 1, j = (r >> 3) % 9216; float ref = ((const float*)F.ka->in[4])[(size_t)l * 9216 + j];
      for (int k = 0; k < 1024; ++k) ref += dbg_silu(((const float*)F.ka->in[1])[b * 1024 + k]) * ((const float*)F.ka->in[3])[((size_t)l * 1024 + k) * 9216 + j];
      dbg_flag(F, dbg_ne(ADA[(size_t)(l * 2 + b) * 9216 + j], ref), 1); }
    { const int mat = r % 8, k = (r >> 3) % 1024, n = (r >> 13) % 5632; const float src = ((const float*)F.ka->in[6])[((size_t)mat * 1024 + k) * 5632 + n];
      const int drow = n < 2816 ? (n >> 7) * 256 + (n & 127) : ((n - 2816) >> 7) * 256 + 128 + ((n - 2816) & 127);
      dbg_flag(F, dbg_ne(bf2f(((const bf16r*)(F.ws + WS_W13))[((size_t)mat * 5632 + drow) * 1024 + k]), src), 2); }
    { const int mat = r % 8, k = (r >> 3) % 2816, n = (r >> 15) % 1024; const float src = ((const float*)F.ka->in[7])[((size_t)mat * 2816 + k) * 1024 + n];
      dbg_flag(F, dbg_ne(bf2f(((const bf16r*)(F.ws + WS_W2))[((size_t)mat * 1024 + n) * 2816 + k]), src), 3); }
    { const int mat = r % 2, k = (r >> 1) % 1024, n = (r >> 11) % 3072; const float src = ((const float*)F.ka->in[8])[((size_t)mat * 1024 + k) * 3080 + n];
      dbg_flag(F, dbg_ne(bf2f(((const bf16r*)(F.ws + WS_WINA))[((size_t)mat * 3072 + n) * 1024 + k]), src), 4); }
    { const int mat = r % 2, k = (r >> 1) % 1024, n = (r >> 11) % 3072; const float src = ((const float*)F.ka->in[14])[((size_t)mat * 1024 + k) * 3072 + n];
      dbg_flag(F, dbg_ne(bf2f(((const bf16r*)(F.ws + WS_WINB))[((size_t)mat * 3072 + n) * 1024 + k]), src), 5); }
    { const int mat = r % 2, k = (r >> 1) % 1024, n = (r >> 11) % 1024; const float sa = ((const float*)F.ka->in[13])[((size_t)mat * 1024 + k) * 1024 + n], sb = ((const float*)F.ka->in[17])[((size_t)mat * 1024 + k) * 1024 + n];
      dbg_flag(F, dbg_ne(bf2f(((const bf16r*)(F.ws + WS_WOA))[((size_t)mat * 1024 + n) * 1024 + k]), sa) || dbg_ne(bf2f(((const bf16r*)(F.ws + WS_WOB))[((size_t)mat * 1024 + n) * 1024 + k]), sb), 6); }
}
__device__ __forceinline__ void dbg_check_p1(const Ctx& F) {
    if (F.wg != 0) return;
    const unsigned r = dbg_hash(F.tid + 1000);
    const float* ADA = (const float*)(F.ws + WS_ADA);
    { const int m = r % 16384, col = (r >> 14) % 1024, b = m >> 13;
      const float ref = ((const float*)F.ka->in[0])[(size_t)m * 1024 + col] * ((const float*)F.ka->in[5])[col] * (1.0f + ADA[(size_t)b * 9216 + 1024 + col]);
      dbg_flag(F, dbg_ne(bf2f(((const bf16r*)(F.ws + WS_XS))[(size_t)m * 1024 + col]), ref) || dbg_ne(F.out[(size_t)m * 1024 + col], ((const float*)F.ka->in[0])[(size_t)m * 1024 + col]), 7); }
    { const int q = r % 8, b = (r >> 3) & 1, n = (r >> 4) % 5632, l = q >> 1, f = q & 1; float ref = 0.f;
      for (int k = 0; k < 1024; ++k) ref += ADA[(size_t)(l * 2 + b) * 9216 + (f ? 2 : 0) * 3072 + k] * bf2f(((const bf16r*)(F.ws + WS_W13))[((size_t)q * 5632 + n) * 1024 + k]);
      dbg_flag(F, dbg_ne(((const float*)(F.ws + WS_SWF))[(size_t)(q * 2 + b) * 5632 + n], ref), b ? 31 : 8); }
    { const int l = r % 4, b = (r >> 2) & 1, n = (r >> 3) % 3072; const bf16r* W = (const bf16r*)(F.ws + ((l & 1) ? WS_WINB : WS_WINA)) + ((size_t)(l >> 1) * 3072 + n) * 1024; float ref = 0.f;
      for (int k = 0; k < 1024; ++k) ref += ADA[(size_t)(l * 2 + b) * 9216 + 3072 + k] * bf2f(W[k]);
      dbg_flag(F, dbg_ne(((const float*)(F.ws + WS_SWM))[(size_t)(l * 2 + b) * 3072 + n], ref), 9); }
    { const int m = r % 16384; float s = 0.f; for (int k = 0; k < 1024; ++k) { const float v = ((const float*)F.ka->in[0])[(size_t)m * 1024 + k]; s += v * v; }
      const float rs = rsqrtf(s * (1.0f / 1024.0f) + EPS); dbg_flag(F, fabsf(dbg_rstd(F, m) - rs) > 1e-3f * rs, 10); }
}
__device__ __forceinline__ void dbg_check_up(const Ctx& F) {
    if (F.wg != 0) return;
    const unsigned r = dbg_hash(F.tid + 2000);
    const int m = r % 16384, n = (r >> 14) % 2816, b = m >> 13, grow = (n >> 7) * 256 + (n & 127), urow = grow + 128;
    const float rs = dbg_rstd(F, m); const bf16r* XS = (const bf16r*)(F.ws + WS_XS) + (size_t)m * 1024; const bf16r* W = (const bf16r*)(F.ws + WS_W13);
    float g = 0.f, u = 0.f;
    for (int k = 0; k < 1024; ++k) { const float xv = bf2f(XS[k]); g += xv * bf2f(W[(size_t)grow * 1024 + k]); u += xv * bf2f(W[(size_t)urow * 1024 + k]); }
    const float* SWF = (const float*)(F.ws + WS_SWF) + (size_t)b * 5632;
    g = g * rs + SWF[grow]; u = u * rs + SWF[urow];
    dbg_flag(F, dbg_ne(bf2f(((const bf16r*)(F.ws + WS_H))[(size_t)m * 2816 + n]), dbg_silu(g) * u), 11);
}
__device__ __forceinline__ void dbg_check_down(const Ctx& F) {
    if (F.wg != 0) return;
    const unsigned r = dbg_hash(F.tid + 3000);
    const int m = r % 16384, n = (r >> 14) % 1024, b = m >> 13;
    const bf16r* H = (const bf16r*)(F.ws + WS_H) + (size_t)m * 2816; const bf16r* W = (const bf16r*)(F.ws + WS_W2) + (size_t)n * 2816;
    float d = 0.f; for (int k = 0; k < 2816; ++k) d += bf2f(H[k]) * bf2f(W[k]);
    const float* ADA = (const float*)(F.ws + WS_ADA);
    const float ref = ((const float*)F.ka->in[0])[(size_t)m * 1024 + n] + 0.5f * ADA[(size_t)b * 9216 + 2048 + n] * d, got = F.out[(size_t)m * 1024 + n];
    dbg_flag(F, dbg_ne(got, ref), 13);
    dbg_flag(F, dbg_ne(bf2f(((const bf16r*)(F.ws + WS_XS))[(size_t)m * 1024 + n]), got * ((const float*)(F.ws + WS_GS))[(size_t)(0 * 3 + 1) * 2048 + b * 1024 + n]), 14);
    float s = 0.f; for (int k = 0; k < 1024; ++k) { const float v = F.out[(size_t)m * 1024 + k]; s += v * v; }
    const float rs = rsqrtf(s * (1.0f / 1024.0f) + EPS); dbg_flag(F, fabsf(dbg_rstd(F, m) - rs) > 1e-3f * rs, 15);
}
__device__ __forceinline__ float dbg_inproj(const Ctx& F, int l, int m, int n) {
    const int b = m >> 13; const float rs = dbg_rstd(F, m);
    const bf16r* XS = (const bf16r*)(F.ws + WS_XS) + (size_t)m * 1024; const bf16r* W = (const bf16r*)(F.ws + ((l & 1) ? WS_WINB : WS_WINA)) + ((size_t)(l >> 1) * 3072 + n) * 1024;
    float a = 0.f; for (int k = 0; k < 1024; ++k) a += bf2f(XS[k]) * bf2f(W[k]);
    return a * rs + ((const float*)(F.ws + WS_SWM))[(size_t)(l * 2 + b) * 3072 + n];
}
__device__ __forceinline__ void dbg_check_inproj0(const Ctx& F) {
    if (F.wg != 0) return;
    const unsigned r = dbg_hash(F.tid + 4000);
    const int m = r % 16384, n = (r >> 14) % 3072, b = m >> 13;
    dbg_flag(F, dbg_ne(bf2f(((const bf16r*)(F.ws + WS_P))[(size_t)m * 3072 + n]), dbg_inproj(F, 0, m, n)), 16);
    const int g = n & 7; const float rs = dbg_rstd(F, m); const bf16r* XS = (const bf16r*)(F.ws + WS_XS) + (size_t)m * 1024; const float* ADA = (const float*)(F.ws + WS_ADA);
    float a = 0.f, sgw = 0.f; for (int k = 0; k < 1024; ++k) { const float w = ((const float*)F.ka->in[8])[(size_t)k * 3080 + 3072 + g]; a += bf2f(XS[k]) * w; sgw += ADA[(size_t)b * 9216 + 3072 + k] * w; }
    dbg_flag(F, dbg_ne(((const float*)(F.ws + WS_GATES))[(size_t)m * 8 + g], a * rs + sgw), 17);
}
__device__ __forceinline__ void dbg_check_inproj1(const Ctx& F) {
    if (F.wg != 0) return;
    const unsigned r = dbg_hash(F.tid + 5000);
    const int m = r % 16384, n = (r >> 14) % 3072, b = m >> 13, s = m & 8191, blk = n >> 7, d = n & 127, which = blk >> 3, idx = blk & 7;
    float ref = dbg_inproj(F, 1, m, n);
    if (which < 2 && d < 32) {
        const int fi = d & 15; const float other = dbg_inproj(F, 1, m, d < 16 ? n + 16 : n - 16);
        const float a = (float)((const int*)F.ka->in[2])[m] * pg8::ROPE_INVF[fi];
        const float kk = rintf(a * 0.15915494309189535f); float rr = fmaf(-kk, 6.2831854820251465f, a); rr = fmaf(-kk, -1.7484555314695172e-07f, rr);
        const float c = __cosf(rr), sn = __sinf(rr);
        ref = d < 16 ? ref * c - other * sn : ref * c + other * sn;
    }
    dbg_flag(F, dbg_ne(bf2f(((const bf16r*)(F.ws + WS_P))[(size_t)which * 16777216 + ((size_t)(b * 8 + idx) * 8192 + s) * 128 + d]), ref), 20);
}
__device__ __forceinline__ void dbg_check_mlstm(const Ctx& F, LAS unsigned char* lds) {
    if (F.wg != 0) return;
    LAS float* C = (LAS float*)lds;
    LAS float* qs = C + 32768, *ks = qs + 128, *vs = ks + 128, *nn = vs + 256, *hv = nn + 128, *red = hv + 256;
    const int h = 1, tid = F.tid;
    const bf16r* P = (const bf16r*)(F.ws + WS_P); const float* GT = (const float*)(F.ws + WS_GATES); const bf16r* Y = (const bf16r*)(F.ws + WS_Y);
    const float* cw = (const float*)F.ka->in[9]; const float* cb = (const float*)F.ka->in[10]; const float* bif = (const float*)F.ka->in[11]; const float* ng = (const float*)F.ka->in[12];
    for (int i = tid; i < 32768; i += 512) C[i] = 0.f;
    if (tid < 128) nn[tid] = 0.f;
    float mstate = 0.f;
    __syncthreads();
    for (int t = 0; t < 160; ++t) {
        if (tid < 256) { const int isk = tid >> 7, d = tid & 127, ch = isk * 512 + h * 128 + d; float a = cb[ch];
            for (int jt = 0; jt < 4; ++jt) if (t - 3 + jt >= 0) a += cw[jt * 1024 + ch] * bf2f(P[(size_t)(t - 3 + jt) * 3072 + ch]);
            a = dbg_silu(a); if (isk) ks[d] = a * 0.08838834764831845f; else qs[d] = a; }
        else { const int v = tid - 256; vs[v] = bf2f(P[(size_t)t * 3072 + 1024 + h * 256 + v]); }
        __syncthreads();
        const float li = GT[(size_t)t * 8 + h] + bif[h], gf = GT[(size_t)t * 8 + 4 + h] + bif[4 + h];
        const float lf = fminf(gf, 0.f) - log1pf(expf(-fabsf(gf)));
        const float mn = fmaxf(lf + mstate, li), fd = expf(lf + mstate - mn), ig = expf(li - mn);
        for (int i = tid; i < 32768; i += 512) { const int v = i >> 7, d = i & 127; C[i] = fd * C[i] + ig * vs[v] * ks[d]; }
        if (tid < 128) nn[tid] = fd * nn[tid] + ig * ks[tid];
        mstate = mn;
        __syncthreads();
        float den = 0.f; for (int d = 0; d < 128; ++d) den += nn[d] * qs[d];
        const float dn = 1.0f / fmaxf(fabsf(den), expf(-mn));
        { const int v = tid >> 1, half = tid & 1; float a = 0.f; for (int d = 0; d < 64; ++d) a += C[v * 128 + half * 64 + d] * qs[half * 64 + d];
          a += swz_xor<1>(a); if (half == 0) hv[v] = a * dn; }
        __syncthreads();
        float ss = 0.f; for (int v = 0; v < 256; ++v) ss += hv[v] * hv[v];
        const float rr = rsqrtf(ss * (1.0f / 256.0f) + EPS);
        if (tid < 256) { const int v = tid; const float o = bf2f(P[(size_t)t * 3072 + 2048 + h * 256 + v]);
            const float ref = hv[v] * rr * ng[h * 256 + v] / (1.0f + expf(-o));
            dbg_flag(F, dbg_ne(bf2f(Y[(size_t)t * 1024 + h * 256 + v]), ref), t < 64 ? 18 : 19); }
        __syncthreads();
    }
}
__device__ __forceinline__ void dbg_check_attn(const Ctx& F) {
    if (F.wg >= 8) return;
    const bf16r* Qb = (const bf16r*)(F.ws + WS_P); const bf16r* Kb = Qb + 16777216; const bf16r* Vb = Kb + 16777216; const bf16r* Ob = (const bf16r*)(F.ws + WS_O);
    const unsigned r = dbg_hash(F.wg * 8 + F.wave + 6000);
    const int hd = r % 32, row = (F.wave == 0) ? (int)((r >> 5) % 300) : (int)((r >> 5) % 8192);
    const int b = hd >> 4, h = (hd >> 2) & 3, c = (hd >> 1) & 1, vh = hd & 1, lane = F.lane;
    const bf16r* q = Qb + ((size_t)(b * 8 + h * 2 + c) * 8192 + row) * 128; const bf16r* K = Kb + (size_t)(b * 8 + h * 2 + c) * 8192 * 128; const bf16r* V = Vb + (size_t)(b * 8 + h * 2 + vh) * 8192 * 128;
    const float q0 = bf2f(q[lane * 2]), q1 = bf2f(q[lane * 2 + 1]);
    float mx = -1e30f, l = 0.f, o0 = 0.f, o1 = 0.f;
    for (int jk = 0; jk <= row; ++jk) {
        float sc = q0 * bf2f(K[(size_t)jk * 128 + lane * 2]) + q1 * bf2f(K[(size_t)jk * 128 + lane * 2 + 1]); sc = wave_sum(sc) * 0.08838834764831845f;
        const float mn = fmaxf(mx, sc), al = expf(mx - mn), p = expf(sc - mn);
        l = l * al + p; o0 = o0 * al + p * bf2f(V[(size_t)jk * 128 + lane * 2]); o1 = o1 * al + p * bf2f(V[(size_t)jk * 128 + lane * 2 + 1]); mx = mn;
    }
    const bf16r* O = Ob + ((size_t)hd * 8192 + row) * 128;
    dbg_flag(F, dbg_ne(bf2f(O[lane * 2]), o0 / l) || dbg_ne(bf2f(O[lane * 2 + 1]), o1 / l), 21);
}
__device__ __forceinline__ void dbg_check_combine(const Ctx& F) {
    if (F.wg != 0) return;
    const unsigned r = dbg_hash(F.tid + 7000);
    const int m = r % 16384, h = (r >> 14) & 3, vv = (r >> 16) & 255, b = m >> 13, s = m & 8191;
    const bf16r* Ob = (const bf16r*)(F.ws + WS_O); const float lam = ((const float*)(F.ws + WS_LAM))[0];
    float ss = 0.f, mine = 0.f;
    for (int v = 0; v < 256; ++v) { const int hd0 = ((b * 4 + h) * 2) * 2 + (v >> 7);
        const float o = bf2f(Ob[((size_t)hd0 * 8192 + s) * 128 + (v & 127)]) - lam * bf2f(Ob[((size_t)(hd0 + 2) * 8192 + s) * 128 + (v & 127)]); ss += o * o; if (v == vv) mine = o; }
    const float ref = mine * rsqrtf(ss * (1.0f / 256.0f) + EPS) * ((const float*)F.ka->in[16])[vv] * (1.0f - 0.35550906759096934f);
    dbg_flag(F, dbg_ne(bf2f(((const bf16r*)(F.ws + WS_Y))[(size_t)m * 1024 + h * 256 + vv]), ref), 23);
}
#endif

constexpr int N_PHASES = 2 + 9 * DEPTH + 1;
constexpr int PH_ATT1 = 2 + 9 * 1 + 3, PH_ATT3 = 2 + 9 * 3 + 3;
#ifndef DBL_MASK
#define DBL_MASK 0
#endif
#ifndef MK_ONE_LAUNCH
#define MK_ONE_LAUNCH 1
#endif
__device__ __forceinline__ Ctx make_ctx(int wave_s) {
    KArgs ka = (KArgs)__builtin_amdgcn_kernarg_segment_ptr();
    asm volatile("" : "+s"(ka));
    Ctx F; F.ka = ka; F.out = ka->out; F.ws = ka->ws;
    { unsigned z0 = 0u; asm volatile("" : "+v"(z0)); const int t0 = wave_s * 64 + (int)__builtin_amdgcn_mbcnt_hi(~0u, __builtin_amdgcn_mbcnt_lo(~0u, z0)); F.tid = t0 & 511; }
    F.lane = F.tid & 63; F.wave = __builtin_amdgcn_readfirstlane(F.tid >> 6);
    { int g0 = gridDim.x, w0 = blockIdx.x; asm volatile("" : "+s"(g0), "+s"(w0)); F.G = g0; F.wg = w0; }
    return F;
}
template <bool FIRST> __device__ __forceinline__ void grid_seam(const Ctx& F, int& epoch) {
    if (FIRST && epoch == 0) {
        if (F.wg == 0 && F.tid == 0) __hip_atomic_store((unsigned*)F.ws, 0u, __ATOMIC_RELAXED, __HIP_MEMORY_SCOPE_AGENT);
        __threadfence(); cg::this_grid().sync(); epoch = 1; return;
    }
    asm volatile("s_waitcnt vmcnt(0) lgkmcnt(0)" ::: "memory");
    __syncthreads();
    if (F.tid == 0) {
        unsigned* cnt = (unsigned*)F.ws;
        __builtin_amdgcn_fence(__ATOMIC_RELEASE, "agent");
        asm volatile("s_waitcnt vmcnt(0)" ::: "memory");
        __hip_atomic_fetch_add(cnt, 1u, __ATOMIC_RELAXED, __HIP_MEMORY_SCOPE_AGENT);
        const unsigned target = (unsigned)epoch * (unsigned)F.G;
        while (__hip_atomic_load(cnt, __ATOMIC_RELAXED, __HIP_MEMORY_SCOPE_AGENT) < target) __builtin_amdgcn_s_sleep(2);
        __builtin_amdgcn_fence(__ATOMIC_ACQUIRE, "agent");
        asm volatile("s_waitcnt vmcnt(0)" ::: "memory");
    }
    __syncthreads();
    epoch += 1;
}
template <int PH, bool DRY = false> __device__ __forceinline__ void do_phase(int lo, int hi, int wave_s, LAS unsigned char* lds, unsigned char* lds_raw, int& epoch) {
    if (!(lo <= PH && PH < hi)) return;
    const Ctx F = make_ctx(wave_s);
    unsigned char* ws = F.ws;
    const float* ADA = (const float*)(ws + WS_ADA); const float* GS = (const float*)(ws + WS_GS); float* SSQP = (float*)(ws + WS_SSQP);
    bf16r* XS = (bf16r*)(ws + WS_XS); bf16r* H = (bf16r*)(ws + WS_H); bf16r* P = (bf16r*)(ws + WS_P); bf16r* Y = (bf16r*)(ws + WS_Y);
    constexpr bool is_layer = PH >= 2 && PH < N_PHASES - 1;
    constexpr int l = is_layer ? (PH - 2) / 9 : 0, s = is_layer ? (PH - 2) % 9 : -1, isattn = l & 1, j = l >> 1;
    constexpr bool empty = is_layer && s == 5 && isattn;
#if MK_DEBUG
    if constexpr (PH == 1) dbg_check_p0(F); else if constexpr (PH == 2) dbg_check_p1(F); else if constexpr (PH == 3) dbg_check_up(F); else if constexpr (PH == 4) dbg_check_down(F);
    else if constexpr (PH == 5) dbg_check_inproj0(F); else if constexpr (PH == 8) dbg_check_mlstm(F, lds); else if constexpr (PH == 14) dbg_check_inproj1(F);
    else if constexpr (PH == 15) dbg_check_attn(F); else if constexpr (PH == 17) dbg_check_combine(F);
    __syncthreads();
#endif
    if constexpr (PH == 0) p0_phase(F, lds);
    else if constexpr (PH == 1) p1_phase(F);
    else if constexpr (PH == N_PHASES - 1) { final_phase(F);
#if MK_DEBUG
        if (F.wg == 0) { asm volatile("s_waitcnt vmcnt(0)" ::: "memory"); __syncthreads(); const unsigned code = *(const unsigned*)(F.ws + 64); if (code) { float v = (float)(10 + (code % 90)) * 100.0f; for (unsigned q = 0; q < code / 90; ++q) v *= 10.0f; F.out[F.tid] = v; } }
#endif
    }
    else if constexpr (s == 0 || s == 7) {
        constexpr int f = s == 0 ? 0 : 1;
        pg8::Gemm g{XS, (const bf16r*)(ws + WS_W13) + (size_t)(l * 2 + f) * NUP * 1024, M, NUP, 1024};
        pg8::EpiGen E{0, H, (const float*)(ws + WS_SWF) + (size_t)(l * 2 + f) * 2 * NUP, SSQP, nullptr, nullptr, nullptr};
        pg8::StaticOrder S; S.init(M, NUP, F.G, F.wg);
        pg8::gemm_phase<pg8::EpiGen, pg8::StaticOrder, true, true>(lds, g, S, E, F.tid);
    } else if constexpr (s == 1 || s == 8) {
        constexpr int f = s == 1 ? 0 : 1, sub = f ? 2 : 0;
        pg8::Gemm g{H, (const bf16r*)(ws + WS_W2) + (size_t)(l * 2 + f) * 1024 * DFF, M, 1024, DFF};
        const float* gsn = f == 0 ? GS + (size_t)(l * 3 + 1) * 2048 : GS + (size_t)((l + 1 < DEPTH ? l + 1 : 0) * 3) * 2048;
        pg8::EpiGen E{DRY ? 5 : 1, F.out, ADA + (size_t)l * 2 * 9216 + sub * 3072 + 2048, gsn, (l == 0 && f == 0) ? (const void*)((const float*)F.ka->in[0]) : (const void*)F.out, XS, SSQP};
        pg8::StaticOrder S; S.init(M, 1024, F.G, F.wg);
        pg8::gemm_phase<pg8::EpiGen, pg8::StaticOrder, true, true>(lds, g, S, E, F.tid);
    } else if constexpr (s == 2) {
        pg8::Gemm g{XS, (const bf16r*)(ws + (isattn ? WS_WINB : WS_WINA)) + (size_t)j * NIN * 1024, M, NIN, 1024};
        pg8::EpiGen E{isattn ? 4 : 3, P, (const float*)(ws + WS_SWM) + (size_t)l * 2 * NIN, SSQP, ((const int*)F.ka->in[2]), nullptr, nullptr};
        pg8::StaticOrder S; S.init(M, NIN, F.G, F.wg);
        pg8::gemm_phase<pg8::EpiGen, pg8::StaticOrder, true, true>(lds, g, S, E, F.tid);
        if constexpr (!isattn) { __syncthreads(); gates_phase(F, lds, l); }
    } else if constexpr (s == 6) {
        pg8::Gemm g{Y, (const bf16r*)(ws + (isattn ? WS_WOB : WS_WOA)) + (size_t)j * 1024 * 1024, M, 1024, 1024};
        pg8::EpiGen E{DRY ? 5 : 2, F.out, ADA + (size_t)l * 2 * 9216 + 3072 + 2048, GS + (size_t)(l * 3 + 2) * 2048, (const void*)F.out, XS, SSQP};
        pg8::StaticOrder S; S.init(M, 1024, F.G, F.wg);
        pg8::gemm_phase<pg8::EpiGen, pg8::StaticOrder, true, true>(lds, g, S, E, F.tid);
    }
    else if constexpr (s == 3) { if constexpr (isattn) attn_phase(F, (char*)lds_raw); else s1_phase(F, lds, l); }
    else if constexpr (s == 4) { if constexpr (isattn) combine_phase(F, l); else s2_phase(F, lds); }
    else if constexpr (s == 5) { if constexpr (!isattn) s3_phase(F, lds, l); }
    if (PH + 1 < hi && !empty) grid_seam<PH == 0>(F, epoch);
}
template <int PH> __device__ __forceinline__ void do_twice(int lo, int hi, int wave_s, LAS unsigned char* lds, unsigned char* lds_raw, int& epoch) {
    constexpr bool is_layer = PH >= 2 && PH < N_PHASES - 1;
    constexpr int l = is_layer ? (PH - 2) / 9 : 0, s = is_layer ? (PH - 2) % 9 : -1, isattn = l & 1;
    constexpr bool dbl = ((DBL_MASK & 1) && (PH == 0 || PH == 1)) || ((DBL_MASK & 2) && is_layer && !isattn && (s == 3 || s == 4 || s == 5)) || ((DBL_MASK & 4) && is_layer && isattn && s == 3)
                      || ((DBL_MASK & 8) && is_layer && (s == 0 || s == 7)) || ((DBL_MASK & 16) && is_layer && s == 2) || ((DBL_MASK & 32) && is_layer && isattn && s == 4) || ((DBL_MASK & 256) && is_layer && !isattn && s == 3) || ((DBL_MASK & 512) && is_layer && !isattn && s == 4) || ((DBL_MASK & 1024) && is_layer && !isattn && s == 5) || ((DBL_MASK & 2048) && PH == 0) || ((DBL_MASK & 4096) && PH == 1);
    constexpr bool dry = ((DBL_MASK & 64) && is_layer && (s == 1 || s == 8)) || ((DBL_MASK & 128) && is_layer && s == 6);
    if constexpr (dry) do_phase<PH, true>(lo, hi, wave_s, lds, lds_raw, epoch);
    do_phase<PH>(lo, hi, wave_s, lds, lds_raw, epoch);
    if constexpr (dbl) do_phase<PH>(lo, hi, wave_s, lds, lds_raw, epoch);
}
template <int... I> __device__ __forceinline__ void all_phases(std::integer_sequence<int, I...>, int lo, int hi, int wave_s, LAS unsigned char* lds, unsigned char* lds_raw, int& epoch) {
    (do_twice<I>(lo, hi, wave_s, lds, lds_raw, epoch), ...);
}
__global__ void __launch_bounds__(NWAVES * 64, 2) mk_fwd(Args args) {
    extern __shared__ __attribute__((aligned(16))) unsigned char lds_raw[];
    LAS unsigned char* lds = (LAS unsigned char*)lds_raw;
    const int ph_lo = args.ph_lo, ph_hi = args.ph_hi;
    const int wave_s = __builtin_amdgcn_readfirstlane(threadIdx.x >> 6);
    if (ph_lo != 0 && ph_hi - ph_lo > 1) return;
    int epoch = 0;
    all_phases(std::make_integer_sequence<int, N_PHASES>{}, ph_lo, ph_hi, wave_s, lds, lds_raw, epoch);
}

extern "C" void kernel_launch(void* const* d_in, const int* in_sizes, int n_in, void* d_out, int out_size, void* d_ws, size_t ws_size, hipStream_t stream) {
    static int grid = 0;
    if (grid == 0) {
        if (n_in != 19 || out_size != M * DM || ws_size < WS_END) { fprintf(stderr, "kernel_launch: unexpected shapes (n_in %d out %d ws %zu)\n", n_in, out_size, ws_size); grid = -1; return; }
        int dev = 0, cus = 0, per_cu = 0;
        (void)hipGetDevice(&dev); (void)hipDeviceGetAttribute(&cus, hipDeviceAttributeMultiprocessorCount, dev);
        if (hipFuncSetAttribute((const void*)mk_fwd, hipFuncAttributeMaxDynamicSharedMemorySize, LDS_BYTES) != hipSuccess) { fprintf(stderr, "kernel_launch: hipFuncSetAttribute failed\n"); grid = -1; return; }
        if (hipOccupancyMaxActiveBlocksPerMultiprocessor(&per_cu, (const void*)mk_fwd, NWAVES * 64, LDS_BYTES) != hipSuccess || per_cu < 1) { fprintf(stderr, "kernel_launch: occupancy query gave %d\n", per_cu); per_cu = 1; }
        (void)hipGetLastError();
        grid = cus > 0 ? cus : 256;
    }
    if (grid < 0) return;
    Args a{};
    for (int i = 0; i < 19; ++i) a.in[i] = d_in[i];
    a.out = (float*)d_out; a.ws = (unsigned char*)d_ws;
#if MK_ONE_LAUNCH
    a.ph_lo = 0; a.ph_hi = N_PHASES;
    void* kargs[] = {&a};
    hipError_t e = hipLaunchCooperativeKernel((const void*)mk_fwd, dim3(grid), dim3(NWAVES * 64), kargs, LDS_BYTES, stream);
    if (e != hipSuccess) fprintf(stderr, "kernel_launch: cooperative launch failed: %s (grid %d)\n", hipGetErrorString(e), grid);
#else
    for (int ph = 0; ph < N_PHASES; ++ph) {
        if (ph >= 2 && ph < N_PHASES - 1 && ((ph - 2) / 9 & 1) && ((ph - 2) % 9 == 5)) continue;
        a.ph_lo = ph; a.ph_hi = ph + 1;
        hipLaunchKernelGGL(mk_fwd, dim3(grid), dim3(NWAVES * 64), LDS_BYTES, stream, a);
    }
#endif
}
```

```cpp
#include <hip/hip_runtime.h>
#include <hip/hip_bf16.h>
#include <hip/hip_cooperative_groups.h>
#include <cstdio>
#include <cstdint>
#include <cmath>
#include <utility>
template <int MASK> __device__ __forceinline__ float swz_xor(float v) { return __builtin_bit_cast(float, __builtin_amdgcn_ds_swizzle(__builtin_bit_cast(int, v), (MASK << 10) | 0x1f)); }
__device__ __forceinline__ float sum_x32(float v) { const unsigned u = __float_as_uint(v); auto rr = __builtin_amdgcn_permlane32_swap(u, u, false, false); const unsigned r0 = rr[0], r1 = rr[1]; return __uint_as_float(r0) + __uint_as_float(r1); }
__device__ __forceinline__ float max_x32(float v) { const unsigned u = __float_as_uint(v); auto rr = __builtin_amdgcn_permlane32_swap(u, u, false, false); const unsigned r0 = rr[0], r1 = rr[1]; return fmaxf(__uint_as_float(r0), __uint_as_float(r1)); }
namespace pg8 {
#define PG8_LAS __attribute__((address_space(3)))
typedef unsigned short bf16_t;
typedef short bf16x8 __attribute__((ext_vector_type(8)));
typedef float f32x4 __attribute__((ext_vector_type(4)));
typedef unsigned u32x4 __attribute__((ext_vector_type(4)));
constexpr int BM = 256, BK = 64, HALF = 128, HTB = HALF * BK * 2  , STAGE_BYTES = 8 * HTB, NXCD = 8, WGM = 8;

__host__ __device__ __forceinline__ int lds_byte(int r, int c) { const int st = (r >> 4) * 2 + (c >> 5), rr = r & 15, cc = c & 31, ob = rr * 64 + cc * 2; return st * 1024 + (ob ^ (((ob >> 9) & 1) << 5)); }
__host__ __device__ __forceinline__ void stage_rc(int b, int& R, int& C) { const int st = b / 1024, sb = b % 1024, swz = sb ^ (((sb >> 9) & 1) << 5); R = (st >> 1) * 16 + swz / 64; C = (st & 1) * 32 + (swz % 64) / 2; }
__host__ __device__ __forceinline__ int perm32(int rho) { const int n = rho >> 4, i = rho & 15; return 8 * (i >> 2) + 4 * n + (i & 3); }

struct Unit { int pm, pn; };
struct Gemm { const bf16_t* A; const bf16_t* Bt; int M, N, K; };

struct StaticOrder {
    int nM, nN, nwg, G, c;
    __host__ __device__ void init(int M, int N, int G_, int c_) { nM = M / BM; nN = N / BM; nwg = nM * nN; G = G_; c = c_; }
    __host__ __device__ bool next(int i, Unit& u) const {
        const long L = (long)i * G + c; if (L >= nwg) return false;
        int wgid = (int)L; { const int q = nwg / NXCD, r = nwg % NXCD, xcd = wgid % NXCD, off = wgid / NXCD; wgid = (xcd < r ? xcd * (q + 1) : r * (q + 1) + (xcd - r) * q) + off; }
        const int nig = WGM * nN, gid = wgid / nig, fm = gid * WGM, gsz = (nM - fm) < WGM ? (nM - fm) : WGM;
        u.pm = fm + ((wgid % nig) % gsz); u.pn = (wgid % nig) / gsz; return true;
    }
    __device__ __forceinline__ void a_ready(const Unit&) const {}
    __device__ __forceinline__ void done(const Unit&) const {}
};
__device__ __forceinline__ unsigned cvt_pk_bf16(float lo, float hi) { unsigned r; asm volatile("v_cvt_pk_bf16_f32 %0, %1, %2" : "=v"(r) : "v"(lo), "v"(hi)); return r; }
constexpr int MROWS = 16384;
constexpr float RMS_EPS = 1e-6f;
__device__ __forceinline__ float silu_f(float g) { return g * __builtin_amdgcn_rcpf(1.0f + __expf(-g)); }
__device__ __forceinline__ void rows_rstd(const float* ssqp, int row0, int fq, float (&rs)[2][4]) {
    float s[2][4];
#pragma unroll
    for (int ai = 0; ai < 2; ++ai)
#pragma unroll
        for (int m = 0; m < 4; ++m) { const float* p = ssqp + (size_t)(fq * 4) * MROWS + row0 + ai * HALF + m * 16;
            s[ai][m] = (p[0] + p[MROWS]) + (p[2 * MROWS] + p[3 * MROWS]); }
#pragma unroll
    for (int ai = 0; ai < 2; ++ai)
#pragma unroll
        for (int m = 0; m < 4; ++m) { float t = s[ai][m]; t += swz_xor<16>(t); t = sum_x32(t); rs[ai][m] = rsqrtf(t * (1.0f / 1024.0f) + RMS_EPS); }
}
__device__ __forceinline__ float row_rstd(const float* ssqp, int row, int fq) {
    float s = 0.f;
#pragma unroll
    for (int i = 0; i < 4; ++i) s += ssqp[(size_t)(fq * 4 + i) * MROWS + row];
    s += swz_xor<16>(s); s = sum_x32(s);
    return rsqrtf(s * (1.0f / 1024.0f) + RMS_EPS);
}
struct EpiUp {
    static constexpr bool PERM = true, AFTER_DRAIN = false;
    bf16_t* H; const float* sw; const float* ssqp;
    __device__ __forceinline__ void operator()(const f32x4 (&acc)[2][2][4][2], const Unit& u, int wr, int wc, int fr, int fq) const {
        const int b = u.pm >> 5, row0 = u.pm * BM + wr * 64 + fr, c8 = wc * 32 + 8 * fq;
        const float* swp = sw + (size_t)b * 5632 + u.pn * 256 + c8;
        const f32x4 sg0 = *(const f32x4*)(swp), sg1 = *(const f32x4*)(swp + 4), su0 = *(const f32x4*)(swp + 128), su1 = *(const f32x4*)(swp + 132);
        bf16_t* hp = H + (size_t)u.pn * 128 + c8;
        float rsv[2][4]; rows_rstd(ssqp, row0, fq, rsv);
#pragma unroll
        for (int ai = 0; ai < 2; ++ai)
#pragma unroll
            for (int m = 0; m < 4; ++m) {
                const int row = row0 + ai * HALF + m * 16;
                const float rs = rsv[ai][m];
                const f32x4 g0 = acc[ai][0][m][0] * rs + sg0, g1 = acc[ai][0][m][1] * rs + sg1;
                const f32x4 u0 = acc[ai][1][m][0] * rs + su0, u1 = acc[ai][1][m][1] * rs + su1;
                u32x4 w;
                w.x = cvt_pk_bf16(silu_f(g0[0]) * u0[0], silu_f(g0[1]) * u0[1]); w.y = cvt_pk_bf16(silu_f(g0[2]) * u0[2], silu_f(g0[3]) * u0[3]);
                w.z = cvt_pk_bf16(silu_f(g1[0]) * u1[0], silu_f(g1[1]) * u1[1]); w.w = cvt_pk_bf16(silu_f(g1[2]) * u1[2], silu_f(g1[3]) * u1[3]);
                *(u32x4*)(hp + (size_t)row * 2816) = w;
            }
    }
};
struct EpiBias {
    static constexpr bool PERM = true, AFTER_DRAIN = false;
    bf16_t* O; int ldc; const float* sw; int nsw; const float* ssqp;
    __device__ __forceinline__ void operator()(const f32x4 (&acc)[2][2][4][2], const Unit& u, int wr, int wc, int fr, int fq) const {
        const int b = u.pm >> 5, row0 = u.pm * BM + wr * 64 + fr, col0 = u.pn * BM + wc * 32 + 8 * fq;
        f32x4 sv[2][2];
#pragma unroll
        for (int bj = 0; bj < 2; ++bj)
#pragma unroll
            for (int n = 0; n < 2; ++n) sv[bj][n] = *(const f32x4*)(sw + (size_t)b * nsw + col0 + bj * HALF + 4 * n);
        float rsv[2][4]; rows_rstd(ssqp, row0, fq, rsv);
#pragma unroll
        for (int ai = 0; ai < 2; ++ai)
#pragma unroll
            for (int m = 0; m < 4; ++m) {
                const int row = row0 + ai * HALF + m * 16;
                const float rs = rsv[ai][m];
                bf16_t* rowp = O + (size_t)row * ldc + col0;
#pragma unroll
                for (int bj = 0; bj < 2; ++bj) {
                    const f32x4 v0 = acc[ai][bj][m][0] * rs + sv[bj][0], v1 = acc[ai][bj][m][1] * rs + sv[bj][1];
                    u32x4 w; w.x = cvt_pk_bf16(v0[0], v0[1]); w.y = cvt_pk_bf16(v0[2], v0[3]); w.z = cvt_pk_bf16(v1[0], v1[1]); w.w = cvt_pk_bf16(v1[2], v1[3]);
                    *(u32x4*)(rowp + bj * HALF) = w;
                }
            }
    }
};
template <int HALFC> struct EpiResidT {
    static constexpr bool PERM = true, AFTER_DRAIN = false;
    float* x; const float* xin; const float* gate; const float* gsn; bf16_t* xs; float* ssqp;
    __device__ __forceinline__ void operator()(const f32x4 (&acc)[2][2][4][2], const Unit& u, int wr, int wc, int fr, int fq) const {
        const int b = u.pm >> 5, row0 = u.pm * BM + wr * 64 + fr, col0 = u.pn * BM + wc * 32 + 8 * fq;
        constexpr float gcoef = HALFC == 2 ? 0.0f : (HALFC ? 0.5f : 1.0f);
        f32x4 gt[2][2], gs[2][2];
#pragma unroll
        for (int bj = 0; bj < 2; ++bj)
#pragma unroll
            for (int n = 0; n < 2; ++n) {
                gt[bj][n] = *(const f32x4*)(gate + (size_t)b * 9216 + col0 + bj * HALF + 4 * n) * gcoef;
                gs[bj][n] = *(const f32x4*)(gsn + (size_t)b * 1024 + col0 + bj * HALF + 4 * n);
            }
#pragma unroll
        for (int ai = 0; ai < 2; ++ai)
#pragma unroll
        for (int mp = 0; mp < 2; ++mp) {
            f32x4 xv[2][2][2];
#pragma unroll
            for (int mm = 0; mm < 2; ++mm)
#pragma unroll
                for (int bj = 0; bj < 2; ++bj) { const float* xp = xin + (size_t)(row0 + ai * HALF + (mp * 2 + mm) * 16) * 1024 + col0 + bj * HALF; xv[mm][bj][0] = *(const f32x4*)xp; xv[mm][bj][1] = *(const f32x4*)(xp + 4); }
#pragma unroll
            for (int mm = 0; mm < 2; ++mm) {
                const int m = mp * 2 + mm, row = row0 + ai * HALF + m * 16;
                float ss = 0.f;
#pragma unroll
                for (int bj = 0; bj < 2; ++bj) {
                    float* xp = x + (size_t)row * 1024 + col0 + bj * HALF;
                    const f32x4 x0 = xv[mm][bj][0] + gt[bj][0] * acc[ai][bj][m][0], x1 = xv[mm][bj][1] + gt[bj][1] * acc[ai][bj][m][1];
                    *(f32x4*)xp = x0; *(f32x4*)(xp + 4) = x1;
                    ss += (x0[0] * x0[0] + x0[1] * x0[1]) + (x0[2] * x0[2] + x0[3] * x0[3]) + (x1[0] * x1[0] + x1[1] * x1[1]) + (x1[2] * x1[2] + x1[3] * x1[3]);
                    const f32x4 y0 = x0 * gs[bj][0], y1 = x1 * gs[bj][1];
                    u32x4 w; w.x = cvt_pk_bf16(y0[0], y0[1]); w.y = cvt_pk_bf16(y0[2], y0[3]); w.z = cvt_pk_bf16(y1[0], y1[1]); w.w = cvt_pk_bf16(y1[2], y1[3]);
                    *(u32x4*)(xs + (size_t)row * 1024 + col0 + bj * HALF) = w;
                }
                ss += swz_xor<16>(ss); ss = sum_x32(ss);
                if (fq == 0) ssqp[(size_t)(u.pn * 4 + wc) * MROWS + row] = ss;
            }
            asm volatile("" ::: "memory");
        }
    }
};
__constant__ float ROPE_INVF[16] = {1.000000000e+00f, 4.403665960e-01f, 1.939227432e-01f, 8.539710194e-02f, 3.760603070e-02f, 1.656044088e-02f, 7.292664610e-03f, 3.211446106e-03f,
                                    1.414213562e-03f, 6.227724371e-04f, 2.742481884e-04f, 1.207697351e-04f, 5.318295734e-05f, 2.341999971e-05f, 1.031338525e-05f, 4.541670478e-06f};
struct EpiRope {
    static constexpr bool PERM = true, AFTER_DRAIN = false;
    bf16_t* QKV; const float* sw; const float* ssqp; const int* pos;
    __device__ __forceinline__ void operator()(const f32x4 (&acc)[2][2][4][2], const Unit& u, int wr, int wc, int fr, int fq) const {
        const int b = u.pm >> 5, row0 = u.pm * BM + wr * 64 + fr, col0 = u.pn * BM + wc * 32 + 8 * fq;
        f32x4 sv[2][2];
#pragma unroll
        for (int bj = 0; bj < 2; ++bj)
#pragma unroll
            for (int n = 0; n < 2; ++n) sv[bj][n] = *(const f32x4*)(sw + (size_t)b * 3072 + col0 + bj * HALF + 4 * n);
        const bool rot = (wc == 0) && (u.pn < 8);
        const bool lower = fq < 2;
        float rsv[2][4]; rows_rstd(ssqp, row0, fq, rsv);
        f32x4 fr4[2] = {{0.f, 0.f, 0.f, 0.f}, {0.f, 0.f, 0.f, 0.f}};
        if (rot) { fr4[0] = *(const f32x4*)(ROPE_INVF + 8 * (fq & 1)); fr4[1] = *(const f32x4*)(ROPE_INVF + 8 * (fq & 1) + 4); }
#pragma unroll
        for (int ai = 0; ai < 2; ++ai)
#pragma unroll
            for (int m = 0; m < 4; ++m) {
                const int row = row0 + ai * HALF + m * 16, srow = row & 8191;
                const float rs = rsv[ai][m];
                f32x4 cs[2] = {{1.f, 1.f, 1.f, 1.f}, {1.f, 1.f, 1.f, 1.f}}, sn[2] = {{0.f, 0.f, 0.f, 0.f}, {0.f, 0.f, 0.f, 0.f}};
                if (rot) {
                    const float p = (float)pos[row];
#pragma unroll
                    for (int n = 0; n < 2; ++n)
#pragma unroll
                        for (int j = 0; j < 4; ++j) {
                            const float a = p * fr4[n][j];
                            const float k = rintf(a * 0.15915494309189535f);
                            float r = fmaf(-k, 6.2831854820251465f, a); r = fmaf(-k, -1.7484555314695172e-07f, r);
                            cs[n][j] = __cosf(r); sn[n][j] = lower ? -__sinf(r) : __sinf(r);
                        }
                }
#pragma unroll
                for (int bj = 0; bj < 2; ++bj) {
                    const int blk = u.pn * 2 + bj, which = blk >> 3, idx = blk & 7;
                    f32x4 v[2] = {acc[ai][bj][m][0] * rs + sv[bj][0], acc[ai][bj][m][1] * rs + sv[bj][1]};
                    if (rot) {
#pragma unroll
                        for (int n = 0; n < 2; ++n)
#pragma unroll
                            for (int j = 0; j < 4; ++j) {
                                const unsigned bits = __float_as_uint(v[n][j]);
                                auto rr = __builtin_amdgcn_permlane32_swap(bits, bits, false, false);
                                const unsigned r0 = rr[0], r1 = rr[1];
                                const float pv = __uint_as_float(lower ? r1 : r0);
                                v[n][j] = v[n][j] * cs[n][j] + pv * sn[n][j];
                            }
                    }
                    bf16_t* dp = QKV + (size_t)which * 16777216 + ((size_t)(b * 8 + idx) * 8192 + srow) * 128 + wc * 32 + 8 * fq;
                    u32x4 w; w.x = cvt_pk_bf16(v[0][0], v[0][1]); w.y = cvt_pk_bf16(v[0][2], v[0][3]); w.z = cvt_pk_bf16(v[1][0], v[1][1]); w.w = cvt_pk_bf16(v[1][2], v[1][3]);
                    *(u32x4*)dp = w;
                }
            }
    }
};
struct EpiGen {
    static constexpr bool PERM = true, AFTER_DRAIN = false;
    int kind; void* p0; const void* p1; const void* p2; const void* p3; void* p4; void* p5;
    __device__ __forceinline__ void operator()(const f32x4 (&acc)[2][2][4][2], const Unit& u, int wr, int wc, int fr, int fq) const {
        if (kind == 0) { EpiUp e{(bf16_t*)p0, (const float*)p1, (const float*)p2}; e(acc, u, wr, wc, fr, fq); }
        else if (kind == 1) { EpiResidT<1> e{(float*)p0, (const float*)p3, (const float*)p1, (const float*)p2, (bf16_t*)p4, (float*)p5}; e(acc, u, wr, wc, fr, fq); }
        else if (kind == 2) { EpiResidT<0> e{(float*)p0, (const float*)p3, (const float*)p1, (const float*)p2, (bf16_t*)p4, (float*)p5}; e(acc, u, wr, wc, fr, fq); }
        else if (kind == 3) { EpiBias e{(bf16_t*)p0, 3072, (const float*)p1, 3072, (const float*)p2}; e(acc, u, wr, wc, fr, fq); }
        else if (kind == 5) { EpiResidT<2> e{(float*)p0, (const float*)p3, (const float*)p1, (const float*)p2, (bf16_t*)p4, (float*)p5}; e(acc, u, wr, wc, fr, fq); }
        else { EpiRope e{(bf16_t*)p0, (const float*)p1, (const float*)p2, (const int*)p3}; e(acc, u, wr, wc, fr, fq); }
    }
};
template <class Epi, class Sched, bool ALIGN_EPI = false, bool SP2 = false>
__device__ __forceinline__ void gemm_phase(PG8_LAS unsigned char* lds, const Gemm g, const Sched& S, const Epi& E, const int tid_in) {
    const int tid = tid_in, wid = __builtin_amdgcn_readfirstlane(tid >> 6), lane = tid & 63, wr = wid >> 2, wc = wid & 3, fr = lane & 15, fq = lane >> 4;
    const int K = g.K, nt = K / BK;
    unsigned voffA[2], voffB[2];
#pragma unroll
    for (int i = 0; i < 2; ++i) { int R, C; stage_rc(tid * 16 + i * 8192, R, C); const int Rb = Epi::PERM ? ((R & ~31) + perm32(R & 31)) : R;
        voffA[i] = (unsigned)(R * K + C) * 2u; voffB[i] = (unsigned)(Rb * K + C) * 2u; }
    const size_t kstep = (size_t)(BK * 2);
    const size_t hstep = (size_t)HALF * K * 2;
    const size_t tstep = 2 * hstep;
    const unsigned ldsw = (unsigned)wid * 1024u;
    const int aoff = lds_byte(wr * 64 + fr, fq * 8), boff = lds_byte(wc * 32 + fr, fq * 8);
#define PG8_SA(b, h) (((b) * 2 + (h)) * HTB)
#define PG8_SB(b, h) ((4 + (b) * 2 + (h)) * HTB)
#define PG8_STAGE(bufoff, gbase, voff) do { _Pragma("unroll") for (int _i = 0; _i < 2; ++_i) \
        __builtin_amdgcn_global_load_lds((const unsigned*)((const char*)(gbase) + (voff)[_i]), (PG8_LAS unsigned*)(lds + (bufoff) + ldsw + _i * 8192), 16, 0, 0); } while (0)
#define PG8_LDA(dst, b, h) do { _Pragma("unroll") for (int m = 0; m < 4; ++m) _Pragma("unroll") for (int k = 0; k < 2; ++k) dst[m][k] = *(const PG8_LAS bf16x8*)(lds + PG8_SA(b, h) + aoff + m * 2048 + k * 1024); } while (0)
#define PG8_LDB(dst, b, h) do { _Pragma("unroll") for (int n = 0; n < 2; ++n) _Pragma("unroll") for (int k = 0; k < 2; ++k) dst[n][k] = *(const PG8_LAS bf16x8*)(lds + PG8_SB(b, h) + boff + n * 2048 + k * 1024); } while (0)
#define PG8_MMA(ai, bj, At, Bt) do { __builtin_amdgcn_s_setprio(1); _Pragma("unroll") for (int m = 0; m < 4; ++m) _Pragma("unroll") for (int n = 0; n < 2; ++n) _Pragma("unroll") for (int k = 0; k < 2; ++k) \
        acc[ai][bj][m][n] = __builtin_amdgcn_mfma_f32_16x16x32_bf16(Bt[n][k], At[m][k], acc[ai][bj][m][n], 0, 0, 0); __builtin_amdgcn_s_setprio(0); } while (0)
#define PG8_WAIT_V(n) asm volatile("s_waitcnt vmcnt(" #n ")" ::: "memory")
#define PG8_WAIT_L(n) asm volatile("s_waitcnt lgkmcnt(" #n ")" ::: "memory")
#define PG8_BAR __builtin_amdgcn_s_barrier()
#define PG8_SCHED __builtin_amdgcn_sched_barrier(0)
    Unit cur, nxt; int ui = 0;
    if (!S.next(0, cur)) return;
    f32x4 acc[2][2][4][2];
#pragma unroll
    for (int a = 0; a < 2; ++a)
#pragma unroll
        for (int b = 0; b < 2; ++b)
#pragma unroll
            for (int m = 0; m < 4; ++m)
#pragma unroll
                for (int n = 0; n < 2; ++n) acc[a][b][m][n] = (f32x4){0.f, 0.f, 0.f, 0.f};
    bf16x8 At[4][2], B0[2][2], B1[2][2];
    const char* cA = (const char*)g.A + (size_t)cur.pm * tstep; const char* cB = (const char*)g.Bt + (size_t)cur.pn * tstep;
    S.a_ready(cur);
    if constexpr (SP2) {
        PG8_STAGE(PG8_SB(0, 0), cB, voffB); PG8_STAGE(PG8_SB(0, 1), cB + hstep, voffB); PG8_STAGE(PG8_SA(0, 0), cA, voffA); PG8_STAGE(PG8_SA(0, 1), cA + hstep, voffA);
        if (wr == 1) PG8_BAR;
        PG8_WAIT_V(2); PG8_BAR;
        PG8_STAGE(PG8_SB(1, 0), cB + kstep, voffB); PG8_STAGE(PG8_SA(1, 0), cA + kstep, voffA); PG8_STAGE(PG8_SB(1, 1), cB + hstep + kstep, voffB);
        PG8_WAIT_V(6); PG8_BAR;
    } else {
        PG8_STAGE(PG8_SB(0, 0), cB, voffB); PG8_STAGE(PG8_SA(0, 0), cA, voffA); PG8_STAGE(PG8_SB(0, 1), cB + hstep, voffB); PG8_STAGE(PG8_SA(0, 1), cA + hstep, voffA);
        if (wr == 1) PG8_BAR;
        PG8_WAIT_V(4); PG8_BAR;
        PG8_STAGE(PG8_SB(1, 0), cB + kstep, voffB); PG8_STAGE(PG8_SA(1, 0), cA + kstep, voffA); PG8_STAGE(PG8_SB(1, 1), cB + hstep + kstep, voffB);
        PG8_WAIT_V(6); PG8_BAR;
    }
    for (;;) {
        const bool has_next = S.next(ui + 1, nxt);
        const char* nA = has_next ? (const char*)g.A + (size_t)nxt.pm * tstep : cA; const char* nB = has_next ? (const char*)g.Bt + (size_t)nxt.pn * tstep : cB;
        for (int t = 0; t < nt; t += 2) {
            const bool last = (t == nt - 2);
            const char* a1 = cA + (size_t)(t + 1) * kstep;
            const char* a2 = last ? nA : cA + (size_t)(t + 2) * kstep; const char* b2 = last ? nB : cB + (size_t)(t + 2) * kstep;
            const char* a3 = a2 + kstep; const char* b3 = b2 + kstep;
            if (last && has_next) S.a_ready(nxt);
            if constexpr (SP2) {
            PG8_LDB(B0, 0, 0); PG8_LDB(B1, 0, 1); PG8_SCHED; PG8_LDA(At, 0, 0); PG8_STAGE(PG8_SA(1, 1), a1 + hstep, voffA);
            PG8_WAIT_V(8); PG8_WAIT_L(0); PG8_BAR; PG8_MMA(0, 0, At, B0); PG8_MMA(0, 1, At, B1); PG8_BAR; PG8_SCHED;
            PG8_LDA(At, 0, 1); PG8_STAGE(PG8_SB(0, 0), b2, voffB); PG8_STAGE(PG8_SB(0, 1), b2 + hstep, voffB); PG8_STAGE(PG8_SA(0, 0), a2, voffA);
            PG8_WAIT_V(8); PG8_WAIT_L(0); PG8_BAR; PG8_MMA(1, 0, At, B0); PG8_MMA(1, 1, At, B1); PG8_BAR; PG8_SCHED;
            PG8_LDB(B0, 1, 0); PG8_LDB(B1, 1, 1); PG8_SCHED; PG8_LDA(At, 1, 0); PG8_STAGE(PG8_SA(0, 1), a2 + hstep, voffA);
            PG8_WAIT_V(8); PG8_WAIT_L(0); PG8_BAR; PG8_MMA(0, 0, At, B0); PG8_MMA(0, 1, At, B1); PG8_BAR; PG8_SCHED;
            PG8_LDA(At, 1, 1); PG8_STAGE(PG8_SB(1, 0), b3, voffB); PG8_STAGE(PG8_SB(1, 1), b3 + hstep, voffB); PG8_STAGE(PG8_SA(1, 0), a3, voffA);
            PG8_WAIT_V(8); PG8_WAIT_L(0); PG8_BAR; PG8_MMA(1, 0, At, B0); PG8_MMA(1, 1, At, B1); PG8_BAR; PG8_SCHED;
            } else {
            PG8_LDB(B0, 0, 0); PG8_SCHED; PG8_LDA(At, 0, 0); PG8_STAGE(PG8_SA(1, 1), a1 + hstep, voffA);
            PG8_WAIT_L(8); PG8_BAR; PG8_WAIT_L(0); PG8_MMA(0, 0, At, B0); PG8_BAR; PG8_SCHED;
            PG8_LDB(B1, 0, 1); PG8_STAGE(PG8_SB(0, 0), b2, voffB);
            PG8_BAR; PG8_WAIT_L(0); PG8_MMA(0, 1, At, B1); PG8_BAR;
            PG8_LDA(At, 0, 1); PG8_STAGE(PG8_SA(0, 0), a2, voffA);
            PG8_BAR; PG8_WAIT_L(0); PG8_MMA(1, 0, At, B0); PG8_BAR; PG8_SCHED;
            PG8_STAGE(PG8_SB(0, 1), b2 + hstep, voffB);
            PG8_WAIT_V(6); PG8_BAR; PG8_MMA(1, 1, At, B1); PG8_BAR;
            PG8_LDB(B0, 1, 0); PG8_SCHED; PG8_LDA(At, 1, 0); PG8_STAGE(PG8_SA(0, 1), a2 + hstep, voffA);
            PG8_WAIT_L(8); PG8_BAR; PG8_WAIT_L(0); PG8_MMA(0, 0, At, B0); PG8_BAR; PG8_SCHED;
            PG8_LDB(B1, 1, 1); PG8_STAGE(PG8_SB(1, 0), b3, voffB);
            PG8_BAR; PG8_WAIT_L(0); PG8_MMA(0, 1, At, B1); PG8_BAR;
            PG8_LDA(At, 1, 1); PG8_STAGE(PG8_SA(1, 0), a3, voffA);
            PG8_BAR; PG8_WAIT_L(0); PG8_MMA(1, 0, At, B0); PG8_BAR; PG8_SCHED;
            PG8_STAGE(PG8_SB(1, 1), b3 + hstep, voffB);
            PG8_WAIT_V(6); PG8_BAR; PG8_MMA(1, 1, At, B1); PG8_BAR;
            }
        }
        if constexpr (ALIGN_EPI) { if (wr == 0) PG8_BAR; }
        if constexpr (!Epi::AFTER_DRAIN) { E(acc, cur, wr, wc, fr, fq); S.done(cur); }
        if (!has_next) break;
#pragma unroll
        for (int a = 0; a < 2; ++a)
#pragma unroll
            for (int b = 0; b < 2; ++b)
#pragma unroll
                for (int m = 0; m < 4; ++m)
#pragma unroll
                    for (int n = 0; n < 2; ++n) acc[a][b][m][n] = (f32x4){0.f, 0.f, 0.f, 0.f};
        cur = nxt; cA = nA; cB = nB; ++ui;
        if constexpr (ALIGN_EPI) { if (wr == 1) PG8_BAR; }
    }
    PG8_WAIT_V(0);
    if constexpr (!ALIGN_EPI) { if (wr == 0) PG8_BAR; }
    PG8_BAR;
    if constexpr (Epi::AFTER_DRAIN) { E.fused(acc, cur, wr, wc, fr, fq, lds, wid, lane); S.done(cur); }
#undef PG8_SA
#undef PG8_SB
#undef PG8_STAGE
#undef PG8_LDA
#undef PG8_LDB
#undef PG8_MMA
#undef PG8_WAIT_V
#undef PG8_WAIT_L
#undef PG8_BAR
#undef PG8_SCHED
}
}
namespace att {
using bf16 = __hip_bfloat16;
constexpr int D = 128; constexpr float THR = 8.f; constexpr bool WSKIP = false;
constexpr float SCALE = 0.08838834764831845f;
constexpr int NW = 8, QBLK = 32, KVBLK = 64, QB = NW * QBLK;
constexpr int SHM_V = KVBLK * D * 2, SHM_K = KVBLK * D * 2;
constexpr int LDS_BYTES = 2 * SHM_V + 2 * SHM_K + NW * 64 * 4;
typedef short bf16x8 __attribute__((ext_vector_type(8)));
typedef short s16x4 __attribute__((ext_vector_type(4)));
typedef float f32x16 __attribute__((ext_vector_type(16)));
typedef float f32x4 __attribute__((ext_vector_type(4)));
typedef unsigned u32x4 __attribute__((ext_vector_type(4)));
template <class A, class Bt> struct same_t { static constexpr bool v = false; };
template <class A> struct same_t<A, A> { static constexpr bool v = true; };

#define KSWZ(row, colB) ((row) * 256 + ((colB) ^ (((row) & 7) << 4)))
#define SBAR() __builtin_amdgcn_sched_barrier(0)
__device__ __forceinline__ int v_st(int k, int c) { const int kk = (k & ~0xC) | ((k & 4) << 1) | ((k & 8) >> 1); return ((kk >> 3) * 4 + (c >> 5)) * 512 + ((kk & 7) * 32 + (c & 31)) * 2; }
__device__ __forceinline__ int v_rd_base(int lane) { return ((lane & 3) << 3) | (((lane >> 2) & 3) << 6) | (((lane >> 4) & 1) << 5) | (((lane >> 5) & 1) << 8); }
constexpr int v_rd_off(int d0, int ks, int half) { return d0 * 512 + ks * 4096 + half * 2048; }
__device__ __forceinline__ int crow(int r, int hi) { return (r & 3) + 8 * (r >> 2) + 4 * hi; }
__device__ __forceinline__ unsigned cvtpk(float lo, float hi) {
    unsigned r; asm volatile("v_cvt_pk_bf16_f32 %0, %1, %2" : "=v"(r) : "v"(lo), "v"(hi)); return r;
}
__device__ __forceinline__ bf16x8 pack8(f32x4 a, f32x4 b) {
    u32x4 w = {cvtpk(a[0], a[1]), cvtpk(a[2], a[3]), cvtpk(b[0], b[1]), cvtpk(b[2], b[3])};
    return *reinterpret_cast<bf16x8*>(&w);
}
template <class T> __device__ __forceinline__ bf16x8 load8(const T* p) {
    if constexpr (same_t<T, float>::v) { return pack8(*(const f32x4*)p, *(const f32x4*)(p + 4)); }
    else { return *reinterpret_cast<const bf16x8*>(p); }
}
__device__ __forceinline__ void mask_tile(f32x16& p0, f32x16& p1, int dq, unsigned W) {
    const float NEG = -__builtin_inff();
#pragma unroll
    for (int r = 0; r < 16; ++r) {
        const int c = (r & 3) + 8 * (r >> 2);
        if ((unsigned)(dq - c) >= W) p0[r] = NEG;
        if ((unsigned)(dq - c - 32) >= W) p1[r] = NEG;
    }
}
__device__ __forceinline__ void partialSM(f32x16& p0, f32x16& p1, float& m_reg, float& mn, float& alpha) {
    float pmax = p0[0]; for (int r = 1; r < 16; ++r) pmax = fmaxf(pmax, p0[r]); for (int r = 0; r < 16; ++r) pmax = fmaxf(pmax, p1[r]);
    { auto rr = __builtin_amdgcn_permlane32_swap(__float_as_uint(pmax), __float_as_uint(pmax), false, false);
      pmax = fmaxf(__uint_as_float(rr[0]), __uint_as_float(rr[1])); }
    constexpr float C2 = 1.4426950408889634f * SCALE;
    if (__builtin_expect(__all((pmax - m_reg) * SCALE <= THR), 1)) { mn = m_reg; alpha = 1.f; }
    else { mn = fmaxf(m_reg, pmax); alpha = __builtin_amdgcn_exp2f((m_reg - mn) * C2); m_reg = mn; }
    const float mnL = -mn * C2;
    for (int r = 0; r < 16; ++r) p0[r] = fmaf(p0[r], C2, mnL); for (int r = 0; r < 16; ++r) p1[r] = fmaf(p1[r], C2, mnL);
    for (int r = 0; r < 16; ++r) p0[r] = __builtin_amdgcn_exp2f(p0[r]);
}
__device__ __forceinline__ void finishSM(f32x16& p0, f32x16& p1, float alpha, float& l_reg, bf16x8& pa0, bf16x8& pa1, bf16x8& pa2, bf16x8& pa3) {
    for (int r = 0; r < 16; ++r) p1[r] = __builtin_amdgcn_exp2f(p1[r]);
    float ps = 0; for (int r = 0; r < 16; ++r) ps += p0[r]; for (int r = 0; r < 16; ++r) ps += p1[r];
    { auto rr = __builtin_amdgcn_permlane32_swap(__float_as_uint(ps), __float_as_uint(ps), false, false);
      ps = __uint_as_float(rr[0]) + __uint_as_float(rr[1]); }
    l_reg = l_reg * alpha + ps;
#define PK4(P, B_, OUT) do { unsigned a0 = cvtpk(P[B_+0], P[B_+1]), a1 = cvtpk(P[B_+2], P[B_+3]);                          \
        unsigned b0 = cvtpk(P[B_+4], P[B_+5]), b1 = cvtpk(P[B_+6], P[B_+7]);                                             \
        auto r0 = __builtin_amdgcn_permlane32_swap(a0, b0, false, false); auto r1 = __builtin_amdgcn_permlane32_swap(a1, b1, false, false); \
        u32x4 w = {r0[0], r1[0], r0[1], r1[1]}; OUT = *reinterpret_cast<bf16x8*>(&w); } while (0)
    PK4(p0, 0, pa0); PK4(p0, 8, pa1); PK4(p1, 0, pa2); PK4(p1, 8, pa3);
#undef PK4
}
template <int KB, bool SK>
__device__ __forceinline__ void qkt(f32x16& p0, f32x16& p1, const char* K_lds, int r32, int hi, const bf16x8* qr, bool act) {
    if (SK && !act) { const float NEG = -__builtin_inff();
#pragma unroll
        for (int r = 0; r < 16; ++r) { p0[r] = NEG; p1[r] = NEG; } return; }
    p0 = f32x16{}; p1 = f32x16{};
    const char* kb[4];
#pragma unroll
    for (int dd = 0; dd < 4; ++dd) kb[dd] = K_lds + KB * SHM_K + KSWZ(r32, (dd * 16 + hi * 8) * 2);
#pragma unroll
    for (int d0 = 0; d0 < 8; ++d0) { const char* a = kb[d0 & 3] + (d0 >> 2) * 128;
        bf16x8 b0 = *reinterpret_cast<const bf16x8*>(a);
        bf16x8 b1 = *reinterpret_cast<const bf16x8*>(a + 32 * 256);
        p0 = __builtin_amdgcn_mfma_f32_32x32x16_bf16(b0, qr[d0], p0, 0, 0, 0);
        p1 = __builtin_amdgcn_mfma_f32_32x32x16_bf16(b1, qr[d0], p1, 0, 0, 0); }
}
template <int VB, bool SK>
__device__ __forceinline__ void pv_tile(f32x16* o, int vb0, bf16x8 pa0, bf16x8 pa1, bf16x8 pa2, bf16x8 pa3, bool act) {
    if (SK && !act) return;
#define TRRD(dst, off) asm volatile("ds_read_b64_tr_b16 %0, %1 offset:%2" : "=&v"(dst) : "v"(vb0), "i"(off) : "memory")
#define PV_D0(d0) do { s16x4 l0, l1, l2, l3, h0, h1, h2, h3; constexpr int b_ = VB * SHM_V + v_rd_off(d0, 0, 0);     \
        TRRD(l0, b_); TRRD(h0, b_ + 2048); TRRD(l1, b_ + 4096); TRRD(h1, b_ + 6144); TRRD(l2, b_ + 8192); TRRD(h2, b_ + 10240); TRRD(l3, b_ + 12288); TRRD(h3, b_ + 14336); \
        asm volatile("s_waitcnt lgkmcnt(0)" ::: "memory"); SBAR();                 \
        o[d0] = __builtin_amdgcn_mfma_f32_32x32x16_bf16(pa0, (bf16x8){l0[0], l0[1], l0[2], l0[3], h0[0], h0[1], h0[2], h0[3]}, o[d0], 0, 0, 0);   \
        o[d0] = __builtin_amdgcn_mfma_f32_32x32x16_bf16(pa1, (bf16x8){l1[0], l1[1], l1[2], l1[3], h1[0], h1[1], h1[2], h1[3]}, o[d0], 0, 0, 0);   \
        o[d0] = __builtin_amdgcn_mfma_f32_32x32x16_bf16(pa2, (bf16x8){l2[0], l2[1], l2[2], l2[3], h2[0], h2[1], h2[2], h2[3]}, o[d0], 0, 0, 0);   \
        o[d0] = __builtin_amdgcn_mfma_f32_32x32x16_bf16(pa3, (bf16x8){l3[0], l3[1], l3[2], l3[3], h3[0], h3[1], h3[2], h3[3]}, o[d0], 0, 0, 0); } while (0)
    PV_D0(0); PV_D0(1); PV_D0(2); PV_D0(3);
#undef PV_D0
#undef TRRD
}

template <class TIn, class TOut> struct BlockRef { const TIn* Q; const TIn* K; const TIn* V; TOut* O; int P0; };
template <class TIn> struct Seam {
    bf16x8 qr[8];
    bf16x8 st_v0, st_v1, st_k0, st_k1; f32x4 sf0, sf1, sf2, sf3;
    f32x4 tq[16];
};
__device__ __forceinline__ int swa_jlo(int P0, int W) { const int lowk = P0 - W + 1; return lowk > 0 ? lowk / KVBLK : 0; }
#define ROW(p, k0, rr) ((p) + (size_t)((k0) + (rr)) * D + sc)
#define VMW() asm volatile("s_waitcnt vmcnt(0)" ::: "memory")
#define VMWN(n) asm volatile("s_waitcnt vmcnt(%0)" :: "i"(n) : "memory")
#define SLOAD_H(Kp, Vp, k0) do { S.st_v0 = load8<TIn>(ROW(Vp, k0, sr)); S.st_v1 = load8<TIn>(ROW(Vp, k0, 32 + sr));              \
                         S.st_k0 = load8<TIn>(ROW(Kp, k0, sr)); S.st_k1 = load8<TIn>(ROW(Kp, k0, 32 + sr)); } while (0)
#define SWRITE_HK(bf) do { *(bf16x8*)(K_lds + (bf) * SHM_K + kws) = S.st_k0; *(bf16x8*)(K_lds + (bf) * SHM_K + kws + 32 * 256) = S.st_k1; } while (0)
#define SWRITE_HV(bf) do { *(bf16x8*)(V_lds + (bf) * SHM_V + vst0) = S.st_v0; *(bf16x8*)(V_lds + (bf) * SHM_V + vst1) = S.st_v1; } while (0)
#define SWRITE_H(bf) do { SWRITE_HV(bf); SWRITE_HK(bf); } while (0)
#define SLOAD_F(p, k0) do { S.sf0 = *(const f32x4*)ROW(p, k0, sr); S.sf1 = *(const f32x4*)(ROW(p, k0, sr) + 4);                \
                            S.sf2 = *(const f32x4*)ROW(p, k0, 32 + sr); S.sf3 = *(const f32x4*)(ROW(p, k0, 32 + sr) + 4); } while (0)
#define SWRITE_KF(bf) do { *(bf16x8*)(K_lds + (bf) * SHM_K + kws) = pack8(S.sf0, S.sf1); *(bf16x8*)(K_lds + (bf) * SHM_K + kws + 32 * 256) = pack8(S.sf2, S.sf3); } while (0)
#define SWRITE_VF(bf) do { *(bf16x8*)(V_lds + (bf) * SHM_V + vst0) = pack8(S.sf0, S.sf1); *(bf16x8*)(V_lds + (bf) * SHM_V + vst1) = pack8(S.sf2, S.sf3); } while (0)
template <class TIn, class TOut>
__device__ __forceinline__ void causal_swa_prime(const BlockRef<TIn, TOut>& cur, int W, char* lds, Seam<TIn>& S, int tid_in) {
    constexpr bool F32 = same_t<TIn, float>::v;
    const int tid = tid_in, wid = __builtin_amdgcn_readfirstlane(tid >> 6), lane = tid & 63, r32 = lane & 31, hi = lane >> 5;
    const int sr = tid >> 4, sc = (tid & 15) * 8, kws = KSWZ(sr, sc * 2); char* K_lds = lds + 2 * SHM_V;
    const int kb0 = swa_jlo(cur.P0, W) * KVBLK;
    for (int d0 = 0; d0 < 8; ++d0) S.qr[d0] = load8<TIn>(cur.Q + (size_t)(wid * QBLK + r32) * D + d0 * 16 + hi * 8);
    if constexpr (F32) { SLOAD_F((const float*)cur.K, kb0); VMW(); SWRITE_KF(0); SBAR(); SLOAD_F((const float*)cur.V, kb0); }
    else { SLOAD_H(cur.K, cur.V, kb0); VMW(); SWRITE_HK(0); }
    __syncthreads();
}
template <class TIn, class TOut>
__device__ __forceinline__ void causal_swa_block(const BlockRef<TIn, TOut>& cur, const BlockRef<TIn, TOut>& nxt, int skv, int W, char* lds, Seam<TIn>& S, int tid_in) {
    constexpr bool F32 = same_t<TIn, float>::v;
    const int tid = tid_in, wid = __builtin_amdgcn_readfirstlane(tid >> 6), lane = tid & 63, r32 = lane & 31, hi = lane >> 5;
    const int j_lo = swa_jlo(cur.P0, W);
    int j_hi = (cur.P0 + QB - 1) / KVBLK + 1; if (j_hi > skv / KVBLK) j_hi = skv / KVBLK;
    const int NT = j_hi - j_lo;
    const int kbn = swa_jlo(nxt.P0, W) * KVBLK;
    const int qlo = cur.P0 + wid * QBLK, qm = qlo + r32 - 4 * hi;
    char* V_lds = lds; char* K_lds = lds + 2 * SHM_V;
    float* ws = (float*)(lds + 2 * SHM_V + 2 * SHM_K) + wid * 64; float* li_l = ws, * al_l = ws + 32;
    float m_reg = -1e30f, l_reg = 0; f32x16 o[4] = {};
    const int sr = tid >> 4, sc = (tid & 15) * 8, vst0 = v_st(sr, sc), vst1 = v_st(32 + sr, sc), kws = KSWZ(sr, sc * 2);
    const int vb0 = (int)(uintptr_t)V_lds + v_rd_base(lane);
    const TIn* Kh = cur.K; const TIn* Vh = cur.V;
#define RESC(a) do { if (__any((a) < 1.f)) { if (hi == 0) al_l[r32] = (a); asm volatile("s_waitcnt lgkmcnt(0)" ::: "memory");              \
                     for (int d_ = 0; d_ < 4; ++d_) for (int r = 0; r < 16; ++r) o[d_][r] *= al_l[crow(r, hi)]; } } while (0)
#define KBASE(t) ((j_lo + (t)) * KVBLK)
#define ACT(t) (KBASE(t) <= qlo + QBLK - 1 && KBASE(t) + KVBLK - 1 >= qlo - W + 1)
#define MASKT(P0_, P1_, t) do { const int kb_ = KBASE(t); if ((!SK || ACT(t)) && (kb_ + KVBLK - 1 > qlo || kb_ <= qlo + QBLK - 1 - W)) mask_tile(P0_, P1_, qm - kb_, (unsigned)W); } while (0)
    constexpr int NQL = F32 ? 16 : 8;
    constexpr bool SK = WSKIP && !F32;
#define SEAM_K0() do { VMWN(NQL); if constexpr (F32) { SWRITE_KF(0); SBAR(); SLOAD_F((const float*)nxt.V, kbn); } else { SWRITE_HK(0); } SBAR(); } while (0)
    f32x16 pA0, pA1, pB0, pB1; float mnA, mnB, alA, alB; bf16x8 pa0, pa1, pa2, pa3;
    if constexpr (F32) { VMW(); SWRITE_VF(0); SBAR(); } else { SWRITE_HV(0); SBAR(); }
    if (NT > 1) { if constexpr (F32) SLOAD_F((const float*)Kh, KBASE(1)); else SLOAD_H(Kh, Vh, KBASE(1)); }
    SBAR(); qkt<0, SK>(pA0, pA1, K_lds, r32, hi, S.qr, ACT(0));
    if constexpr (F32) { if (NT > 1) { VMW(); SWRITE_KF(1); SBAR(); SLOAD_F((const float*)Vh, KBASE(1)); } }
    MASKT(pA0, pA1, 0); partialSM(pA0, pA1, m_reg, mnA, alA);
    if (NT > 1) { VMW(); if constexpr (F32) { SWRITE_VF(1); SBAR(); if (NT > 2) SLOAD_F((const float*)Kh, KBASE(2)); } else SWRITE_H(1); }
    __syncthreads();
#define HALF_STEP(PX0, PX1, mnX, alX, PY0, PY1, alY, t, KB, VB, SB) do {                                                      \
        SBAR(); qkt<KB, SK>(PX0, PX1, K_lds, r32, hi, S.qr, ACT(t));                                             \
        finishSM(PY0, PY1, alY, l_reg, pa0, pa1, pa2, pa3); SBAR();                                                           \
        if ((t) + 1 < NT) { if constexpr (F32) { VMW(); SWRITE_KF(SB); SBAR(); SLOAD_F((const float*)Vh, KBASE((t) + 1)); }  \
                            else { SLOAD_H(Kh, Vh, KBASE((t) + 1)); } SBAR(); }                                               \
        pv_tile<VB, SK>(o, vb0, pa0, pa1, pa2, pa3, ACT((t) - 1)); MASKT(PX0, PX1, (t)); partialSM(PX0, PX1, m_reg, mnX, alX);                                        \
        __syncthreads();                                                                                                      \
        if ((t) + 1 < NT) { VMW(); if constexpr (F32) { SWRITE_VF(SB); SBAR(); if ((t) + 2 < NT) SLOAD_F((const float*)Kh, KBASE((t) + 2)); } \
                            else { SWRITE_H(SB); } }                                                                          \
        RESC(alX); __syncthreads(); } while (0)
    for (int t = 1; t + 1 < NT; t += 2) {
        HALF_STEP(pB0, pB1, mnB, alB, pA0, pA1, alA, t, 1, 0, 0);
        HALF_STEP(pA0, pA1, mnA, alA, pB0, pB1, alB, t + 1, 0, 1, 1);
    }
    const bool even = (NT & 1) == 0;
    if (even) { SBAR(); qkt<1, SK>(pB0, pB1, K_lds, r32, hi, S.qr, ACT(NT - 1)); SBAR(); }
#define QROW(e) (nxt.Q + (size_t)(wid * QBLK + r32) * D + ((e) >> 1) * 16 + hi * 8 + ((e) & 1) * 4)
    if constexpr (F32) { SLOAD_F((const float*)nxt.K, kbn); SBAR();
#pragma unroll
        for (int e = 0; e < 8; ++e) S.tq[e] = *(const f32x4*)QROW(e); }
    else { SLOAD_H(nxt.K, nxt.V, kbn); SBAR();
#pragma unroll
        for (int d0 = 0; d0 < 8; ++d0) S.qr[d0] = load8<TIn>(nxt.Q + (size_t)(wid * QBLK + r32) * D + d0 * 16 + hi * 8); }
    SBAR();
    finishSM(pA0, pA1, alA, l_reg, pa0, pa1, pa2, pa3); SBAR();
    if constexpr (F32) {
#pragma unroll
        for (int e = 8; e < 16; ++e) S.tq[e] = *(const f32x4*)QROW(e); SBAR(); }
#undef QROW
    pv_tile<0, SK>(o, vb0, pa0, pa1, pa2, pa3, ACT(even ? NT - 2 : NT - 1));
    if (even) { MASKT(pB0, pB1, NT - 1); partialSM(pB0, pB1, m_reg, mnB, alB); __syncthreads(); RESC(alB);
        finishSM(pB0, pB1, alB, l_reg, pa0, pa1, pa2, pa3); SBAR(); pv_tile<1, SK>(o, vb0, pa0, pa1, pa2, pa3, ACT(NT - 1)); }
    SBAR(); SEAM_K0();
    if (hi == 0) li_l[r32] = l_reg; asm volatile("s_waitcnt lgkmcnt(0)" ::: "memory");
    float rli[16];
#pragma unroll
    for (int r = 0; r < 16; ++r) rli[r] = __builtin_amdgcn_rcpf(li_l[crow(r, hi)]);
    TOut* Ow = cur.O + (size_t)(wid * QBLK) * D;
    int hi_e = hi; asm volatile("" : "+v"(hi_e));
#pragma unroll
    for (int r = 0; r < 16; ++r) { const int orow = crow(r, hi_e);
#pragma unroll
        for (int d0 = 0; d0 < 4; ++d0) { const float v = o[d0][r] * rli[r];
            if constexpr (same_t<TOut, float>::v) { Ow[(size_t)orow * D + d0 * 32 + r32] = v; }
            else { const float vn = swz_xor<1>(v);
                   if ((r32 & 1) == 0) *(unsigned*)(Ow + (size_t)orow * D + d0 * 32 + r32) = cvtpk(v, vn); } } }
    if constexpr (F32) {
#pragma unroll
        for (int d0 = 0; d0 < 8; ++d0) S.qr[d0] = pack8(S.tq[2 * d0], S.tq[2 * d0 + 1]); }
    __syncthreads();
#undef RESC
#undef KBASE
#undef ACT
#undef MASKT
#undef SEAM_K0
#undef HALF_STEP
}
#undef ROW
#undef VMW
#undef VMWN
#undef SLOAD_H
#undef SWRITE_HK
#undef SWRITE_HV
#undef SWRITE_H
#undef SLOAD_F
#undef SWRITE_KF
#undef SWRITE_VF
#undef SBAR
#undef KSWZ
}
namespace cg = cooperative_groups;
#ifndef S3_REP
#define S3_REP 1
#endif
#ifndef MK_DEBUG
#define MK_DEBUG 0
#endif
#define LAS __attribute__((address_space(3)))
typedef unsigned short bf16r;
typedef unsigned v4u __attribute__((ext_vector_type(4)));
typedef unsigned v2u __attribute__((ext_vector_type(2)));
typedef float f32x4 __attribute__((ext_vector_type(4)));
typedef short bf16x8 __attribute__((ext_vector_type(8)));
constexpr int M = 16384, SEQ = 8192, DM = 1024, DFF = 2816, NUP = 5632, NIN = 3072, DEPTH = 4;
constexpr float EPS = 1e-6f;
constexpr size_t MiB = 1u << 20;
constexpr size_t WS_ADA = 1 * MiB, WS_GS = 2 * MiB, WS_SWF = 3 * MiB, WS_SWM = 4 * MiB, WS_SSQP = 5 * MiB, WS_GATES = 6 * MiB, WS_BCUM = 7 * MiB, WS_LOGI = 8 * MiB,
                 WS_SCAL = 9 * MiB, WS_NLOC = 10 * MiB, WS_NST = 11 * MiB, WS_LAM = 12 * MiB, WS_WGT = 13 * MiB, WS_SWG = 14 * MiB;
constexpr size_t WS_W13 = 16 * MiB, WS_W2 = 104 * MiB, WS_WINA = 148 * MiB, WS_WINB = 160 * MiB, WS_WOA = 172 * MiB, WS_WOB = 176 * MiB;
constexpr size_t WS_XS = 180 * MiB, WS_H = 212 * MiB, WS_P = 300 * MiB, WS_Y = 396 * MiB, WS_U = 428 * MiB, WS_CST = 556 * MiB, WS_END = 620 * MiB;
constexpr size_t WS_O = WS_H;
constexpr int LDS_BYTES = 147456;
constexpr int NWAVES = 8;

typedef float f32x2_t __attribute__((ext_vector_type(2))); typedef __bf16 bf16x2_t __attribute__((ext_vector_type(2)));
__device__ __forceinline__ unsigned pk2(float lo, float hi) { f32x2_t v = {lo, hi}; bf16x2_t b = __builtin_convertvector(v, bf16x2_t); return __builtin_bit_cast(unsigned, b); }
__device__ __forceinline__ unsigned f2bf(float f) { return pk2(f, f) & 0xffffu; }
__device__ __forceinline__ float bflo(unsigned w) { return __uint_as_float(w << 16); }
__device__ __forceinline__ float bfhi(unsigned w) { return __uint_as_float(w & 0xffff0000u); }
__device__ __forceinline__ float bf2f(bf16r v) { return __uint_as_float((unsigned)v << 16); }
__device__ __forceinline__ float wave_sum(float v) {
    v += swz_xor<1>(v); v += swz_xor<2>(v); v += swz_xor<4>(v); v += swz_xor<8>(v); v += swz_xor<16>(v); return sum_x32(v);
}
__device__ __forceinline__ float wave_max(float v) {
    v = fmaxf(v, swz_xor<1>(v)); v = fmaxf(v, swz_xor<2>(v)); v = fmaxf(v, swz_xor<4>(v)); v = fmaxf(v, swz_xor<8>(v)); v = fmaxf(v, swz_xor<16>(v)); return max_x32(v);
}
__device__ __forceinline__ float lane_up(float v, int lane, int o) { return __builtin_bit_cast(float, __builtin_amdgcn_ds_bpermute(((lane - o) & 63) << 2, __builtin_bit_cast(int, v))); }
#define LDS_WAIT() asm volatile("s_waitcnt lgkmcnt(0)" ::: "memory")

struct Args { const void* in[19]; float* out; unsigned char* ws; int ph_lo, ph_hi; };
typedef const Args __attribute__((address_space(4)))* KArgs;
struct Ctx { KArgs ka; float* out; unsigned char* ws; int tid, lane, wave, G, wg; };

__device__ __forceinline__ void transpose_item(const float* W, int ldw, int k0, int n0, bf16r* dst  , int Kdst, LAS float* scr, int lane) {
#pragma unroll 8
    for (int i = 0; i < 32; ++i) { const int kk = 2 * i + (lane >> 5); scr[kk * 33 + (lane & 31)] = W[(size_t)(k0 + kk) * ldw + n0 + (lane & 31)]; }
    LDS_WAIT(); asm volatile("" ::: "memory");
    const int c = lane & 7;
#pragma unroll
    for (int j = 0; j < 4; ++j) { const int n = (lane >> 3) + 8 * j; const LAS float* s = scr + (8 * c) * 33 + n;
        v4u o; o.x = pk2(s[0 * 33], s[1 * 33]); o.y = pk2(s[2 * 33], s[3 * 33]); o.z = pk2(s[4 * 33], s[5 * 33]); o.w = pk2(s[6 * 33], s[7 * 33]);
        *(v4u*)(dst + (size_t)n * Kdst + k0 + 8 * c) = o; }
    LDS_WAIT(); asm volatile("" ::: "memory");
}
__device__ __forceinline__ void p0_phase(const Ctx& F, LAS unsigned char* lds) {
#if MK_DEBUG
    if (F.wg == 0 && F.tid == 1) *(unsigned*)(F.ws + 64) = 0u;
#endif
    {
        LAS float* red = (LAS float*)lds;
        float* ADA = (float*)(F.ws + WS_ADA);
        const int l32 = F.tid & 31, kg = F.tid >> 5;
        for (int task = F.wg; task < 4 * 72; task += F.G) {
            const int l = task / 72, col0 = (task % 72) * 128;
            f32x4 a0 = {0.f, 0.f, 0.f, 0.f}, a1 = {0.f, 0.f, 0.f, 0.f};
            const float* wp = ((const float*)F.ka->in[3]) + ((size_t)l * 1024 + kg * 64) * 9216 + col0 + l32 * 4;
#pragma unroll 8
            for (int kk = 0; kk < 64; ++kk) {
                const f32x4 w = *(const f32x4*)(wp + (size_t)kk * 9216);
                const float c0 = ((const float*)F.ka->in[1])[kg * 64 + kk], c1 = ((const float*)F.ka->in[1])[1024 + kg * 64 + kk];
                a0 += w * pg8::silu_f(c0); a1 += w * pg8::silu_f(c1);
            }
            *(LAS f32x4*)(red + (kg * 2 + 0) * 128 + l32 * 4) = a0; *(LAS f32x4*)(red + (kg * 2 + 1) * 128 + l32 * 4) = a1;
            __syncthreads();
            if (F.tid < 256) { const int b = F.tid >> 7, col = F.tid & 127; float s = 0.f;
#pragma unroll
                for (int g = 0; g < 16; ++g) s += red[(g * 2 + b) * 128 + col];
                ADA[(size_t)(l * 2 + b) * 9216 + col0 + col] = s + ((const float*)F.ka->in[4])[(size_t)l * 9216 + col0 + col]; }
            __syncthreads();
        }
    }
    for (int i = F.wg * 512 + F.tid; i < 2 * 8 * 1024; i += F.G * 512) { const int jj = i >> 13, g = (i >> 10) & 7, k = i & 1023;
        ((float*)(F.ws + WS_WGT))[i] = ((const float*)F.ka->in[8])[((size_t)jj * 1024 + k) * 3080 + 3072 + g]; }
    {
        LAS float* scr = (LAS float*)(lds + 16384 + F.wave * 8448);
        const int gw = F.wg * NWAVES + F.wave, NGW = F.G * NWAVES;
        constexpr int I13 = 16 * 176, I2 = 44 * 32, IIN = 16 * 96, IOUT = 16 * 32;
        constexpr int T0 = 8 * I13, T1 = T0 + 8 * I2, T2 = T1 + 2 * IIN, T3 = T2 + 2 * IIN, T4 = T3 + 2 * IOUT, T5 = T4 + 2 * IOUT;
        for (int it = gw; it < T5; it += NGW) {
            if (it < T0) { const int mat = it / I13, r = it % I13, kb = r / 176, n0 = (r % 176) * 32;
                const int drow = n0 < 2816 ? (n0 >> 7) * 256 + (n0 & 127) : ((n0 - 2816) >> 7) * 256 + 128 + ((n0 - 2816) & 127);
                transpose_item(((const float*)F.ka->in[6]) + (size_t)mat * 1024 * 5632, 5632, kb * 64, n0, (bf16r*)(F.ws + WS_W13) + ((size_t)mat * 5632 + drow) * 1024, 1024, scr, F.lane); }
            else if (it < T1) { const int q = it - T0, mat = q / I2, r = q % I2, kb = r / 32, n0 = (r % 32) * 32;
                transpose_item(((const float*)F.ka->in[7]) + (size_t)mat * 2816 * 1024, 1024, kb * 64, n0, (bf16r*)(F.ws + WS_W2) + ((size_t)mat * 1024 + n0) * 2816, 2816, scr, F.lane); }
            else if (it < T2) { const int q = it - T1, mat = q / IIN, r = q % IIN, kb = r / 96, n0 = (r % 96) * 32;
                transpose_item(((const float*)F.ka->in[8]) + (size_t)mat * 1024 * 3080, 3080, kb * 64, n0, (bf16r*)(F.ws + WS_WINA) + ((size_t)mat * 3072 + n0) * 1024, 1024, scr, F.lane); }
            else if (it < T3) { const int q = it - T2, mat = q / IIN, r = q % IIN, kb = r / 96, n0 = (r % 96) * 32;
                transpose_item(((const float*)F.ka->in[14]) + (size_t)mat * 1024 * 3072, 3072, kb * 64, n0, (bf16r*)(F.ws + WS_WINB) + ((size_t)mat * 3072 + n0) * 1024, 1024, scr, F.lane); }
            else if (it < T4) { const int q = it - T3, mat = q / IOUT, r = q % IOUT, kb = r / 32, n0 = (r % 32) * 32;
                transpose_item(((const float*)F.ka->in[13]) + (size_t)mat * 1024 * 1024, 1024, kb * 64, n0, (bf16r*)(F.ws + WS_WOA) + ((size_t)mat * 1024 + n0) * 1024, 1024, scr, F.lane); }
            else { const int q = it - T4, mat = q / IOUT, r = q % IOUT, kb = r / 32, n0 = (r % 32) * 32;
                transpose_item(((const float*)F.ka->in[17]) + (size_t)mat * 1024 * 1024, 1024, kb * 64, n0, (bf16r*)(F.ws + WS_WOB) + ((size_t)mat * 1024 + n0) * 1024, 1024, scr, F.lane); }
        }
    }
}
__device__ __forceinline__ void p1_phase(const Ctx& F) {
    const float* ADA = (const float*)(F.ws + WS_ADA);
    float* GS = (float*)(F.ws + WS_GS);
    const int gw = F.wg * NWAVES + F.wave, NGW = F.G * NWAVES;
    for (int i = F.wg * 512 + F.tid; i < 4 * 3 * 2 * 1024; i += F.G * 512) {
        const int d = i & 1023, b = (i >> 10) & 1, ls = i >> 11, l = ls / 3, sub = ls % 3;
        GS[i] = ((const float*)F.ka->in[5])[(size_t)ls * 1024 + d] * (1.0f + ADA[(size_t)(l * 2 + b) * 9216 + sub * 3072 + 1024 + d]);
    }
    if (F.wg == 0 && F.tid < 2) {
        const float* lm = ((const float*)F.ka->in[15]) + F.tid * 512; float s1 = 0.f, s2 = 0.f;
        for (int k = 0; k < 128; ++k) { s1 += lm[k] * lm[128 + k]; s2 += lm[256 + k] * lm[384 + k]; }
        const float lam_init = F.tid == 0 ? 0.35550906759096934f : 0.5560582041556406f;
        ((float*)(F.ws + WS_LAM))[F.tid] = expf(s1) - expf(s2) + lam_init;
    }
    if (gw < 32) { const int jj = gw >> 4, b = (gw >> 3) & 1, g = gw & 7, l = jj * 2; const float* sh = ADA + (size_t)(l * 2 + b) * 9216 + 3072; const float* w = (const float*)(F.ws + WS_WGT) + (size_t)(jj * 8 + g) * 1024;
        float s = 0.f;
#pragma unroll
        for (int q = 0; q < 16; ++q) s += sh[q * 64 + F.lane] * w[q * 64 + F.lane];
        s = wave_sum(s); if (F.lane == 0) ((float*)(F.ws + WS_SWG))[gw] = s; }
    {
        float* ssqp = (float*)(F.ws + WS_SSQP); bf16r* XS = (bf16r*)(F.ws + WS_XS);
        for (int m = gw; m < M; m += NGW) {
            const int b = m >> 13;
            const f32x4* xr = (const f32x4*)(((const float*)F.ka->in[0]) + (size_t)m * 1024) + F.lane;
            v2u* xsr = (v2u*)(XS + (size_t)m * 1024) + F.lane;
            float ss = 0.f;
#pragma unroll
            for (int j = 0; j < 4; ++j) {
                const f32x4 v = xr[64 * j];
                ss += (v[0] * v[0] + v[1] * v[1]) + (v[2] * v[2] + v[3] * v[3]);
                const int col = 4 * F.lane + 256 * j;
                const f32x4 ng = *(const f32x4*)(((const float*)F.ka->in[5]) + col);
                const f32x4 sc = *(const f32x4*)(ADA + (size_t)b * 9216 + 1024 + col);
                const f32x4 y = v * ng * (sc + 1.0f);
                v2u w; w.x = pk2(y[0], y[1]); w.y = pk2(y[2], y[3]); xsr[64 * j] = w;
            }
            ss = wave_sum(ss);
            if (F.lane < 16) ssqp[(size_t)F.lane * M + m] = F.lane == 0 ? ss : 0.f;
        }
    }
    {
        float* SWF = (float*)(F.ws + WS_SWF); float* SWM = (float*)(F.ws + WS_SWM);
        constexpr int RF = 8 * 5632, RT = RF + 4 * 3072;
        for (int r = gw; r < RT; r += NGW) {
            const bf16r* wt; const float* sh; float* o; int ostride;
            if (r < RF) { const int q = r / 5632, n = r % 5632, l = q >> 1, f = q & 1;
                wt = (const bf16r*)(F.ws + WS_W13) + (size_t)r * 1024; sh = ADA + (size_t)l * 2 * 9216 + (f ? 2 : 0) * 3072; o = SWF + (size_t)q * 2 * 5632 + n; ostride = 5632; }
            else { const int rr = r - RF, l = rr / 3072, n = rr % 3072;
                wt = (const bf16r*)(F.ws + ((l & 1) ? WS_WINB : WS_WINA)) + ((size_t)(l >> 1) * 3072 + n) * 1024; sh = ADA + (size_t)l * 2 * 9216 + 3072; o = SWM + (size_t)l * 2 * 3072 + n; ostride = 3072; }
            const v4u w0 = *(const v4u*)(wt + F.lane * 16), w1 = *(const v4u*)(wt + F.lane * 16 + 8);
            float wv[16] = {bflo(w0.x), bfhi(w0.x), bflo(w0.y), bfhi(w0.y), bflo(w0.z), bfhi(w0.z), bflo(w0.w), bfhi(w0.w),
                            bflo(w1.x), bfhi(w1.x), bflo(w1.y), bfhi(w1.y), bflo(w1.z), bfhi(w1.z), bflo(w1.w), bfhi(w1.w)};
            float s0 = 0.f, s1 = 0.f;
#pragma unroll
            for (int j = 0; j < 4; ++j) {
                const f32x4 h0 = *(const f32x4*)(sh + F.lane * 16 + 4 * j), h1 = *(const f32x4*)(sh + 9216 + F.lane * 16 + 4 * j);
#pragma unroll
                for (int e = 0; e < 4; ++e) { s0 += wv[4 * j + e] * h0[e]; s1 += wv[4 * j + e] * h1[e]; }
            }
            s0 = wave_sum(s0); s1 = wave_sum(s1);
            if (F.lane == 0) { o[0] = s0; o[ostride] = s1; }
        }
    }
}
__device__ __forceinline__ void gates_phase(const Ctx& F, LAS unsigned char* lds, int l) {
    const int j = l >> 1;
    const float* ssqp = (const float*)(F.ws + WS_SSQP); const bf16r* XS = (const bf16r*)(F.ws + WS_XS); float* GT = (float*)(F.ws + WS_GATES);
    const float* WGT = (const float*)(F.ws + WS_WGT) + (size_t)j * 8192; const float* SWG = (const float*)(F.ws + WS_SWG) + j * 16;
    for (int ch = F.wg; ch < 256; ch += F.G) {
        const int b = ch >> 7, m0 = ch * 64;
        f32x4 w[8][2][2];
#pragma unroll
        for (int g = 0; g < 8; ++g)
#pragma unroll
            for (int jj = 0; jj < 2; ++jj) { const float* p = WGT + g * 1024 + jj * 512 + F.lane * 8; w[g][jj][0] = *(const f32x4*)p; w[g][jj][1] = *(const f32x4*)(p + 4); }
        const float swg = F.lane < 8 ? SWG[b * 8 + F.lane] : 0.f;
#pragma unroll
        for (int half = 0; half < 2; ++half) {
            v4u xr[4][2]; float ssv[4];
#pragma unroll
            for (int i = 0; i < 4; ++i) { const int row = m0 + F.wave * 8 + half * 4 + i;
                xr[i][0] = *(const v4u*)(XS + (size_t)row * 1024 + F.lane * 8); xr[i][1] = *(const v4u*)(XS + (size_t)row * 1024 + 512 + F.lane * 8);
                ssv[i] = F.lane < 16 ? ssqp[(size_t)F.lane * M + row] : 0.f; }
#pragma unroll
            for (int i = 0; i < 4; ++i) { const int row = m0 + F.wave * 8 + half * 4 + i;
                const float rs = rsqrtf(wave_sum(ssv[i]) * (1.0f / 1024.0f) + EPS);
                float mine = 0.f;
#pragma unroll
                for (int g = 0; g < 8; ++g) { float a = 0.f;
#pragma unroll
                    for (int jj = 0; jj < 2; ++jj) { const v4u x = xr[i][jj]; const f32x4 w0 = w[g][jj][0], w1 = w[g][jj][1];
                        a += bflo(x.x) * w0[0] + bfhi(x.x) * w0[1] + bflo(x.y) * w0[2] + bfhi(x.y) * w0[3] + bflo(x.z) * w1[0] + bfhi(x.z) * w1[1] + bflo(x.w) * w1[2] + bfhi(x.w) * w1[3]; }
                    a = wave_sum(a); if (F.lane == g) mine = a; }
                if (F.lane < 8) GT[(size_t)row * 8 + F.lane] = mine * rs + swg; }
        }
    }
}
__device__ __forceinline__ bf16x8 ldfrag(const LAS bf16r* base, int row0, int stride, int k0, int lane) {
    return *(const LAS bf16x8*)(base + (row0 + (lane & 15)) * stride + k0 + (lane >> 4) * 8);
}
__device__ __forceinline__ void conv8(const bf16r* P, size_t mrow, int ps, int ch0, const float* cw, const float* cb, float scale, float (&o)[8]) {
    float acc[8];
    { const f32x4 b0 = *(const f32x4*)(cb + ch0), b1 = *(const f32x4*)(cb + ch0 + 4); acc[0] = b0[0]; acc[1] = b0[1]; acc[2] = b0[2]; acc[3] = b0[3]; acc[4] = b1[0]; acc[5] = b1[1]; acc[6] = b1[2]; acc[7] = b1[3]; }
#pragma unroll
    for (int jt = 0; jt < 4; ++jt) {
        if (ps - 3 + jt >= 0) {
            const v4u w = *(const v4u*)(P + (mrow - 3 + jt) * 3072 + ch0);
            const f32x4 c0 = *(const f32x4*)(cw + jt * 1024 + ch0), c1 = *(const f32x4*)(cw + jt * 1024 + ch0 + 4);
            acc[0] += bflo(w.x) * c0[0]; acc[1] += bfhi(w.x) * c0[1]; acc[2] += bflo(w.y) * c0[2]; acc[3] += bfhi(w.y) * c0[3];
            acc[4] += bflo(w.z) * c1[0]; acc[5] += bfhi(w.z) * c1[1]; acc[6] += bflo(w.w) * c1[2]; acc[7] += bfhi(w.w) * c1[3];
        }
    }
#pragma unroll
    for (int e = 0; e < 8; ++e) o[e] = pg8::silu_f(acc[e]) * scale;
}
__device__ __forceinline__ void conv_load(const bf16r* P, size_t mrow, int ps, int ch0, v4u (&raw)[4]) {
#pragma unroll
    for (int jt = 0; jt < 4; ++jt) raw[jt] = (ps - 3 + jt >= 0) ? *(const v4u*)(P + (mrow - 3 + jt) * 3072 + ch0) : (v4u){0u, 0u, 0u, 0u};
}
__device__ __forceinline__ void conv_apply(const v4u (&raw)[4], const f32x4 (&cwv)[4][2], const f32x4 (&cbv)[2], float scale, float (&o)[8]) {
    float acc[8] = {cbv[0][0], cbv[0][1], cbv[0][2], cbv[0][3], cbv[1][0], cbv[1][1], cbv[1][2], cbv[1][3]};
#pragma unroll
    for (int jt = 0; jt < 4; ++jt) { const v4u w = raw[jt]; const f32x4 c0 = cwv[jt][0], c1 = cwv[jt][1];
        acc[0] += bflo(w.x) * c0[0]; acc[1] += bfhi(w.x) * c0[1]; acc[2] += bflo(w.y) * c0[2]; acc[3] += bfhi(w.y) * c0[3];
        acc[4] += bflo(w.z) * c1[0]; acc[5] += bfhi(w.z) * c1[1]; acc[6] += bflo(w.w) * c1[2]; acc[7] += bfhi(w.w) * c1[3]; }
#pragma unroll
    for (int e = 0; e < 8; ++e) o[e] = pg8::silu_f(acc[e]) * scale;
}
__device__ __forceinline__ void conv_weights(const float* cw, const float* cb, int ch0, f32x4 (&cwv)[4][2], f32x4 (&cbv)[2]) {
#pragma unroll
    for (int jt = 0; jt < 4; ++jt) { cwv[jt][0] = *(const f32x4*)(cw + jt * 1024 + ch0); cwv[jt][1] = *(const f32x4*)(cw + jt * 1024 + ch0 + 4); }
    cbv[0] = *(const f32x4*)(cb + ch0); cbv[1] = *(const f32x4*)(cb + ch0 + 4);
}
__device__ __forceinline__ int vt_idx(int r, int s) { return r * 72 + ((((s >> 3) ^ (r >> 3)) & 7) << 3) + (s & 7); }
__device__ __forceinline__ void vt_scatter(LAS bf16r* T, int r0  , int s, const v4u w) {
    LAS bf16r* d = T + vt_idx(r0, s);
    d[0] = (bf16r)(w.x & 0xffffu); d[72] = (bf16r)(w.x >> 16); d[2 * 72] = (bf16r)(w.y & 0xffffu); d[3 * 72] = (bf16r)(w.y >> 16);
    d[4 * 72] = (bf16r)(w.z & 0xffffu); d[5 * 72] = (bf16r)(w.z >> 16); d[6 * 72] = (bf16r)(w.w & 0xffffu); d[7 * 72] = (bf16r)(w.w >> 16);
}
__device__ __forceinline__ bf16x8 ldfrag_sw(const LAS bf16r* base, int row0, int k0, int lane) {
    const int r = row0 + (lane & 15);
    return *(const LAS bf16x8*)(base + r * 72 + (((((k0 >> 3) + (lane >> 4)) ^ (r >> 3)) & 7) << 3));
}
constexpr int VT_STRIDE = 72, QK_STRIDE = 136;
__device__ __forceinline__ void s1_phase(const Ctx& F, LAS unsigned char* lds, int l) {
    const int j = l >> 1;
    LAS bf16r* VT = (LAS bf16r*)lds;
    LAS bf16r* KT = (LAS bf16r*)(lds + 36864);
    LAS float* wS = (LAS float*)(lds + 36864 + 18432);
    const bf16r* P = (const bf16r*)(F.ws + WS_P); const float* GT = (const float*)(F.ws + WS_GATES);
    float* BCUM = (float*)(F.ws + WS_BCUM); float* LOGI = (float*)(F.ws + WS_LOGI); float* BLAST = (float*)(F.ws + WS_SCAL); float* MLOC = BLAST + 16384;
    float* NLOC = (float*)(F.ws + WS_NLOC); bf16r* U = (bf16r*)(F.ws + WS_U);
    const float* cw = ((const float*)F.ka->in[9]) + (size_t)j * 4096; const float* cb = ((const float*)F.ka->in[10]) + (size_t)j * 1024; const float* bif = ((const float*)F.ka->in[11]) + j * 8;
    for (int u = F.wg; u < 1024; u += F.G) {
        const int b = u >> 9, h = (u >> 7) & 3, c = u & 127, bh = b * 4 + h;
        const size_t m0 = (size_t)b * 8192 + c * 64;
        if (F.wave == 0) {
            const int s = F.lane;
            const float gi = GT[(m0 + s) * 8 + h] + bif[h], gf = GT[(m0 + s) * 8 + 4 + h] + bif[4 + h];
            const float lf = fminf(gf, 0.f) - log1pf(expf(-fabsf(gf)));
            float bc = lf;
#pragma unroll
            for (int o = 1; o < 64; o <<= 1) { const float t = lane_up(bc, s, o); if (s >= o) bc += t; }
            const float blast = __builtin_bit_cast(float, __builtin_amdgcn_readlane(__builtin_bit_cast(int, bc), 63));
            const float wl = blast - bc + gi;
            const float mloc = wave_max(wl);
            wS[s] = __expf(wl - mloc);
            BCUM[(size_t)bh * 8192 + c * 64 + s] = bc; LOGI[(size_t)bh * 8192 + c * 64 + s] = gi;
            if (s == 0) { BLAST[bh * 128 + c] = blast; MLOC[bh * 128 + c] = mloc; }
        }
        __syncthreads();
        {
            const int cg = F.tid & 15, s0 = F.tid >> 4, vg = F.tid & 31, sv0 = F.tid >> 5, kch = 512 + h * 128 + cg * 8;
            v4u rk[2][4], rv[4];
#pragma unroll
            for (int i = 0; i < 2; ++i) conv_load(P, m0 + s0 + 32 * i, c * 64 + s0 + 32 * i, kch, rk[i]);
#pragma unroll
            for (int i = 0; i < 4; ++i) rv[i] = *(const v4u*)(P + (m0 + sv0 + 16 * i) * 3072 + 1024 + h * 256 + vg * 8);
            f32x4 cwv[4][2], cbv[2]; conv_weights(cw, cb, kch, cwv, cbv);
#pragma unroll
            for (int i = 0; i < 2; ++i) { const int s = s0 + 32 * i; float kv[8]; conv_apply(rk[i], cwv, cbv, 0.08838834764831845f, kv);
                const float w = wS[s];
#pragma unroll
                for (int e2 = 0; e2 < 8; ++e2) KT[vt_idx(cg * 8, s) + e2 * 72] = (bf16r)f2bf(kv[e2] * w); }
#pragma unroll
            for (int i = 0; i < 4; ++i) vt_scatter(VT, vg * 8, sv0 + 16 * i, rv[i]);
        }
        __syncthreads();
        { const int d = F.tid >> 2, q4 = F.tid & 3; float s = 0.f;
#pragma unroll
          for (int e = 0; e < 16; ++e) s += bf2f(KT[vt_idx(d, q4 * 16 + e)]);
          s += swz_xor<1>(s); s += swz_xor<2>(s);
          if (q4 == 0) NLOC[(size_t)u * 128 + d] = s; }
        {
            f32x4 acc[2][8];
#pragma unroll
            for (int mt = 0; mt < 2; ++mt)
#pragma unroll
                for (int nt = 0; nt < 8; ++nt) acc[mt][nt] = (f32x4){0.f, 0.f, 0.f, 0.f};
#pragma unroll
            for (int ks = 0; ks < 2; ++ks) {
                bf16x8 av[2];
#pragma unroll
                for (int mt = 0; mt < 2; ++mt) av[mt] = ldfrag_sw(VT, 32 * F.wave + 16 * mt, ks * 32, F.lane);
#pragma unroll
                for (int nt = 0; nt < 8; ++nt) { const bf16x8 bk = ldfrag_sw(KT, 16 * nt, ks * 32, F.lane);
#pragma unroll
                    for (int mt = 0; mt < 2; ++mt) acc[mt][nt] = __builtin_amdgcn_mfma_f32_16x16x32_bf16(bk, av[mt], acc[mt][nt], 0, 0, 0); }
            }
            bf16r* up = U + (size_t)u * 32768;
#pragma unroll
            for (int mt = 0; mt < 2; ++mt)
#pragma unroll
                for (int nt = 0; nt < 8; ++nt) { v2u w; w.x = pk2(acc[mt][nt][0], acc[mt][nt][1]); w.y = pk2(acc[mt][nt][2], acc[mt][nt][3]);
                    *(v2u*)(up + (size_t)(32 * F.wave + 16 * mt + (F.lane & 15)) * 128 + 16 * nt + 4 * (F.lane >> 4)) = w; }
        }
        __syncthreads();
    }
}
__device__ __forceinline__ void s2_phase(const Ctx& F, LAS unsigned char* lds) {
    const float* BLAST = (const float*)(F.ws + WS_SCAL); const float* MLOC = BLAST + 16384; float* MST = (float*)(F.ws + WS_SCAL) + 32768;
    const bf16r* U = (const bf16r*)(F.ws + WS_U); const float* NLOC = (const float*)(F.ws + WS_NLOC); float* NST = (float*)(F.ws + WS_NST); bf16r* CST = (bf16r*)(F.ws + WS_CST);
    LAS float* decS = (LAS float*)lds; LAS float* gainS = decS + 128;
    for (int w = F.wg; w < 256; w += F.G) {
        const int bh = w >> 5, slice = w & 31;
        if (F.tid == 0) { float m = 0.f;
            for (int c = 0; c < 128; ++c) { const int unit = bh * 128 + c; const float bl = BLAST[unit], ml = MLOC[unit], mn = fmaxf(bl + m, ml);
                decS[c] = expf(bl + m - mn); gainS[c] = expf(ml - mn); if (slice == 0) MST[unit] = m; m = mn; } }
        __syncthreads();
        const size_t e2 = (size_t)slice * 1024 + F.tid * 2;
        float s0 = 0.f, s1 = 0.f;
        for (int c0 = 0; c0 < 128; c0 += 16) {
            unsigned uv[16];
#pragma unroll
            for (int i = 0; i < 16; ++i) uv[i] = *(const unsigned*)(U + (size_t)(bh * 128 + c0 + i) * 32768 + e2);
#pragma unroll
            for (int i = 0; i < 16; ++i) { const int c = c0 + i;
                *(unsigned*)(CST + (size_t)(bh * 128 + c) * 32768 + e2) = pk2(s0, s1);
                const float dec = decS[c], gain = gainS[c];
                s0 = s0 * dec + bflo(uv[i]) * gain; s1 = s1 * dec + bfhi(uv[i]) * gain; }
        }
        if (slice == 0 && F.tid < 128) { float s = 0.f;
            for (int c0 = 0; c0 < 128; c0 += 16) { float nv[16];
#pragma unroll
                for (int i = 0; i < 16; ++i) nv[i] = NLOC[(size_t)(bh * 128 + c0 + i) * 128 + F.tid];
#pragma unroll
                for (int i = 0; i < 16; ++i) { const int c = c0 + i; NST[(size_t)(bh * 128 + c) * 128 + F.tid] = s; s = s * decS[c] + nv[i] * gainS[c]; } } }
        __syncthreads();
    }
}
__device__ __forceinline__ void s3_phase(const Ctx& F, LAS unsigned char* lds, int l) {
    const int j = l >> 1;
    LAS bf16r* VT = (LAS bf16r*)lds;
    LAS bf16r* Qs = (LAS bf16r*)(lds + 36864);
    LAS bf16r* Ks = (LAS bf16r*)(lds + 36864 + 17408);
    LAS bf16r* Sw = (LAS bf16r*)(lds + 36864 + 34816);
    LAS float* fa = (LAS float*)(lds + 36864 + 34816 + 9216);
    LAS float* bS = fa, *zS = fa + 64, *mtS = fa + 128, *inS = fa + 192, *dnS = fa + 256, *nS = fa + 320  , *sqS = fa + 448  ;
    const bf16r* P = (const bf16r*)(F.ws + WS_P);
    const float* BCUM = (const float*)(F.ws + WS_BCUM); const float* LOGI = (const float*)(F.ws + WS_LOGI); const float* MST = (const float*)(F.ws + WS_SCAL) + 32768;
    const float* NST = (const float*)(F.ws + WS_NST); const bf16r* CST = (const bf16r*)(F.ws + WS_CST); bf16r* Y = (bf16r*)(F.ws + WS_Y);
    const float* cw = ((const float*)F.ka->in[9]) + (size_t)j * 4096; const float* cb = ((const float*)F.ka->in[10]) + (size_t)j * 1024; const float* ng = ((const float*)F.ka->in[12]) + (size_t)j * 1024;
    const int lane = F.lane, w = F.wave, fr = lane & 15, fq = lane >> 4;
    for (int u = F.wg; u < 1024; u += F.G) {
        const int b = u >> 9, h = (u >> 7) & 3, c = u & 127, bh = b * 4 + h;
        const size_t m0 = (size_t)b * 8192 + c * 64;
        bf16x8 cf[2][4];
#pragma unroll
        for (int nt = 0; nt < 2; ++nt)
#pragma unroll
            for (int ks = 0; ks < 4; ++ks) cf[nt][ks] = *(const bf16x8*)(CST + (size_t)u * 32768 + (size_t)(32 * w + 16 * nt + fr) * 128 + ks * 32 + fq * 8);
        if (w == 0) {
            const int s = lane;
            const float bs = BCUM[(size_t)bh * 8192 + c * 64 + s], li = LOGI[(size_t)bh * 8192 + c * 64 + s], mc = MST[bh * 128 + c];
            const float a = bs + mc, z = li - bs;
            float pm = z;
#pragma unroll
            for (int o = 1; o < 64; o <<= 1) { const float t = lane_up(pm, s, o); if (s >= o) pm = fmaxf(pm, t); }
            const float mt = fmaxf(a, bs + pm);
            bS[s] = bs; zS[s] = z; mtS[s] = mt; inS[s] = __expf(a - mt);
        } else if (w <= 2) { const int d = (w - 1) * 64 + lane; nS[d] = NST[(size_t)u * 128 + d]; }
        {
            const int cg = F.tid & 15, s0 = F.tid >> 4, vg = F.tid & 31, sv0 = F.tid >> 5, qch = h * 128 + cg * 8, kch = 512 + qch;
            v4u rq[2][4], rk[2][4], rv[4];
#pragma unroll
            for (int i = 0; i < 2; ++i) { conv_load(P, m0 + s0 + 32 * i, c * 64 + s0 + 32 * i, qch, rq[i]); conv_load(P, m0 + s0 + 32 * i, c * 64 + s0 + 32 * i, kch, rk[i]); }
#pragma unroll
            for (int i = 0; i < 4; ++i) rv[i] = *(const v4u*)(P + (m0 + sv0 + 16 * i) * 3072 + 1024 + h * 256 + vg * 8);
            { f32x4 cwv[4][2], cbv[2]; conv_weights(cw, cb, qch, cwv, cbv);
#pragma unroll
              for (int i = 0; i < 2; ++i) { float kv[8]; conv_apply(rq[i], cwv, cbv, 1.0f, kv);
                  v4u o; o.x = pk2(kv[0], kv[1]); o.y = pk2(kv[2], kv[3]); o.z = pk2(kv[4], kv[5]); o.w = pk2(kv[6], kv[7]); *(LAS v4u*)(Qs + (s0 + 32 * i) * QK_STRIDE + cg * 8) = o; } }
            { f32x4 cwv[4][2], cbv[2]; conv_weights(cw, cb, kch, cwv, cbv);
#pragma unroll
              for (int i = 0; i < 2; ++i) { float kv[8]; conv_apply(rk[i], cwv, cbv, 0.08838834764831845f, kv);
                  v4u o; o.x = pk2(kv[0], kv[1]); o.y = pk2(kv[2], kv[3]); o.z = pk2(kv[4], kv[5]); o.w = pk2(kv[6], kv[7]); *(LAS v4u*)(Ks + (s0 + 32 * i) * QK_STRIDE + cg * 8) = o; } }
#pragma unroll
            for (int i = 0; i < 4; ++i) vt_scatter(VT, vg * 8, sv0 + 16 * i, rv[i]);
        }
#if S3_REP > 1
        __syncthreads();
        {
            const int cg = F.tid & 15, s0 = F.tid >> 4, vg = F.tid & 31, sv0 = F.tid >> 5, qch = h * 128 + cg * 8, kch = 512 + qch;
            v4u rq[2][4], rk[2][4], rv[4];
#pragma unroll
            for (int i = 0; i < 2; ++i) { conv_load(P, m0 + s0 + 32 * i, c * 64 + s0 + 32 * i, qch, rq[i]); conv_load(P, m0 + s0 + 32 * i, c * 64 + s0 + 32 * i, kch, rk[i]); }
#pragma unroll
            for (int i = 0; i < 4; ++i) rv[i] = *(const v4u*)(P + (m0 + sv0 + 16 * i) * 3072 + 1024 + h * 256 + vg * 8);
            { f32x4 cwv[4][2], cbv[2]; conv_weights(cw, cb, qch, cwv, cbv);
#pragma unroll
              for (int i = 0; i < 2; ++i) { float kv[8]; conv_apply(rq[i], cwv, cbv, 1.0f, kv);
                  v4u o; o.x = pk2(kv[0], kv[1]); o.y = pk2(kv[2], kv[3]); o.z = pk2(kv[4], kv[5]); o.w = pk2(kv[6], kv[7]); *(LAS v4u*)(Qs + (s0 + 32 * i) * QK_STRIDE + cg * 8) = o; } }
            { f32x4 cwv[4][2], cbv[2]; conv_weights(cw, cb, kch, cwv, cbv);
#pragma unroll
              for (int i = 0; i < 2; ++i) { float kv[8]; conv_apply(rk[i], cwv, cbv, 0.08838834764831845f, kv);
                  v4u o; o.x = pk2(kv[0], kv[1]); o.y = pk2(kv[2], kv[3]); o.z = pk2(kv[4], kv[5]); o.w = pk2(kv[6], kv[7]); *(LAS v4u*)(Ks + (s0 + 32 * i) * QK_STRIDE + cg * 8) = o; } }
#pragma unroll
            for (int i = 0; i < 4; ++i) vt_scatter(VT, vg * 8, sv0 + 16 * i, rv[i]);
        }
#endif
        __syncthreads();
        {
            const int tt = w >> 1;
            const int t = 16 * tt + fr; const float bt = bS[t], mt = mtS[t];
#pragma unroll
            for (int i = 0; i < 2; ++i) {
                const int st = 2 * (w & 1) + i;
                f32x4 acc = {0.f, 0.f, 0.f, 0.f};
                if (st <= tt) {
#pragma unroll
                    for (int ks = 0; ks < 4; ++ks) acc = __builtin_amdgcn_mfma_f32_16x16x32_bf16(ldfrag(Ks, 16 * st, QK_STRIDE, ks * 32, lane), ldfrag(Qs, 16 * tt, QK_STRIDE, ks * 32, lane), acc, 0, 0, 0);
                }
                float o[4];
#pragma unroll
                for (int e = 0; e < 4; ++e) { const int s = 16 * st + 4 * fq + e; o[e] = (s <= t) ? acc[e] * __expf(bt + zS[s] - mt) : 0.f; }
                v2u pw; pw.x = pk2(o[0], o[1]); pw.y = pk2(o[2], o[3]);
                *(LAS v2u*)(Sw + t * VT_STRIDE + 16 * st + 4 * fq) = pw;
            }
        }
        __syncthreads();
        { const int t = F.tid >> 3, part = F.tid & 7; float rsum = 0.f, qn = 0.f;
#pragma unroll
          for (int e = 0; e < 8; ++e) rsum += bf2f(Sw[t * VT_STRIDE + part * 8 + e]);
#pragma unroll
          for (int e = 0; e < 16; ++e) qn += bf2f(Qs[t * QK_STRIDE + part * 16 + e]) * nS[part * 16 + e];
          rsum += swz_xor<1>(rsum); rsum += swz_xor<2>(rsum); rsum += swz_xor<4>(rsum);
          qn += swz_xor<1>(qn); qn += swz_xor<2>(qn); qn += swz_xor<4>(qn);
          if (part == 0) { const float den = inS[t] * qn + rsum; dnS[t] = __builtin_amdgcn_rcpf(fmaxf(fabsf(den), __expf(-mtS[t]))); } }
        f32x4 a1[4][2], a2[4][2];
#pragma unroll
        for (int mt = 0; mt < 4; ++mt)
#pragma unroll
            for (int nt = 0; nt < 2; ++nt) { a1[mt][nt] = (f32x4){0.f, 0.f, 0.f, 0.f}; a2[mt][nt] = (f32x4){0.f, 0.f, 0.f, 0.f}; }
#pragma unroll
        for (int ks = 0; ks < 4; ++ks)
#pragma unroll
            for (int mt = 0; mt < 4; ++mt) { const bf16x8 qf = ldfrag(Qs, 16 * mt, QK_STRIDE, ks * 32, lane);
#pragma unroll
                for (int nt = 0; nt < 2; ++nt) a1[mt][nt] = __builtin_amdgcn_mfma_f32_16x16x32_bf16(cf[nt][ks], qf, a1[mt][nt], 0, 0, 0); }
#pragma unroll
        for (int ks = 0; ks < 2; ++ks) {
            bf16x8 vf[2];
#pragma unroll
            for (int nt = 0; nt < 2; ++nt) vf[nt] = ldfrag_sw(VT, 32 * w + 16 * nt, ks * 32, lane);
#pragma unroll
            for (int mt = 0; mt < 4; ++mt) { const bf16x8 sf = ldfrag(Sw, 16 * mt, VT_STRIDE, ks * 32, lane);
#pragma unroll
                for (int nt = 0; nt < 2; ++nt) a2[mt][nt] = __builtin_amdgcn_mfma_f32_16x16x32_bf16(vf[nt], sf, a2[mt][nt], 0, 0, 0); }
        }
        v2u owv[4][2]; f32x4 gv[2];
#pragma unroll
        for (int mt = 0; mt < 4; ++mt)
#pragma unroll
            for (int nt = 0; nt < 2; ++nt) owv[mt][nt] = *(const v2u*)(P + (m0 + 16 * mt + fr) * 3072 + 2048 + h * 256 + 32 * w + 16 * nt + 4 * fq);
#pragma unroll
        for (int nt = 0; nt < 2; ++nt) gv[nt] = *(const f32x4*)(ng + h * 256 + 32 * w + 16 * nt + 4 * fq);
        __syncthreads();
#pragma unroll
        for (int mt = 0; mt < 4; ++mt) {
            const int t = 16 * mt + fr; const float it = inS[t], dn = dnS[t]; float ss = 0.f;
#pragma unroll
            for (int nt = 0; nt < 2; ++nt) { a1[mt][nt] = (a1[mt][nt] * it + a2[mt][nt]) * dn;
                ss += (a1[mt][nt][0] * a1[mt][nt][0] + a1[mt][nt][1] * a1[mt][nt][1]) + (a1[mt][nt][2] * a1[mt][nt][2] + a1[mt][nt][3] * a1[mt][nt][3]); }
            ss += swz_xor<16>(ss); ss = sum_x32(ss);
            if (fq == 0) sqS[w * 64 + t] = ss;
        }
        __syncthreads();
#pragma unroll
        for (int mt = 0; mt < 4; ++mt) {
            const int t = 16 * mt + fr; float tot = 0.f;
#pragma unroll
            for (int ww = 0; ww < 8; ++ww) tot += sqS[ww * 64 + t];
            const float r = rsqrtf(tot * (1.0f / 256.0f) + EPS);
#pragma unroll
            for (int nt = 0; nt < 2; ++nt) {
                const int vv = 32 * w + 16 * nt + 4 * fq;
                const v2u ow = owv[mt][nt];
                const f32x4 g = gv[nt];
                const float o0 = bflo(ow.x), o1 = bfhi(ow.x), o2 = bflo(ow.y), o3 = bfhi(ow.y);
                const f32x4 hv = a1[mt][nt] * r * g;
                v2u yw; yw.x = pk2(hv[0] * __builtin_amdgcn_rcpf(1.0f + __expf(-o0)), hv[1] * __builtin_amdgcn_rcpf(1.0f + __expf(-o1)));
                yw.y = pk2(hv[2] * __builtin_amdgcn_rcpf(1.0f + __expf(-o2)), hv[3] * __builtin_amdgcn_rcpf(1.0f + __expf(-o3)));
                *(v2u*)(Y + (m0 + t) * 1024 + h * 256 + vv) = yw;
            }
        }
        __syncthreads();
    }
}
__device__ __forceinline__ att::BlockRef<att::bf16, att::bf16> attn_ref(int item, int grp, int pass, const att::bf16* Qb, const att::bf16* Kb, const att::bf16* Vb, att::bf16* Ob) {
    const int pc = item & 3, y = item >> 2, qb = pass ? 31 - y : y;
    const int b = grp >> 2, h = grp & 3, c = pc >> 1, vh = pc & 1, hd = ((b * 4 + h) * 2 + c) * 2 + vh;
    att::BlockRef<att::bf16, att::bf16> r;
    r.Q = Qb + ((size_t)(b * 8 + h * 2 + c) * 8192 + (size_t)qb * 256) * 128;
    r.K = Kb + (size_t)(b * 8 + h * 2 + c) * 8192 * 128;
    r.V = Vb + (size_t)(b * 8 + h * 2 + vh) * 8192 * 128;
    r.O = Ob + ((size_t)hd * 8192 + (size_t)qb * 256) * 128;
    r.P0 = qb * 256;
    return r;
}
__device__ __forceinline__ void attn_phase(const Ctx& F, char* lds) {
    const att::bf16* Qb = (const att::bf16*)(F.ws + WS_P); const att::bf16* Kb = Qb + 16777216; const att::bf16* Vb = Kb + 16777216; att::bf16* Ob = (att::bf16*)(F.ws + WS_O);
    constexpr int total = 512; const int stride = F.G;
    int L = F.wg; if (L >= total) return;
    int pass = 0;
#define ATT_ITEM(L_) (((L_) >> 3) & 63)
#define ATT_GRP(L_) ((L_) & 7)
    att::BlockRef<att::bf16, att::bf16> cur = attn_ref(ATT_ITEM(L), ATT_GRP(L), 0, Qb, Kb, Vb, Ob);
    att::Seam<att::bf16> S;
    att::causal_swa_prime<att::bf16, att::bf16>(cur, 8192, lds, S, F.tid);
    for (;;) {
        const bool more_pass = pass == 0, more_item = L + stride < total, last = !more_pass && !more_item;
        int passn = pass + 1, Ln = L;
        if (!more_pass) { passn = 0; Ln = more_item ? L + stride : L; }
        const att::BlockRef<att::bf16, att::bf16> nxt = last ? cur : attn_ref(ATT_ITEM(Ln), ATT_GRP(Ln), passn, Qb, Kb, Vb, Ob);
        att::causal_swa_block<att::bf16, att::bf16>(cur, nxt, 8192, 8192, lds, S, F.tid);
        if (last) break;
        cur = nxt; pass = passn; L = Ln;
    }
#undef ATT_ITEM
#undef ATT_GRP
}
__device__ __forceinline__ void combine_phase(const Ctx& F, int l) {
    const int j = l >> 1;
    const bf16r* Ob = (const bf16r*)(F.ws + WS_O); bf16r* Y = (bf16r*)(F.ws + WS_Y);
    const float lam = ((const float*)(F.ws + WS_LAM))[j];
    const float omi = 1.0f - (j == 0 ? 0.35550906759096934f : 0.5560582041556406f);
    const float* ng = ((const float*)F.ka->in[16]) + j * 256;
    const int gw = F.wg * NWAVES + F.wave, NGW = F.G * NWAVES;
    const int vv = F.lane * 4, vh = vv >> 7, dd = vv & 127;
    const f32x4 g = *(const f32x4*)(ng + vv);
    for (int task = gw; task < M * 4; task += NGW) {
        const int m = task >> 2, h = task & 3, b = m >> 13, s = m & 8191;
        const int hd0 = ((b * 4 + h) * 2 + 0) * 2 + vh, hd1 = hd0 + 2;
        const v2u w0 = *(const v2u*)(Ob + ((size_t)hd0 * 8192 + s) * 128 + dd), w1 = *(const v2u*)(Ob + ((size_t)hd1 * 8192 + s) * 128 + dd);
        f32x4 o = {bflo(w0.x) - lam * bflo(w1.x), bfhi(w0.x) - lam * bfhi(w1.x), bflo(w0.y) - lam * bflo(w1.y), bfhi(w0.y) - lam * bfhi(w1.y)};
        const float ss = wave_sum((o[0] * o[0] + o[1] * o[1]) + (o[2] * o[2] + o[3] * o[3]));
        const float r = rsqrtf(ss * (1.0f / 256.0f) + EPS) * omi;
        o = o * r * g;
        v2u yw; yw.x = pk2(o[0], o[1]); yw.y = pk2(o[2], o[3]);
        *(v2u*)(Y + (size_t)m * 1024 + h * 256 + vv) = yw;
    }
}
__device__ __forceinline__ void final_phase(const Ctx& F) {
    const float* ssqp = (const float*)(F.ws + WS_SSQP);
    const int gw = F.wg * NWAVES + F.wave, NGW = F.G * NWAVES;
    for (int m = gw; m < M; m += NGW) {
        float ss = F.lane < 16 ? ssqp[(size_t)F.lane * M + m] : 0.f; ss = wave_sum(ss);
        const float rs = rsqrtf(ss * (1.0f / 1024.0f) + EPS);
        f32x4* orow = (f32x4*)(F.out + (size_t)m * 1024) + F.lane;
#pragma unroll
        for (int jj = 0; jj < 4; ++jj) { const f32x4 g = *(const f32x4*)(((const float*)F.ka->in[18]) + 4 * F.lane + 256 * jj); orow[64 * jj] = orow[64 * jj] * rs * g; }
    }
}

#if MK_DEBUG
#ifndef DBG_SET
#define DBG_SET 0
#endif
__device__ __forceinline__ void dbg_flag(const Ctx& F, bool bad, unsigned code) {
    int bit = -1;
    switch (code) { case 30: bit = 0; break; case 8: case 31: case 9: bit = 1; break; case 10: bit = 2; break; case 11: bit = 3; break; case 13: case 14: case 15: bit = 4; break;
                    case 16: case 17: bit = 5; break; case 18: bit = 6; break; case 19: bit = 7; break; case 20: bit = 8; break; case 21: bit = 9; break; case 23: bit = 10; break; default: break; }
    if (bad && bit >= 0) atomicOr((unsigned*)(F.ws + 64), 1u << bit);
}
__device__ __forceinline__ bool dbg_ne(float got, float ref) { return !(fabsf(got - ref) <= 0.03f * fabsf(ref) + 0.03f); }
__device__ __forceinline__ unsigned dbg_hash(unsigned i) { i = i * 2654435761u + 12345u; i ^= i >> 15; i *= 2246822519u; i ^= i >> 13; i *= 3266489917u; i ^= i >> 16; return i; }
__device__ __forceinline__ float dbg_rstd(const Ctx& F, int m) { const float* ssqp = (const float*)(F.ws + WS_SSQP); float s = 0.f; for (int p = 0; p < 16; ++p) s += ssqp[(size_t)p * M + m]; return rsqrtf(s * (1.0f / 1024.0f) + EPS); }
__device__ __forceinline__ float dbg_silu(float g) { return g / (1.0f + expf(-g)); }
__device__ __forceinline__ void dbg_check_p0(const Ctx& F) {
    if (F.wg != 0) return;
    const unsigned r = dbg_hash(F.tid);
    const float* ADA = (const float*)(F.ws + WS_ADA);
    { const float t = wave_sum((float)(F.lane + 1)), t2 = wave_max((float)((F.lane * 37) & 63)); dbg_flag(F, t != 2080.0f || t2 != 63.0f, 30); }
    { const int l = r % 4, b = (r >> 2) & 1, j = (r >> 3) % 9216; float ref = ((const float*)F.ka->in[4])[(size_t)l * 9216 + j];
      for (int k = 0; k < 1024; ++k) ref += dbg_silu(((const float*)F.ka->in[1])[b * 1024 + k]) * ((const float*)F.ka->in[3])[((size_t)l * 1024 + k) * 9216 + j];
      dbg_flag(F, dbg_ne(ADA[(size_t)(l * 2 + b) * 9216 + j], ref), 1); }
    { const int mat = r % 8, k = (r >> 3) % 1024, n = (r >> 13) % 5632; const float src = ((const float*)F.ka->in[6])[((size_t)mat * 1024 + k) * 5632 + n];
      const int drow = n < 2816 ? (n >> 7) * 256 + (n & 127) : ((n - 2816) >> 7) * 256 + 128 + ((n - 2816) & 127);
      dbg_flag(F, dbg_ne(bf2f(((const bf16r*)(F.ws + WS_W13))[((size_t)mat * 5632 + drow) * 1024 + k]), src), 2); }
    { const int mat = r % 8, k = (r >> 3) % 2816, n = (r >> 15) % 1024; const float src = ((const float*)F.ka->in[7])[((size_t)mat * 2816 + k) * 1024 + n];
      dbg_flag(F, dbg_ne(bf2f(((const bf16r*)(F.ws + WS_W2))[((size_t)mat * 1024 + n) * 2816 + k]), src), 3); }
    { const int mat = r % 2, k = (r >> 1) % 1024, n = (r >> 11) % 3072; const float src = ((const float*)F.ka->in[8])[((size_t)mat * 1024 + k) * 3080 + n];
      dbg_flag(F, dbg_ne(bf2f(((const bf16r*)(F.ws + WS_WINA))[((size_t)mat * 3072 + n) * 1024 + k]), src), 4); }
    { const int mat = r % 2, k = (r >> 1) % 1024, n = (r >> 11) % 3072; const float src = ((const float*)F.ka->in[14])[((size_t)mat * 1024 + k) * 3072 + n];
      dbg_flag(F, dbg_ne(bf2f(((const bf16r*)(F.ws + WS_WINB))[((size_t)mat * 3072 + n) * 1024 + k]), src), 5); }
    { const int mat = r % 2, k = (r >> 1) % 1024, n = (r >> 11) % 1024; const float sa = ((const float*)F.ka->in[13])[((size_t)mat * 1024 + k) * 1024 + n], sb = ((const float*)F.ka->in[17])[((size_t)mat * 1024 + k) * 1024 + n];
      dbg_flag(F, dbg_ne(bf2f(((const bf16r*)(F.ws + WS_WOA))[((size_t)mat * 1024 + n) * 1024 + k]), sa) || dbg_ne(bf2f(((const bf16r*)(F.ws + WS_WOB))[((size_t)mat * 1024 + n) * 1024 + k]), sb), 6); }
}
__device__ __forceinline__ void dbg_check_p1(const Ctx& F) {
    if (F.wg != 0) return;
    const unsigned r = dbg_hash(F.tid + 1000);
    const float* ADA = (const float*)(F.ws + WS_ADA);
    { const int m = r % 16384, col = (r >> 14) % 1024, b = m >> 13;
      const float ref = ((const float*)F.ka->in[0])[(size_t)m * 1024 + col] * ((const float*)F.ka->in[5])[col] * (1.0f + ADA[(size_t)b * 9216 + 1024 + col]);
      dbg_flag(F, dbg_ne(bf2f(((const bf16r*)(F.ws + WS_XS))[(size_t)m * 1024 + col]), ref) || dbg_ne(F.out[(size_t)m * 1024 + col], ((const float*)F.ka->in[0])[(size_t)m * 1024 + col]), 7); }
    { const int q = r % 8, b = (r >> 3) & 1, n = (r >> 4) % 5632, l = q >> 1, f = q & 1; float ref = 0.f;
      for (int k = 0; k < 1024; ++k) ref += ADA[(size_t)(l * 2 + b) * 9216 + (f ? 2 : 0) * 3072 + k] * bf2f(((const bf16r*)(F.ws + WS_W13))[((size_t)q * 5632 + n) * 1024 + k]);
      dbg_flag(F, dbg_ne(((const float*)(F.ws + WS_SWF))[(size_t)(q * 2 + b) * 5632 + n], ref), b ? 31 : 8); }
    { const int l = r % 4, b = (r >> 2) & 1, n = (r >> 3) % 3072; const bf16r* W = (const bf16r*)(F.ws + ((l & 1) ? WS_WINB : WS_WINA)) + ((size_t)(l >> 1) * 3072 + n) * 1024; float ref = 0.f;
      for (int k = 0; k < 1024; ++k) ref += ADA[(size_t)(l * 2 + b) * 9216 + 3072 + k] * bf2f(W[k]);
      dbg_flag(F, dbg_ne(((const float*)(F.ws + WS_SWM))[(size_t)(l * 2 + b) * 3072 + n], ref), 9); }
    { const int m = r % 16384; float s = 0.f; for (int k = 0; k < 1024; ++k) { const float v = ((const float*)F.ka->in[0])[(size_t)m * 1024 + k]; s += v * v; }
      const float rs = rsqrtf(s * (1.0f / 1024.0f) + EPS); dbg_flag(F, fabsf(dbg_rstd(F, m) - rs) > 1e-3f * rs, 10); }
}
__device__ __forceinline__ void dbg_check_up(const Ctx& F) {
    if (F.wg != 0) return;
    const unsigned r = dbg_hash(F.tid + 2000);
    const int m = r % 16384, n = (r >> 14) % 2816, b = m >> 13, grow = (n >> 7) * 256 + (n & 127), urow = grow + 128;
    const float rs = dbg_rstd(F, m); const bf16r* XS = (const bf16r*)(F.ws + WS_XS) + (size_t)m * 1024; const bf16r* W = (const bf16r*)(F.ws + WS_W13);
    float g = 0.f, u = 0.f;
    for (int k = 0; k < 1024; ++k) { const float xv = bf2f(XS[k]); g += xv * bf2f(W[(size_t)grow * 1024 + k]); u += xv * bf2f(W[(size_t)urow * 1024 + k]); }
    const float* SWF = (const float*)(F.ws + WS_SWF) + (size_t)b * 5632;
    g = g * rs + SWF[grow]; u = u * rs + SWF[urow];
    dbg_flag(F, dbg_ne(bf2f(((const bf16r*)(F.ws + WS_H))[(size_t)m * 2816 + n]), dbg_silu(g) * u), 11);
}
__device__ __forceinline__ void dbg_check_down(const Ctx& F) {
    if (F.wg != 0) return;
    const unsigned r = dbg_hash(F.tid + 3000);
    const int m = r % 16384, n = (r >> 14) % 1024, b = m >> 13;
    const bf16r* H = (const bf16r*)(F.ws + WS_H) + (size_t)m * 2816; const bf16r* W = (const bf16r*)(F.ws + WS_W2) + (size_t)n * 2816;
    float d = 0.f; for (int k = 0; k < 2816; ++k) d += bf2f(H[k]) * bf2f(W[k]);
    const float* ADA = (const float*)(F.ws + WS_ADA);
    const float ref = ((const float*)F.ka->in[0])[(size_t)m * 1024 + n] + 0.5f * ADA[(size_t)b * 9216 + 2048 + n] * d, got = F.out[(size_t)m * 1024 + n];
    dbg_flag(F, dbg_ne(got, ref), 13);
    dbg_flag(F, dbg_ne(bf2f(((const bf16r*)(F.ws + WS_XS))[(size_t)m * 1024 + n]), got * ((const float*)(F.ws + WS_GS))[(size_t)(0 * 3 + 1) * 2048 + b * 1024 + n]), 14);
    float s = 0.f; for (int k = 0; k < 1024; ++k) { const float v = F.out[(size_t)m * 1024 + k]; s += v * v; }
    const float rs = rsqrtf(s * (1.0f / 1024.0f) + EPS); dbg_flag(F, fabsf(dbg_rstd(F, m) - rs) > 1e-3f * rs, 15);
}
__device__ __forceinline__ float dbg_inproj(const Ctx& F, int l, int m, int n) {
    const int b = m >> 13; const float rs = dbg_rstd(F, m);
    const bf16r* XS = (const bf16r*)(F.ws + WS_XS) + (size_t)m * 1024; const bf16r* W = (const bf16r*)(F.ws + ((l & 1) ? WS_WINB : WS_WINA)) + ((size_t)(l >> 1) * 3072 + n) * 1024;
    float a = 0.f; for (int k = 0; k < 1024; ++k) a += bf2f(XS[k]) * bf2f(W[k]);
    return a * rs + ((const float*)(F.ws + WS_SWM))[(size_t)(l * 2 + b) * 3072 + n];
}
__device__ __forceinline__ void dbg_check_inproj0(const Ctx& F) {
    if (F.wg != 0) return;
    const unsigned r = dbg_hash(F.tid + 4000);
    const int m = r % 16384, n = (r >> 14) % 3072, b = m >> 13;
    dbg_flag(F, dbg_ne(bf2f(((const bf16r*)(F.ws + WS_P))[(size_t)m * 3072 + n]), dbg_inproj(F, 0, m, n)), 16);
    const int g = n & 7; const float rs = dbg_rstd(F, m); const bf16r* XS = (const bf16r*)(F.ws + WS_XS) + (size_t)m * 1024; const float* ADA = (const float*)(F.ws + WS_ADA);
    float a = 0.f, sgw = 0.f; for (int k = 0; k < 1024; ++k) { const float w = ((const float*)F.ka->in[8])[(size_t)k * 3080 + 3072 + g]; a += bf2f(XS[k]) * w; sgw += ADA[(size_t)b * 9216 + 3072 + k] * w; }
    dbg_flag(F, dbg_ne(((const float*)(F.ws + WS_GATES))[(size_t)m * 8 + g], a * rs + sgw), 17);
}
__device__ __forceinline__ void dbg_check_inproj1(const Ctx& F) {
    if (F.wg != 0) return;
    const unsigned r = dbg_hash(F.tid + 5000);
    const int m = r % 16384, n = (r >> 14) % 3072, b = m >> 13, s = m & 8191, blk = n >> 7, d = n & 127, which = blk >> 3, idx = blk & 7;
    float ref = dbg_inproj(F, 1, m, n);
    if (which < 2 && d < 32) {
        const int fi = d & 15; const float other = dbg_inproj(F, 1, m, d < 16 ? n + 16 : n - 16);
        const float a = (float)((const int*)F.ka->in[2])[m] * pg8::ROPE_INVF[fi];
        const float kk = rintf(a * 0.15915494309189535f); float rr = fmaf(-kk, 6.2831854820251465f, a); rr = fmaf(-kk, -1.7484555314695172e-07f, rr);
        const float c = __cosf(rr), sn = __sinf(rr);
        ref = d < 16 ? ref * c - other * sn : ref * c + other * sn;
    }
    dbg_flag(F, dbg_ne(bf2f(((const bf16r*)(F.ws + WS_P))[(size_t)which * 16777216 + ((size_t)(b * 8 + idx) * 8192 + s) * 128 + d]), ref), 20);
}
__device__ __forceinline__ void dbg_check_mlstm(const Ctx& F, LAS unsigned char* lds) {
    if (F.wg != 0) return;
    LAS float* C = (LAS float*)lds;
    LAS float* qs = C + 32768, *ks = qs + 128, *vs = ks + 128, *nn = vs + 256, *hv = nn + 128, *red = hv + 256;
    const int h = 1, tid = F.tid;
    const bf16r* P = (const bf16r*)(F.ws + WS_P); const float* GT = (const float*)(F.ws + WS_GATES); const bf16r* Y = (const bf16r*)(F.ws + WS_Y);
    const float* cw = (const float*)F.ka->in[9]; const float* cb = (const float*)F.ka->in[10]; const float* bif = (const float*)F.ka->in[11]; const float* ng = (const float*)F.ka->in[12];
    for (int i = tid; i < 32768; i += 512) C[i] = 0.f;
    if (tid < 128) nn[tid] = 0.f;
    float mstate = 0.f;
    __syncthreads();
    for (int t = 0; t < 160; ++t) {
        if (tid < 256) { const int isk = tid >> 7, d = tid & 127, ch = isk * 512 + h * 128 + d; float a = cb[ch];
            for (int jt = 0; jt < 4; ++jt) if (t - 3 + jt >= 0) a += cw[jt * 1024 + ch] * bf2f(P[(size_t)(t - 3 + jt) * 3072 + ch]);
            a = dbg_silu(a); if (isk) ks[d] = a * 0.08838834764831845f; else qs[d] = a; }
        else { const int v = tid - 256; vs[v] = bf2f(P[(size_t)t * 3072 + 1024 + h * 256 + v]); }
        __syncthreads();
        const float li = GT[(size_t)t * 8 + h] + bif[h], gf = GT[(size_t)t * 8 + 4 + h] + bif[4 + h];
        const float lf = fminf(gf, 0.f) - log1pf(expf(-fabsf(gf)));
        const float mn = fmaxf(lf + mstate, li), fd = expf(lf + mstate - mn), ig = expf(li - mn);
        for (int i = tid; i < 32768; i += 512) { const int v = i >> 7, d = i & 127; C[i] = fd * C[i] + ig * vs[v] * ks[d]; }
        if (tid < 128) nn[tid] = fd * nn[tid] + ig * ks[tid];
        mstate = mn;
        __syncthreads();
        float den = 0.f; for (int d = 0; d < 128; ++d) den += nn[d] * qs[d];
        const float dn = 1.0f / fmaxf(fabsf(den), expf(-mn));
        { const int v = tid >> 1, half = tid & 1; float a = 0.f; for (int d = 0; d < 64; ++d) a += C[v * 128 + half * 64 + d] * qs[half * 64 + d];
          a += swz_xor<1>(a); if (half == 0) hv[v] = a * dn; }
        __syncthreads();
        float ss = 0.f; for (int v = 0; v < 256; ++v) ss += hv[v] * hv[v];
        const float rr = rsqrtf(ss * (1.0f / 256.0f) + EPS);
        if (tid < 256) { const int v = tid; const float o = bf2f(P[(size_t)t * 3072 + 2048 + h * 256 + v]);
            const float ref = hv[v] * rr * ng[h * 256 + v] / (1.0f + expf(-o));
            dbg_flag(F, dbg_ne(bf2f(Y[(size_t)t * 1024 + h * 256 + v]), ref), t < 64 ? 18 : 19); }
        __syncthreads();
    }
}
__device__ __forceinline__ void dbg_check_attn(const Ctx& F) {
    if (F.wg >= 8) return;
    const bf16r* Qb = (const bf16r*)(F.ws + WS_P); const bf16r* Kb = Qb + 16777216; const bf16r* Vb = Kb + 16777216; const bf16r* Ob = (const bf16r*)(F.ws + WS_O);
    const unsigned r = dbg_hash(F.wg * 8 + F.wave + 6000);
    const int hd = r % 32, row = (F.wave == 0) ? (int)((r >> 5) % 300) : (int)((r >> 5) % 8192);
    const int b = hd >> 4, h = (hd >> 2) & 3, c = (hd >> 1) & 1, vh = hd & 1, lane = F.lane;
    const bf16r* q = Qb + ((size_t)(b * 8 + h * 2 + c) * 8192 + row) * 128; const bf16r* K = Kb + (size_t)(b * 8 + h * 2 + c) * 8192 * 128; const bf16r* V = Vb + (size_t)(b * 8 + h * 2 + vh) * 8192 * 128;
    const float q0 = bf2f(q[lane * 2]), q1 = bf2f(q[lane * 2 + 1]);
    float mx = -1e30f, l = 0.f, o0 = 0.f, o1 = 0.f;
    for (int jk = 0; jk <= row; ++jk) {
        float sc = q0 * bf2f(K[(size_t)jk * 128 + lane * 2]) + q1 * bf2f(K[(size_t)jk * 128 + lane * 2 + 1]); sc = wave_sum(sc) * 0.08838834764831845f;
        const float mn = fmaxf(mx, sc), al = expf(mx - mn), p = expf(sc - mn);
        l = l * al + p; o0 = o0 * al + p * bf2f(V[(size_t)jk * 128 + lane * 2]); o1 = o1 * al + p * bf2f(V[(size_t)jk * 128 + lane * 2 + 1]); mx = mn;
    }
    const bf16r* O = Ob + ((size_t)hd * 8192 + row) * 128;
    dbg_flag(F, dbg_ne(bf2f(O[lane * 2]), o0 / l) || dbg_ne(bf2f(O[lane * 2 + 1]), o1 / l), 21);
}
__device__ __forceinline__ void dbg_check_combine(const Ctx& F) {
    if (F.wg != 0) return;
    const unsigned r = dbg_hash(F.tid + 7000);
    const int m = r % 16384, h = (r >> 14) & 3, vv = (r >> 16) & 255, b = m >> 13, s = m & 8191;
    const bf16r* Ob = (const bf16r*)(F.ws + WS_O); const float lam = ((const float*)(F.ws + WS_LAM))[0];
    float ss = 0.f, mine = 0.f;
    for (int v = 0; v < 256; ++v) { const int hd0 = ((b * 4 + h) * 2) * 2 + (v >> 7);
        const float o = bf2f(Ob[((size_t)hd0 * 8192 + s) * 128 + (v & 127)]) - lam * bf2f(Ob[((size_t)(hd0 + 2) * 8192 + s) * 128 + (v & 127)]); ss += o * o; if (v == vv) mine = o; }
    const float ref = mine * rsqrtf(ss * (1.0f / 256.0f) + EPS) * ((const float*)F.ka->in[16])[vv] * (1.0f - 0.35550906759096934f);
    dbg_flag(F, dbg_ne(bf2f(((const bf16r*)(F.ws + WS_Y))[(size_t)m * 1024 + h * 256 + vv]), ref), 23);
}
#endif

constexpr int N_PHASES = 2 + 9 * DEPTH + 1;
constexpr int PH_ATT1 = 2 + 9 * 1 + 3, PH_ATT3 = 2 + 9 * 3 + 3;
#ifndef DBL_MASK
#define DBL_MASK 0
#endif
#ifndef MK_ONE_LAUNCH
#define MK_ONE_LAUNCH 1
#endif
__device__ __forceinline__ Ctx make_ctx(int wave_s) {
    KArgs ka = (KArgs)__builtin_amdgcn_kernarg_segment_ptr();
    asm volatile("" : "+s"(ka));
    Ctx F; F.ka = ka; F.out = ka->out; F.ws = ka->ws;
    { unsigned z0 = 0u; asm volatile("" : "+v"(z0)); const int t0 = wave_s * 64 + (int)__builtin_amdgcn_mbcnt_hi(~0u, __builtin_amdgcn_mbcnt_lo(~0u, z0)); F.tid = t0 & 511; }
    F.lane = F.tid & 63; F.wave = __builtin_amdgcn_readfirstlane(F.tid >> 6);
    { int g0 = gridDim.x, w0 = blockIdx.x; asm volatile("" : "+s"(g0), "+s"(w0)); F.G = g0; F.wg = w0; }
    return F;
}
#define XB_TMO      128
#define XB_XCNT(j)  (256  + 64 * (j))
#define XB_XSUB(j)  (1280 + 64 * (j))
#define XB_XGEN(j)  (2304 + 64 * (j))
#define XB_TOP      3328
#define XB_TOPGEN   3392
#define XCD_BAR_WORDS 3456
#define XB_SPIN_CAP (1u << 18)

__device__ __forceinline__ unsigned xb_ld(unsigned* p)              { return __hip_atomic_load(p, __ATOMIC_RELAXED, __HIP_MEMORY_SCOPE_AGENT); }
__device__ __forceinline__ unsigned xb_add(unsigned* p, unsigned v) { return __hip_atomic_fetch_add(p, v, __ATOMIC_RELAXED, __HIP_MEMORY_SCOPE_AGENT); }
__device__ __forceinline__ unsigned xb_xcc_id() { return (unsigned)__builtin_amdgcn_s_getreg((3 << 11) | 20) & 0xFu; }
#define XB_SPIN(cond, bar) do { unsigned _sp = 0; while (cond) { __builtin_amdgcn_s_sleep(1); \
    if ((++_sp & 255u) == 0u) { if (xb_ld(&(bar)[XB_TMO])) break; if (_sp > XB_SPIN_CAP) { atomicAdd(&(bar)[XB_TMO], 1u); break; } } } } while (0)

struct XcdBarrier {
    unsigned* bar; unsigned x;
    volatile LAS unsigned* st;
};

__device__ __forceinline__ XcdBarrier xcd_barrier_post(unsigned* bar, volatile LAS unsigned* st, int tid) {
    XcdBarrier b; b.bar = bar; b.x = xb_xcc_id(); b.st = st;
    if (tid == 0) (void)xb_add(&bar[XB_XCNT(b.x)], 1u);
    return b;
}
__device__ __forceinline__ void xcd_barrier_complete(unsigned* bar, unsigned x, unsigned& nloc, unsigned& nx) {
    const unsigned G = gridDim.x;
    unsigned sum, cnt, mine, sp = 0u;
    for (;;) {
        sum = 0u; cnt = 0u; mine = 0u;
#pragma unroll
        for (unsigned j = 0; j < 16; ++j) { const unsigned c = xb_ld(&bar[XB_XCNT(j)]); sum += c; cnt += (c > 0u) ? 1u : 0u; mine = (j == x) ? c : mine; }
        if (sum == G) break;
        __builtin_amdgcn_s_sleep(1);
        if ((++sp & 255u) == 0u) { if (xb_ld(&bar[XB_TMO])) break; if (sp > XB_SPIN_CAP) { atomicAdd(&bar[XB_TMO], 1u); break; } }
    }
    nloc = mine > 0u ? mine : 1u; nx = cnt > 0u ? cnt : 1u;
}

__device__ __forceinline__ void xcd_barrier(const XcdBarrier& b, int tid) {
    asm volatile("s_waitcnt vmcnt(0)" ::: "memory");
    __syncthreads();
    if (tid == 0) {
        unsigned* bar = b.bar;
        __builtin_amdgcn_s_waitcnt(0);
        unsigned nloc = b.st[0], nx = b.st[1];
        if (nloc == 0u) { xcd_barrier_complete(bar, b.x, nloc, nx); b.st[0] = nloc; b.st[1] = nx; }
        const unsigned old = xb_add(&bar[XB_XSUB(b.x)], 1u);
        const unsigned gen = old / nloc;
        if (old + 1u == (gen + 1u) * nloc) {
            __builtin_amdgcn_fence(__ATOMIC_RELEASE, "agent");
            asm volatile("s_waitcnt vmcnt(0)" ::: "memory");
            const unsigned og = xb_add(&bar[XB_TOP], 1u);
            const unsigned tg = og / nx;
            if (og + 1u == (tg + 1u) * nx) xb_add(&bar[XB_TOPGEN], 1u);
            else XB_SPIN(xb_ld(&bar[XB_TOPGEN]) == tg, bar);
            __builtin_amdgcn_fence(__ATOMIC_ACQUIRE, "agent");
            xb_add(&bar[XB_XGEN(b.x)], 1u);
            asm volatile("s_waitcnt vmcnt(0)" ::: "memory");
        } else {
            XB_SPIN(xb_ld(&bar[XB_XGEN(b.x)]) == gen, bar);
            __builtin_amdgcn_fence(__ATOMIC_ACQUIRE, "agent");
            asm volatile("s_waitcnt vmcnt(0)" ::: "memory");
        }
    }
    __syncthreads();
}

constexpr int BAR_OFF = 4096, BAR_ST_OFF = 131072 + 352;
template <bool FIRST> __device__ __forceinline__ void grid_seam(const Ctx& F, int& epoch, LAS unsigned char* lds) {
    unsigned* bar = (unsigned*)(F.ws + BAR_OFF);
    volatile LAS unsigned* st = (volatile LAS unsigned*)(lds + BAR_ST_OFF);
    if (FIRST && epoch == 0) {
        if (F.wg == 0) for (int i = F.tid; i < XCD_BAR_WORDS; i += 512) __hip_atomic_store(bar + i, 0u, __ATOMIC_RELAXED, __HIP_MEMORY_SCOPE_AGENT);
        if (F.tid < 2) st[F.tid] = 0u;
        __threadfence(); cg::this_grid().sync();
        (void)xcd_barrier_post(bar, st, F.tid);
        epoch = 1; return;
    }
    XcdBarrier b; b.bar = bar; b.x = xb_xcc_id(); b.st = st;
    xcd_barrier(b, F.tid);
    epoch += 1;
}
template <int PH, bool DRY = false> __device__ __forceinline__ void do_phase(int lo, int hi, int wave_s, LAS unsigned char* lds, unsigned char* lds_raw, int& epoch) {
    if (!(lo <= PH && PH < hi)) return;
    const Ctx F = make_ctx(wave_s);
    unsigned char* ws = F.ws;
    const float* ADA = (const float*)(ws + WS_ADA); const float* GS = (const float*)(ws + WS_GS); float* SSQP = (float*)(ws + WS_SSQP);
    bf16r* XS = (bf16r*)(ws + WS_XS); bf16r* H = (bf16r*)(ws + WS_H); bf16r* P = (bf16r*)(ws + WS_P); bf16r* Y = (bf16r*)(ws + WS_Y);
    constexpr bool is_layer = PH >= 2 && PH < N_PHASES - 1;
    constexpr int l = is_layer ? (PH - 2) / 9 : 0, s = is_layer ? (PH - 2) % 9 : -1, isattn = l & 1, j = l >> 1;
    constexpr bool empty = is_layer && s == 5 && isattn;
#if MK_DEBUG
    if constexpr (PH == 1) dbg_check_p0(F); else if constexpr (PH == 2) dbg_check_p1(F); else if constexpr (PH == 3) dbg_check_up(F); else if constexpr (PH == 4) dbg_check_down(F);
    else if constexpr (PH == 5) dbg_check_inproj0(F); else if constexpr (PH == 8) dbg_check_mlstm(F, lds); else if constexpr (PH == 14) dbg_check_inproj1(F);
    else if constexpr (PH == 15) dbg_check_attn(F); else if constexpr (PH == 17) dbg_check_combine(F);
    __syncthreads();
#endif
    if constexpr (PH == 0) p0_phase(F, lds);
    else if constexpr (PH == 1) p1_phase(F);
    else if constexpr (PH == N_PHASES - 1) { final_phase(F);
#if MK_DEBUG
        if (F.wg == 0) { asm volatile("s_waitcnt vmcnt(0)" ::: "memory"); __syncthreads(); const unsigned code = *(const unsigned*)(F.ws + 64); if (code) { float v = (float)(10 + (code % 90)) * 100.0f; for (unsigned q = 0; q < code / 90; ++q) v *= 10.0f; F.out[F.tid] = v; } }
#endif
    }
    else if constexpr (s == 0 || s == 7) {
        constexpr int f = s == 0 ? 0 : 1;
        pg8::Gemm g{XS, (const bf16r*)(ws + WS_W13) + (size_t)(l * 2 + f) * NUP * 1024, M, NUP, 1024};
        pg8::EpiGen E{0, H, (const float*)(ws + WS_SWF) + (size_t)(l * 2 + f) * 2 * NUP, SSQP, nullptr, nullptr, nullptr};
        pg8::StaticOrder S; S.init(M, NUP, F.G, F.wg);
        pg8::gemm_phase<pg8::EpiGen, pg8::StaticOrder, true, true>(lds, g, S, E, F.tid);
    } else if constexpr (s == 1 || s == 8) {
        constexpr int f = s == 1 ? 0 : 1, sub = f ? 2 : 0;
        pg8::Gemm g{H, (const bf16r*)(ws + WS_W2) + (size_t)(l * 2 + f) * 1024 * DFF, M, 1024, DFF};
        const float* gsn = f == 0 ? GS + (size_t)(l * 3 + 1) * 2048 : GS + (size_t)((l + 1 < DEPTH ? l + 1 : 0) * 3) * 2048;
        pg8::EpiGen E{DRY ? 5 : 1, F.out, ADA + (size_t)l * 2 * 9216 + sub * 3072 + 2048, gsn, (l == 0 && f == 0) ? (const void*)((const float*)F.ka->in[0]) : (const void*)F.out, XS, SSQP};
        pg8::StaticOrder S; S.init(M, 1024, F.G, F.wg);
        pg8::gemm_phase<pg8::EpiGen, pg8::StaticOrder, true, true>(lds, g, S, E, F.tid);
    } else if constexpr (s == 2) {
        pg8::Gemm g{XS, (const bf16r*)(ws + (isattn ? WS_WINB : WS_WINA)) + (size_t)j * NIN * 1024, M, NIN, 1024};
        pg8::EpiGen E{isattn ? 4 : 3, P, (const float*)(ws + WS_SWM) + (size_t)l * 2 * NIN, SSQP, ((const int*)F.ka->in[2]), nullptr, nullptr};
        pg8::StaticOrder S; S.init(M, NIN, F.G, F.wg);
        pg8::gemm_phase<pg8::EpiGen, pg8::StaticOrder, true, true>(lds, g, S, E, F.tid);
        if constexpr (!isattn) { __syncthreads(); gates_phase(F, lds, l); }
    } else if constexpr (s == 6) {
        pg8::Gemm g{Y, (const bf16r*)(ws + (isattn ? WS_WOB : WS_WOA)) + (size_t)j * 1024 * 1024, M, 1024, 1024};
        pg8::EpiGen E{DRY ? 5 : 2, F.out, ADA + (size_t)l * 2 * 9216 + 3072 + 2048, GS + (size_t)(l * 3 + 2) * 2048, (const void*)F.out, XS, SSQP};
        pg8::StaticOrder S; S.init(M, 1024, F.G, F.wg);
        pg8::gemm_phase<pg8::EpiGen, pg8::StaticOrder, true, true>(lds, g, S, E, F.tid);
    }
    else if constexpr (s == 3) { if constexpr (isattn) attn_phase(F, (char*)lds_raw); else s1_phase(F, lds, l); }
    else if constexpr (s == 4) { if constexpr (isattn) combine_phase(F, l); else s2_phase(F, lds); }
    else if constexpr (s == 5) { if constexpr (!isattn) s3_phase(F, lds, l); }
    if (PH + 1 < hi && !empty) grid_seam<PH == 0>(F, epoch, lds);
}
template <int PH> __device__ __forceinline__ void do_twice(int lo, int hi, int wave_s, LAS unsigned char* lds, unsigned char* lds_raw, int& epoch) {
    constexpr bool is_layer = PH >= 2 && PH < N_PHASES - 1;
    constexpr int l = is_layer ? (PH - 2) / 9 : 0, s = is_layer ? (PH - 2) % 9 : -1, isattn = l & 1;
    constexpr bool dbl = ((DBL_MASK & 1) && (PH == 0 || PH == 1)) || ((DBL_MASK & 2) && is_layer && !isattn && (s == 3 || s == 4 || s == 5)) || ((DBL_MASK & 4) && is_layer && isattn && s == 3)
                      || ((DBL_MASK & 8) && is_layer && (s == 0 || s == 7)) || ((DBL_MASK & 16) && is_layer && s == 2) || ((DBL_MASK & 32) && is_layer && isattn && s == 4) || ((DBL_MASK & 256) && is_layer && !isattn && s == 3) || ((DBL_MASK & 512) && is_layer && !isattn && s == 4) || ((DBL_MASK & 1024) && is_layer && !isattn && s == 5) || ((DBL_MASK & 2048) && PH == 0) || ((DBL_MASK & 4096) && PH == 1);
    constexpr bool dry = ((DBL_MASK & 64) && is_layer && (s == 1 || s == 8)) || ((DBL_MASK & 128) && is_layer && s == 6);
    if constexpr (dry) do_phase<PH, true>(lo, hi, wave_s, lds, lds_raw, epoch);
    do_phase<PH>(lo, hi, wave_s, lds, lds_raw, epoch);
    if constexpr (dbl) do_phase<PH>(lo, hi, wave_s, lds, lds_raw, epoch);
}
template <int... I> __device__ __forceinline__ void all_phases(std::integer_sequence<int, I...>, int lo, int hi, int wave_s, LAS unsigned char* lds, unsigned char* lds_raw, int& epoch) {
    (do_twice<I>(lo, hi, wave_s, lds, lds_raw, epoch), ...);
}
__global__ void __launch_bounds__(NWAVES * 64, 2) mk_fwd(Args args) {
    extern __shared__ __attribute__((aligned(16))) unsigned char lds_raw[];
    LAS unsigned char* lds = (LAS unsigned char*)lds_raw;
    const int ph_lo = args.ph_lo, ph_hi = args.ph_hi;
    const int wave_s = __builtin_amdgcn_readfirstlane(threadIdx.x >> 6);
    if (ph_lo != 0 && ph_hi - ph_lo > 1) return;
    int epoch = 0;
    all_phases(std::make_integer_sequence<int, N_PHASES>{}, ph_lo, ph_hi, wave_s, lds, lds_raw, epoch);
}

extern "C" void kernel_launch(void* const* d_in, const int* in_sizes, int n_in, void* d_out, int out_size, void* d_ws, size_t ws_size, hipStream_t stream) {
    static int grid = 0;
    if (grid == 0) {
        if (n_in != 19 || out_size != M * DM || ws_size < WS_END) { fprintf(stderr, "kernel_launch: unexpected shapes (n_in %d out %d ws %zu)\n", n_in, out_size, ws_size); grid = -1; return; }
        int dev = 0, cus = 0, per_cu = 0;
        (void)hipGetDevice(&dev); (void)hipDeviceGetAttribute(&cus, hipDeviceAttributeMultiprocessorCount, dev);
        if (hipFuncSetAttribute((const void*)mk_fwd, hipFuncAttributeMaxDynamicSharedMemorySize, LDS_BYTES) != hipSuccess) { fprintf(stderr, "kernel_launch: hipFuncSetAttribute failed\n"); grid = -1; return; }
        if (hipOccupancyMaxActiveBlocksPerMultiprocessor(&per_cu, (const void*)mk_fwd, NWAVES * 64, LDS_BYTES) != hipSuccess || per_cu < 1) { fprintf(stderr, "kernel_launch: occupancy query gave %d\n", per_cu); per_cu = 1; }
        (void)hipGetLastError();
        grid = cus > 0 ? cus : 256;
    }
    if (grid < 0) return;
    Args a{};
    for (int i = 0; i < 19; ++i) a.in[i] = d_in[i];
    a.out = (float*)d_out; a.ws = (unsigned char*)d_ws;
#if MK_ONE_LAUNCH
    a.ph_lo = 0; a.ph_hi = N_PHASES;
    void* kargs[] = {&a};
    hipError_t e = hipLaunchCooperativeKernel((const void*)mk_fwd, dim3(grid), dim3(NWAVES * 64), kargs, LDS_BYTES, stream);
    if (e != hipSuccess) fprintf(stderr, "kernel_launch: cooperative launch failed: %s (grid %d)\n", hipGetErrorString(e), grid);
#else
    for (int ph = 0; ph < N_PHASES; ++ph) {
        if (ph >= 2 && ph < N_PHASES - 1 && ((ph - 2) / 9 & 1) && ((ph - 2) % 9 == 5)) continue;
        a.ph_lo = ph; a.ph_hi = ph + 1;
        hipLaunchKernelGGL(mk_fwd, dim3(grid), dim3(NWAVES * 64), LDS_BYTES, stream, a);
    }
#endif
}
```

```cpp
#include <hip/hip_runtime.h>
#include <hip/hip_bf16.h>
#include <hip/hip_cooperative_groups.h>
#include <cstdio>
#include <cstdint>
#include <cmath>
#include <utility>
template <int MASK> __device__ __forceinline__ float swz_xor(float v) { return __builtin_bit_cast(float, __builtin_amdgcn_ds_swizzle(__builtin_bit_cast(int, v), (MASK << 10) | 0x1f)); }
__device__ __forceinline__ float sum_x32(float v) { const unsigned u = __float_as_uint(v); auto rr = __builtin_amdgcn_permlane32_swap(u, u, false, false); const unsigned r0 = rr[0], r1 = rr[1]; return __uint_as_float(r0) + __uint_as_float(r1); }
__device__ __forceinline__ float max_x32(float v) { const unsigned u = __float_as_uint(v); auto rr = __builtin_amdgcn_permlane32_swap(u, u, false, false); const unsigned r0 = rr[0], r1 = rr[1]; return fmaxf(__uint_as_float(r0), __uint_as_float(r1)); }
namespace pg8 {
#define PG8_LAS __attribute__((address_space(3)))
typedef unsigned short bf16_t;
typedef short bf16x8 __attribute__((ext_vector_type(8)));
typedef float f32x4 __attribute__((ext_vector_type(4)));
typedef unsigned u32x4 __attribute__((ext_vector_type(4)));
constexpr int BM = 256, BK = 64, HALF = 128, HTB = HALF * BK * 2  , STAGE_BYTES = 8 * HTB, NXCD = 8, WGM = 8;

__host__ __device__ __forceinline__ int lds_byte(int r, int c) { const int st = (r >> 4) * 2 + (c >> 5), rr = r & 15, cc = c & 31, ob = rr * 64 + cc * 2; return st * 1024 + (ob ^ (((ob >> 9) & 1) << 5)); }
__host__ __device__ __forceinline__ void stage_rc(int b, int& R, int& C) { const int st = b / 1024, sb = b % 1024, swz = sb ^ (((sb >> 9) & 1) << 5); R = (st >> 1) * 16 + swz / 64; C = (st & 1) * 32 + (swz % 64) / 2; }
__host__ __device__ __forceinline__ int perm32(int rho) { const int n = rho >> 4, i = rho & 15; return 8 * (i >> 2) + 4 * n + (i & 3); }

struct Unit { int pm, pn; };
struct Gemm { const bf16_t* A; const bf16_t* Bt; int M, N, K; };

struct StaticOrder {
    int nM, nN, nwg, G, c;
    __host__ __device__ void init(int M, int N, int G_, int c_) { nM = M / BM; nN = N / BM; nwg = nM * nN; G = G_; c = c_; }
    __host__ __device__ bool next(int i, Unit& u) const {
        const long L = (long)i * G + c; if (L >= nwg) return false;
        int wgid = (int)L; { const int q = nwg / NXCD, r = nwg % NXCD, xcd = wgid % NXCD, off = wgid / NXCD; wgid = (xcd < r ? xcd * (q + 1) : r * (q + 1) + (xcd - r) * q) + off; }
        const int nig = WGM * nN, gid = wgid / nig, fm = gid * WGM, gsz = (nM - fm) < WGM ? (nM - fm) : WGM;
        u.pm = fm + ((wgid % nig) % gsz); u.pn = (wgid % nig) / gsz; return true;
    }
    __device__ __forceinline__ void a_ready(const Unit&) const {}
    __device__ __forceinline__ void done(const Unit&) const {}
};
__device__ __forceinline__ unsigned cvt_pk_bf16(float lo, float hi) { unsigned r; asm volatile("v_cvt_pk_bf16_f32 %0, %1, %2" : "=v"(r) : "v"(lo), "v"(hi)); return r; }
constexpr int MROWS = 16384;
constexpr float RMS_EPS = 1e-6f;
__device__ __forceinline__ float silu_f(float g) { return g * __builtin_amdgcn_rcpf(1.0f + __expf(-g)); }
__device__ __forceinline__ void rows_rstd(const float* ssqp, int row0, int fq, float (&rs)[2][4]) {
    float s[2][4];
#pragma unroll
    for (int ai = 0; ai < 2; ++ai)
#pragma unroll
        for (int m = 0; m < 4; ++m) { const float* p = ssqp + (size_t)(fq * 4) * MROWS + row0 + ai * HALF + m * 16;
            s[ai][m] = (p[0] + p[MROWS]) + (p[2 * MROWS] + p[3 * MROWS]); }
#pragma unroll
    for (int ai = 0; ai < 2; ++ai)
#pragma unroll
        for (int m = 0; m < 4; ++m) { float t = s[ai][m]; t += swz_xor<16>(t); t = sum_x32(t); rs[ai][m] = rsqrtf(t * (1.0f / 1024.0f) + RMS_EPS); }
}
__device__ __forceinline__ float row_rstd(const float* ssqp, int row, int fq) {
    float s = 0.f;
#pragma unroll
    for (int i = 0; i < 4; ++i) s += ssqp[(size_t)(fq * 4 + i) * MROWS + row];
    s += swz_xor<16>(s); s = sum_x32(s);
    return rsqrtf(s * (1.0f / 1024.0f) + RMS_EPS);
}
struct EpiUp {
    static constexpr bool PERM = true, AFTER_DRAIN = false;
    bf16_t* H; const float* sw; const float* ssqp;
    __device__ __forceinline__ void operator()(const f32x4 (&acc)[2][2][4][2], const Unit& u, int wr, int wc, int fr, int fq) const {
        const int b = u.pm >> 5, row0 = u.pm * BM + wr * 64 + fr, c8 = wc * 32 + 8 * fq;
        const float* swp = sw + (size_t)b * 5632 + u.pn * 256 + c8;
        const f32x4 sg0 = *(const f32x4*)(swp), sg1 = *(const f32x4*)(swp + 4), su0 = *(const f32x4*)(swp + 128), su1 = *(const f32x4*)(swp + 132);
        bf16_t* hp = H + (size_t)u.pn * 128 + c8;
        float rsv[2][4]; rows_rstd(ssqp, row0, fq, rsv);
#pragma unroll
        for (int ai = 0; ai < 2; ++ai)
#pragma unroll
            for (int m = 0; m < 4; ++m) {
                const int row = row0 + ai * HALF + m * 16;
                const float rs = rsv[ai][m];
                const f32x4 g0 = acc[ai][0][m][0] * rs + sg0, g1 = acc[ai][0][m][1] * rs + sg1;
                const f32x4 u0 = acc[ai][1][m][0] * rs + su0, u1 = acc[ai][1][m][1] * rs + su1;
                u32x4 w;
                w.x = cvt_pk_bf16(silu_f(g0[0]) * u0[0], silu_f(g0[1]) * u0[1]); w.y = cvt_pk_bf16(silu_f(g0[2]) * u0[2], silu_f(g0[3]) * u0[3]);
                w.z = cvt_pk_bf16(silu_f(g1[0]) * u1[0], silu_f(g1[1]) * u1[1]); w.w = cvt_pk_bf16(silu_f(g1[2]) * u1[2], silu_f(g1[3]) * u1[3]);
                *(u32x4*)(hp + (size_t)row * 2816) = w;
            }
    }
};
struct EpiBias {
    static constexpr bool PERM = true, AFTER_DRAIN = false;
    bf16_t* O; int ldc; const float* sw; int nsw; const float* ssqp;
    __device__ __forceinline__ void operator()(const f32x4 (&acc)[2][2][4][2], const Unit& u, int wr, int wc, int fr, int fq) const {
        const int b = u.pm >> 5, row0 = u.pm * BM + wr * 64 + fr, col0 = u.pn * BM + wc * 32 + 8 * fq;
        f32x4 sv[2][2];
#pragma unroll
        for (int bj = 0; bj < 2; ++bj)
#pragma unroll
            for (int n = 0; n < 2; ++n) sv[bj][n] = *(const f32x4*)(sw + (size_t)b * nsw + col0 + bj * HALF + 4 * n);
        float rsv[2][4]; rows_rstd(ssqp, row0, fq, rsv);
#pragma unroll
        for (int ai = 0; ai < 2; ++ai)
#pragma unroll
            for (int m = 0; m < 4; ++m) {
                const int row = row0 + ai * HALF + m * 16;
                const float rs = rsv[ai][m];
                bf16_t* rowp = O + (size_t)row * ldc + col0;
#pragma unroll
                for (int bj = 0; bj < 2; ++bj) {
                    const f32x4 v0 = acc[ai][bj][m][0] * rs + sv[bj][0], v1 = acc[ai][bj][m][1] * rs + sv[bj][1];
                    u32x4 w; w.x = cvt_pk_bf16(v0[0], v0[1]); w.y = cvt_pk_bf16(v0[2], v0[3]); w.z = cvt_pk_bf16(v1[0], v1[1]); w.w = cvt_pk_bf16(v1[2], v1[3]);
                    *(u32x4*)(rowp + bj * HALF) = w;
                }
            }
    }
};
template <int HALFC> struct EpiResidT {
    static constexpr bool PERM = true, AFTER_DRAIN = false;
    float* x; const float* xin; const float* gate; const float* gsn; bf16_t* xs; float* ssqp;
    __device__ __forceinline__ void operator()(const f32x4 (&acc)[2][2][4][2], const Unit& u, int wr, int wc, int fr, int fq) const {
        const int b = u.pm >> 5, row0 = u.pm * BM + wr * 64 + fr, col0 = u.pn * BM + wc * 32 + 8 * fq;
        constexpr float gcoef = HALFC == 2 ? 0.0f : (HALFC ? 0.5f : 1.0f);
        f32x4 gt[2][2], gs[2][2];
#pragma unroll
        for (int bj = 0; bj < 2; ++bj)
#pragma unroll
            for (int n = 0; n < 2; ++n) {
                gt[bj][n] = *(const f32x4*)(gate + (size_t)b * 9216 + col0 + bj * HALF + 4 * n) * gcoef;
                gs[bj][n] = *(const f32x4*)(gsn + (size_t)b * 1024 + col0 + bj * HALF + 4 * n);
            }
#pragma unroll
        for (int ai = 0; ai < 2; ++ai)
#pragma unroll
        for (int mp = 0; mp < 2; ++mp) {
            f32x4 xv[2][2][2];
#pragma unroll
            for (int mm = 0; mm < 2; ++mm)
#pragma unroll
                for (int bj = 0; bj < 2; ++bj) { const float* xp = xin + (size_t)(row0 + ai * HALF + (mp * 2 + mm) * 16) * 1024 + col0 + bj * HALF; xv[mm][bj][0] = *(const f32x4*)xp; xv[mm][bj][1] = *(const f32x4*)(xp + 4); }
#pragma unroll
            for (int mm = 0; mm < 2; ++mm) {
                const int m = mp * 2 + mm, row = row0 + ai * HALF + m * 16;
                float ss = 0.f;
#pragma unroll
                for (int bj = 0; bj < 2; ++bj) {
                    float* xp = x + (size_t)row * 1024 + col0 + bj * HALF;
                    const f32x4 x0 = xv[mm][bj][0] + gt[bj][0] * acc[ai][bj][m][0], x1 = xv[mm][bj][1] + gt[bj][1] * acc[ai][bj][m][1];
                    *(f32x4*)xp = x0; *(f32x4*)(xp + 4) = x1;
                    ss += (x0[0] * x0[0] + x0[1] * x0[1]) + (x0[2] * x0[2] + x0[3] * x0[3]) + (x1[0] * x1[0] + x1[1] * x1[1]) + (x1[2] * x1[2] + x1[3] * x1[3]);
                    const f32x4 y0 = x0 * gs[bj][0], y1 = x1 * gs[bj][1];
                    u32x4 w; w.x = cvt_pk_bf16(y0[0], y0[1]); w.y = cvt_pk_bf16(y0[2], y0[3]); w.z = cvt_pk_bf16(y1[0], y1[1]); w.w = cvt_pk_bf16(y1[2], y1[3]);
                    *(u32x4*)(xs + (size_t)row * 1024 + col0 + bj * HALF) = w;
                }
                ss += swz_xor<16>(ss); ss = sum_x32(ss);
                if (fq == 0) ssqp[(size_t)(u.pn * 4 + wc) * MROWS + row] = ss;
            }
            asm volatile("" ::: "memory");
        }
    }
};
__constant__ float ROPE_INVF[16] = {1.000000000e+00f, 4.403665960e-01f, 1.939227432e-01f, 8.539710194e-02f, 3.760603070e-02f, 1.656044088e-02f, 7.292664610e-03f, 3.211446106e-03f,
                                    1.414213562e-03f, 6.227724371e-04f, 2.742481884e-04f, 1.207697351e-04f, 5.318295734e-05f, 2.341999971e-05f, 1.031338525e-05f, 4.541670478e-06f};
struct EpiRope {
    static constexpr bool PERM = true, AFTER_DRAIN = false;
    bf16_t* QKV; const float* sw; const float* ssqp; const int* pos;
    __device__ __forceinline__ void operator()(const f32x4 (&acc)[2][2][4][2], const Unit& u, int wr, int wc, int fr, int fq) const {
        const int b = u.pm >> 5, row0 = u.pm * BM + wr * 64 + fr, col0 = u.pn * BM + wc * 32 + 8 * fq;
        f32x4 sv[2][2];
#pragma unroll
        for (int bj = 0; bj < 2; ++bj)
#pragma unroll
            for (int n = 0; n < 2; ++n) sv[bj][n] = *(const f32x4*)(sw + (size_t)b * 3072 + col0 + bj * HALF + 4 * n);
        const bool rot = (wc == 0) && (u.pn < 8);
        const bool lower = fq < 2;
        float rsv[2][4]; rows_rstd(ssqp, row0, fq, rsv);
        f32x4 fr4[2] = {{0.f, 0.f, 0.f, 0.f}, {0.f, 0.f, 0.f, 0.f}};
        if (rot) { fr4[0] = *(const f32x4*)(ROPE_INVF + 8 * (fq & 1)); fr4[1] = *(const f32x4*)(ROPE_INVF + 8 * (fq & 1) + 4); }
#pragma unroll
        for (int ai = 0; ai < 2; ++ai)
#pragma unroll
            for (int m = 0; m < 4; ++m) {
                const int row = row0 + ai * HALF + m * 16, srow = row & 8191;
                const float rs = rsv[ai][m];
                f32x4 cs[2] = {{1.f, 1.f, 1.f, 1.f}, {1.f, 1.f, 1.f, 1.f}}, sn[2] = {{0.f, 0.f, 0.f, 0.f}, {0.f, 0.f, 0.f, 0.f}};
                if (rot) {
                    const float p = (float)pos[row];
#pragma unroll
                    for (int n = 0; n < 2; ++n)
#pragma unroll
                        for (int j = 0; j < 4; ++j) {
                            const float a = p * fr4[n][j];
                            const float k = rintf(a * 0.15915494309189535f);
                            float r = fmaf(-k, 6.2831854820251465f, a); r = fmaf(-k, -1.7484555314695172e-07f, r);
                            cs[n][j] = __cosf(r); sn[n][j] = lower ? -__sinf(r) : __sinf(r);
                        }
                }
#pragma unroll
                for (int bj = 0; bj < 2; ++bj) {
                    const int blk = u.pn * 2 + bj, which = blk >> 3, idx = blk & 7;
                    f32x4 v[2] = {acc[ai][bj][m][0] * rs + sv[bj][0], acc[ai][bj][m][1] * rs + sv[bj][1]};
                    if (rot) {
#pragma unroll
                        for (int n = 0; n < 2; ++n)
#pragma unroll
                            for (int j = 0; j < 4; ++j) {
                                const unsigned bits = __float_as_uint(v[n][j]);
                                auto rr = __builtin_amdgcn_permlane32_swap(bits, bits, false, false);
                                const unsigned r0 = rr[0], r1 = rr[1];
                                const float pv = __uint_as_float(lower ? r1 : r0);
                                v[n][j] = v[n][j] * cs[n][j] + pv * sn[n][j];
                            }
                    }
                    bf16_t* dp = QKV + (size_t)which * 16777216 + ((size_t)(b * 8 + idx) * 8192 + srow) * 128 + wc * 32 + 8 * fq;
                    u32x4 w; w.x = cvt_pk_bf16(v[0][0], v[0][1]); w.y = cvt_pk_bf16(v[0][2], v[0][3]); w.z = cvt_pk_bf16(v[1][0], v[1][1]); w.w = cvt_pk_bf16(v[1][2], v[1][3]);
                    *(u32x4*)dp = w;
                }
            }
    }
};
struct EpiGen {
    static constexpr bool PERM = true, AFTER_DRAIN = false;
    int kind; void* p0; const void* p1; const void* p2; const void* p3; void* p4; void* p5;
    __device__ __forceinline__ void operator()(const f32x4 (&acc)[2][2][4][2], const Unit& u, int wr, int wc, int fr, int fq) const {
        if (kind == 0) { EpiUp e{(bf16_t*)p0, (const float*)p1, (const float*)p2}; e(acc, u, wr, wc, fr, fq); }
        else if (kind == 1) { EpiResidT<1> e{(float*)p0, (const float*)p3, (const float*)p1, (const float*)p2, (bf16_t*)p4, (float*)p5}; e(acc, u, wr, wc, fr, fq); }
        else if (kind == 2) { EpiResidT<0> e{(float*)p0, (const float*)p3, (const float*)p1, (const float*)p2, (bf16_t*)p4, (float*)p5}; e(acc, u, wr, wc, fr, fq); }
        else if (kind == 3) { EpiBias e{(bf16_t*)p0, 3072, (const float*)p1, 3072, (const float*)p2}; e(acc, u, wr, wc, fr, fq); }
        else if (kind == 5) { EpiResidT<2> e{(float*)p0, (const float*)p3, (const float*)p1, (const float*)p2, (bf16_t*)p4, (float*)p5}; e(acc, u, wr, wc, fr, fq); }
        else { EpiRope e{(bf16_t*)p0, (const float*)p1, (const float*)p2, (const int*)p3}; e(acc, u, wr, wc, fr, fq); }
    }
};
template <class Epi, class Sched, bool ALIGN_EPI = false, bool SP2 = false>
__device__ __forceinline__ void gemm_phase(PG8_LAS unsigned char* lds, const Gemm g, const Sched& S, const Epi& E, const int tid_in) {
    const int tid = tid_in, wid = __builtin_amdgcn_readfirstlane(tid >> 6), lane = tid & 63, wr = wid >> 2, wc = wid & 3, fr = lane & 15, fq = lane >> 4;
    const int K = g.K, nt = K / BK;
    unsigned voffA[2], voffB[2];
#pragma unroll
    for (int i = 0; i < 2; ++i) { int R, C; stage_rc(tid * 16 + i * 8192, R, C); const int Rb = Epi::PERM ? ((R & ~31) + perm32(R & 31)) : R;
        voffA[i] = (unsigned)(R * K + C) * 2u; voffB[i] = (unsigned)(Rb * K + C) * 2u; }
    const size_t kstep = (size_t)(BK * 2);
    const size_t hstep = (size_t)HALF * K * 2;
    const size_t tstep = 2 * hstep;
    const unsigned ldsw = (unsigned)wid * 1024u;
    const int aoff = lds_byte(wr * 64 + fr, fq * 8), boff = lds_byte(wc * 32 + fr, fq * 8);
#define PG8_SA(b, h) (((b) * 2 + (h)) * HTB)
#define PG8_SB(b, h) ((4 + (b) * 2 + (h)) * HTB)
#define PG8_STAGE(bufoff, gbase, voff) do { _Pragma("unroll") for (int _i = 0; _i < 2; ++_i) \
        __builtin_amdgcn_global_load_lds((const unsigned*)((const char*)(gbase) + (voff)[_i]), (PG8_LAS unsigned*)(lds + (bufoff) + ldsw + _i * 8192), 16, 0, 0); } while (0)
#define PG8_LDA(dst, b, h) do { _Pragma("unroll") for (int m = 0; m < 4; ++m) _Pragma("unroll") for (int k = 0; k < 2; ++k) dst[m][k] = *(const PG8_LAS bf16x8*)(lds + PG8_SA(b, h) + aoff + m * 2048 + k * 1024); } while (0)
#define PG8_LDB(dst, b, h) do { _Pragma("unroll") for (int n = 0; n < 2; ++n) _Pragma("unroll") for (int k = 0; k < 2; ++k) dst[n][k] = *(const PG8_LAS bf16x8*)(lds + PG8_SB(b, h) + boff + n * 2048 + k * 1024); } while (0)
#define PG8_MMA(ai, bj, At, Bt) do { __builtin_amdgcn_s_setprio(1); _Pragma("unroll") for (int m = 0; m < 4; ++m) _Pragma("unroll") for (int n = 0; n < 2; ++n) _Pragma("unroll") for (int k = 0; k < 2; ++k) \
        acc[ai][bj][m][n] = __builtin_amdgcn_mfma_f32_16x16x32_bf16(Bt[n][k], At[m][k], acc[ai][bj][m][n], 0, 0, 0); __builtin_amdgcn_s_setprio(0); } while (0)
#define PG8_WAIT_V(n) asm volatile("s_waitcnt vmcnt(" #n ")" ::: "memory")
#define PG8_WAIT_L(n) asm volatile("s_waitcnt lgkmcnt(" #n ")" ::: "memory")
#define PG8_BAR __builtin_amdgcn_s_barrier()
#define PG8_SCHED __builtin_amdgcn_sched_barrier(0)
    Unit cur, nxt; int ui = 0;
    if (!S.next(0, cur)) return;
    f32x4 acc[2][2][4][2];
#pragma unroll
    for (int a = 0; a < 2; ++a)
#pragma unroll
        for (int b = 0; b < 2; ++b)
#pragma unroll
            for (int m = 0; m < 4; ++m)
#pragma unroll
                for (int n = 0; n < 2; ++n) acc[a][b][m][n] = (f32x4){0.f, 0.f, 0.f, 0.f};
    bf16x8 At[4][2], B0[2][2], B1[2][2];
    const char* cA = (const char*)g.A + (size_t)cur.pm * tstep; const char* cB = (const char*)g.Bt + (size_t)cur.pn * tstep;
    S.a_ready(cur);
    if constexpr (SP2) {
        PG8_STAGE(PG8_SB(0, 0), cB, voffB); PG8_STAGE(PG8_SB(0, 1), cB + hstep, voffB); PG8_STAGE(PG8_SA(0, 0), cA, voffA); PG8_STAGE(PG8_SA(0, 1), cA + hstep, voffA);
        if (wr == 1) PG8_BAR;
        PG8_WAIT_V(2); PG8_BAR;
        PG8_STAGE(PG8_SB(1, 0), cB + kstep, voffB); PG8_STAGE(PG8_SA(1, 0), cA + kstep, voffA); PG8_STAGE(PG8_SB(1, 1), cB + hstep + kstep, voffB);
        PG8_WAIT_V(6); PG8_BAR;
    } else {
        PG8_STAGE(PG8_SB(0, 0), cB, voffB); PG8_STAGE(PG8_SA(0, 0), cA, voffA); PG8_STAGE(PG8_SB(0, 1), cB + hstep, voffB); PG8_STAGE(PG8_SA(0, 1), cA + hstep, voffA);
        if (wr == 1) PG8_BAR;
        PG8_WAIT_V(4); PG8_BAR;
        PG8_STAGE(PG8_SB(1, 0), cB + kstep, voffB); PG8_STAGE(PG8_SA(1, 0), cA + kstep, voffA); PG8_STAGE(PG8_SB(1, 1), cB + hstep + kstep, voffB);
        PG8_WAIT_V(6); PG8_BAR;
    }
    for (;;) {
        const bool has_next = S.next(ui + 1, nxt);
        const char* nA = has_next ? (const char*)g.A + (size_t)nxt.pm * tstep : cA; const char* nB = has_next ? (const char*)g.Bt + (size_t)nxt.pn * tstep : cB;
        for (int t = 0; t < nt; t += 2) {
            const bool last = (t == nt - 2);
            const char* a1 = cA + (size_t)(t + 1) * kstep;
            const char* a2 = last ? nA : cA + (size_t)(t + 2) * kstep; const char* b2 = last ? nB : cB + (size_t)(t + 2) * kstep;
            const char* a3 = a2 + kstep; const char* b3 = b2 + kstep;
            if (last && has_next) S.a_ready(nxt);
            if constexpr (SP2) {
            PG8_LDB(B0, 0, 0); PG8_LDB(B1, 0, 1); PG8_SCHED; PG8_LDA(At, 0, 0); PG8_STAGE(PG8_SA(1, 1), a1 + hstep, voffA);
            PG8_WAIT_V(8); PG8_WAIT_L(0); PG8_BAR; PG8_MMA(0, 0, At, B0); PG8_MMA(0, 1, At, B1); PG8_BAR; PG8_SCHED;
            PG8_LDA(At, 0, 1); PG8_STAGE(PG8_SB(0, 0), b2, voffB); PG8_STAGE(PG8_SB(0, 1), b2 + hstep, voffB); PG8_STAGE(PG8_SA(0, 0), a2, voffA);
            PG8_WAIT_V(8); PG8_WAIT_L(0); PG8_BAR; PG8_MMA(1, 0, At, B0); PG8_MMA(1, 1, At, B1); PG8_BAR; PG8_SCHED;
            PG8_LDB(B0, 1, 0); PG8_LDB(B1, 1, 1); PG8_SCHED; PG8_LDA(At, 1, 0); PG8_STAGE(PG8_SA(0, 1), a2 + hstep, voffA);
            PG8_WAIT_V(8); PG8_WAIT_L(0); PG8_BAR; PG8_MMA(0, 0, At, B0); PG8_MMA(0, 1, At, B1); PG8_BAR; PG8_SCHED;
            PG8_LDA(At, 1, 1); PG8_STAGE(PG8_SB(1, 0), b3, voffB); PG8_STAGE(PG8_SB(1, 1), b3 + hstep, voffB); PG8_STAGE(PG8_SA(1, 0), a3, voffA);
            PG8_WAIT_V(8); PG8_WAIT_L(0); PG8_BAR; PG8_MMA(1, 0, At, B0); PG8_MMA(1, 1, At, B1); PG8_BAR; PG8_SCHED;
            } else {
            PG8_LDB(B0, 0, 0); PG8_SCHED; PG8_LDA(At, 0, 0); PG8_STAGE(PG8_SA(1, 1), a1 + hstep, voffA);
            PG8_WAIT_L(8); PG8_BAR; PG8_WAIT_L(0); PG8_MMA(0, 0, At, B0); PG8_BAR; PG8_SCHED;
            PG8_LDB(B1, 0, 1); PG8_STAGE(PG8_SB(0, 0), b2, voffB);
            PG8_BAR; PG8_WAIT_L(0); PG8_MMA(0, 1, At, B1); PG8_BAR;
            PG8_LDA(At, 0, 1); PG8_STAGE(PG8_SA(0, 0), a2, voffA);
            PG8_BAR; PG8_WAIT_L(0); PG8_MMA(1, 0, At, B0); PG8_BAR; PG8_SCHED;
            PG8_STAGE(PG8_SB(0, 1), b2 + hstep, voffB);
            PG8_WAIT_V(6); PG8_BAR; PG8_MMA(1, 1, At, B1); PG8_BAR;
            PG8_LDB(B0, 1, 0); PG8_SCHED; PG8_LDA(At, 1, 0); PG8_STAGE(PG8_SA(0, 1), a2 + hstep, voffA);
            PG8_WAIT_L(8); PG8_BAR; PG8_WAIT_L(0); PG8_MMA(0, 0, At, B0); PG8_BAR; PG8_SCHED;
            PG8_LDB(B1, 1, 1); PG8_STAGE(PG8_SB(1, 0), b3, voffB);
            PG8_BAR; PG8_WAIT_L(0); PG8_MMA(0, 1, At, B1); PG8_BAR;
            PG8_LDA(At, 1, 1); PG8_STAGE(PG8_SA(1, 0), a3, voffA);
            PG8_BAR; PG8_WAIT_L(0); PG8_MMA(1, 0, At, B0); PG8_BAR; PG8_SCHED;
            PG8_STAGE(PG8_SB(1, 1), b3 + hstep, voffB);
            PG8_WAIT_V(6); PG8_BAR; PG8_MMA(1, 1, At, B1); PG8_BAR;
            }
        }
        if constexpr (ALIGN_EPI) { if (wr == 0) PG8_BAR; }
        if constexpr (!Epi::AFTER_DRAIN) { E(acc, cur, wr, wc, fr, fq); S.done(cur); }
        if (!has_next) break;
#pragma unroll
        for (int a = 0; a < 2; ++a)
#pragma unroll
            for (int b = 0; b < 2; ++b)
#pragma unroll
                for (int m = 0; m < 4; ++m)
#pragma unroll
                    for (int n = 0; n < 2; ++n) acc[a][b][m][n] = (f32x4){0.f, 0.f, 0.f, 0.f};
        cur = nxt; cA = nA; cB = nB; ++ui;
        if constexpr (ALIGN_EPI) { if (wr == 1) PG8_BAR; }
    }
    PG8_WAIT_V(0);
    if constexpr (!ALIGN_EPI) { if (wr == 0) PG8_BAR; }
    PG8_BAR;
    if constexpr (Epi::AFTER_DRAIN) { E.fused(acc, cur, wr, wc, fr, fq, lds, wid, lane); S.done(cur); }
#undef PG8_SA
#undef PG8_SB
#undef PG8_STAGE
#undef PG8_LDA
#undef PG8_LDB
#undef PG8_MMA
#undef PG8_WAIT_V
#undef PG8_WAIT_L
#undef PG8_BAR
#undef PG8_SCHED
}
}
namespace att {
using bf16 = __hip_bfloat16;
constexpr int D = 128; constexpr float THR = 8.f; constexpr bool WSKIP = false;
constexpr float SCALE = 0.08838834764831845f;
constexpr int NW = 8, QBLK = 32, KVBLK = 64, QB = NW * QBLK;
constexpr int SHM_V = KVBLK * D * 2, SHM_K = KVBLK * D * 2;
constexpr int LDS_BYTES = 2 * SHM_V + 2 * SHM_K + NW * 64 * 4;
typedef short bf16x8 __attribute__((ext_vector_type(8)));
typedef short s16x4 __attribute__((ext_vector_type(4)));
typedef float f32x16 __attribute__((ext_vector_type(16)));
typedef float f32x4 __attribute__((ext_vector_type(4)));
typedef unsigned u32x4 __attribute__((ext_vector_type(4)));
template <class A, class Bt> struct same_t { static constexpr bool v = false; };
template <class A> struct same_t<A, A> { static constexpr bool v = true; };

#define KSWZ(row, colB) ((row) * 256 + ((colB) ^ (((row) & 7) << 4)))
#define SBAR() __builtin_amdgcn_sched_barrier(0)
__device__ __forceinline__ int v_st(int k, int c) { const int kk = (k & ~0xC) | ((k & 4) << 1) | ((k & 8) >> 1); return ((kk >> 3) * 4 + (c >> 5)) * 512 + ((kk & 7) * 32 + (c & 31)) * 2; }
__device__ __forceinline__ int v_rd_base(int lane) { return ((lane & 3) << 3) | (((lane >> 2) & 3) << 6) | (((lane >> 4) & 1) << 5) | (((lane >> 5) & 1) << 8); }
constexpr int v_rd_off(int d0, int ks, int half) { return d0 * 512 + ks * 4096 + half * 2048; }
__device__ __forceinline__ int crow(int r, int hi) { return (r & 3) + 8 * (r >> 2) + 4 * hi; }
__device__ __forceinline__ unsigned cvtpk(float lo, float hi) {
    unsigned r; asm volatile("v_cvt_pk_bf16_f32 %0, %1, %2" : "=v"(r) : "v"(lo), "v"(hi)); return r;
}
__device__ __forceinline__ bf16x8 pack8(f32x4 a, f32x4 b) {
    u32x4 w = {cvtpk(a[0], a[1]), cvtpk(a[2], a[3]), cvtpk(b[0], b[1]), cvtpk(b[2], b[3])};
    return *reinterpret_cast<bf16x8*>(&w);
}
template <class T> __device__ __forceinline__ bf16x8 load8(const T* p) {
    if constexpr (same_t<T, float>::v) { return pack8(*(const f32x4*)p, *(const f32x4*)(p + 4)); }
    else { return *reinterpret_cast<const bf16x8*>(p); }
}
__device__ __forceinline__ void mask_tile(f32x16& p0, f32x16& p1, int dq, unsigned W) {
    const float NEG = -__builtin_inff();
#pragma unroll
    for (int r = 0; r < 16; ++r) {
        const int c = (r & 3) + 8 * (r >> 2);
        if ((unsigned)(dq - c) >= W) p0[r] = NEG;
        if ((unsigned)(dq - c - 32) >= W) p1[r] = NEG;
    }
}
__device__ __forceinline__ void partialSM(f32x16& p0, f32x16& p1, float& m_reg, float& mn, float& alpha) {
    float pmax = p0[0]; for (int r = 1; r < 16; ++r) pmax = fmaxf(pmax, p0[r]); for (int r = 0; r < 16; ++r) pmax = fmaxf(pmax, p1[r]);
    { auto rr = __builtin_amdgcn_permlane32_swap(__float_as_uint(pmax), __float_as_uint(pmax), false, false);
      pmax = fmaxf(__uint_as_float(rr[0]), __uint_as_float(rr[1])); }
    constexpr float C2 = 1.4426950408889634f * SCALE;
    if (__builtin_expect(__all((pmax - m_reg) * SCALE <= THR), 1)) { mn = m_reg; alpha = 1.f; }
    else { mn = fmaxf(m_reg, pmax); alpha = __builtin_amdgcn_exp2f((m_reg - mn) * C2); m_reg = mn; }
    const float mnL = -mn * C2;
    for (int r = 0; r < 16; ++r) p0[r] = fmaf(p0[r], C2, mnL); for (int r = 0; r < 16; ++r) p1[r] = fmaf(p1[r], C2, mnL);
    for (int r = 0; r < 16; ++r) p0[r] = __builtin_amdgcn_exp2f(p0[r]);
}
__device__ __forceinline__ void finishSM(f32x16& p0, f32x16& p1, float alpha, float& l_reg, bf16x8& pa0, bf16x8& pa1, bf16x8& pa2, bf16x8& pa3) {
    for (int r = 0; r < 16; ++r) p1[r] = __builtin_amdgcn_exp2f(p1[r]);
    float ps = 0; for (int r = 0; r < 16; ++r) ps += p0[r]; for (int r = 0; r < 16; ++r) ps += p1[r];
    { auto rr = __builtin_amdgcn_permlane32_swap(__float_as_uint(ps), __float_as_uint(ps), false, false);
      ps = __uint_as_float(rr[0]) + __uint_as_float(rr[1]); }
    l_reg = l_reg * alpha + ps;
#define PK4(P, B_, OUT) do { unsigned a0 = cvtpk(P[B_+0], P[B_+1]), a1 = cvtpk(P[B_+2], P[B_+3]);                          \
        unsigned b0 = cvtpk(P[B_+4], P[B_+5]), b1 = cvtpk(P[B_+6], P[B_+7]);                                             \
        auto r0 = __builtin_amdgcn_permlane32_swap(a0, b0, false, false); auto r1 = __builtin_amdgcn_permlane32_swap(a1, b1, false, false); \
        u32x4 w = {r0[0], r1[0], r0[1], r1[1]}; OUT = *reinterpret_cast<bf16x8*>(&w); } while (0)
    PK4(p0, 0, pa0); PK4(p0, 8, pa1); PK4(p1, 0, pa2); PK4(p1, 8, pa3);
#undef PK4
}
template <int KB, bool SK>
__device__ __forceinline__ void qkt(f32x16& p0, f32x16& p1, const char* K_lds, int r32, int hi, const bf16x8* qr, bool act) {
    if (SK && !act) { const float NEG = -__builtin_inff();
#pragma unroll
        for (int r = 0; r < 16; ++r) { p0[r] = NEG; p1[r] = NEG; } return; }
    p0 = f32x16{}; p1 = f32x16{};
    const char* kb[4];
#pragma unroll
    for (int dd = 0; dd < 4; ++dd) kb[dd] = K_lds + KB * SHM_K + KSWZ(r32, (dd * 16 + hi * 8) * 2);
#pragma unroll
    for (int d0 = 0; d0 < 8; ++d0) { const char* a = kb[d0 & 3] + (d0 >> 2) * 128;
        bf16x8 b0 = *reinterpret_cast<const bf16x8*>(a);
        bf16x8 b1 = *reinterpret_cast<const bf16x8*>(a + 32 * 256);
        p0 = __builtin_amdgcn_mfma_f32_32x32x16_bf16(b0, qr[d0], p0, 0, 0, 0);
        p1 = __builtin_amdgcn_mfma_f32_32x32x16_bf16(b1, qr[d0], p1, 0, 0, 0); }
}
template <int VB, bool SK>
__device__ __forceinline__ void pv_tile(f32x16* o, int vb0, bf16x8 pa0, bf16x8 pa1, bf16x8 pa2, bf16x8 pa3, bool act) {
    if (SK && !act) return;
#define TRRD(dst, off) asm volatile("ds_read_b64_tr_b16 %0, %1 offset:%2" : "=&v"(dst) : "v"(vb0), "i"(off) : "memory")
#define PV_D0(d0) do { s16x4 l0, l1, l2, l3, h0, h1, h2, h3; constexpr int b_ = VB * SHM_V + v_rd_off(d0, 0, 0);     \
        TRRD(l0, b_); TRRD(h0, b_ + 2048); TRRD(l1, b_ + 4096); TRRD(h1, b_ + 6144); TRRD(l2, b_ + 8192); TRRD(h2, b_ + 10240); TRRD(l3, b_ + 12288); TRRD(h3, b_ + 14336); \
        asm volatile("s_waitcnt lgkmcnt(0)" ::: "memory"); SBAR();                 \
        o[d0] = __builtin_amdgcn_mfma_f32_32x32x16_bf16(pa0, (bf16x8){l0[0], l0[1], l0[2], l0[3], h0[0], h0[1], h0[2], h0[3]}, o[d0], 0, 0, 0);   \
        o[d0] = __builtin_amdgcn_mfma_f32_32x32x16_bf16(pa1, (bf16x8){l1[0], l1[1], l1[2], l1[3], h1[0], h1[1], h1[2], h1[3]}, o[d0], 0, 0, 0);   \
        o[d0] = __builtin_amdgcn_mfma_f32_32x32x16_bf16(pa2, (bf16x8){l2[0], l2[1], l2[2], l2[3], h2[0], h2[1], h2[2], h2[3]}, o[d0], 0, 0, 0);   \
        o[d0] = __builtin_amdgcn_mfma_f32_32x32x16_bf16(pa3, (bf16x8){l3[0], l3[1], l3[2], l3[3], h3[0], h3[1], h3[2], h3[3]}, o[d0], 0, 0, 0); } while (0)
    PV_D0(0); PV_D0(1); PV_D0(2); PV_D0(3);
#undef PV_D0
#undef TRRD
}

template <class TIn, class TOut> struct BlockRef { const TIn* Q; const TIn* K; const TIn* V; TOut* O; int P0; };
template <class TIn> struct Seam {
    bf16x8 qr[8];
    bf16x8 st_v0, st_v1, st_k0, st_k1; f32x4 sf0, sf1, sf2, sf3;
    f32x4 tq[16];
};
__device__ __forceinline__ int swa_jlo(int P0, int W) { const int lowk = P0 - W + 1; return lowk > 0 ? lowk / KVBLK : 0; }
#define ROW(p, k0, rr) ((p) + (size_t)((k0) + (rr)) * D + sc)
#define VMW() asm volatile("s_waitcnt vmcnt(0)" ::: "memory")
#define VMWN(n) asm volatile("s_waitcnt vmcnt(%0)" :: "i"(n) : "memory")
#define SLOAD_H(Kp, Vp, k0) do { S.st_v0 = load8<TIn>(ROW(Vp, k0, sr)); S.st_v1 = load8<TIn>(ROW(Vp, k0, 32 + sr));              \
                         S.st_k0 = load8<TIn>(ROW(Kp, k0, sr)); S.st_k1 = load8<TIn>(ROW(Kp, k0, 32 + sr)); } while (0)
#define SWRITE_HK(bf) do { *(bf16x8*)(K_lds + (bf) * SHM_K + kws) = S.st_k0; *(bf16x8*)(K_lds + (bf) * SHM_K + kws + 32 * 256) = S.st_k1; } while (0)
#define SWRITE_HV(bf) do { *(bf16x8*)(V_lds + (bf) * SHM_V + vst0) = S.st_v0; *(bf16x8*)(V_lds + (bf) * SHM_V + vst1) = S.st_v1; } while (0)
#define SWRITE_H(bf) do { SWRITE_HV(bf); SWRITE_HK(bf); } while (0)
#define SLOAD_F(p, k0) do { S.sf0 = *(const f32x4*)ROW(p, k0, sr); S.sf1 = *(const f32x4*)(ROW(p, k0, sr) + 4);                \
                            S.sf2 = *(const f32x4*)ROW(p, k0, 32 + sr); S.sf3 = *(const f32x4*)(ROW(p, k0, 32 + sr) + 4); } while (0)
#define SWRITE_KF(bf) do { *(bf16x8*)(K_lds + (bf) * SHM_K + kws) = pack8(S.sf0, S.sf1); *(bf16x8*)(K_lds + (bf) * SHM_K + kws + 32 * 256) = pack8(S.sf2, S.sf3); } while (0)
#define SWRITE_VF(bf) do { *(bf16x8*)(V_lds + (bf) * SHM_V + vst0) = pack8(S.sf0, S.sf1); *(bf16x8*)(V_lds + (bf) * SHM_V + vst1) = pack8(S.sf2, S.sf3); } while (0)
template <class TIn, class TOut>
__device__ __forceinline__ void causal_swa_prime(const BlockRef<TIn, TOut>& cur, int W, char* lds, Seam<TIn>& S, int tid_in) {
    constexpr bool F32 = same_t<TIn, float>::v;
    const int tid = tid_in, wid = __builtin_amdgcn_readfirstlane(tid >> 6), lane = tid & 63, r32 = lane & 31, hi = lane >> 5;
    const int sr = tid >> 4, sc = (tid & 15) * 8, kws = KSWZ(sr, sc * 2); char* K_lds = lds + 2 * SHM_V;
    const int kb0 = swa_jlo(cur.P0, W) * KVBLK;
    for (int d0 = 0; d0 < 8; ++d0) S.qr[d0] = load8<TIn>(cur.Q + (size_t)(wid * QBLK + r32) * D + d0 * 16 + hi * 8);
    if constexpr (F32) { SLOAD_F((const float*)cur.K, kb0); VMW(); SWRITE_KF(0); SBAR(); SLOAD_F((const float*)cur.V, kb0); }
    else { SLOAD_H(cur.K, cur.V, kb0); VMW(); SWRITE_HK(0); }
    __syncthreads();
}
template <class TIn, class TOut>
__device__ __forceinline__ void causal_swa_block(const BlockRef<TIn, TOut>& cur, const BlockRef<TIn, TOut>& nxt, int skv, int W, char* lds, Seam<TIn>& S, int tid_in) {
    constexpr bool F32 = same_t<TIn, float>::v;
    const int tid = tid_in, wid = __builtin_amdgcn_readfirstlane(tid >> 6), lane = tid & 63, r32 = lane & 31, hi = lane >> 5;
    const int j_lo = swa_jlo(cur.P0, W);
    int j_hi = (cur.P0 + QB - 1) / KVBLK + 1; if (j_hi > skv / KVBLK) j_hi = skv / KVBLK;
    const int NT = j_hi - j_lo;
    const int kbn = swa_jlo(nxt.P0, W) * KVBLK;
    const int qlo = cur.P0 + wid * QBLK, qm = qlo + r32 - 4 * hi;
    char* V_lds = lds; char* K_lds = lds + 2 * SHM_V;
    float* ws = (float*)(lds + 2 * SHM_V + 2 * SHM_K) + wid * 64; float* li_l = ws, * al_l = ws + 32;
    float m_reg = -1e30f, l_reg = 0; f32x16 o[4] = {};
    const int sr = tid >> 4, sc = (tid & 15) * 8, vst0 = v_st(sr, sc), vst1 = v_st(32 + sr, sc), kws = KSWZ(sr, sc * 2);
    const int vb0 = (int)(uintptr_t)V_lds + v_rd_base(lane);
    const TIn* Kh = cur.K; const TIn* Vh = cur.V;
#define RESC(a) do { if (__any((a) < 1.f)) { if (hi == 0) al_l[r32] = (a); asm volatile("s_waitcnt lgkmcnt(0)" ::: "memory");              \
                     for (int d_ = 0; d_ < 4; ++d_) for (int r = 0; r < 16; ++r) o[d_][r] *= al_l[crow(r, hi)]; } } while (0)
#define KBASE(t) ((j_lo + (t)) * KVBLK)
#define ACT(t) (KBASE(t) <= qlo + QBLK - 1 && KBASE(t) + KVBLK - 1 >= qlo - W + 1)
#define MASKT(P0_, P1_, t) do { const int kb_ = KBASE(t); if ((!SK || ACT(t)) && (kb_ + KVBLK - 1 > qlo || kb_ <= qlo + QBLK - 1 - W)) mask_tile(P0_, P1_, qm - kb_, (unsigned)W); } while (0)
    constexpr int NQL = F32 ? 16 : 8;
    constexpr bool SK = WSKIP && !F32;
#define SEAM_K0() do { VMWN(NQL); if constexpr (F32) { SWRITE_KF(0); SBAR(); SLOAD_F((const float*)nxt.V, kbn); } else { SWRITE_HK(0); } SBAR(); } while (0)
    f32x16 pA0, pA1, pB0, pB1; float mnA, mnB, alA, alB; bf16x8 pa0, pa1, pa2, pa3;
    if constexpr (F32) { VMW(); SWRITE_VF(0); SBAR(); } else { SWRITE_HV(0); SBAR(); }
    if (NT > 1) { if constexpr (F32) SLOAD_F((const float*)Kh, KBASE(1)); else SLOAD_H(Kh, Vh, KBASE(1)); }
    SBAR(); qkt<0, SK>(pA0, pA1, K_lds, r32, hi, S.qr, ACT(0));
    if constexpr (F32) { if (NT > 1) { VMW(); SWRITE_KF(1); SBAR(); SLOAD_F((const float*)Vh, KBASE(1)); } }
    MASKT(pA0, pA1, 0); partialSM(pA0, pA1, m_reg, mnA, alA);
    if (NT > 1) { VMW(); if constexpr (F32) { SWRITE_VF(1); SBAR(); if (NT > 2) SLOAD_F((const float*)Kh, KBASE(2)); } else SWRITE_H(1); }
    __syncthreads();
#define HALF_STEP(PX0, PX1, mnX, alX, PY0, PY1, alY, t, KB, VB, SB) do {                                                      \
        SBAR(); qkt<KB, SK>(PX0, PX1, K_lds, r32, hi, S.qr, ACT(t));                                             \
        finishSM(PY0, PY1, alY, l_reg, pa0, pa1, pa2, pa3); SBAR();                                                           \
        if ((t) + 1 < NT) { if constexpr (F32) { VMW(); SWRITE_KF(SB); SBAR(); SLOAD_F((const float*)Vh, KBASE((t) + 1)); }  \
                            else { SLOAD_H(Kh, Vh, KBASE((t) + 1)); } SBAR(); }                                               \
        pv_tile<VB, SK>(o, vb0, pa0, pa1, pa2, pa3, ACT((t) - 1)); MASKT(PX0, PX1, (t)); partialSM(PX0, PX1, m_reg, mnX, alX);                                        \
        __syncthreads();                                                                                                      \
        if ((t) + 1 < NT) { VMW(); if constexpr (F32) { SWRITE_VF(SB); SBAR(); if ((t) + 2 < NT) SLOAD_F((const float*)Kh, KBASE((t) + 2)); } \
                            else { SWRITE_H(SB); } }                                                                          \
        RESC(alX); __syncthreads(); } while (0)
    for (int t = 1; t + 1 < NT; t += 2) {
        HALF_STEP(pB0, pB1, mnB, alB, pA0, pA1, alA, t, 1, 0, 0);
        HALF_STEP(pA0, pA1, mnA, alA, pB0, pB1, alB, t + 1, 0, 1, 1);
    }
    const bool even = (NT & 1) == 0;
    if (even) { SBAR(); qkt<1, SK>(pB0, pB1, K_lds, r32, hi, S.qr, ACT(NT - 1)); SBAR(); }
#define QROW(e) (nxt.Q + (size_t)(wid * QBLK + r32) * D + ((e) >> 1) * 16 + hi * 8 + ((e) & 1) * 4)
    if constexpr (F32) { SLOAD_F((const float*)nxt.K, kbn); SBAR();
#pragma unroll
        for (int e = 0; e < 8; ++e) S.tq[e] = *(const f32x4*)QROW(e); }
    else { SLOAD_H(nxt.K, nxt.V, kbn); SBAR();
#pragma unroll
        for (int d0 = 0; d0 < 8; ++d0) S.qr[d0] = load8<TIn>(nxt.Q + (size_t)(wid * QBLK + r32) * D + d0 * 16 + hi * 8); }
    SBAR();
    finishSM(pA0, pA1, alA, l_reg, pa0, pa1, pa2, pa3); SBAR();
    if constexpr (F32) {
#pragma unroll
        for (int e = 8; e < 16; ++e) S.tq[e] = *(const f32x4*)QROW(e); SBAR(); }
#undef QROW
    pv_tile<0, SK>(o, vb0, pa0, pa1, pa2, pa3, ACT(even ? NT - 2 : NT - 1));
    if (even) { MASKT(pB0, pB1, NT - 1); partialSM(pB0, pB1, m_reg, mnB, alB); __syncthreads(); RESC(alB);
        finishSM(pB0, pB1, alB, l_reg, pa0, pa1, pa2, pa3); SBAR(); pv_tile<1, SK>(o, vb0, pa0, pa1, pa2, pa3, ACT(NT - 1)); }
    SBAR(); SEAM_K0();
    if (hi == 0) li_l[r32] = l_reg; asm volatile("s_waitcnt lgkmcnt(0)" ::: "memory");
    float rli[16];
#pragma unroll
    for (int r = 0; r < 16; ++r) rli[r] = __builtin_amdgcn_rcpf(li_l[crow(r, hi)]);
    TOut* Ow = cur.O + (size_t)(wid * QBLK) * D;
    int hi_e = hi; asm volatile("" : "+v"(hi_e));
#pragma unroll
    for (int r = 0; r < 16; ++r) { const int orow = crow(r, hi_e);
#pragma unroll
        for (int d0 = 0; d0 < 4; ++d0) { const float v = o[d0][r] * rli[r];
            if constexpr (same_t<TOut, float>::v) { Ow[(size_t)orow * D + d0 * 32 + r32] = v; }
            else { const float vn = swz_xor<1>(v);
                   if ((r32 & 1) == 0) *(unsigned*)(Ow + (size_t)orow * D + d0 * 32 + r32) = cvtpk(v, vn); } } }
    if constexpr (F32) {
#pragma unroll
        for (int d0 = 0; d0 < 8; ++d0) S.qr[d0] = pack8(S.tq[2 * d0], S.tq[2 * d0 + 1]); }
    __syncthreads();
#undef RESC
#undef KBASE
#undef ACT
#undef MASKT
#undef SEAM_K0
#undef HALF_STEP
}
#undef ROW
#undef VMW
#undef VMWN
#undef SLOAD_H
#undef SWRITE_HK
#undef SWRITE_HV
#undef SWRITE_H
#undef SLOAD_F
#undef SWRITE_KF
#undef SWRITE_VF
#undef SBAR
#undef KSWZ
}
namespace cg = cooperative_groups;
#ifndef S3_REP
#define S3_REP 1
#endif
#ifndef MK_DEBUG
#define MK_DEBUG 0
#endif
#define LAS __attribute__((address_space(3)))
typedef unsigned short bf16r;
typedef unsigned v4u __attribute__((ext_vector_type(4)));
typedef unsigned v2u __attribute__((ext_vector_type(2)));
typedef float f32x4 __attribute__((ext_vector_type(4)));
typedef short bf16x8 __attribute__((ext_vector_type(8)));
constexpr int M = 16384, SEQ = 8192, DM = 1024, DFF = 2816, NUP = 5632, NIN = 3072, DEPTH = 4;
constexpr float EPS = 1e-6f;
constexpr size_t MiB = 1u << 20;
constexpr size_t WS_ADA = 1 * MiB, WS_GS = 2 * MiB, WS_SWF = 3 * MiB, WS_SWM = 4 * MiB, WS_SSQP = 5 * MiB, WS_GATES = 6 * MiB, WS_BCUM = 7 * MiB, WS_LOGI = 8 * MiB,
                 WS_SCAL = 9 * MiB, WS_NLOC = 10 * MiB, WS_NST = 11 * MiB, WS_LAM = 12 * MiB, WS_WGT = 13 * MiB, WS_SWG = 14 * MiB;
constexpr size_t WS_W13 = 16 * MiB, WS_W2 = 104 * MiB, WS_WINA = 148 * MiB, WS_WINB = 160 * MiB, WS_WOA = 172 * MiB, WS_WOB = 176 * MiB;
constexpr size_t WS_XS = 180 * MiB, WS_H = 212 * MiB, WS_P = 300 * MiB, WS_Y = 396 * MiB, WS_U = 428 * MiB, WS_CST = 556 * MiB, WS_END = 620 * MiB;
constexpr size_t WS_O = WS_H;
constexpr int LDS_BYTES = 147456;
constexpr int NWAVES = 8;

typedef float f32x2_t __attribute__((ext_vector_type(2))); typedef __bf16 bf16x2_t __attribute__((ext_vector_type(2)));
__device__ __forceinline__ unsigned pk2(float lo, float hi) { f32x2_t v = {lo, hi}; bf16x2_t b = __builtin_convertvector(v, bf16x2_t); return __builtin_bit_cast(unsigned, b); }
__device__ __forceinline__ unsigned f2bf(float f) { return pk2(f, f) & 0xffffu; }
__device__ __forceinline__ float bflo(unsigned w) { return __uint_as_float(w << 16); }
__device__ __forceinline__ float bfhi(unsigned w) { return __uint_as_float(w & 0xffff0000u); }
__device__ __forceinline__ float bf2f(bf16r v) { return __uint_as_float((unsigned)v << 16); }
__device__ __forceinline__ float wave_sum(float v) {
    v += swz_xor<1>(v); v += swz_xor<2>(v); v += swz_xor<4>(v); v += swz_xor<8>(v); v += swz_xor<16>(v); return sum_x32(v);
}
__device__ __forceinline__ float wave_max(float v) {
    v = fmaxf(v, swz_xor<1>(v)); v = fmaxf(v, swz_xor<2>(v)); v = fmaxf(v, swz_xor<4>(v)); v = fmaxf(v, swz_xor<8>(v)); v = fmaxf(v, swz_xor<16>(v)); return max_x32(v);
}
__device__ __forceinline__ float lane_up(float v, int lane, int o) { return __builtin_bit_cast(float, __builtin_amdgcn_ds_bpermute(((lane - o) & 63) << 2, __builtin_bit_cast(int, v))); }
#define LDS_WAIT() asm volatile("s_waitcnt lgkmcnt(0)" ::: "memory")

struct Args { const void* in[19]; float* out; unsigned char* ws; int ph_lo, ph_hi; };
typedef const Args __attribute__((address_space(4)))* KArgs;
struct Ctx { KArgs ka; float* out; unsigned char* ws; int tid, lane, wave, G, wg; };

__device__ __forceinline__ void transpose_item(const float* W, int ldw, int k0, int n0, bf16r* dst  , int Kdst, LAS float* scr, int lane) {
#pragma unroll 8
    for (int i = 0; i < 32; ++i) { const int kk = 2 * i + (lane >> 5); scr[kk * 33 + (lane & 31)] = W[(size_t)(k0 + kk) * ldw + n0 + (lane & 31)]; }
    LDS_WAIT(); asm volatile("" ::: "memory");
    const int c = lane & 7;
#pragma unroll
    for (int j = 0; j < 4; ++j) { const int n = (lane >> 3) + 8 * j; const LAS float* s = scr + (8 * c) * 33 + n;
        v4u o; o.x = pk2(s[0 * 33], s[1 * 33]); o.y = pk2(s[2 * 33], s[3 * 33]); o.z = pk2(s[4 * 33], s[5 * 33]); o.w = pk2(s[6 * 33], s[7 * 33]);
        *(v4u*)(dst + (size_t)n * Kdst + k0 + 8 * c) = o; }
    LDS_WAIT(); asm volatile("" ::: "memory");
}
__device__ __forceinline__ void p0_phase(const Ctx& F, LAS unsigned char* lds) {
#if MK_DEBUG
    if (F.wg == 0 && F.tid == 1) *(unsigned*)(F.ws + 64) = 0u;
#endif
    {
        LAS float* red = (LAS float*)lds;
        float* ADA = (float*)(F.ws + WS_ADA);
        const int l32 = F.tid & 31, kg = F.tid >> 5;
        for (int task = F.wg; task < 4 * 72; task += F.G) {
            const int l = task / 72, col0 = (task % 72) * 128;
            f32x4 a0 = {0.f, 0.f, 0.f, 0.f}, a1 = {0.f, 0.f, 0.f, 0.f};
            const float* wp = ((const float*)F.ka->in[3]) + ((size_t)l * 1024 + kg * 64) * 9216 + col0 + l32 * 4;
#pragma unroll 8
            for (int kk = 0; kk < 64; ++kk) {
                const f32x4 w = *(const f32x4*)(wp + (size_t)kk * 9216);
                const float c0 = ((const float*)F.ka->in[1])[kg * 64 + kk], c1 = ((const float*)F.ka->in[1])[1024 + kg * 64 + kk];
                a0 += w * pg8::silu_f(c0); a1 += w * pg8::silu_f(c1);
            }
            *(LAS f32x4*)(red + (kg * 2 + 0) * 128 + l32 * 4) = a0; *(LAS f32x4*)(red + (kg * 2 + 1) * 128 + l32 * 4) = a1;
            __syncthreads();
            if (F.tid < 256) { const int b = F.tid >> 7, col = F.tid & 127; float s = 0.f;
#pragma unroll
                for (int g = 0; g < 16; ++g) s += red[(g * 2 + b) * 128 + col];
                ADA[(size_t)(l * 2 + b) * 9216 + col0 + col] = s + ((const float*)F.ka->in[4])[(size_t)l * 9216 + col0 + col]; }
            __syncthreads();
        }
    }
    for (int i = F.wg * 512 + F.tid; i < 2 * 8 * 1024; i += F.G * 512) { const int jj = i >> 13, g = (i >> 10) & 7, k = i & 1023;
        ((float*)(F.ws + WS_WGT))[i] = ((const float*)F.ka->in[8])[((size_t)jj * 1024 + k) * 3080 + 3072 + g]; }
    {
        LAS float* scr = (LAS float*)(lds + 16384 + F.wave * 8448);
        const int gw = F.wg * NWAVES + F.wave, NGW = F.G * NWAVES;
        constexpr int I13 = 16 * 176, I2 = 44 * 32, IIN = 16 * 96, IOUT = 16 * 32;
        constexpr int T0 = 8 * I13, T1 = T0 + 8 * I2, T2 = T1 + 2 * IIN, T3 = T2 + 2 * IIN, T4 = T3 + 2 * IOUT, T5 = T4 + 2 * IOUT;
        for (int it = gw; it < T5; it += NGW) {
            if (it < T0) { const int mat = it / I13, r = it % I13, kb = r / 176, n0 = (r % 176) * 32;
                const int drow = n0 < 2816 ? (n0 >> 7) * 256 + (n0 & 127) : ((n0 - 2816) >> 7) * 256 + 128 + ((n0 - 2816) & 127);
                transpose_item(((const float*)F.ka->in[6]) + (size_t)mat * 1024 * 5632, 5632, kb * 64, n0, (bf16r*)(F.ws + WS_W13) + ((size_t)mat * 5632 + drow) * 1024, 1024, scr, F.lane); }
            else if (it < T1) { const int q = it - T0, mat = q / I2, r = q % I2, kb = r / 32, n0 = (r % 32) * 32;
                transpose_item(((const float*)F.ka->in[7]) + (size_t)mat * 2816 * 1024, 1024, kb * 64, n0, (bf16r*)(F.ws + WS_W2) + ((size_t)mat * 1024 + n0) * 2816, 2816, scr, F.lane); }
            else if (it < T2) { const int q = it - T1, mat = q / IIN, r = q % IIN, kb = r / 96, n0 = (r % 96) * 32;
                transpose_item(((const float*)F.ka->in[8]) + (size_t)mat * 1024 * 3080, 3080, kb * 64, n0, (bf16r*)(F.ws + WS_WINA) + ((size_t)mat * 3072 + n0) * 1024, 1024, scr, F.lane); }
            else if (it < T3) { const int q = it - T2, mat = q / IIN, r = q % IIN, kb = r / 96, n0 = (r % 96) * 32;
                transpose_item(((const float*)F.ka->in[14]) + (size_t)mat * 1024 * 3072, 3072, kb * 64, n0, (bf16r*)(F.ws + WS_WINB) + ((size_t)mat * 3072 + n0) * 1024, 1024, scr, F.lane); }
            else if (it < T4) { const int q = it - T3, mat = q / IOUT, r = q % IOUT, kb = r / 32, n0 = (r % 32) * 32;
                transpose_item(((const float*)F.ka->in[13]) + (size_t)mat * 1024 * 1024, 1024, kb * 64, n0, (bf16r*)(F.ws + WS_WOA) + ((size_t)mat * 1024 + n0) * 1024, 1024, scr, F.lane); }
            else { const int q = it - T4, mat = q / IOUT, r = q % IOUT, kb = r / 32, n0 = (r % 32) * 32;
                transpose_item(((const float*)F.ka->in[17]) + (size_t)mat * 1024 * 1024, 1024, kb * 64, n0, (bf16r*)(F.ws + WS_WOB) + ((size_t)mat * 1024 + n0) * 1024, 1024, scr, F.lane); }
        }
    }
}
__device__ __forceinline__ void p1_phase(const Ctx& F) {
    const float* ADA = (const float*)(F.ws + WS_ADA);
    float* GS = (float*)(F.ws + WS_GS);
    const int gw = F.wg * NWAVES + F.wave, NGW = F.G * NWAVES;
    for (int i = F.wg * 512 + F.tid; i < 4 * 3 * 2 * 1024; i += F.G * 512) {
        const int d = i & 1023, b = (i >> 10) & 1, ls = i >> 11, l = ls / 3, sub = ls % 3;
        GS[i] = ((const float*)F.ka->in[5])[(size_t)ls * 1024 + d] * (1.0f + ADA[(size_t)(l * 2 + b) * 9216 + sub * 3072 + 1024 + d]);
    }
    if (F.wg == 0 && F.tid < 2) {
        const float* lm = ((const float*)F.ka->in[15]) + F.tid * 512; float s1 = 0.f, s2 = 0.f;
        for (int k = 0; k < 128; ++k) { s1 += lm[k] * lm[128 + k]; s2 += lm[256 + k] * lm[384 + k]; }
        const float lam_init = F.tid == 0 ? 0.35550906759096934f : 0.5560582041556406f;
        ((float*)(F.ws + WS_LAM))[F.tid] = expf(s1) - expf(s2) + lam_init;
    }
    if (gw < 32) { const int jj = gw >> 4, b = (gw >> 3) & 1, g = gw & 7, l = jj * 2; const float* sh = ADA + (size_t)(l * 2 + b) * 9216 + 3072; const float* w = (const float*)(F.ws + WS_WGT) + (size_t)(jj * 8 + g) * 1024;
        float s = 0.f;
#pragma unroll
        for (int q = 0; q < 16; ++q) s += sh[q * 64 + F.lane] * w[q * 64 + F.lane];
        s = wave_sum(s); if (F.lane == 0) ((float*)(F.ws + WS_SWG))[gw] = s; }
    {
        float* ssqp = (float*)(F.ws + WS_SSQP); bf16r* XS = (bf16r*)(F.ws + WS_XS);
        for (int m = gw; m < M; m += NGW) {
            const int b = m >> 13;
            const f32x4* xr = (const f32x4*)(((const float*)F.ka->in[0]) + (size_t)m * 1024) + F.lane;
            v2u* xsr = (v2u*)(XS + (size_t)m * 1024) + F.lane;
            float ss = 0.f;
#pragma unroll
            for (int j = 0; j < 4; ++j) {
                const f32x4 v = xr[64 * j];
                ss += (v[0] * v[0] + v[1] * v[1]) + (v[2] * v[2] + v[3] * v[3]);
                const int col = 4 * F.lane + 256 * j;
                const f32x4 ng = *(const f32x4*)(((const float*)F.ka->in[5]) + col);
                const f32x4 sc = *(const f32x4*)(ADA + (size_t)b * 9216 + 1024 + col);
                const f32x4 y = v * ng * (sc + 1.0f);
                v2u w; w.x = pk2(y[0], y[1]); w.y = pk2(y[2], y[3]); xsr[64 * j] = w;
            }
            ss = wave_sum(ss);
            if (F.lane < 16) ssqp[(size_t)F.lane * M + m] = F.lane == 0 ? ss : 0.f;
        }
    }
    {
        float* SWF = (float*)(F.ws + WS_SWF); float* SWM = (float*)(F.ws + WS_SWM);
        constexpr int RF = 8 * 5632, RT = RF + 4 * 3072;
        for (int r = gw; r < RT; r += NGW) {
            const bf16r* wt; const float* sh; float* o; int ostride;
            if (r < RF) { const int q = r / 5632, n = r % 5632, l = q >> 1, f = q & 1;
                wt = (const bf16r*)(F.ws + WS_W13) + (size_t)r * 1024; sh = ADA + (size_t)l * 2 * 9216 + (f ? 2 : 0) * 3072; o = SWF + (size_t)q * 2 * 5632 + n; ostride = 5632; }
            else { const int rr = r - RF, l = rr / 3072, n = rr % 3072;
                wt = (const bf16r*)(F.ws + ((l & 1) ? WS_WINB : WS_WINA)) + ((size_t)(l >> 1) * 3072 + n) * 1024; sh = ADA + (size_t)l * 2 * 9216 + 3072; o = SWM + (size_t)l * 2 * 3072 + n; ostride = 3072; }
            const v4u w0 = *(const v4u*)(wt + F.lane * 16), w1 = *(const v4u*)(wt + F.lane * 16 + 8);
            float wv[16] = {bflo(w0.x), bfhi(w0.x), bflo(w0.y), bfhi(w0.y), bflo(w0.z), bfhi(w0.z), bflo(w0.w), bfhi(w0.w),
                            bflo(w1.x), bfhi(w1.x), bflo(w1.y), bfhi(w1.y), bflo(w1.z), bfhi(w1.z), bflo(w1.w), bfhi(w1.w)};
            float s0 = 0.f, s1 = 0.f;
#pragma unroll
            for (int j = 0; j < 4; ++j) {
                const f32x4 h0 = *(const f32x4*)(sh + F.lane * 16 + 4 * j), h1 = *(const f32x4*)(sh + 9216 + F.lane * 16 + 4 * j);
#pragma unroll
                for (int e = 0; e < 4; ++e) { s0 += wv[4 * j + e] * h0[e]; s1 += wv[4 * j + e] * h1[e]; }
            }
            s0 = wave_sum(s0); s1 = wave_sum(s1);
            if (F.lane == 0) { o[0] = s0; o[ostride] = s1; }
        }
    }
}
__device__ __forceinline__ void gates_phase(const Ctx& F, LAS unsigned char* lds, int l) {
    const int j = l >> 1;
    const float* ssqp = (const float*)(F.ws + WS_SSQP); const bf16r* XS = (const bf16r*)(F.ws + WS_XS); float* GT = (float*)(F.ws + WS_GATES);
    const float* WGT = (const float*)(F.ws + WS_WGT) + (size_t)j * 8192; const float* SWG = (const float*)(F.ws + WS_SWG) + j * 16;
    for (int ch = F.wg; ch < 256; ch += F.G) {
        const int b = ch >> 7, m0 = ch * 64;
        f32x4 w[8][2][2];
#pragma unroll
        for (int g = 0; g < 8; ++g)
#pragma unroll
            for (int jj = 0; jj < 2; ++jj) { const float* p = WGT + g * 1024 + jj * 512 + F.lane * 8; w[g][jj][0] = *(const f32x4*)p; w[g][jj][1] = *(const f32x4*)(p + 4); }
        const float swg = F.lane < 8 ? SWG[b * 8 + F.lane] : 0.f;
#pragma unroll
        for (int half = 0; half < 2; ++half) {
            v4u xr[4][2]; float ssv[4];
#pragma unroll
            for (int i = 0; i < 4; ++i) { const int row = m0 + F.wave * 8 + half * 4 + i;
                xr[i][0] = *(const v4u*)(XS + (size_t)row * 1024 + F.lane * 8); xr[i][1] = *(const v4u*)(XS + (size_t)row * 1024 + 512 + F.lane * 8);
                ssv[i] = F.lane < 16 ? ssqp[(size_t)F.lane * M + row] : 0.f; }
#pragma unroll
            for (int i = 0; i < 4; ++i) { const int row = m0 + F.wave * 8 + half * 4 + i;
                const float rs = rsqrtf(wave_sum(ssv[i]) * (1.0f / 1024.0f) + EPS);
                float mine = 0.f;
#pragma unroll
                for (int g = 0; g < 8; ++g) { float a = 0.f;
#pragma unroll
                    for (int jj = 0; jj < 2; ++jj) { const v4u x = xr[i][jj]; const f32x4 w0 = w[g][jj][0], w1 = w[g][jj][1];
                        a += bflo(x.x) * w0[0] + bfhi(x.x) * w0[1] + bflo(x.y) * w0[2] + bfhi(x.y) * w0[3] + bflo(x.z) * w1[0] + bfhi(x.z) * w1[1] + bflo(x.w) * w1[2] + bfhi(x.w) * w1[3]; }
                    a = wave_sum(a); if (F.lane == g) mine = a; }
                if (F.lane < 8) GT[(size_t)row * 8 + F.lane] = mine * rs + swg; }
        }
    }
}
__device__ __forceinline__ bf16x8 ldfrag(const LAS bf16r* base, int row0, int stride, int k0, int lane) {
    return *(const LAS bf16x8*)(base + (row0 + (lane & 15)) * stride + k0 + (lane >> 4) * 8);
}
__device__ __forceinline__ void conv8(const bf16r* P, size_t mrow, int ps, int ch0, const float* cw, const float* cb, float scale, float (&o)[8]) {
    float acc[8];
    { const f32x4 b0 = *(const f32x4*)(cb + ch0), b1 = *(const f32x4*)(cb + ch0 + 4); acc[0] = b0[0]; acc[1] = b0[1]; acc[2] = b0[2]; acc[3] = b0[3]; acc[4] = b1[0]; acc[5] = b1[1]; acc[6] = b1[2]; acc[7] = b1[3]; }
#pragma unroll
    for (int jt = 0; jt < 4; ++jt) {
        if (ps - 3 + jt >= 0) {
            const v4u w = *(const v4u*)(P + (mrow - 3 + jt) * 3072 + ch0);
            const f32x4 c0 = *(const f32x4*)(cw + jt * 1024 + ch0), c1 = *(const f32x4*)(cw + jt * 1024 + ch0 + 4);
            acc[0] += bflo(w.x) * c0[0]; acc[1] += bfhi(w.x) * c0[1]; acc[2] += bflo(w.y) * c0[2]; acc[3] += bfhi(w.y) * c0[3];
            acc[4] += bflo(w.z) * c1[0]; acc[5] += bfhi(w.z) * c1[1]; acc[6] += bflo(w.w) * c1[2]; acc[7] += bfhi(w.w) * c1[3];
        }
    }
#pragma unroll
    for (int e = 0; e < 8; ++e) o[e] = pg8::silu_f(acc[e]) * scale;
}
__device__ __forceinline__ void conv_load(const bf16r* P, size_t mrow, int ps, int ch0, v4u (&raw)[4]) {
#pragma unroll
    for (int jt = 0; jt < 4; ++jt) raw[jt] = (ps - 3 + jt >= 0) ? *(const v4u*)(P + (mrow - 3 + jt) * 3072 + ch0) : (v4u){0u, 0u, 0u, 0u};
}
__device__ __forceinline__ void conv_apply(const v4u (&raw)[4], const f32x4 (&cwv)[4][2], const f32x4 (&cbv)[2], float scale, float (&o)[8]) {
    float acc[8] = {cbv[0][0], cbv[0][1], cbv[0][2], cbv[0][3], cbv[1][0], cbv[1][1], cbv[1][2], cbv[1][3]};
#pragma unroll
    for (int jt = 0; jt < 4; ++jt) { const v4u w = raw[jt]; const f32x4 c0 = cwv[jt][0], c1 = cwv[jt][1];
        acc[0] += bflo(w.x) * c0[0]; acc[1] += bfhi(w.x) * c0[1]; acc[2] += bflo(w.y) * c0[2]; acc[3] += bfhi(w.y) * c0[3];
        acc[4] += bflo(w.z) * c1[0]; acc[5] += bfhi(w.z) * c1[1]; acc[6] += bflo(w.w) * c1[2]; acc[7] += bfhi(w.w) * c1[3]; }
#pragma unroll
    for (int e = 0; e < 8; ++e) o[e] = pg8::silu_f(acc[e]) * scale;
}
__device__ __forceinline__ void conv_weights(const float* cw, const float* cb, int ch0, f32x4 (&cwv)[4][2], f32x4 (&cbv)[2]) {
#pragma unroll
    for (int jt = 0; jt < 4; ++jt) { cwv[jt][0] = *(const f32x4*)(cw + jt * 1024 + ch0); cwv[jt][1] = *(const f32x4*)(cw + jt * 1024 + ch0 + 4); }
    cbv[0] = *(const f32x4*)(cb + ch0); cbv[1] = *(const f32x4*)(cb + ch0 + 4);
}
__device__ __forceinline__ int vt_idx(int r, int s) { return r * 72 + ((((s >> 3) ^ (r >> 3)) & 7) << 3) + (s & 7); }
__device__ __forceinline__ void vt_scatter(LAS bf16r* T, int r0  , int s, const v4u w) {
    LAS bf16r* d = T + vt_idx(r0, s);
    d[0] = (bf16r)(w.x & 0xffffu); d[72] = (bf16r)(w.x >> 16); d[2 * 72] = (bf16r)(w.y & 0xffffu); d[3 * 72] = (bf16r)(w.y >> 16);
    d[4 * 72] = (bf16r)(w.z & 0xffffu); d[5 * 72] = (bf16r)(w.z >> 16); d[6 * 72] = (bf16r)(w.w & 0xffffu); d[7 * 72] = (bf16r)(w.w >> 16);
}
__device__ __forceinline__ bf16x8 ldfrag_swp(const LAS bf16r* base, int nt, int k0, int lane) {
    const int i = lane & 15, r = 32 * (nt >> 1) + 8 * (i >> 2) + 4 * (nt & 1) + (i & 3);
    return *(const LAS bf16x8*)(base + r * 72 + (((((k0 >> 3) + (lane >> 4)) ^ (r >> 3)) & 7) << 3));
}
__device__ __forceinline__ bf16x8 ldfrag_sw(const LAS bf16r* base, int row0, int k0, int lane) {
    const int r = row0 + (lane & 15);
    return *(const LAS bf16x8*)(base + r * 72 + (((((k0 >> 3) + (lane >> 4)) ^ (r >> 3)) & 7) << 3));
}
constexpr int VT_STRIDE = 72, QK_STRIDE = 136;
__device__ __forceinline__ void s1_phase(const Ctx& F, LAS unsigned char* lds, int l) {
    const int j = l >> 1;
    LAS bf16r* VT = (LAS bf16r*)lds;
    LAS bf16r* KT = (LAS bf16r*)(lds + 36864);
    LAS float* wS = (LAS float*)(lds + 36864 + 18432);
    const bf16r* P = (const bf16r*)(F.ws + WS_P); const float* GT = (const float*)(F.ws + WS_GATES);
    float* BCUM = (float*)(F.ws + WS_BCUM); float* LOGI = (float*)(F.ws + WS_LOGI); float* BLAST = (float*)(F.ws + WS_SCAL); float* MLOC = BLAST + 16384;
    float* NLOC = (float*)(F.ws + WS_NLOC); bf16r* U = (bf16r*)(F.ws + WS_U);
    const float* cw = ((const float*)F.ka->in[9]) + (size_t)j * 4096; const float* cb = ((const float*)F.ka->in[10]) + (size_t)j * 1024; const float* bif = ((const float*)F.ka->in[11]) + j * 8;
    for (int u = F.wg; u < 1024; u += F.G) {
        const int b = u >> 9, h = (u >> 7) & 3, c = u & 127, bh = b * 4 + h;
        const size_t m0 = (size_t)b * 8192 + c * 64;
        if (F.wave == 0) {
            const int s = F.lane;
            const float gi = GT[(m0 + s) * 8 + h] + bif[h], gf = GT[(m0 + s) * 8 + 4 + h] + bif[4 + h];
            const float lf = fminf(gf, 0.f) - log1pf(expf(-fabsf(gf)));
            float bc = lf;
#pragma unroll
            for (int o = 1; o < 64; o <<= 1) { const float t = lane_up(bc, s, o); if (s >= o) bc += t; }
            const float blast = __builtin_bit_cast(float, __builtin_amdgcn_readlane(__builtin_bit_cast(int, bc), 63));
            const float wl = blast - bc + gi;
            const float mloc = wave_max(wl);
            wS[s] = __expf(wl - mloc);
            BCUM[(size_t)bh * 8192 + c * 64 + s] = bc; LOGI[(size_t)bh * 8192 + c * 64 + s] = gi;
            if (s == 0) { BLAST[bh * 128 + c] = blast; MLOC[bh * 128 + c] = mloc; }
        }
        __syncthreads();
        {
            const int cg = F.tid & 15, s0 = F.tid >> 4, vg = F.tid & 31, sv0 = F.tid >> 5, kch = 512 + h * 128 + cg * 8;
            v4u rk[2][4], rv[4];
#pragma unroll
            for (int i = 0; i < 2; ++i) conv_load(P, m0 + s0 + 32 * i, c * 64 + s0 + 32 * i, kch, rk[i]);
#pragma unroll
            for (int i = 0; i < 4; ++i) rv[i] = *(const v4u*)(P + (m0 + sv0 + 16 * i) * 3072 + 1024 + h * 256 + vg * 8);
            f32x4 cwv[4][2], cbv[2]; conv_weights(cw, cb, kch, cwv, cbv);
#pragma unroll
            for (int i = 0; i < 2; ++i) { const int s = s0 + 32 * i; float kv[8]; conv_apply(rk[i], cwv, cbv, 0.08838834764831845f, kv);
                const float w = wS[s];
#pragma unroll
                for (int e2 = 0; e2 < 8; ++e2) KT[vt_idx(cg * 8, s) + e2 * 72] = (bf16r)f2bf(kv[e2] * w); }
#pragma unroll
            for (int i = 0; i < 4; ++i) vt_scatter(VT, vg * 8, sv0 + 16 * i, rv[i]);
        }
        __syncthreads();
        { const int d = F.tid >> 2, q4 = F.tid & 3; float s = 0.f;
#pragma unroll
          for (int e = 0; e < 16; ++e) s += bf2f(KT[vt_idx(d, q4 * 16 + e)]);
          s += swz_xor<1>(s); s += swz_xor<2>(s);
          if (q4 == 0) NLOC[(size_t)u * 128 + d] = s; }
        {
            f32x4 acc[2][8];
#pragma unroll
            for (int mt = 0; mt < 2; ++mt)
#pragma unroll
                for (int nt = 0; nt < 8; ++nt) acc[mt][nt] = (f32x4){0.f, 0.f, 0.f, 0.f};
#pragma unroll
            for (int ks = 0; ks < 2; ++ks) {
                bf16x8 av[2];
#pragma unroll
                for (int mt = 0; mt < 2; ++mt) av[mt] = ldfrag_sw(VT, 32 * F.wave + 16 * mt, ks * 32, F.lane);
#pragma unroll
                for (int nt = 0; nt < 8; ++nt) { const bf16x8 bk = ldfrag_swp(KT, nt, ks * 32, F.lane);
#pragma unroll
                    for (int mt = 0; mt < 2; ++mt) acc[mt][nt] = __builtin_amdgcn_mfma_f32_16x16x32_bf16(bk, av[mt], acc[mt][nt], 0, 0, 0); }
            }
            bf16r* up = U + (size_t)u * 32768;
#pragma unroll
            for (int mt = 0; mt < 2; ++mt)
#pragma unroll
                for (int p = 0; p < 4; ++p) { v4u w; w.x = pk2(acc[mt][2 * p][0], acc[mt][2 * p][1]); w.y = pk2(acc[mt][2 * p][2], acc[mt][2 * p][3]);
                    w.z = pk2(acc[mt][2 * p + 1][0], acc[mt][2 * p + 1][1]); w.w = pk2(acc[mt][2 * p + 1][2], acc[mt][2 * p + 1][3]);
                    *(v4u*)(up + (size_t)(32 * F.wave + 16 * mt + (F.lane & 15)) * 128 + 32 * p + 8 * (F.lane >> 4)) = w; }
        }
        __syncthreads();
    }
}
__device__ __forceinline__ void s2_phase(const Ctx& F, LAS unsigned char* lds) {
    const float* BLAST = (const float*)(F.ws + WS_SCAL); const float* MLOC = BLAST + 16384; float* MST = (float*)(F.ws + WS_SCAL) + 32768;
    const bf16r* U = (const bf16r*)(F.ws + WS_U); const float* NLOC = (const float*)(F.ws + WS_NLOC); float* NST = (float*)(F.ws + WS_NST); bf16r* CST = (bf16r*)(F.ws + WS_CST);
    LAS float* decS = (LAS float*)lds; LAS float* gainS = decS + 128;
    for (int w = F.wg; w < 256; w += F.G) {
        const int bh = w >> 5, slice = w & 31;
        LAS float* blS = gainS + 128; LAS float* mlS = blS + 128; LAS float* mS = mlS + 128;
        if (F.tid < 128) { blS[F.tid] = BLAST[bh * 128 + F.tid]; mlS[F.tid] = MLOC[bh * 128 + F.tid]; }
        __syncthreads();
        if (F.tid == 0) { float m = 0.f;
            for (int c = 0; c < 128; ++c) { const float bl = blS[c], ml = mlS[c], mn = fmaxf(bl + m, ml); mS[c] = m; blS[c] = bl + m - mn; mlS[c] = ml - mn; m = mn; } }
        __syncthreads();
        if (F.tid < 128) { decS[F.tid] = expf(blS[F.tid]); gainS[F.tid] = expf(mlS[F.tid]); if (slice == 0) MST[bh * 128 + F.tid] = mS[F.tid]; }
        __syncthreads();
        const size_t e2 = (size_t)slice * 1024 + F.tid * 2;
        float s0 = 0.f, s1 = 0.f;
        for (int c0 = 0; c0 < 128; c0 += 16) {
            unsigned uv[16];
#pragma unroll
            for (int i = 0; i < 16; ++i) uv[i] = *(const unsigned*)(U + (size_t)(bh * 128 + c0 + i) * 32768 + e2);
#pragma unroll
            for (int i = 0; i < 16; ++i) { const int c = c0 + i;
                *(unsigned*)(CST + (size_t)(bh * 128 + c) * 32768 + e2) = pk2(s0, s1);
                const float dec = decS[c], gain = gainS[c];
                s0 = s0 * dec + bflo(uv[i]) * gain; s1 = s1 * dec + bfhi(uv[i]) * gain; }
        }
        if (slice == 0 && F.tid < 128) { float s = 0.f;
            for (int c0 = 0; c0 < 128; c0 += 16) { float nv[16];
#pragma unroll
                for (int i = 0; i < 16; ++i) nv[i] = NLOC[(size_t)(bh * 128 + c0 + i) * 128 + F.tid];
#pragma unroll
                for (int i = 0; i < 16; ++i) { const int c = c0 + i; NST[(size_t)(bh * 128 + c) * 128 + F.tid] = s; s = s * decS[c] + nv[i] * gainS[c]; } } }
        __syncthreads();
    }
}
__device__ __forceinline__ void s3_phase(const Ctx& F, LAS unsigned char* lds, int l) {
    const int j = l >> 1;
    LAS bf16r* VT = (LAS bf16r*)lds;
    LAS bf16r* Qs = (LAS bf16r*)(lds + 36864);
    LAS bf16r* Ks = (LAS bf16r*)(lds + 36864 + 17408);
    LAS bf16r* Sw = (LAS bf16r*)(lds + 36864 + 34816);
    LAS float* fa = (LAS float*)(lds + 36864 + 34816 + 9216);
    LAS float* bS = fa, *zS = fa + 64, *mtS = fa + 128, *inS = fa + 192, *dnS = fa + 256, *nS = fa + 320  , *sqS = fa + 448  ;
    const bf16r* P = (const bf16r*)(F.ws + WS_P);
    const float* BCUM = (const float*)(F.ws + WS_BCUM); const float* LOGI = (const float*)(F.ws + WS_LOGI); const float* MST = (const float*)(F.ws + WS_SCAL) + 32768;
    const float* NST = (const float*)(F.ws + WS_NST); const bf16r* CST = (const bf16r*)(F.ws + WS_CST); bf16r* Y = (bf16r*)(F.ws + WS_Y);
    const float* cw = ((const float*)F.ka->in[9]) + (size_t)j * 4096; const float* cb = ((const float*)F.ka->in[10]) + (size_t)j * 1024; const float* ng = ((const float*)F.ka->in[12]) + (size_t)j * 1024;
    const int lane = F.lane, w = F.wave, fr = lane & 15, fq = lane >> 4;
    for (int u = F.wg; u < 1024; u += F.G) {
        const int b = u >> 9, h = (u >> 7) & 3, c = u & 127, bh = b * 4 + h;
        const size_t m0 = (size_t)b * 8192 + c * 64;
        bf16x8 cf[2][4];
#pragma unroll
        for (int nt = 0; nt < 2; ++nt)
#pragma unroll
            for (int ks = 0; ks < 4; ++ks) cf[nt][ks] = *(const bf16x8*)(CST + (size_t)u * 32768 + (size_t)(32 * w + 16 * nt + fr) * 128 + ks * 32 + fq * 8);
        if (w == 0) {
            const int s = lane;
            const float bs = BCUM[(size_t)bh * 8192 + c * 64 + s], li = LOGI[(size_t)bh * 8192 + c * 64 + s], mc = MST[bh * 128 + c];
            const float a = bs + mc, z = li - bs;
            float pm = z;
#pragma unroll
            for (int o = 1; o < 64; o <<= 1) { const float t = lane_up(pm, s, o); if (s >= o) pm = fmaxf(pm, t); }
            const float mt = fmaxf(a, bs + pm);
            bS[s] = bs; zS[s] = z; mtS[s] = mt; inS[s] = __expf(a - mt);
        } else if (w <= 2) { const int d = (w - 1) * 64 + lane; nS[d] = NST[(size_t)u * 128 + d]; }
        {
            const int cg = F.tid & 15, s0 = F.tid >> 4, vg = F.tid & 31, sv0 = F.tid >> 5, qch = h * 128 + cg * 8, kch = 512 + qch;
            v4u rq[2][4], rk[2][4], rv[4];
#pragma unroll
            for (int i = 0; i < 2; ++i) { conv_load(P, m0 + s0 + 32 * i, c * 64 + s0 + 32 * i, qch, rq[i]); conv_load(P, m0 + s0 + 32 * i, c * 64 + s0 + 32 * i, kch, rk[i]); }
#pragma unroll
            for (int i = 0; i < 4; ++i) rv[i] = *(const v4u*)(P + (m0 + sv0 + 16 * i) * 3072 + 1024 + h * 256 + vg * 8);
            { f32x4 cwv[4][2], cbv[2]; conv_weights(cw, cb, qch, cwv, cbv);
#pragma unroll
              for (int i = 0; i < 2; ++i) { float kv[8]; conv_apply(rq[i], cwv, cbv, 1.0f, kv);
                  v4u o; o.x = pk2(kv[0], kv[1]); o.y = pk2(kv[2], kv[3]); o.z = pk2(kv[4], kv[5]); o.w = pk2(kv[6], kv[7]); *(LAS v4u*)(Qs + (s0 + 32 * i) * QK_STRIDE + cg * 8) = o; } }
            { f32x4 cwv[4][2], cbv[2]; conv_weights(cw, cb, kch, cwv, cbv);
#pragma unroll
              for (int i = 0; i < 2; ++i) { float kv[8]; conv_apply(rk[i], cwv, cbv, 0.08838834764831845f, kv);
                  v4u o; o.x = pk2(kv[0], kv[1]); o.y = pk2(kv[2], kv[3]); o.z = pk2(kv[4], kv[5]); o.w = pk2(kv[6], kv[7]); *(LAS v4u*)(Ks + (s0 + 32 * i) * QK_STRIDE + cg * 8) = o; } }
#pragma unroll
            for (int i = 0; i < 4; ++i) vt_scatter(VT, vg * 8, sv0 + 16 * i, rv[i]);
        }
#if S3_REP > 1
        __syncthreads();
        {
            const int cg = F.tid & 15, s0 = F.tid >> 4, vg = F.tid & 31, sv0 = F.tid >> 5, qch = h * 128 + cg * 8, kch = 512 + qch;
            v4u rq[2][4], rk[2][4], rv[4];
#pragma unroll
            for (int i = 0; i < 2; ++i) { conv_load(P, m0 + s0 + 32 * i, c * 64 + s0 + 32 * i, qch, rq[i]); conv_load(P, m0 + s0 + 32 * i, c * 64 + s0 + 32 * i, kch, rk[i]); }
#pragma unroll
            for (int i = 0; i < 4; ++i) rv[i] = *(const v4u*)(P + (m0 + sv0 + 16 * i) * 3072 + 1024 + h * 256 + vg * 8);
            { f32x4 cwv[4][2], cbv[2]; conv_weights(cw, cb, qch, cwv, cbv);
#pragma unroll
              for (int i = 0; i < 2; ++i) { float kv[8]; conv_apply(rq[i], cwv, cbv, 1.0f, kv);
                  v4u o; o.x = pk2(kv[0], kv[1]); o.y = pk2(kv[2], kv[3]); o.z = pk2(kv[4], kv[5]); o.w = pk2(kv[6], kv[7]); *(LAS v4u*)(Qs + (s0 + 32 * i) * QK_STRIDE + cg * 8) = o; } }
            { f32x4 cwv[4][2], cbv[2]; conv_weights(cw, cb, kch, cwv, cbv);
#pragma unroll
              for (int i = 0; i < 2; ++i) { float kv[8]; conv_apply(rk[i], cwv, cbv, 0.08838834764831845f, kv);
                  v4u o; o.x = pk2(kv[0], kv[1]); o.y = pk2(kv[2], kv[3]); o.z = pk2(kv[4], kv[5]); o.w = pk2(kv[6], kv[7]); *(LAS v4u*)(Ks + (s0 + 32 * i) * QK_STRIDE + cg * 8) = o; } }
#pragma unroll
            for (int i = 0; i < 4; ++i) vt_scatter(VT, vg * 8, sv0 + 16 * i, rv[i]);
        }
#endif
        __syncthreads();
        {
            const int tt = w >> 1;
            const int t = 16 * tt + fr; const float bt = bS[t], mt = mtS[t];
#pragma unroll
            for (int i = 0; i < 2; ++i) {
                const int st = 2 * (w & 1) + i;
                f32x4 acc = {0.f, 0.f, 0.f, 0.f};
                if (st <= tt) {
#pragma unroll
                    for (int ks = 0; ks < 4; ++ks) acc = __builtin_amdgcn_mfma_f32_16x16x32_bf16(ldfrag(Ks, 16 * st, QK_STRIDE, ks * 32, lane), ldfrag(Qs, 16 * tt, QK_STRIDE, ks * 32, lane), acc, 0, 0, 0);
                }
                float o[4];
#pragma unroll
                for (int e = 0; e < 4; ++e) { const int s = 16 * st + 4 * fq + e; o[e] = (s <= t) ? acc[e] * __expf(bt + zS[s] - mt) : 0.f; }
                v2u pw; pw.x = pk2(o[0], o[1]); pw.y = pk2(o[2], o[3]);
                *(LAS v2u*)(Sw + t * VT_STRIDE + 16 * st + 4 * fq) = pw;
            }
        }
        __syncthreads();
        { const int t = F.tid >> 3, part = F.tid & 7; float rsum = 0.f, qn = 0.f;
#pragma unroll
          for (int e = 0; e < 8; ++e) rsum += bf2f(Sw[t * VT_STRIDE + part * 8 + e]);
#pragma unroll
          for (int e = 0; e < 16; ++e) qn += bf2f(Qs[t * QK_STRIDE + part * 16 + e]) * nS[part * 16 + e];
          rsum += swz_xor<1>(rsum); rsum += swz_xor<2>(rsum); rsum += swz_xor<4>(rsum);
          qn += swz_xor<1>(qn); qn += swz_xor<2>(qn); qn += swz_xor<4>(qn);
          if (part == 0) { const float den = inS[t] * qn + rsum; dnS[t] = __builtin_amdgcn_rcpf(fmaxf(fabsf(den), __expf(-mtS[t]))); } }
        f32x4 a1[4][2], a2[4][2];
#pragma unroll
        for (int mt = 0; mt < 4; ++mt)
#pragma unroll
            for (int nt = 0; nt < 2; ++nt) { a1[mt][nt] = (f32x4){0.f, 0.f, 0.f, 0.f}; a2[mt][nt] = (f32x4){0.f, 0.f, 0.f, 0.f}; }
#pragma unroll
        for (int ks = 0; ks < 4; ++ks)
#pragma unroll
            for (int mt = 0; mt < 4; ++mt) { const bf16x8 qf = ldfrag(Qs, 16 * mt, QK_STRIDE, ks * 32, lane);
#pragma unroll
                for (int nt = 0; nt < 2; ++nt) a1[mt][nt] = __builtin_amdgcn_mfma_f32_16x16x32_bf16(cf[nt][ks], qf, a1[mt][nt], 0, 0, 0); }
#pragma unroll
        for (int ks = 0; ks < 2; ++ks) {
            bf16x8 vf[2];
#pragma unroll
            for (int nt = 0; nt < 2; ++nt) vf[nt] = ldfrag_sw(VT, 32 * w + 16 * nt, ks * 32, lane);
#pragma unroll
            for (int mt = 0; mt < 4; ++mt) { const bf16x8 sf = ldfrag(Sw, 16 * mt, VT_STRIDE, ks * 32, lane);
#pragma unroll
                for (int nt = 0; nt < 2; ++nt) a2[mt][nt] = __builtin_amdgcn_mfma_f32_16x16x32_bf16(vf[nt], sf, a2[mt][nt], 0, 0, 0); }
        }
        v2u owv[4][2]; f32x4 gv[2];
#pragma unroll
        for (int mt = 0; mt < 4; ++mt)
#pragma unroll
            for (int nt = 0; nt < 2; ++nt) owv[mt][nt] = *(const v2u*)(P + (m0 + 16 * mt + fr) * 3072 + 2048 + h * 256 + 32 * w + 16 * nt + 4 * fq);
#pragma unroll
        for (int nt = 0; nt < 2; ++nt) gv[nt] = *(const f32x4*)(ng + h * 256 + 32 * w + 16 * nt + 4 * fq);
        __syncthreads();
#pragma unroll
        for (int mt = 0; mt < 4; ++mt) {
            const int t = 16 * mt + fr; const float it = inS[t], dn = dnS[t]; float ss = 0.f;
#pragma unroll
            for (int nt = 0; nt < 2; ++nt) { a1[mt][nt] = (a1[mt][nt] * it + a2[mt][nt]) * dn;
                ss += (a1[mt][nt][0] * a1[mt][nt][0] + a1[mt][nt][1] * a1[mt][nt][1]) + (a1[mt][nt][2] * a1[mt][nt][2] + a1[mt][nt][3] * a1[mt][nt][3]); }
            ss += swz_xor<16>(ss); ss = sum_x32(ss);
            if (fq == 0) sqS[w * 64 + t] = ss;
        }
        __syncthreads();
#pragma unroll
        for (int mt = 0; mt < 4; ++mt) {
            const int t = 16 * mt + fr; float tot = 0.f;
#pragma unroll
            for (int ww = 0; ww < 8; ++ww) tot += sqS[ww * 64 + t];
            const float r = rsqrtf(tot * (1.0f / 256.0f) + EPS);
#pragma unroll
            for (int nt = 0; nt < 2; ++nt) {
                const int vv = 32 * w + 16 * nt + 4 * fq;
                const v2u ow = owv[mt][nt];
                const f32x4 g = gv[nt];
                const float o0 = bflo(ow.x), o1 = bfhi(ow.x), o2 = bflo(ow.y), o3 = bfhi(ow.y);
                const f32x4 hv = a1[mt][nt] * r * g;
                v2u yw; yw.x = pk2(hv[0] * __builtin_amdgcn_rcpf(1.0f + __expf(-o0)), hv[1] * __builtin_amdgcn_rcpf(1.0f + __expf(-o1)));
                yw.y = pk2(hv[2] * __builtin_amdgcn_rcpf(1.0f + __expf(-o2)), hv[3] * __builtin_amdgcn_rcpf(1.0f + __expf(-o3)));
                *(v2u*)(Y + (m0 + t) * 1024 + h * 256 + vv) = yw;
            }
        }
        __syncthreads();
    }
}
__device__ __forceinline__ att::BlockRef<att::bf16, att::bf16> attn_ref(int item, int grp, int pass, const att::bf16* Qb, const att::bf16* Kb, const att::bf16* Vb, att::bf16* Ob) {
    const int pc = item & 3, y = item >> 2, qb = pass ? 31 - y : y;
    const int b = grp >> 2, h = grp & 3, c = pc >> 1, vh = pc & 1, hd = ((b * 4 + h) * 2 + c) * 2 + vh;
    att::BlockRef<att::bf16, att::bf16> r;
    r.Q = Qb + ((size_t)(b * 8 + h * 2 + c) * 8192 + (size_t)qb * 256) * 128;
    r.K = Kb + (size_t)(b * 8 + h * 2 + c) * 8192 * 128;
    r.V = Vb + (size_t)(b * 8 + h * 2 + vh) * 8192 * 128;
    r.O = Ob + ((size_t)hd * 8192 + (size_t)qb * 256) * 128;
    r.P0 = qb * 256;
    return r;
}
__device__ __forceinline__ void attn_phase(const Ctx& F, char* lds) {
    const att::bf16* Qb = (const att::bf16*)(F.ws + WS_P); const att::bf16* Kb = Qb + 16777216; const att::bf16* Vb = Kb + 16777216; att::bf16* Ob = (att::bf16*)(F.ws + WS_O);
    constexpr int total = 512; const int stride = F.G;
    int L = F.wg; if (L >= total) return;
    int pass = 0;
#define ATT_ITEM(L_) (((L_) >> 3) & 63)
#define ATT_GRP(L_) ((L_) & 7)
    att::BlockRef<att::bf16, att::bf16> cur = attn_ref(ATT_ITEM(L), ATT_GRP(L), 0, Qb, Kb, Vb, Ob);
    att::Seam<att::bf16> S;
    att::causal_swa_prime<att::bf16, att::bf16>(cur, 8192, lds, S, F.tid);
    for (;;) {
        const bool more_pass = pass == 0, more_item = L + stride < total, last = !more_pass && !more_item;
        int passn = pass + 1, Ln = L;
        if (!more_pass) { passn = 0; Ln = more_item ? L + stride : L; }
        const att::BlockRef<att::bf16, att::bf16> nxt = last ? cur : attn_ref(ATT_ITEM(Ln), ATT_GRP(Ln), passn, Qb, Kb, Vb, Ob);
        att::causal_swa_block<att::bf16, att::bf16>(cur, nxt, 8192, 8192, lds, S, F.tid);
        if (last) break;
        cur = nxt; pass = passn; L = Ln;
    }
#undef ATT_ITEM
#undef ATT_GRP
}
__device__ __forceinline__ void combine_phase(const Ctx& F, int l) {
    const int j = l >> 1;
    const bf16r* Ob = (const bf16r*)(F.ws + WS_O); bf16r* Y = (bf16r*)(F.ws + WS_Y);
    const float lam = ((const float*)(F.ws + WS_LAM))[j];
    const float omi = 1.0f - (j == 0 ? 0.35550906759096934f : 0.5560582041556406f);
    const float* ng = ((const float*)F.ka->in[16]) + j * 256;
    const int gw = F.wg * NWAVES + F.wave, NGW = F.G * NWAVES;
    const int vv = F.lane * 4, vh = vv >> 7, dd = vv & 127;
    const f32x4 g = *(const f32x4*)(ng + vv);
    for (int task = gw; task < M * 4; task += NGW) {
        const int m = task >> 2, h = task & 3, b = m >> 13, s = m & 8191;
        const int hd0 = ((b * 4 + h) * 2 + 0) * 2 + vh, hd1 = hd0 + 2;
        const v2u w0 = *(const v2u*)(Ob + ((size_t)hd0 * 8192 + s) * 128 + dd), w1 = *(const v2u*)(Ob + ((size_t)hd1 * 8192 + s) * 128 + dd);
        f32x4 o = {bflo(w0.x) - lam * bflo(w1.x), bfhi(w0.x) - lam * bfhi(w1.x), bflo(w0.y) - lam * bflo(w1.y), bfhi(w0.y) - lam * bfhi(w1.y)};
        const float ss = wave_sum((o[0] * o[0] + o[1] * o[1]) + (o[2] * o[2] + o[3] * o[3]));
        const float r = rsqrtf(ss * (1.0f / 256.0f) + EPS) * omi;
        o = o * r * g;
        v2u yw; yw.x = pk2(o[0], o[1]); yw.y = pk2(o[2], o[3]);
        *(v2u*)(Y + (size_t)m * 1024 + h * 256 + vv) = yw;
    }
}
__device__ __forceinline__ void final_phase(const Ctx& F) {
    const float* ssqp = (const float*)(F.ws + WS_SSQP);
    const int gw = F.wg * NWAVES + F.wave, NGW = F.G * NWAVES;
    for (int m = gw; m < M; m += NGW) {
        float ss = F.lane < 16 ? ssqp[(size_t)F.lane * M + m] : 0.f; ss = wave_sum(ss);
        const float rs = rsqrtf(ss * (1.0f / 1024.0f) + EPS);
        f32x4* orow = (f32x4*)(F.out + (size_t)m * 1024) + F.lane;
#pragma unroll
        for (int jj = 0; jj < 4; ++jj) { const f32x4 g = *(const f32x4*)(((const float*)F.ka->in[18]) + 4 * F.lane + 256 * jj); orow[64 * jj] = orow[64 * jj] * rs * g; }
    }
}

#if MK_DEBUG
#ifndef DBG_SET
#define DBG_SET 0
#endif
__device__ __forceinline__ void dbg_flag(const Ctx& F, bool bad, unsigned code) {
    int bit = -1;
    switch (code) { case 30: bit = 0; break; case 8: case 31: case 9: bit = 1; break; case 10: bit = 2; break; case 11: bit = 3; break; case 13: case 14: case 15: bit = 4; break;
                    case 16: case 17: bit = 5; break; case 18: bit = 6; break; case 19: bit = 7; break; case 20: bit = 8; break; case 21: bit = 9; break; case 23: bit = 10; break; default: break; }
    if (bad && bit >= 0) atomicOr((unsigned*)(F.ws + 64), 1u << bit);
}
__device__ __forceinline__ bool dbg_ne(float got, float ref) { return !(fabsf(got - ref) <= 0.03f * fabsf(ref) + 0.03f); }
__device__ __forceinline__ unsigned dbg_hash(unsigned i) { i = i * 2654435761u + 12345u; i ^= i >> 15; i *= 2246822519u; i ^= i >> 13; i *= 3266489917u; i ^= i >> 16; return i; }
__device__ __forceinline__ float dbg_rstd(const Ctx& F, int m) { const float* ssqp = (const float*)(F.ws + WS_SSQP); float s = 0.f; for (int p = 0; p < 16; ++p) s += ssqp[(size_t)p * M + m]; return rsqrtf(s * (1.0f / 1024.0f) + EPS); }
__device__ __forceinline__ float dbg_silu(float g) { return g / (1.0f + expf(-g)); }
__device__ __forceinline__ void dbg_check_p0(const Ctx& F) {
    if (F.wg != 0) return;
    const unsigned r = dbg_hash(F.tid);
    const float* ADA = (const float*)(F.ws + WS_ADA);
    { const float t = wave_sum((float)(F.lane + 1)), t2 = wave_max((float)((F.lane * 37) & 63)); dbg_flag(F, t != 2080.0f || t2 != 63.0f, 30); }
    { const int l = r % 4, b = (r >> 2) & 1, j = (r >> 3) % 9216; float ref = ((const float*)F.ka->in[4])[(size_t)l * 9216 + j];
      for (int k = 0; k < 1024; ++k) ref += dbg_silu(((const float*)F.ka->in[1])[b * 1024 + k]) * ((const float*)F.ka->in[3])[((size_t)l * 1024 + k) * 9216 + j];
      dbg_flag(F, dbg_ne(ADA[(size_t)(l * 2 + b) * 9216 + j], ref), 1); }
    { const int mat = r % 8, k = (r >> 3) % 1024, n = (r >> 13) % 5632; const float src = ((const float*)F.ka->in[6])[((size_t)mat * 1024 + k) * 5632 + n];
      const int drow = n < 2816 ? (n >> 7) * 256 + (n & 127) : ((n - 2816) >> 7) * 256 + 128 + ((n - 2816) & 127);
      dbg_flag(F, dbg_ne(bf2f(((const bf16r*)(F.ws + WS_W13))[((size_t)mat * 5632 + drow) * 1024 + k]), src), 2); }
    { const int mat = r % 8, k = (r >> 3) % 2816, n = (r >> 15) % 1024; const float src = ((const float*)F.ka->in[7])[((size_t)mat * 2816 + k) * 1024 + n];
      dbg_flag(F, dbg_ne(bf2f(((const bf16r*)(F.ws + WS_W2))[((size_t)mat * 1024 + n) * 2816 + k]), src), 3); }
    { const int mat = r % 2, k = (r >> 1) % 1024, n = (r >> 11) % 3072; const float src = ((const float*)F.ka->in[8])[((size_t)mat * 1024 + k) * 3080 + n];
      dbg_flag(F, dbg_ne(bf2f(((const bf16r*)(F.ws + WS_WINA))[((size_t)mat * 3072 + n) * 1024 + k]), src), 4); }
    { const int mat = r % 2, k = (r >> 1) % 1024, n = (r >> 11) % 3072; const float src = ((const float*)F.ka->in[14])[((size_t)mat * 1024 + k) * 3072 + n];
      dbg_flag(F, dbg_ne(bf2f(((const bf16r*)(F.ws + WS_WINB))[((size_t)mat * 3072 + n) * 1024 + k]), src), 5); }
    { const int mat = r % 2, k = (r >> 1) % 1024, n = (r >> 11) % 1024; const float sa = ((const float*)F.ka->in[13])[((size_t)mat * 1024 + k) * 1024 + n], sb = ((const float*)F.ka->in[17])[((size_t)mat * 1024 + k) * 1024 + n];
      dbg_flag(F, dbg_ne(bf2f(((const bf16r*)(F.ws + WS_WOA))[((size_t)mat * 1024 + n) * 1024 + k]), sa) || dbg_ne(bf2f(((const bf16r*)(F.ws + WS_WOB))[((size_t)mat * 1024 + n) * 1024 + k]), sb), 6); }
}
__device__ __forceinline__ void dbg_check_p1(const Ctx& F) {
    if (F.wg != 0) return;
    const unsigned r = dbg_hash(F.tid + 1000);
    const float* ADA = (const float*)(F.ws + WS_ADA);
    { const int m = r % 16384, col = (r >> 14) % 1024, b = m >> 13;
      const float ref = ((const float*)F.ka->in[0])[(size_t)m * 1024 + col] * ((const float*)F.ka->in[5])[col] * (1.0f + ADA[(size_t)b * 9216 + 1024 + col]);
      dbg_flag(F, dbg_ne(bf2f(((const bf16r*)(F.ws + WS_XS))[(size_t)m * 1024 + col]), ref) || dbg_ne(F.out[(size_t)m * 1024 + col], ((const float*)F.ka->in[0])[(size_t)m * 1024 + col]), 7); }
    { const int q = r % 8, b = (r >> 3) & 1, n = (r >> 4) % 5632, l = q >> 1, f = q & 1; float ref = 0.f;
      for (int k = 0; k < 1024; ++k) ref += ADA[(size_t)(l * 2 + b) * 9216 + (f ? 2 : 0) * 3072 + k] * bf2f(((const bf16r*)(F.ws + WS_W13))[((size_t)q * 5632 + n) * 1024 + k]);
      dbg_flag(F, dbg_ne(((const float*)(F.ws + WS_SWF))[(size_t)(q * 2 + b) * 5632 + n], ref), b ? 31 : 8); }
    { const int l = r % 4, b = (r >> 2) & 1, n = (r >> 3) % 3072; const bf16r* W = (const bf16r*)(F.ws + ((l & 1) ? WS_WINB : WS_WINA)) + ((size_t)(l >> 1) * 3072 + n) * 1024; float ref = 0.f;
      for (int k = 0; k < 1024; ++k) ref += ADA[(size_t)(l * 2 + b) * 9216 + 3072 + k] * bf2f(W[k]);
      dbg_flag(F, dbg_ne(((const float*)(F.ws + WS_SWM))[(size_t)(l * 2 + b) * 3072 + n], ref), 9); }
    { const int m = r % 16384; float s = 0.f; for (int k = 0; k < 1024; ++k) { const float v = ((const float*)F.ka->in[0])[(size_t)m * 1024 + k]; s += v * v; }
      const float rs = rsqrtf(s * (1.0f / 1024.0f) + EPS); dbg_flag(F, fabsf(dbg_rstd(F, m) - rs) > 1e-3f * rs, 10); }
}
__device__ __forceinline__ void dbg_check_up(const Ctx& F) {
    if (F.wg != 0) return;
    const unsigned r = dbg_hash(F.tid + 2000);
    const int m = r % 16384, n = (r >> 14) % 2816, b = m >> 13, grow = (n >> 7) * 256 + (n & 127), urow = grow + 128;
    const float rs = dbg_rstd(F, m); const bf16r* XS = (const bf16r*)(F.ws + WS_XS) + (size_t)m * 1024; const bf16r* W = (const bf16r*)(F.ws + WS_W13);
    float g = 0.f, u = 0.f;
    for (int k = 0; k < 1024; ++k) { const float xv = bf2f(XS[k]); g += xv * bf2f(W[(size_t)grow * 1024 + k]); u += xv * bf2f(W[(size_t)urow * 1024 + k]); }
    const float* SWF = (const float*)(F.ws + WS_SWF) + (size_t)b * 5632;
    g = g * rs + SWF[grow]; u = u * rs + SWF[urow];
    dbg_flag(F, dbg_ne(bf2f(((const bf16r*)(F.ws + WS_H))[(size_t)m * 2816 + n]), dbg_silu(g) * u), 11);
}
__device__ __forceinline__ void dbg_check_down(const Ctx& F) {
    if (F.wg != 0) return;
    const unsigned r = dbg_hash(F.tid + 3000);
    const int m = r % 16384, n = (r >> 14) % 1024, b = m >> 13;
    const bf16r* H = (const bf16r*)(F.ws + WS_H) + (size_t)m * 2816; const bf16r* W = (const bf16r*)(F.ws + WS_W2) + (size_t)n * 2816;
    float d = 0.f; for (int k = 0; k < 2816; ++k) d += bf2f(H[k]) * bf2f(W[k]);
    const float* ADA = (const float*)(F.ws + WS_ADA);
    const float ref = ((const float*)F.ka->in[0])[(size_t)m * 1024 + n] + 0.5f * ADA[(size_t)b * 9216 + 2048 + n] * d, got = F.out[(size_t)m * 1024 + n];
    dbg_flag(F, dbg_ne(got, ref), 13);
    dbg_flag(F, dbg_ne(bf2f(((const bf16r*)(F.ws + WS_XS))[(size_t)m * 1024 + n]), got * ((const float*)(F.ws + WS_GS))[(size_t)(0 * 3 + 1) * 2048 + b * 1024 + n]), 14);
    float s = 0.f; for (int k = 0; k < 1024; ++k) { const float v = F.out[(size_t)m * 1024 + k]; s += v * v; }
    const float rs = rsqrtf(s * (1.0f / 1024.0f) + EPS); dbg_flag(F, fabsf(dbg_rstd(F, m) - rs) > 1e-3f * rs, 15);
}
__device__ __forceinline__ float dbg_inproj(const Ctx& F, int l, int m, int n) {
    const int b = m >> 13; const float rs = dbg_rstd(F, m);
    const bf16r* XS = (const bf16r*)(F.ws + WS_XS) + (size_t)m * 1024; const bf16r* W = (const bf16r*)(F.ws + ((l & 1) ? WS_WINB : WS_WINA)) + ((size_t)(l >> 1) * 3072 + n) * 1024;
    float a = 0.f; for (int k = 0; k < 1024; ++k) a += bf2f(XS[k]) * bf2f(W[k]);
    return a * rs + ((const float*)(F.ws + WS_SWM))[(size_t)(l * 2 + b) * 3072 + n];
}
__device__ __forceinline__ void dbg_check_inproj0(const Ctx& F) {
    if (F.wg != 0) return;
    const unsigned r = dbg_hash(F.tid + 4000);
    const int m = r % 16384, n = (r >> 14) % 3072, b = m >> 13;
    dbg_flag(F, dbg_ne(bf2f(((const bf16r*)(F.ws + WS_P))[(size_t)m * 3072 + n]), dbg_inproj(F, 0, m, n)), 16);
    const int g = n & 7; const float rs = dbg_rstd(F, m); const bf16r* XS = (const bf16r*)(F.ws + WS_XS) + (size_t)m * 1024; const float* ADA = (const float*)(F.ws + WS_ADA);
    float a = 0.f, sgw = 0.f; for (int k = 0; k < 1024; ++k) { const float w = ((const float*)F.ka->in[8])[(size_t)k * 3080 + 3072 + g]; a += bf2f(XS[k]) * w; sgw += ADA[(size_t)b * 9216 + 3072 + k] * w; }
    dbg_flag(F, dbg_ne(((const float*)(F.ws + WS_GATES))[(size_t)m * 8 + g], a * rs + sgw), 17);
}
__device__ __forceinline__ void dbg_check_inproj1(const Ctx& F) {
    if (F.wg != 0) return;
    const unsigned r = dbg_hash(F.tid + 5000);
    const int m = r % 16384, n = (r >> 14) % 3072, b = m >> 13, s = m & 8191, blk = n >> 7, d = n & 127, which = blk >> 3, idx = blk & 7;
    float ref = dbg_inproj(F, 1, m, n);
    if (which < 2 && d < 32) {
        const int fi = d & 15; const float other = dbg_inproj(F, 1, m, d < 16 ? n + 16 : n - 16);
        const float a = (float)((const int*)F.ka->in[2])[m] * pg8::ROPE_INVF[fi];
        const float kk = rintf(a * 0.15915494309189535f); float rr = fmaf(-kk, 6.2831854820251465f, a); rr = fmaf(-kk, -1.7484555314695172e-07f, rr);
        const float c = __cosf(rr), sn = __sinf(rr);
        ref = d < 16 ? ref * c - other * sn : ref * c + other * sn;
    }
    dbg_flag(F, dbg_ne(bf2f(((const bf16r*)(F.ws + WS_P))[(size_t)which * 16777216 + ((size_t)(b * 8 + idx) * 8192 + s) * 128 + d]), ref), 20);
}
__device__ __forceinline__ void dbg_check_mlstm(const Ctx& F, LAS unsigned char* lds) {
    if (F.wg != 0) return;
    LAS float* C = (LAS float*)lds;
    LAS float* qs = C + 32768, *ks = qs + 128, *vs = ks + 128, *nn = vs + 256, *hv = nn + 128, *red = hv + 256;
    const int h = 1, tid = F.tid;
    const bf16r* P = (const bf16r*)(F.ws + WS_P); const float* GT = (const float*)(F.ws + WS_GATES); const bf16r* Y = (const bf16r*)(F.ws + WS_Y);
    const float* cw = (const float*)F.ka->in[9]; const float* cb = (const float*)F.ka->in[10]; const float* bif = (const float*)F.ka->in[11]; const float* ng = (const float*)F.ka->in[12];
    for (int i = tid; i < 32768; i += 512) C[i] = 0.f;
    if (tid < 128) nn[tid] = 0.f;
    float mstate = 0.f;
    __syncthreads();
    for (int t = 0; t < 160; ++t) {
        if (tid < 256) { const int isk = tid >> 7, d = tid & 127, ch = isk * 512 + h * 128 + d; float a = cb[ch];
            for (int jt = 0; jt < 4; ++jt) if (t - 3 + jt >= 0) a += cw[jt * 1024 + ch] * bf2f(P[(size_t)(t - 3 + jt) * 3072 + ch]);
            a = dbg_silu(a); if (isk) ks[d] = a * 0.08838834764831845f; else qs[d] = a; }
        else { const int v = tid - 256; vs[v] = bf2f(P[(size_t)t * 3072 + 1024 + h * 256 + v]); }
        __syncthreads();
        const float li = GT[(size_t)t * 8 + h] + bif[h], gf = GT[(size_t)t * 8 + 4 + h] + bif[4 + h];
        const float lf = fminf(gf, 0.f) - log1pf(expf(-fabsf(gf)));
        const float mn = fmaxf(lf + mstate, li), fd = expf(lf + mstate - mn), ig = expf(li - mn);
        for (int i = tid; i < 32768; i += 512) { const int v = i >> 7, d = i & 127; C[i] = fd * C[i] + ig * vs[v] * ks[d]; }
        if (tid < 128) nn[tid] = fd * nn[tid] + ig * ks[tid];
        mstate = mn;
        __syncthreads();
        float den = 0.f; for (int d = 0; d < 128; ++d) den += nn[d] * qs[d];
        const float dn = 1.0f / fmaxf(fabsf(den), expf(-mn));
        { const int v = tid >> 1, half = tid & 1; float a = 0.f; for (int d = 0; d < 64; ++d) a += C[v * 128 + half * 64 + d] * qs[half * 64 + d];
          a += swz_xor<1>(a); if (half == 0) hv[v] = a * dn; }
        __syncthreads();
        float ss = 0.f; for (int v = 0; v < 256; ++v) ss += hv[v] * hv[v];
        const float rr = rsqrtf(ss * (1.0f / 256.0f) + EPS);
        if (tid < 256) { const int v = tid; const float o = bf2f(P[(size_t)t * 3072 + 2048 + h * 256 + v]);
            const float ref = hv[v] * rr * ng[h * 256 + v] / (1.0f + expf(-o));
            dbg_flag(F, dbg_ne(bf2f(Y[(size_t)t * 1024 + h * 256 + v]), ref), t < 64 ? 18 : 19); }
        __syncthreads();
    }
}
__device__ __forceinline__ void dbg_check_attn(const Ctx& F) {
    if (F.wg >= 8) return;
    const bf16r* Qb = (const bf16r*)(F.ws + WS_P); const bf16r* Kb = Qb + 16777216; const bf16r* Vb = Kb + 16777216; const bf16r* Ob = (const bf16r*)(F.ws + WS_O);
    const unsigned r = dbg_hash(F.wg * 8 + F.wave + 6000);
    const int hd = r % 32, row = (F.wave == 0) ? (int)((r >> 5) % 300) : (int)((r >> 5) % 8192);
    const int b = hd >> 4, h = (hd >> 2) & 3, c = (hd >> 1) & 1, vh = hd & 1, lane = F.lane;
    const bf16r* q = Qb + ((size_t)(b * 8 + h * 2 + c) * 8192 + row) * 128; const bf16r* K = Kb + (size_t)(b * 8 + h * 2 + c) * 8192 * 128; const bf16r* V = Vb + (size_t)(b * 8 + h * 2 + vh) * 8192 * 128;
    const float q0 = bf2f(q[lane * 2]), q1 = bf2f(q[lane * 2 + 1]);
    float mx = -1e30f, l = 0.f, o0 = 0.f, o1 = 0.f;
    for (int jk = 0; jk <= row; ++jk) {
        float sc = q0 * bf2f(K[(size_t)jk * 128 + lane * 2]) + q1 * bf2f(K[(size_t)jk * 128 + lane * 2 + 1]); sc = wave_sum(sc) * 0.08838834764831845f;
        const float mn = fmaxf(mx, sc), al = expf(mx - mn), p = expf(sc - mn);
        l = l * al + p; o0 = o0 * al + p * bf2f(V[(size_t)jk * 128 + lane * 2]); o1 = o1 * al + p * bf2f(V[(size_t)jk * 128 + lane * 2 + 1]); mx = mn;
    }
    const bf16r* O = Ob + ((size_t)hd * 8192 + row) * 128;
    dbg_flag(F, dbg_ne(bf2f(O[lane * 2]), o0 / l) || dbg_ne(bf2f(O[lane * 2 + 1]), o1 / l), 21);
}
__device__ __forceinline__ void dbg_check_combine(const Ctx& F) {
    if (F.wg != 0) return;
    const unsigned r = dbg_hash(F.tid + 7000);
    const int m = r % 16384, h = (r >> 14) & 3, vv = (r >> 16) & 255, b = m >> 13, s = m & 8191;
    const bf16r* Ob = (const bf16r*)(F.ws + WS_O); const float lam = ((const float*)(F.ws + WS_LAM))[0];
    float ss = 0.f, mine = 0.f;
    for (int v = 0; v < 256; ++v) { const int hd0 = ((b * 4 + h) * 2) * 2 + (v >> 7);
        const float o = bf2f(Ob[((size_t)hd0 * 8192 + s) * 128 + (v & 127)]) - lam * bf2f(Ob[((size_t)(hd0 + 2) * 8192 + s) * 128 + (v & 127)]); ss += o * o; if (v == vv) mine = o; }
    const float ref = mine * rsqrtf(ss * (1.0f / 256.0f) + EPS) * ((const float*)F.ka->in[16])[vv] * (1.0f - 0.35550906759096934f);
    dbg_flag(F, dbg_ne(bf2f(((const bf16r*)(F.ws + WS_Y))[(size_t)m * 1024 + h * 256 + vv]), ref), 23);
}
#endif

constexpr int N_PHASES = 2 + 9 * DEPTH + 1;
constexpr int PH_ATT1 = 2 + 9 * 1 + 3, PH_ATT3 = 2 + 9 * 3 + 3;
#ifndef DBL_MASK
#define DBL_MASK 0
#endif
#ifndef MK_ONE_LAUNCH
#define MK_ONE_LAUNCH 1
#endif
__device__ __forceinline__ Ctx make_ctx(int wave_s) {
    KArgs ka = (KArgs)__builtin_amdgcn_kernarg_segment_ptr();
    asm volatile("" : "+s"(ka));
    Ctx F; F.ka = ka; F.out = ka->out; F.ws = ka->ws;
    { unsigned z0 = 0u; asm volatile("" : "+v"(z0)); const int t0 = wave_s * 64 + (int)__builtin_amdgcn_mbcnt_hi(~0u, __builtin_amdgcn_mbcnt_lo(~0u, z0)); F.tid = t0 & 511; }
    F.lane = F.tid & 63; F.wave = __builtin_amdgcn_readfirstlane(F.tid >> 6);
    { int g0 = gridDim.x, w0 = blockIdx.x; asm volatile("" : "+s"(g0), "+s"(w0)); F.G = g0; F.wg = w0; }
    return F;
}
#define XB_TMO      128
#define XB_XCNT(j)  (256  + 64 * (j))
#define XB_XSUB(j)  (1280 + 64 * (j))
#define XB_XGEN(j)  (2304 + 64 * (j))
#define XB_TOP      3328
#define XB_TOPGEN   3392
#define XCD_BAR_WORDS 3456
#define XB_SPIN_CAP (1u << 18)

__device__ __forceinline__ unsigned xb_ld(unsigned* p)              { return __hip_atomic_load(p, __ATOMIC_RELAXED, __HIP_MEMORY_SCOPE_AGENT); }
__device__ __forceinline__ unsigned xb_add(unsigned* p, unsigned v) { return __hip_atomic_fetch_add(p, v, __ATOMIC_RELAXED, __HIP_MEMORY_SCOPE_AGENT); }
__device__ __forceinline__ unsigned xb_xcc_id() { return (unsigned)__builtin_amdgcn_s_getreg((3 << 11) | 20) & 0xFu; }
#define XB_SPIN(cond, bar) do { unsigned _sp = 0; while (cond) { __builtin_amdgcn_s_sleep(1); \
    if ((++_sp & 255u) == 0u) { if (xb_ld(&(bar)[XB_TMO])) break; if (_sp > XB_SPIN_CAP) { atomicAdd(&(bar)[XB_TMO], 1u); break; } } } } while (0)

struct XcdBarrier {
    unsigned* bar; unsigned x;
    volatile LAS unsigned* st;
};

__device__ __forceinline__ XcdBarrier xcd_barrier_post(unsigned* bar, volatile LAS unsigned* st, int tid) {
    XcdBarrier b; b.bar = bar; b.x = xb_xcc_id(); b.st = st;
    if (tid == 0) (void)xb_add(&bar[XB_XCNT(b.x)], 1u);
    return b;
}
__device__ __forceinline__ void xcd_barrier_complete(unsigned* bar, unsigned x, unsigned& nloc, unsigned& nx) {
    const unsigned G = gridDim.x;
    unsigned sum, cnt, mine, sp = 0u;
    for (;;) {
        sum = 0u; cnt = 0u; mine = 0u;
#pragma unroll
        for (unsigned j = 0; j < 16; ++j) { const unsigned c = xb_ld(&bar[XB_XCNT(j)]); sum += c; cnt += (c > 0u) ? 1u : 0u; mine = (j == x) ? c : mine; }
        if (sum == G) break;
        __builtin_amdgcn_s_sleep(1);
        if ((++sp & 255u) == 0u) { if (xb_ld(&bar[XB_TMO])) break; if (sp > XB_SPIN_CAP) { atomicAdd(&bar[XB_TMO], 1u); break; } }
    }
    nloc = mine > 0u ? mine : 1u; nx = cnt > 0u ? cnt : 1u;
}

__device__ __forceinline__ void xcd_barrier(const XcdBarrier& b, int tid) {
    asm volatile("s_waitcnt vmcnt(0)" ::: "memory");
    __syncthreads();
    if (tid == 0) {
        unsigned* bar = b.bar;
        __builtin_amdgcn_s_waitcnt(0);
        unsigned nloc = b.st[0], nx = b.st[1];
        if (nloc == 0u) { xcd_barrier_complete(bar, b.x, nloc, nx); b.st[0] = nloc; b.st[1] = nx; }
        const unsigned old = xb_add(&bar[XB_XSUB(b.x)], 1u);
        const unsigned gen = old / nloc;
        if (old + 1u == (gen + 1u) * nloc) {
            __builtin_amdgcn_fence(__ATOMIC_RELEASE, "agent");
            asm volatile("s_waitcnt vmcnt(0)" ::: "memory");
            const unsigned og = xb_add(&bar[XB_TOP], 1u);
            const unsigned tg = og / nx;
            if (og + 1u == (tg + 1u) * nx) xb_add(&bar[XB_TOPGEN], 1u);
            else XB_SPIN(xb_ld(&bar[XB_TOPGEN]) == tg, bar);
            __builtin_amdgcn_fence(__ATOMIC_ACQUIRE, "agent");
            xb_add(&bar[XB_XGEN(b.x)], 1u);
            asm volatile("s_waitcnt vmcnt(0)" ::: "memory");
        } else {
            XB_SPIN(xb_ld(&bar[XB_XGEN(b.x)]) == gen, bar);
            __builtin_amdgcn_fence(__ATOMIC_ACQUIRE, "agent");
            asm volatile("s_waitcnt vmcnt(0)" ::: "memory");
        }
    }
    __syncthreads();
}

constexpr int BAR_OFF = 4096, BAR_ST_OFF = 131072 + 352;
template <bool FIRST> __device__ __forceinline__ void grid_seam(const Ctx& F, int& epoch, LAS unsigned char* lds) {
    unsigned* bar = (unsigned*)(F.ws + BAR_OFF);
    volatile LAS unsigned* st = (volatile LAS unsigned*)(lds + BAR_ST_OFF);
    if (FIRST && epoch == 0) {
        if (F.wg == 0) for (int i = F.tid; i < XCD_BAR_WORDS; i += 512) __hip_atomic_store(bar + i, 0u, __ATOMIC_RELAXED, __HIP_MEMORY_SCOPE_AGENT);
        if (F.tid < 2) st[F.tid] = 0u;
        asm volatile("s_waitcnt vmcnt(0) lgkmcnt(0)" ::: "memory");
        cg::this_grid().sync();
        (void)xcd_barrier_post(bar, st, F.tid);
        epoch = 1; return;
    }
    XcdBarrier b; b.bar = bar; b.x = xb_xcc_id(); b.st = st;
    xcd_barrier(b, F.tid);
    epoch += 1;
}
template <int PH, bool DRY = false> __device__ __forceinline__ void do_phase(int lo, int hi, int wave_s, LAS unsigned char* lds, unsigned char* lds_raw, int& epoch) {
    if (!(lo <= PH && PH < hi)) return;
    const Ctx F = make_ctx(wave_s);
    unsigned char* ws = F.ws;
    const float* ADA = (const float*)(ws + WS_ADA); const float* GS = (const float*)(ws + WS_GS); float* SSQP = (float*)(ws + WS_SSQP);
    bf16r* XS = (bf16r*)(ws + WS_XS); bf16r* H = (bf16r*)(ws + WS_H); bf16r* P = (bf16r*)(ws + WS_P); bf16r* Y = (bf16r*)(ws + WS_Y);
    constexpr bool is_layer = PH >= 2 && PH < N_PHASES - 1;
    constexpr int l = is_layer ? (PH - 2) / 9 : 0, s = is_layer ? (PH - 2) % 9 : -1, isattn = l & 1, j = l >> 1;
    constexpr bool empty = is_layer && s == 5 && isattn;
#if MK_DEBUG
    if constexpr (PH == 1) dbg_check_p0(F); else if constexpr (PH == 2) dbg_check_p1(F); else if constexpr (PH == 3) dbg_check_up(F); else if constexpr (PH == 4) dbg_check_down(F);
    else if constexpr (PH == 5) dbg_check_inproj0(F); else if constexpr (PH == 8) dbg_check_mlstm(F, lds); else if constexpr (PH == 14) dbg_check_inproj1(F);
    else if constexpr (PH == 15) dbg_check_attn(F); else if constexpr (PH == 17) dbg_check_combine(F);
    __syncthreads();
#endif
    if constexpr (PH == 0) p0_phase(F, lds);
    else if constexpr (PH == 1) p1_phase(F);
    else if constexpr (PH == N_PHASES - 1) { final_phase(F);
#if MK_DEBUG
        if (F.wg == 0) { asm volatile("s_waitcnt vmcnt(0)" ::: "memory"); __syncthreads(); const unsigned code = *(const unsigned*)(F.ws + 64); if (code) { float v = (float)(10 + (code % 90)) * 100.0f; for (unsigned q = 0; q < code / 90; ++q) v *= 10.0f; F.out[F.tid] = v; } }
#endif
    }
    else if constexpr (s == 0 || s == 7) {
        constexpr int f = s == 0 ? 0 : 1;
        pg8::Gemm g{XS, (const bf16r*)(ws + WS_W13) + (size_t)(l * 2 + f) * NUP * 1024, M, NUP, 1024};
        pg8::EpiGen E{0, H, (const float*)(ws + WS_SWF) + (size_t)(l * 2 + f) * 2 * NUP, SSQP, nullptr, nullptr, nullptr};
        pg8::StaticOrder S; S.init(M, NUP, F.G, F.wg);
        pg8::gemm_phase<pg8::EpiGen, pg8::StaticOrder, true, true>(lds, g, S, E, F.tid);
    } else if constexpr (s == 1 || s == 8) {
        constexpr int f = s == 1 ? 0 : 1, sub = f ? 2 : 0;
        pg8::Gemm g{H, (const bf16r*)(ws + WS_W2) + (size_t)(l * 2 + f) * 1024 * DFF, M, 1024, DFF};
        const float* gsn = f == 0 ? GS + (size_t)(l * 3 + 1) * 2048 : GS + (size_t)((l + 1 < DEPTH ? l + 1 : 0) * 3) * 2048;
        pg8::EpiGen E{DRY ? 5 : 1, F.out, ADA + (size_t)l * 2 * 9216 + sub * 3072 + 2048, gsn, (l == 0 && f == 0) ? (const void*)((const float*)F.ka->in[0]) : (const void*)F.out, XS, SSQP};
        pg8::StaticOrder S; S.init(M, 1024, F.G, F.wg);
        pg8::gemm_phase<pg8::EpiGen, pg8::StaticOrder, true, true>(lds, g, S, E, F.tid);
    } else if constexpr (s == 2) {
        pg8::Gemm g{XS, (const bf16r*)(ws + (isattn ? WS_WINB : WS_WINA)) + (size_t)j * NIN * 1024, M, NIN, 1024};
        pg8::EpiGen E{isattn ? 4 : 3, P, (const float*)(ws + WS_SWM) + (size_t)l * 2 * NIN, SSQP, ((const int*)F.ka->in[2]), nullptr, nullptr};
        pg8::StaticOrder S; S.init(M, NIN, F.G, F.wg);
        pg8::gemm_phase<pg8::EpiGen, pg8::StaticOrder, true, true>(lds, g, S, E, F.tid);
        if constexpr (!isattn) { __syncthreads(); gates_phase(F, lds, l); }
    } else if constexpr (s == 6) {
        pg8::Gemm g{Y, (const bf16r*)(ws + (isattn ? WS_WOB : WS_WOA)) + (size_t)j * 1024 * 1024, M, 1024, 1024};
        pg8::EpiGen E{DRY ? 5 : 2, F.out, ADA + (size_t)l * 2 * 9216 + 3072 + 2048, GS + (size_t)(l * 3 + 2) * 2048, (const void*)F.out, XS, SSQP};
        pg8::StaticOrder S; S.init(M, 1024, F.G, F.wg);
        pg8::gemm_phase<pg8::EpiGen, pg8::StaticOrder, true, true>(lds, g, S, E, F.tid);
    }
    else if constexpr (s == 3) { if constexpr (isattn) attn_phase(F, (char*)lds_raw); else s1_phase(F, lds, l); }
    else if constexpr (s == 4) { if constexpr (isattn) combine_phase(F, l); else s2_phase(F, lds); }
    else if constexpr (s == 5) { if constexpr (!isattn) s3_phase(F, lds, l); }
    if (PH + 1 < hi && !empty) grid_seam<PH == 0>(F, epoch, lds);
}
template <int PH> __device__ __forceinline__ void do_twice(int lo, int hi, int wave_s, LAS unsigned char* lds, unsigned char* lds_raw, int& epoch) {
    constexpr bool is_layer = PH >= 2 && PH < N_PHASES - 1;
    constexpr int l = is_layer ? (PH - 2) / 9 : 0, s = is_layer ? (PH - 2) % 9 : -1, isattn = l & 1;
    constexpr bool dbl = ((DBL_MASK & 1) && (PH == 0 || PH == 1)) || ((DBL_MASK & 2) && is_layer && !isattn && (s == 3 || s == 4 || s == 5)) || ((DBL_MASK & 4) && is_layer && isattn && s == 3)
                      || ((DBL_MASK & 8) && is_layer && (s == 0 || s == 7)) || ((DBL_MASK & 16) && is_layer && s == 2) || ((DBL_MASK & 32) && is_layer && isattn && s == 4) || ((DBL_MASK & 256) && is_layer && !isattn && s == 3) || ((DBL_MASK & 512) && is_layer && !isattn && s == 4) || ((DBL_MASK & 1024) && is_layer && !isattn && s == 5) || ((DBL_MASK & 2048) && PH == 0) || ((DBL_MASK & 4096) && PH == 1);
    constexpr bool dry = ((DBL_MASK & 64) && is_layer && (s == 1 || s == 8)) || ((DBL_MASK & 128) && is_layer && s == 6);
    if constexpr (dry) do_phase<PH, true>(lo, hi, wave_s, lds, lds_raw, epoch);
    do_phase<PH>(lo, hi, wave_s, lds, lds_raw, epoch);
    if constexpr (dbl) do_phase<PH>(lo, hi, wave_s, lds, lds_raw, epoch);
}
template <int... I> __device__ __forceinline__ void all_phases(std::integer_sequence<int, I...>, int lo, int hi, int wave_s, LAS unsigned char* lds, unsigned char* lds_raw, int& epoch) {
    (do_twice<I>(lo, hi, wave_s, lds, lds_raw, epoch), ...);
}
__global__ void __launch_bounds__(NWAVES * 64, 2) mk_fwd(Args args) {
    extern __shared__ __attribute__((aligned(16))) unsigned char lds_raw[];
    LAS unsigned char* lds = (LAS unsigned char*)lds_raw;
    const int ph_lo = args.ph_lo, ph_hi = args.ph_hi;
    const int wave_s = __builtin_amdgcn_readfirstlane(threadIdx.x >> 6);
    if (ph_lo != 0 && ph_hi - ph_lo > 1) return;
    int epoch = 0;
    all_phases(std::make_integer_sequence<int, N_PHASES>{}, ph_lo, ph_hi, wave_s, lds, lds_raw, epoch);
}

extern "C" void kernel_launch(void* const* d_in, const int* in_sizes, int n_in, void* d_out, int out_size, void* d_ws, size_t ws_size, hipStream_t stream) {
    static int grid = 0;
    if (grid == 0) {
        if (n_in != 19 || out_size != M * DM || ws_size < WS_END) { fprintf(stderr, "kernel_launch: unexpected shapes (n_in %d out %d ws %zu)\n", n_in, out_size, ws_size); grid = -1; return; }
        int dev = 0, cus = 0, per_cu = 0;
        (void)hipGetDevice(&dev); (void)hipDeviceGetAttribute(&cus, hipDeviceAttributeMultiprocessorCount, dev);
        if (hipFuncSetAttribute((const void*)mk_fwd, hipFuncAttributeMaxDynamicSharedMemorySize, LDS_BYTES) != hipSuccess) { fprintf(stderr, "kernel_launch: hipFuncSetAttribute failed\n"); grid = -1; return; }
        if (hipOccupancyMaxActiveBlocksPerMultiprocessor(&per_cu, (const void*)mk_fwd, NWAVES * 64, LDS_BYTES) != hipSuccess || per_cu < 1) { fprintf(stderr, "kernel_launch: occupancy query gave %d\n", per_cu); per_cu = 1; }
        (void)hipGetLastError();
        grid = cus > 0 ? cus : 256;
    }
    if (grid < 0) return;
    Args a{};
    for (int i = 0; i < 19; ++i) a.in[i] = d_in[i];
    a.out = (float*)d_out; a.ws = (unsigned char*)d_ws;
#if MK_ONE_LAUNCH
    a.ph_lo = 0; a.ph_hi = N_PHASES;
    void* kargs[] = {&a};
    hipError_t e = hipLaunchCooperativeKernel((const void*)mk_fwd, dim3(grid), dim3(NWAVES * 64), kargs, LDS_BYTES, stream);
    if (e != hipSuccess) fprintf(stderr, "kernel_launch: cooperative launch failed: %s (grid %d)\n", hipGetErrorString(e), grid);
#else
    for (int ph = 0; ph < N_PHASES; ++ph) {
        if (ph >= 2 && ph < N_PHASES - 1 && ((ph - 2) / 9 & 1) && ((ph - 2) % 9 == 5)) continue;
        a.ph_lo = ph; a.ph_hi = ph + 1;
        hipLaunchKernelGGL(mk_fwd, dim3(grid), dim3(NWAVES * 64), LDS_BYTES, stream, a);
    }
#endif
}
```

```cpp
#include <hip/hip_runtime.h>
#include <hip/hip_bf16.h>
#include <hip/hip_cooperative_groups.h>
#include <cstdio>
#include <cstdint>
#include <cmath>
#include <utility>
template <int MASK> __device__ __forceinline__ float swz_xor(float v) { return __builtin_bit_cast(float, __builtin_amdgcn_ds_swizzle(__builtin_bit_cast(int, v), (MASK << 10) | 0x1f)); }
__device__ __forceinline__ float sum_x32(float v) { const unsigned u = __float_as_uint(v); auto rr = __builtin_amdgcn_permlane32_swap(u, u, false, false); const unsigned r0 = rr[0], r1 = rr[1]; return __uint_as_float(r0) + __uint_as_float(r1); }
__device__ __forceinline__ float max_x32(float v) { const unsigned u = __float_as_uint(v); auto rr = __builtin_amdgcn_permlane32_swap(u, u, false, false); const unsigned r0 = rr[0], r1 = rr[1]; return fmaxf(__uint_as_float(r0), __uint_as_float(r1)); }
namespace pg8 {
#define PG8_LAS __attribute__((address_space(3)))
typedef unsigned short bf16_t;
typedef short bf16x8 __attribute__((ext_vector_type(8)));
typedef float f32x4 __attribute__((ext_vector_type(4)));
typedef unsigned u32x4 __attribute__((ext_vector_type(4)));
constexpr int BM = 256, BK = 64, HALF = 128, HTB = HALF * BK * 2  , STAGE_BYTES = 8 * HTB, NXCD = 8, WGM = 8;

__host__ __device__ __forceinline__ int lds_byte(int r, int c) { const int st = (r >> 4) * 2 + (c >> 5), rr = r & 15, cc = c & 31, ob = rr * 64 + cc * 2; return st * 1024 + (ob ^ (((ob >> 9) & 1) << 5)); }
__host__ __device__ __forceinline__ void stage_rc(int b, int& R, int& C) { const int st = b / 1024, sb = b % 1024, swz = sb ^ (((sb >> 9) & 1) << 5); R = (st >> 1) * 16 + swz / 64; C = (st & 1) * 32 + (swz % 64) / 2; }
__host__ __device__ __forceinline__ int perm32(int rho) { const int n = rho >> 4, i = rho & 15; return 8 * (i >> 2) + 4 * n + (i & 3); }

struct Unit { int pm, pn; };
struct Gemm { const bf16_t* A; const bf16_t* Bt; int M, N, K; };

struct StaticOrder {
    int nM, nN, nwg, G, c;
    __host__ __device__ void init(int M, int N, int G_, int c_) { nM = M / BM; nN = N / BM; nwg = nM * nN; G = G_; c = c_; }
    __host__ __device__ bool next(int i, Unit& u) const {
        const long L = (long)i * G + c; if (L >= nwg) return false;
        int wgid = (int)L; { const int q = nwg / NXCD, r = nwg % NXCD, xcd = wgid % NXCD, off = wgid / NXCD; wgid = (xcd < r ? xcd * (q + 1) : r * (q + 1) + (xcd - r) * q) + off; }
        const int nig = WGM * nN, gid = wgid / nig, fm = gid * WGM, gsz = (nM - fm) < WGM ? (nM - fm) : WGM;
        u.pm = fm + ((wgid % nig) % gsz); u.pn = (wgid % nig) / gsz; return true;
    }
    __device__ __forceinline__ void a_ready(const Unit&) const {}
    __device__ __forceinline__ void done(const Unit&) const {}
};
__device__ __forceinline__ unsigned cvt_pk_bf16(float lo, float hi) { unsigned r; asm volatile("v_cvt_pk_bf16_f32 %0, %1, %2" : "=v"(r) : "v"(lo), "v"(hi)); return r; }
constexpr int MROWS = 16384;
constexpr float RMS_EPS = 1e-6f;
__device__ __forceinline__ float silu_f(float g) { return g * __builtin_amdgcn_rcpf(1.0f + __expf(-g)); }
__device__ __forceinline__ void rows_rstd(const float* ssqp, int row0, int fq, float (&rs)[2][4]) {
    float s[2][4];
#pragma unroll
    for (int ai = 0; ai < 2; ++ai)
#pragma unroll
        for (int m = 0; m < 4; ++m) { const float* p = ssqp + (size_t)(fq * 4) * MROWS + row0 + ai * HALF + m * 16;
            s[ai][m] = (p[0] + p[MROWS]) + (p[2 * MROWS] + p[3 * MROWS]); }
#pragma unroll
    for (int ai = 0; ai < 2; ++ai)
#pragma unroll
        for (int m = 0; m < 4; ++m) { float t = s[ai][m]; t += swz_xor<16>(t); t = sum_x32(t); rs[ai][m] = rsqrtf(t * (1.0f / 1024.0f) + RMS_EPS); }
}
__device__ __forceinline__ float row_rstd(const float* ssqp, int row, int fq) {
    float s = 0.f;
#pragma unroll
    for (int i = 0; i < 4; ++i) s += ssqp[(size_t)(fq * 4 + i) * MROWS + row];
    s += swz_xor<16>(s); s = sum_x32(s);
    return rsqrtf(s * (1.0f / 1024.0f) + RMS_EPS);
}
struct EpiUp {
    static constexpr bool PERM = true, AFTER_DRAIN = false;
    bf16_t* H; const float* sw; const float* ssqp;
    __device__ __forceinline__ void operator()(const f32x4 (&acc)[2][2][4][2], const Unit& u, int wr, int wc, int fr, int fq) const {
        const int b = u.pm >> 5, row0 = u.pm * BM + wr * 64 + fr, c8 = wc * 32 + 8 * fq;
        const float* swp = sw + (size_t)b * 5632 + u.pn * 256 + c8;
        const f32x4 sg0 = *(const f32x4*)(swp), sg1 = *(const f32x4*)(swp + 4), su0 = *(const f32x4*)(swp + 128), su1 = *(const f32x4*)(swp + 132);
        bf16_t* hp = H + (size_t)u.pn * 128 + c8;
        float rsv[2][4]; rows_rstd(ssqp, row0, fq, rsv);
#pragma unroll
        for (int ai = 0; ai < 2; ++ai)
#pragma unroll
            for (int m = 0; m < 4; ++m) {
                const int row = row0 + ai * HALF + m * 16;
                const float rs = rsv[ai][m];
                const f32x4 g0 = acc[ai][0][m][0] * rs + sg0, g1 = acc[ai][0][m][1] * rs + sg1;
                const f32x4 u0 = acc[ai][1][m][0] * rs + su0, u1 = acc[ai][1][m][1] * rs + su1;
                u32x4 w;
                w.x = cvt_pk_bf16(silu_f(g0[0]) * u0[0], silu_f(g0[1]) * u0[1]); w.y = cvt_pk_bf16(silu_f(g0[2]) * u0[2], silu_f(g0[3]) * u0[3]);
                w.z = cvt_pk_bf16(silu_f(g1[0]) * u1[0], silu_f(g1[1]) * u1[1]); w.w = cvt_pk_bf16(silu_f(g1[2]) * u1[2], silu_f(g1[3]) * u1[3]);
                *(u32x4*)(hp + (size_t)row * 2816) = w;
            }
    }
};
struct EpiBias {
    static constexpr bool PERM = true, AFTER_DRAIN = false;
    bf16_t* O; int ldc; const float* sw; int nsw; const float* ssqp;
    __device__ __forceinline__ void operator()(const f32x4 (&acc)[2][2][4][2], const Unit& u, int wr, int wc, int fr, int fq) const {
        const int b = u.pm >> 5, row0 = u.pm * BM + wr * 64 + fr, col0 = u.pn * BM + wc * 32 + 8 * fq;
        f32x4 sv[2][2];
#pragma unroll
        for (int bj = 0; bj < 2; ++bj)
#pragma unroll
            for (int n = 0; n < 2; ++n) sv[bj][n] = *(const f32x4*)(sw + (size_t)b * nsw + col0 + bj * HALF + 4 * n);
        float rsv[2][4]; rows_rstd(ssqp, row0, fq, rsv);
#pragma unroll
        for (int ai = 0; ai < 2; ++ai)
#pragma unroll
            for (int m = 0; m < 4; ++m) {
                const int row = row0 + ai * HALF + m * 16;
                const float rs = rsv[ai][m];
                bf16_t* rowp = O + (size_t)row * ldc + col0;
#pragma unroll
                for (int bj = 0; bj < 2; ++bj) {
                    const f32x4 v0 = acc[ai][bj][m][0] * rs + sv[bj][0], v1 = acc[ai][bj][m][1] * rs + sv[bj][1];
                    u32x4 w; w.x = cvt_pk_bf16(v0[0], v0[1]); w.y = cvt_pk_bf16(v0[2], v0[3]); w.z = cvt_pk_bf16(v1[0], v1[1]); w.w = cvt_pk_bf16(v1[2], v1[3]);
                    *(u32x4*)(rowp + bj * HALF) = w;
                }
            }
    }
};
template <int HALFC> struct EpiResidT {
    static constexpr bool PERM = true, AFTER_DRAIN = false;
    float* x; const float* xin; const float* gate; const float* gsn; bf16_t* xs; float* ssqp;
    __device__ __forceinline__ void operator()(const f32x4 (&acc)[2][2][4][2], const Unit& u, int wr, int wc, int fr, int fq) const {
        const int b = u.pm >> 5, row0 = u.pm * BM + wr * 64 + fr, col0 = u.pn * BM + wc * 32 + 8 * fq;
        constexpr float gcoef = HALFC == 2 ? 0.0f : (HALFC ? 0.5f : 1.0f);
        f32x4 gt[2][2], gs[2][2];
#pragma unroll
        for (int bj = 0; bj < 2; ++bj)
#pragma unroll
            for (int n = 0; n < 2; ++n) {
                gt[bj][n] = *(const f32x4*)(gate + (size_t)b * 9216 + col0 + bj * HALF + 4 * n) * gcoef;
                gs[bj][n] = *(const f32x4*)(gsn + (size_t)b * 1024 + col0 + bj * HALF + 4 * n);
            }
#pragma unroll
        for (int ai = 0; ai < 2; ++ai)
#pragma unroll
        for (int mp = 0; mp < 2; ++mp) {
            f32x4 xv[2][2][2];
#pragma unroll
            for (int mm = 0; mm < 2; ++mm)
#pragma unroll
                for (int bj = 0; bj < 2; ++bj) { const float* xp = xin + (size_t)(row0 + ai * HALF + (mp * 2 + mm) * 16) * 1024 + col0 + bj * HALF; xv[mm][bj][0] = *(const f32x4*)xp; xv[mm][bj][1] = *(const f32x4*)(xp + 4); }
#pragma unroll
            for (int mm = 0; mm < 2; ++mm) {
                const int m = mp * 2 + mm, row = row0 + ai * HALF + m * 16;
                float ss = 0.f;
#pragma unroll
                for (int bj = 0; bj < 2; ++bj) {
                    float* xp = x + (size_t)row * 1024 + col0 + bj * HALF;
                    const f32x4 x0 = xv[mm][bj][0] + gt[bj][0] * acc[ai][bj][m][0], x1 = xv[mm][bj][1] + gt[bj][1] * acc[ai][bj][m][1];
                    *(f32x4*)xp = x0; *(f32x4*)(xp + 4) = x1;
                    ss += (x0[0] * x0[0] + x0[1] * x0[1]) + (x0[2] * x0[2] + x0[3] * x0[3]) + (x1[0] * x1[0] + x1[1] * x1[1]) + (x1[2] * x1[2] + x1[3] * x1[3]);
                    const f32x4 y0 = x0 * gs[bj][0], y1 = x1 * gs[bj][1];
                    u32x4 w; w.x = cvt_pk_bf16(y0[0], y0[1]); w.y = cvt_pk_bf16(y0[2], y0[3]); w.z = cvt_pk_bf16(y1[0], y1[1]); w.w = cvt_pk_bf16(y1[2], y1[3]);
                    *(u32x4*)(xs + (size_t)row * 1024 + col0 + bj * HALF) = w;
                }
                ss += swz_xor<16>(ss); ss = sum_x32(ss);
                if (fq == 0) ssqp[(size_t)(u.pn * 4 + wc) * MROWS + row] = ss;
            }
            asm volatile("" ::: "memory");
        }
    }
};
__constant__ float ROPE_INVF[16] = {1.000000000e+00f, 4.403665960e-01f, 1.939227432e-01f, 8.539710194e-02f, 3.760603070e-02f, 1.656044088e-02f, 7.292664610e-03f, 3.211446106e-03f,
                                    1.414213562e-03f, 6.227724371e-04f, 2.742481884e-04f, 1.207697351e-04f, 5.318295734e-05f, 2.341999971e-05f, 1.031338525e-05f, 4.541670478e-06f};
struct EpiRope {
    static constexpr bool PERM = true, AFTER_DRAIN = false;
    bf16_t* QKV; const float* sw; const float* ssqp; const int* pos;
    __device__ __forceinline__ void operator()(const f32x4 (&acc)[2][2][4][2], const Unit& u, int wr, int wc, int fr, int fq) const {
        const int b = u.pm >> 5, row0 = u.pm * BM + wr * 64 + fr, col0 = u.pn * BM + wc * 32 + 8 * fq;
        f32x4 sv[2][2];
#pragma unroll
        for (int bj = 0; bj < 2; ++bj)
#pragma unroll
            for (int n = 0; n < 2; ++n) sv[bj][n] = *(const f32x4*)(sw + (size_t)b * 3072 + col0 + bj * HALF + 4 * n);
        const bool rot = (wc == 0) && (u.pn < 8);
        const bool lower = fq < 2;
        float rsv[2][4]; rows_rstd(ssqp, row0, fq, rsv);
        f32x4 fr4[2] = {{0.f, 0.f, 0.f, 0.f}, {0.f, 0.f, 0.f, 0.f}};
        if (rot) { fr4[0] = *(const f32x4*)(ROPE_INVF + 8 * (fq & 1)); fr4[1] = *(const f32x4*)(ROPE_INVF + 8 * (fq & 1) + 4); }
#pragma unroll
        for (int ai = 0; ai < 2; ++ai)
#pragma unroll
            for (int m = 0; m < 4; ++m) {
                const int row = row0 + ai * HALF + m * 16, srow = row & 8191;
                const float rs = rsv[ai][m];
                f32x4 cs[2] = {{1.f, 1.f, 1.f, 1.f}, {1.f, 1.f, 1.f, 1.f}}, sn[2] = {{0.f, 0.f, 0.f, 0.f}, {0.f, 0.f, 0.f, 0.f}};
                if (rot) {
                    const float p = (float)pos[row];
#pragma unroll
                    for (int n = 0; n < 2; ++n)
#pragma unroll
                        for (int j = 0; j < 4; ++j) {
                            const float a = p * fr4[n][j];
                            const float k = rintf(a * 0.15915494309189535f);
                            float r = fmaf(-k, 6.2831854820251465f, a); r = fmaf(-k, -1.7484555314695172e-07f, r);
                            cs[n][j] = __cosf(r); sn[n][j] = lower ? -__sinf(r) : __sinf(r);
                        }
                }
#pragma unroll
                for (int bj = 0; bj < 2; ++bj) {
                    const int blk = u.pn * 2 + bj, which = blk >> 3, idx = blk & 7;
                    f32x4 v[2] = {acc[ai][bj][m][0] * rs + sv[bj][0], acc[ai][bj][m][1] * rs + sv[bj][1]};
                    if (rot) {
#pragma unroll
                        for (int n = 0; n < 2; ++n)
#pragma unroll
                            for (int j = 0; j < 4; ++j) {
                                const unsigned bits = __float_as_uint(v[n][j]);
                                auto rr = __builtin_amdgcn_permlane32_swap(bits, bits, false, false);
                                const unsigned r0 = rr[0], r1 = rr[1];
                                const float pv = __uint_as_float(lower ? r1 : r0);
                                v[n][j] = v[n][j] * cs[n][j] + pv * sn[n][j];
                            }
                    }
                    bf16_t* dp = QKV + (size_t)which * 16777216 + ((size_t)(b * 8 + idx) * 8192 + srow) * 128 + wc * 32 + 8 * fq;
                    u32x4 w; w.x = cvt_pk_bf16(v[0][0], v[0][1]); w.y = cvt_pk_bf16(v[0][2], v[0][3]); w.z = cvt_pk_bf16(v[1][0], v[1][1]); w.w = cvt_pk_bf16(v[1][2], v[1][3]);
                    *(u32x4*)dp = w;
                }
            }
    }
};
struct EpiGen {
    static constexpr bool PERM = true, AFTER_DRAIN = false;
    int kind; void* p0; const void* p1; const void* p2; const void* p3; void* p4; void* p5;
    __device__ __forceinline__ void operator()(const f32x4 (&acc)[2][2][4][2], const Unit& u, int wr, int wc, int fr, int fq) const {
        if (kind == 0) { EpiUp e{(bf16_t*)p0, (const float*)p1, (const float*)p2}; e(acc, u, wr, wc, fr, fq); }
        else if (kind == 1) { EpiResidT<1> e{(float*)p0, (const float*)p3, (const float*)p1, (const float*)p2, (bf16_t*)p4, (float*)p5}; e(acc, u, wr, wc, fr, fq); }
        else if (kind == 2) { EpiResidT<0> e{(float*)p0, (const float*)p3, (const float*)p1, (const float*)p2, (bf16_t*)p4, (float*)p5}; e(acc, u, wr, wc, fr, fq); }
        else if (kind == 3) { EpiBias e{(bf16_t*)p0, 3072, (const float*)p1, 3072, (const float*)p2}; e(acc, u, wr, wc, fr, fq); }
        else if (kind == 5) { EpiResidT<2> e{(float*)p0, (const float*)p3, (const float*)p1, (const float*)p2, (bf16_t*)p4, (float*)p5}; e(acc, u, wr, wc, fr, fq); }
        else { EpiRope e{(bf16_t*)p0, (const float*)p1, (const float*)p2, (const int*)p3}; e(acc, u, wr, wc, fr, fq); }
    }
};
template <class Epi, class Sched, bool ALIGN_EPI = false, bool SP2 = false>
__device__ __forceinline__ void gemm_phase(PG8_LAS unsigned char* lds, const Gemm g, const Sched& S, const Epi& E, const int tid_in) {
    const int tid = tid_in, wid = __builtin_amdgcn_readfirstlane(tid >> 6), lane = tid & 63, wr = wid >> 2, wc = wid & 3, fr = lane & 15, fq = lane >> 4;
    const int K = g.K, nt = K / BK;
    unsigned voffA[2], voffB[2];
#pragma unroll
    for (int i = 0; i < 2; ++i) { int R, C; stage_rc(tid * 16 + i * 8192, R, C); const int Rb = Epi::PERM ? ((R & ~31) + perm32(R & 31)) : R;
        voffA[i] = (unsigned)(R * K + C) * 2u; voffB[i] = (unsigned)(Rb * K + C) * 2u; }
    const size_t kstep = (size_t)(BK * 2);
    const size_t hstep = (size_t)HALF * K * 2;
    const size_t tstep = 2 * hstep;
    const unsigned ldsw = (unsigned)wid * 1024u;
    const int aoff = lds_byte(wr * 64 + fr, fq * 8), boff = lds_byte(wc * 32 + fr, fq * 8);
#define PG8_SA(b, h) (((b) * 2 + (h)) * HTB)
#define PG8_SB(b, h) ((4 + (b) * 2 + (h)) * HTB)
#define PG8_STAGE(bufoff, gbase, voff) do { _Pragma("unroll") for (int _i = 0; _i < 2; ++_i) \
        __builtin_amdgcn_global_load_lds((const unsigned*)((const char*)(gbase) + (voff)[_i]), (PG8_LAS unsigned*)(lds + (bufoff) + ldsw + _i * 8192), 16, 0, 0); } while (0)
#define PG8_LDA(dst, b, h) do { _Pragma("unroll") for (int m = 0; m < 4; ++m) _Pragma("unroll") for (int k = 0; k < 2; ++k) dst[m][k] = *(const PG8_LAS bf16x8*)(lds + PG8_SA(b, h) + aoff + m * 2048 + k * 1024); } while (0)
#define PG8_LDB(dst, b, h) do { _Pragma("unroll") for (int n = 0; n < 2; ++n) _Pragma("unroll") for (int k = 0; k < 2; ++k) dst[n][k] = *(const PG8_LAS bf16x8*)(lds + PG8_SB(b, h) + boff + n * 2048 + k * 1024); } while (0)
#define PG8_MMA(ai, bj, At, Bt) do { __builtin_amdgcn_s_setprio(1); _Pragma("unroll") for (int m = 0; m < 4; ++m) _Pragma("unroll") for (int n = 0; n < 2; ++n) _Pragma("unroll") for (int k = 0; k < 2; ++k) \
        acc[ai][bj][m][n] = __builtin_amdgcn_mfma_f32_16x16x32_bf16(Bt[n][k], At[m][k], acc[ai][bj][m][n], 0, 0, 0); __builtin_amdgcn_s_setprio(0); } while (0)
#define PG8_WAIT_V(n) asm volatile("s_waitcnt vmcnt(" #n ")" ::: "memory")
#define PG8_WAIT_L(n) asm volatile("s_waitcnt lgkmcnt(" #n ")" ::: "memory")
#define PG8_BAR __builtin_amdgcn_s_barrier()
#define PG8_SCHED __builtin_amdgcn_sched_barrier(0)
    Unit cur, nxt; int ui = 0;
    if (!S.next(0, cur)) return;
    f32x4 acc[2][2][4][2];
#pragma unroll
    for (int a = 0; a < 2; ++a)
#pragma unroll
        for (int b = 0; b < 2; ++b)
#pragma unroll
            for (int m = 0; m < 4; ++m)
#pragma unroll
                for (int n = 0; n < 2; ++n) acc[a][b][m][n] = (f32x4){0.f, 0.f, 0.f, 0.f};
    bf16x8 At[4][2], B0[2][2], B1[2][2];
    const char* cA = (const char*)g.A + (size_t)cur.pm * tstep; const char* cB = (const char*)g.Bt + (size_t)cur.pn * tstep;
    S.a_ready(cur);
    if constexpr (SP2) {
        PG8_STAGE(PG8_SB(0, 0), cB, voffB); PG8_STAGE(PG8_SB(0, 1), cB + hstep, voffB); PG8_STAGE(PG8_SA(0, 0), cA, voffA); PG8_STAGE(PG8_SA(0, 1), cA + hstep, voffA);
        if (wr == 1) PG8_BAR;
        PG8_WAIT_V(2); PG8_BAR;
        PG8_STAGE(PG8_SB(1, 0), cB + kstep, voffB); PG8_STAGE(PG8_SA(1, 0), cA + kstep, voffA); PG8_STAGE(PG8_SB(1, 1), cB + hstep + kstep, voffB);
        PG8_WAIT_V(6); PG8_BAR;
    } else {
        PG8_STAGE(PG8_SB(0, 0), cB, voffB); PG8_STAGE(PG8_SA(0, 0), cA, voffA); PG8_STAGE(PG8_SB(0, 1), cB + hstep, voffB); PG8_STAGE(PG8_SA(0, 1), cA + hstep, voffA);
        if (wr == 1) PG8_BAR;
        PG8_WAIT_V(4); PG8_BAR;
        PG8_STAGE(PG8_SB(1, 0), cB + kstep, voffB); PG8_STAGE(PG8_SA(1, 0), cA + kstep, voffA); PG8_STAGE(PG8_SB(1, 1), cB + hstep + kstep, voffB);
        PG8_WAIT_V(6); PG8_BAR;
    }
    for (;;) {
        const bool has_next = S.next(ui + 1, nxt);
        const char* nA = has_next ? (const char*)g.A + (size_t)nxt.pm * tstep : cA; const char* nB = has_next ? (const char*)g.Bt + (size_t)nxt.pn * tstep : cB;
        for (int t = 0; t < nt; t += 2) {
            const bool last = (t == nt - 2);
            const char* a1 = cA + (size_t)(t + 1) * kstep;
            const char* a2 = last ? nA : cA + (size_t)(t + 2) * kstep; const char* b2 = last ? nB : cB + (size_t)(t + 2) * kstep;
            const char* a3 = a2 + kstep; const char* b3 = b2 + kstep;
            if (last && has_next) S.a_ready(nxt);
            if constexpr (SP2) {
            PG8_LDB(B0, 0, 0); PG8_LDB(B1, 0, 1); PG8_SCHED; PG8_LDA(At, 0, 0); PG8_STAGE(PG8_SA(1, 1), a1 + hstep, voffA);
            PG8_WAIT_V(8); PG8_WAIT_L(0); PG8_BAR; PG8_MMA(0, 0, At, B0); PG8_MMA(0, 1, At, B1); PG8_BAR; PG8_SCHED;
            PG8_LDA(At, 0, 1); PG8_STAGE(PG8_SB(0, 0), b2, voffB); PG8_STAGE(PG8_SB(0, 1), b2 + hstep, voffB); PG8_STAGE(PG8_SA(0, 0), a2, voffA);
            PG8_WAIT_V(8); PG8_WAIT_L(0); PG8_BAR; PG8_MMA(1, 0, At, B0); PG8_MMA(1, 1, At, B1); PG8_BAR; PG8_SCHED;
            PG8_LDB(B0, 1, 0); PG8_LDB(B1, 1, 1); PG8_SCHED; PG8_LDA(At, 1, 0); PG8_STAGE(PG8_SA(0, 1), a2 + hstep, voffA);
            PG8_WAIT_V(8); PG8_WAIT_L(0); PG8_BAR; PG8_MMA(0, 0, At, B0); PG8_MMA(0, 1, At, B1); PG8_BAR; PG8_SCHED;
            PG8_LDA(At, 1, 1); PG8_STAGE(PG8_SB(1, 0), b3, voffB); PG8_STAGE(PG8_SB(1, 1), b3 + hstep, voffB); PG8_STAGE(PG8_SA(1, 0), a3, voffA);
            PG8_WAIT_V(8); PG8_WAIT_L(0); PG8_BAR; PG8_MMA(1, 0, At, B0); PG8_MMA(1, 1, At, B1); PG8_BAR; PG8_SCHED;
            } else {
            PG8_LDB(B0, 0, 0); PG8_SCHED; PG8_LDA(At, 0, 0); PG8_STAGE(PG8_SA(1, 1), a1 + hstep, voffA);
            PG8_WAIT_L(8); PG8_BAR; PG8_WAIT_L(0); PG8_MMA(0, 0, At, B0); PG8_BAR; PG8_SCHED;
            PG8_LDB(B1, 0, 1); PG8_STAGE(PG8_SB(0, 0), b2, voffB);
            PG8_BAR; PG8_WAIT_L(0); PG8_MMA(0, 1, At, B1); PG8_BAR;
            PG8_LDA(At, 0, 1); PG8_STAGE(PG8_SA(0, 0), a2, voffA);
            PG8_BAR; PG8_WAIT_L(0); PG8_MMA(1, 0, At, B0); PG8_BAR; PG8_SCHED;
            PG8_STAGE(PG8_SB(0, 1), b2 + hstep, voffB);
            PG8_WAIT_V(6); PG8_BAR; PG8_MMA(1, 1, At, B1); PG8_BAR;
            PG8_LDB(B0, 1, 0); PG8_SCHED; PG8_LDA(At, 1, 0); PG8_STAGE(PG8_SA(0, 1), a2 + hstep, voffA);
            PG8_WAIT_L(8); PG8_BAR; PG8_WAIT_L(0); PG8_MMA(0, 0, At, B0); PG8_BAR; PG8_SCHED;
            PG8_LDB(B1, 1, 1); PG8_STAGE(PG8_SB(1, 0), b3, voffB);
            PG8_BAR; PG8_WAIT_L(0); PG8_MMA(0, 1, At, B1); PG8_BAR;
            PG8_LDA(At, 1, 1); PG8_STAGE(PG8_SA(1, 0), a3, voffA);
            PG8_BAR; PG8_WAIT_L(0); PG8_MMA(1, 0, At, B0); PG8_BAR; PG8_SCHED;
            PG8_STAGE(PG8_SB(1, 1), b3 + hstep, voffB);
            PG8_WAIT_V(6); PG8_BAR; PG8_MMA(1, 1, At, B1); PG8_BAR;
            }
        }
        if constexpr (ALIGN_EPI) { if (wr == 0) PG8_BAR; }
        if constexpr (!Epi::AFTER_DRAIN) { E(acc, cur, wr, wc, fr, fq); S.done(cur); }
        if (!has_next) break;
#pragma unroll
        for (int a = 0; a < 2; ++a)
#pragma unroll
            for (int b = 0; b < 2; ++b)
#pragma unroll
                for (int m = 0; m < 4; ++m)
#pragma unroll
                    for (int n = 0; n < 2; ++n) acc[a][b][m][n] = (f32x4){0.f, 0.f, 0.f, 0.f};
        cur = nxt; cA = nA; cB = nB; ++ui;
        if constexpr (ALIGN_EPI) { if (wr == 1) PG8_BAR; }
    }
    PG8_WAIT_V(0);
    if constexpr (!ALIGN_EPI) { if (wr == 0) PG8_BAR; }
    PG8_BAR;
    if constexpr (Epi::AFTER_DRAIN) { E.fused(acc, cur, wr, wc, fr, fq, lds, wid, lane); S.done(cur); }
#undef PG8_SA
#undef PG8_SB
#undef PG8_STAGE
#undef PG8_LDA
#undef PG8_LDB
#undef PG8_MMA
#undef PG8_WAIT_V
#undef PG8_WAIT_L
#undef PG8_BAR
#undef PG8_SCHED
}
}
namespace att {
using bf16 = __hip_bfloat16;
constexpr int D = 128; constexpr float THR = 8.f; constexpr bool WSKIP = false;
constexpr float SCALE = 0.08838834764831845f;
constexpr int NW = 8, QBLK = 32, KVBLK = 64, QB = NW * QBLK;
constexpr int SHM_V = KVBLK * D * 2, SHM_K = KVBLK * D * 2;
constexpr int LDS_BYTES = 2 * SHM_V + 2 * SHM_K + NW * 64 * 4;
typedef short bf16x8 __attribute__((ext_vector_type(8)));
typedef short s16x4 __attribute__((ext_vector_type(4)));
typedef float f32x16 __attribute__((ext_vector_type(16)));
typedef float f32x4 __attribute__((ext_vector_type(4)));
typedef unsigned u32x4 __attribute__((ext_vector_type(4)));
template <class A, class Bt> struct same_t { static constexpr bool v = false; };
template <class A> struct same_t<A, A> { static constexpr bool v = true; };

#define KSWZ(row, colB) ((row) * 256 + ((colB) ^ (((row) & 7) << 4)))
#define SBAR() __builtin_amdgcn_sched_barrier(0)
__device__ __forceinline__ int v_st(int k, int c) { const int kk = (k & ~0xC) | ((k & 4) << 1) | ((k & 8) >> 1); return ((kk >> 3) * 4 + (c >> 5)) * 512 + ((kk & 7) * 32 + (c & 31)) * 2; }
__device__ __forceinline__ int v_rd_base(int lane) { return ((lane & 3) << 3) | (((lane >> 2) & 3) << 6) | (((lane >> 4) & 1) << 5) | (((lane >> 5) & 1) << 8); }
constexpr int v_rd_off(int d0, int ks, int half) { return d0 * 512 + ks * 4096 + half * 2048; }
__device__ __forceinline__ int crow(int r, int hi) { return (r & 3) + 8 * (r >> 2) + 4 * hi; }
__device__ __forceinline__ unsigned cvtpk(float lo, float hi) {
    unsigned r; asm volatile("v_cvt_pk_bf16_f32 %0, %1, %2" : "=v"(r) : "v"(lo), "v"(hi)); return r;
}
__device__ __forceinline__ bf16x8 pack8(f32x4 a, f32x4 b) {
    u32x4 w = {cvtpk(a[0], a[1]), cvtpk(a[2], a[3]), cvtpk(b[0], b[1]), cvtpk(b[2], b[3])};
    return *reinterpret_cast<bf16x8*>(&w);
}
template <class T> __device__ __forceinline__ bf16x8 load8(const T* p) {
    if constexpr (same_t<T, float>::v) { return pack8(*(const f32x4*)p, *(const f32x4*)(p + 4)); }
    else { return *reinterpret_cast<const bf16x8*>(p); }
}
__device__ __forceinline__ void mask_tile(f32x16& p0, f32x16& p1, int dq, unsigned W) {
    const float NEG = -__builtin_inff();
#pragma unroll
    for (int r = 0; r < 16; ++r) {
        const int c = (r & 3) + 8 * (r >> 2);
        if ((unsigned)(dq - c) >= W) p0[r] = NEG;
        if ((unsigned)(dq - c - 32) >= W) p1[r] = NEG;
    }
}
__device__ __forceinline__ void partialSM(f32x16& p0, f32x16& p1, float& m_reg, float& mn, float& alpha) {
    float pmax = p0[0]; for (int r = 1; r < 16; ++r) pmax = fmaxf(pmax, p0[r]); for (int r = 0; r < 16; ++r) pmax = fmaxf(pmax, p1[r]);
    { auto rr = __builtin_amdgcn_permlane32_swap(__float_as_uint(pmax), __float_as_uint(pmax), false, false);
      pmax = fmaxf(__uint_as_float(rr[0]), __uint_as_float(rr[1])); }
    constexpr float C2 = 1.4426950408889634f * SCALE;
    if (__builtin_expect(__all((pmax - m_reg) * SCALE <= THR), 1)) { mn = m_reg; alpha = 1.f; }
    else { mn = fmaxf(m_reg, pmax); alpha = __builtin_amdgcn_exp2f((m_reg - mn) * C2); m_reg = mn; }
    const float mnL = -mn * C2;
    for (int r = 0; r < 16; ++r) p0[r] = fmaf(p0[r], C2, mnL); for (int r = 0; r < 16; ++r) p1[r] = fmaf(p1[r], C2, mnL);
    for (int r = 0; r < 16; ++r) p0[r] = __builtin_amdgcn_exp2f(p0[r]);
}
__device__ __forceinline__ void finishSM(f32x16& p0, f32x16& p1, float alpha, float& l_reg, bf16x8& pa0, bf16x8& pa1, bf16x8& pa2, bf16x8& pa3) {
    for (int r = 0; r < 16; ++r) p1[r] = __builtin_amdgcn_exp2f(p1[r]);
    float ps = 0; for (int r = 0; r < 16; ++r) ps += p0[r]; for (int r = 0; r < 16; ++r) ps += p1[r];
    { auto rr = __builtin_amdgcn_permlane32_swap(__float_as_uint(ps), __float_as_uint(ps), false, false);
      ps = __uint_as_float(rr[0]) + __uint_as_float(rr[1]); }
    l_reg = l_reg * alpha + ps;
#define PK4(P, B_, OUT) do { unsigned a0 = cvtpk(P[B_+0], P[B_+1]), a1 = cvtpk(P[B_+2], P[B_+3]);                          \
        unsigned b0 = cvtpk(P[B_+4], P[B_+5]), b1 = cvtpk(P[B_+6], P[B_+7]);                                             \
        auto r0 = __builtin_amdgcn_permlane32_swap(a0, b0, false, false); auto r1 = __builtin_amdgcn_permlane32_swap(a1, b1, false, false); \
        u32x4 w = {r0[0], r1[0], r0[1], r1[1]}; OUT = *reinterpret_cast<bf16x8*>(&w); } while (0)
    PK4(p0, 0, pa0); PK4(p0, 8, pa1); PK4(p1, 0, pa2); PK4(p1, 8, pa3);
#undef PK4
}
template <int KB, bool SK>
__device__ __forceinline__ void qkt(f32x16& p0, f32x16& p1, const char* K_lds, int r32, int hi, const bf16x8* qr, bool act) {
    if (SK && !act) { const float NEG = -__builtin_inff();
#pragma unroll
        for (int r = 0; r < 16; ++r) { p0[r] = NEG; p1[r] = NEG; } return; }
    p0 = f32x16{}; p1 = f32x16{};
    const char* kb[4];
#pragma unroll
    for (int dd = 0; dd < 4; ++dd) kb[dd] = K_lds + KB * SHM_K + KSWZ(r32, (dd * 16 + hi * 8) * 2);
#pragma unroll
    for (int d0 = 0; d0 < 8; ++d0) { const char* a = kb[d0 & 3] + (d0 >> 2) * 128;
        bf16x8 b0 = *reinterpret_cast<const bf16x8*>(a);
        bf16x8 b1 = *reinterpret_cast<const bf16x8*>(a + 32 * 256);
        p0 = __builtin_amdgcn_mfma_f32_32x32x16_bf16(b0, qr[d0], p0, 0, 0, 0);
        p1 = __builtin_amdgcn_mfma_f32_32x32x16_bf16(b1, qr[d0], p1, 0, 0, 0); }
}
template <int VB, bool SK>
__device__ __forceinline__ void pv_tile(f32x16* o, int vb0, bf16x8 pa0, bf16x8 pa1, bf16x8 pa2, bf16x8 pa3, bool act) {
    if (SK && !act) return;
#define TRRD(dst, off) asm volatile("ds_read_b64_tr_b16 %0, %1 offset:%2" : "=&v"(dst) : "v"(vb0), "i"(off) : "memory")
#define PV_D0(d0) do { s16x4 l0, l1, l2, l3, h0, h1, h2, h3; constexpr int b_ = VB * SHM_V + v_rd_off(d0, 0, 0);     \
        TRRD(l0, b_); TRRD(h0, b_ + 2048); TRRD(l1, b_ + 4096); TRRD(h1, b_ + 6144); TRRD(l2, b_ + 8192); TRRD(h2, b_ + 10240); TRRD(l3, b_ + 12288); TRRD(h3, b_ + 14336); \
        asm volatile("s_waitcnt lgkmcnt(0)" ::: "memory"); SBAR();                 \
        o[d0] = __builtin_amdgcn_mfma_f32_32x32x16_bf16(pa0, (bf16x8){l0[0], l0[1], l0[2], l0[3], h0[0], h0[1], h0[2], h0[3]}, o[d0], 0, 0, 0);   \
        o[d0] = __builtin_amdgcn_mfma_f32_32x32x16_bf16(pa1, (bf16x8){l1[0], l1[1], l1[2], l1[3], h1[0], h1[1], h1[2], h1[3]}, o[d0], 0, 0, 0);   \
        o[d0] = __builtin_amdgcn_mfma_f32_32x32x16_bf16(pa2, (bf16x8){l2[0], l2[1], l2[2], l2[3], h2[0], h2[1], h2[2], h2[3]}, o[d0], 0, 0, 0);   \
        o[d0] = __builtin_amdgcn_mfma_f32_32x32x16_bf16(pa3, (bf16x8){l3[0], l3[1], l3[2], l3[3], h3[0], h3[1], h3[2], h3[3]}, o[d0], 0, 0, 0); } while (0)
    PV_D0(0); PV_D0(1); PV_D0(2); PV_D0(3);
#undef PV_D0
#undef TRRD
}

template <class TIn, class TOut> struct BlockRef { const TIn* Q; const TIn* K; const TIn* V; TOut* O; int P0; };
template <class TIn> struct Seam {
    bf16x8 qr[8];
    bf16x8 st_v0, st_v1, st_k0, st_k1; f32x4 sf0, sf1, sf2, sf3;
    f32x4 tq[16];
};
__device__ __forceinline__ int swa_jlo(int P0, int W) { const int lowk = P0 - W + 1; return lowk > 0 ? lowk / KVBLK : 0; }
#define ROW(p, k0, rr) ((p) + (size_t)((k0) + (rr)) * D + sc)
#define VMW() asm volatile("s_waitcnt vmcnt(0)" ::: "memory")
#define VMWN(n) asm volatile("s_waitcnt vmcnt(%0)" :: "i"(n) : "memory")
#define SLOAD_H(Kp, Vp, k0) do { S.st_v0 = load8<TIn>(ROW(Vp, k0, sr)); S.st_v1 = load8<TIn>(ROW(Vp, k0, 32 + sr));              \
                         S.st_k0 = load8<TIn>(ROW(Kp, k0, sr)); S.st_k1 = load8<TIn>(ROW(Kp, k0, 32 + sr)); } while (0)
#define SWRITE_HK(bf) do { *(bf16x8*)(K_lds + (bf) * SHM_K + kws) = S.st_k0; *(bf16x8*)(K_lds + (bf) * SHM_K + kws + 32 * 256) = S.st_k1; } while (0)
#define SWRITE_HV(bf) do { *(bf16x8*)(V_lds + (bf) * SHM_V + vst0) = S.st_v0; *(bf16x8*)(V_lds + (bf) * SHM_V + vst1) = S.st_v1; } while (0)
#define SWRITE_H(bf) do { SWRITE_HV(bf); SWRITE_HK(bf); } while (0)
#define SLOAD_F(p, k0) do { S.sf0 = *(const f32x4*)ROW(p, k0, sr); S.sf1 = *(const f32x4*)(ROW(p, k0, sr) + 4);                \
                            S.sf2 = *(const f32x4*)ROW(p, k0, 32 + sr); S.sf3 = *(const f32x4*)(ROW(p, k0, 32 + sr) + 4); } while (0)
#define SWRITE_KF(bf) do { *(bf16x8*)(K_lds + (bf) * SHM_K + kws) = pack8(S.sf0, S.sf1); *(bf16x8*)(K_lds + (bf) * SHM_K + kws + 32 * 256) = pack8(S.sf2, S.sf3); } while (0)
#define SWRITE_VF(bf) do { *(bf16x8*)(V_lds + (bf) * SHM_V + vst0) = pack8(S.sf0, S.sf1); *(bf16x8*)(V_lds + (bf) * SHM_V + vst1) = pack8(S.sf2, S.sf3); } while (0)
template <class TIn, class TOut>
__device__ __forceinline__ void causal_swa_prime(const BlockRef<TIn, TOut>& cur, int W, char* lds, Seam<TIn>& S, int tid_in) {
    constexpr bool F32 = same_t<TIn, float>::v;
    const int tid = tid_in, wid = __builtin_amdgcn_readfirstlane(tid >> 6), lane = tid & 63, r32 = lane & 31, hi = lane >> 5;
    const int sr = tid >> 4, sc = (tid & 15) * 8, kws = KSWZ(sr, sc * 2); char* K_lds = lds + 2 * SHM_V;
    const int kb0 = swa_jlo(cur.P0, W) * KVBLK;
    for (int d0 = 0; d0 < 8; ++d0) S.qr[d0] = load8<TIn>(cur.Q + (size_t)(wid * QBLK + r32) * D + d0 * 16 + hi * 8);
    if constexpr (F32) { SLOAD_F((const float*)cur.K, kb0); VMW(); SWRITE_KF(0); SBAR(); SLOAD_F((const float*)cur.V, kb0); }
    else { SLOAD_H(cur.K, cur.V, kb0); VMW(); SWRITE_HK(0); }
    __syncthreads();
}
template <class TIn, class TOut>
__device__ __forceinline__ void causal_swa_block(const BlockRef<TIn, TOut>& cur, const BlockRef<TIn, TOut>& nxt, int skv, int W, char* lds, Seam<TIn>& S, int tid_in) {
    constexpr bool F32 = same_t<TIn, float>::v;
    const int tid = tid_in, wid = __builtin_amdgcn_readfirstlane(tid >> 6), lane = tid & 63, r32 = lane & 31, hi = lane >> 5;
    const int j_lo = swa_jlo(cur.P0, W);
    int j_hi = (cur.P0 + QB - 1) / KVBLK + 1; if (j_hi > skv / KVBLK) j_hi = skv / KVBLK;
    const int NT = j_hi - j_lo;
    const int kbn = swa_jlo(nxt.P0, W) * KVBLK;
    const int qlo = cur.P0 + wid * QBLK, qm = qlo + r32 - 4 * hi;
    char* V_lds = lds; char* K_lds = lds + 2 * SHM_V;
    float* ws = (float*)(lds + 2 * SHM_V + 2 * SHM_K) + wid * 64; float* li_l = ws, * al_l = ws + 32;
    float m_reg = -1e30f, l_reg = 0; f32x16 o[4] = {};
    const int sr = tid >> 4, sc = (tid & 15) * 8, vst0 = v_st(sr, sc), vst1 = v_st(32 + sr, sc), kws = KSWZ(sr, sc * 2);
    const int vb0 = (int)(uintptr_t)V_lds + v_rd_base(lane);
    const TIn* Kh = cur.K; const TIn* Vh = cur.V;
#define RESC(a) do { if (__any((a) < 1.f)) { if (hi == 0) al_l[r32] = (a); asm volatile("s_waitcnt lgkmcnt(0)" ::: "memory");              \
                     for (int d_ = 0; d_ < 4; ++d_) for (int r = 0; r < 16; ++r) o[d_][r] *= al_l[crow(r, hi)]; } } while (0)
#define KBASE(t) ((j_lo + (t)) * KVBLK)
#define ACT(t) (KBASE(t) <= qlo + QBLK - 1 && KBASE(t) + KVBLK - 1 >= qlo - W + 1)
#define MASKT(P0_, P1_, t) do { const int kb_ = KBASE(t); if ((!SK || ACT(t)) && (kb_ + KVBLK - 1 > qlo || kb_ <= qlo + QBLK - 1 - W)) mask_tile(P0_, P1_, qm - kb_, (unsigned)W); } while (0)
    constexpr int NQL = F32 ? 16 : 8;
    constexpr bool SK = WSKIP && !F32;
#define SEAM_K0() do { VMWN(NQL); if constexpr (F32) { SWRITE_KF(0); SBAR(); SLOAD_F((const float*)nxt.V, kbn); } else { SWRITE_HK(0); } SBAR(); } while (0)
    f32x16 pA0, pA1, pB0, pB1; float mnA, mnB, alA, alB; bf16x8 pa0, pa1, pa2, pa3;
    if constexpr (F32) { VMW(); SWRITE_VF(0); SBAR(); } else { SWRITE_HV(0); SBAR(); }
    if (NT > 1) { if constexpr (F32) SLOAD_F((const float*)Kh, KBASE(1)); else SLOAD_H(Kh, Vh, KBASE(1)); }
    SBAR(); qkt<0, SK>(pA0, pA1, K_lds, r32, hi, S.qr, ACT(0));
    if constexpr (F32) { if (NT > 1) { VMW(); SWRITE_KF(1); SBAR(); SLOAD_F((const float*)Vh, KBASE(1)); } }
    MASKT(pA0, pA1, 0); partialSM(pA0, pA1, m_reg, mnA, alA);
    if (NT > 1) { VMW(); if constexpr (F32) { SWRITE_VF(1); SBAR(); if (NT > 2) SLOAD_F((const float*)Kh, KBASE(2)); } else SWRITE_H(1); }
    __syncthreads();
#define HALF_STEP(PX0, PX1, mnX, alX, PY0, PY1, alY, t, KB, VB, SB) do {                                                      \
        SBAR(); qkt<KB, SK>(PX0, PX1, K_lds, r32, hi, S.qr, ACT(t));                                             \
        finishSM(PY0, PY1, alY, l_reg, pa0, pa1, pa2, pa3); SBAR();                                                           \
        if ((t) + 1 < NT) { if constexpr (F32) { VMW(); SWRITE_KF(SB); SBAR(); SLOAD_F((const float*)Vh, KBASE((t) + 1)); }  \
                            else { SLOAD_H(Kh, Vh, KBASE((t) + 1)); } SBAR(); }                                               \
        pv_tile<VB, SK>(o, vb0, pa0, pa1, pa2, pa3, ACT((t) - 1)); MASKT(PX0, PX1, (t)); partialSM(PX0, PX1, m_reg, mnX, alX);                                        \
        __syncthreads();                                                                                                      \
        if ((t) + 1 < NT) { VMW(); if constexpr (F32) { SWRITE_VF(SB); SBAR(); if ((t) + 2 < NT) SLOAD_F((const float*)Kh, KBASE((t) + 2)); } \
                            else { SWRITE_H(SB); } }                                                                          \
        RESC(alX); __syncthreads(); } while (0)
    for (int t = 1; t + 1 < NT; t += 2) {
        HALF_STEP(pB0, pB1, mnB, alB, pA0, pA1, alA, t, 1, 0, 0);
        HALF_STEP(pA0, pA1, mnA, alA, pB0, pB1, alB, t + 1, 0, 1, 1);
    }
    const bool even = (NT & 1) == 0;
    if (even) { SBAR(); qkt<1, SK>(pB0, pB1, K_lds, r32, hi, S.qr, ACT(NT - 1)); SBAR(); }
#define QROW(e) (nxt.Q + (size_t)(wid * QBLK + r32) * D + ((e) >> 1) * 16 + hi * 8 + ((e) & 1) * 4)
    if constexpr (F32) { SLOAD_F((const float*)nxt.K, kbn); SBAR();
#pragma unroll
        for (int e = 0; e < 8; ++e) S.tq[e] = *(const f32x4*)QROW(e); }
    else { SLOAD_H(nxt.K, nxt.V, kbn); SBAR();
#pragma unroll
        for (int d0 = 0; d0 < 8; ++d0) S.qr[d0] = load8<TIn>(nxt.Q + (size_t)(wid * QBLK + r32) * D + d0 * 16 + hi * 8); }
    SBAR();
    finishSM(pA0, pA1, alA, l_reg, pa0, pa1, pa2, pa3); SBAR();
    if constexpr (F32) {
#pragma unroll
        for (int e = 8; e < 16; ++e) S.tq[e] = *(const f32x4*)QROW(e); SBAR(); }
#undef QROW
    pv_tile<0, SK>(o, vb0, pa0, pa1, pa2, pa3, ACT(even ? NT - 2 : NT - 1));
    if (even) { MASKT(pB0, pB1, NT - 1); partialSM(pB0, pB1, m_reg, mnB, alB); __syncthreads(); RESC(alB);
        finishSM(pB0, pB1, alB, l_reg, pa0, pa1, pa2, pa3); SBAR(); pv_tile<1, SK>(o, vb0, pa0, pa1, pa2, pa3, ACT(NT - 1)); }
    SBAR(); SEAM_K0();
    if (hi == 0) li_l[r32] = l_reg; asm volatile("s_waitcnt lgkmcnt(0)" ::: "memory");
    float rli[16];
#pragma unroll
    for (int r = 0; r < 16; ++r) rli[r] = __builtin_amdgcn_rcpf(li_l[crow(r, hi)]);
    TOut* Ow = cur.O + (size_t)(wid * QBLK) * D;
    int hi_e = hi; asm volatile("" : "+v"(hi_e));
#pragma unroll
    for (int r = 0; r < 16; ++r) { const int orow = crow(r, hi_e);
#pragma unroll
        for (int d0 = 0; d0 < 4; ++d0) { const float v = o[d0][r] * rli[r];
            if constexpr (same_t<TOut, float>::v) { Ow[(size_t)orow * D + d0 * 32 + r32] = v; }
            else { const float vn = swz_xor<1>(v);
                   if ((r32 & 1) == 0) *(unsigned*)(Ow + (size_t)orow * D + d0 * 32 + r32) = cvtpk(v, vn); } } }
    if constexpr (F32) {
#pragma unroll
        for (int d0 = 0; d0 < 8; ++d0) S.qr[d0] = pack8(S.tq[2 * d0], S.tq[2 * d0 + 1]); }
    __syncthreads();
#undef RESC
#undef KBASE
#undef ACT
#undef MASKT
#undef SEAM_K0
#undef HALF_STEP
}
#undef ROW
#undef VMW
#undef VMWN
#undef SLOAD_H
#undef SWRITE_HK
#undef SWRITE_HV
#undef SWRITE_H
#undef SLOAD_F
#undef SWRITE_KF
#undef SWRITE_VF
#undef SBAR
#undef KSWZ
}
namespace cg = cooperative_groups;
#ifndef S3_REP
#define S3_REP 1
#endif
#ifndef MK_DEBUG
#define MK_DEBUG 0
#endif
#define LAS __attribute__((address_space(3)))
typedef unsigned short bf16r;
typedef unsigned v4u __attribute__((ext_vector_type(4)));
typedef unsigned v2u __attribute__((ext_vector_type(2)));
typedef float f32x4 __attribute__((ext_vector_type(4)));
typedef short bf16x8 __attribute__((ext_vector_type(8)));
constexpr int M = 16384, SEQ = 8192, DM = 1024, DFF = 2816, NUP = 5632, NIN = 3072, DEPTH = 4;
constexpr float EPS = 1e-6f;
constexpr size_t MiB = 1u << 20;
constexpr size_t WS_ADA = 1 * MiB, WS_GS = 2 * MiB, WS_SWF = 3 * MiB, WS_SWM = 4 * MiB, WS_SSQP = 5 * MiB, WS_GATES = 6 * MiB, WS_BCUM = 7 * MiB, WS_LOGI = 8 * MiB,
                 WS_SCAL = 9 * MiB, WS_NLOC = 10 * MiB, WS_NST = 11 * MiB, WS_LAM = 12 * MiB, WS_WGT = 13 * MiB, WS_SWG = 14 * MiB;
constexpr size_t WS_W13 = 16 * MiB, WS_W2 = 104 * MiB, WS_WINA = 148 * MiB, WS_WINB = 160 * MiB, WS_WOA = 172 * MiB, WS_WOB = 176 * MiB;
constexpr size_t WS_XS = 180 * MiB, WS_H = 212 * MiB, WS_P = 300 * MiB, WS_Y = 396 * MiB, WS_U = 428 * MiB, WS_CST = 556 * MiB, WS_END = 620 * MiB;
constexpr size_t WS_O = WS_H;
constexpr int LDS_BYTES = 147456;
constexpr int NWAVES = 8;

typedef float f32x2_t __attribute__((ext_vector_type(2))); typedef __bf16 bf16x2_t __attribute__((ext_vector_type(2)));
__device__ __forceinline__ unsigned pk2(float lo, float hi) { f32x2_t v = {lo, hi}; bf16x2_t b = __builtin_convertvector(v, bf16x2_t); return __builtin_bit_cast(unsigned, b); }
__device__ __forceinline__ unsigned f2bf(float f) { return pk2(f, f) & 0xffffu; }
__device__ __forceinline__ float bflo(unsigned w) { return __uint_as_float(w << 16); }
__device__ __forceinline__ float bfhi(unsigned w) { return __uint_as_float(w & 0xffff0000u); }
__device__ __forceinline__ float bf2f(bf16r v) { return __uint_as_float((unsigned)v << 16); }
__device__ __forceinline__ float wave_sum(float v) {
    v += swz_xor<1>(v); v += swz_xor<2>(v); v += swz_xor<4>(v); v += swz_xor<8>(v); v += swz_xor<16>(v); return sum_x32(v);
}
__device__ __forceinline__ float wave_max(float v) {
    v = fmaxf(v, swz_xor<1>(v)); v = fmaxf(v, swz_xor<2>(v)); v = fmaxf(v, swz_xor<4>(v)); v = fmaxf(v, swz_xor<8>(v)); v = fmaxf(v, swz_xor<16>(v)); return max_x32(v);
}
__device__ __forceinline__ float lane_up(float v, int lane, int o) { return __builtin_bit_cast(float, __builtin_amdgcn_ds_bpermute(((lane - o) & 63) << 2, __builtin_bit_cast(int, v))); }
#define LDS_WAIT() asm volatile("s_waitcnt lgkmcnt(0)" ::: "memory")

struct Args { const void* in[19]; float* out; unsigned char* ws; int ph_lo, ph_hi; };
typedef const Args __attribute__((address_space(4)))* KArgs;
struct Ctx { KArgs ka; float* out; unsigned char* ws; int tid, lane, wave, G, wg; };

__device__ __forceinline__ void transpose_item(const float* W, int ldw, int k0, int n0, bf16r* dst  , int Kdst, LAS float* scr, int lane) {
    const int r8 = lane >> 3, c4 = lane & 7;
    f32x4 v[8];
#pragma unroll
    for (int i = 0; i < 8; ++i) v[i] = *(const f32x4*)(W + (size_t)(k0 + i * 8 + r8) * ldw + n0 + c4 * 4);
#pragma unroll
    for (int i = 0; i < 8; ++i) { LAS float* s = scr + (i * 8 + r8) * 33 + c4 * 4; s[0] = v[i][0]; s[1] = v[i][1]; s[2] = v[i][2]; s[3] = v[i][3]; }
    LDS_WAIT(); asm volatile("" ::: "memory");
    const int c = lane & 7;
#pragma unroll
    for (int j = 0; j < 4; ++j) { const int n = (lane >> 3) + 8 * j; const LAS float* s = scr + (8 * c) * 33 + n;
        v4u o; o.x = pk2(s[0 * 33], s[1 * 33]); o.y = pk2(s[2 * 33], s[3 * 33]); o.z = pk2(s[4 * 33], s[5 * 33]); o.w = pk2(s[6 * 33], s[7 * 33]);
        *(v4u*)(dst + (size_t)n * Kdst + k0 + 8 * c) = o; }
    LDS_WAIT(); asm volatile("" ::: "memory");
}
__device__ __forceinline__ void p0_phase(const Ctx& F, LAS unsigned char* lds) {
#if MK_DEBUG
    if (F.wg == 0 && F.tid == 1) *(unsigned*)(F.ws + 64) = 0u;
#endif
    {
        LAS float* red = (LAS float*)lds;
        float* ADA = (float*)(F.ws + WS_ADA);
        const int l32 = F.tid & 31, kg = F.tid >> 5;
        for (int task = F.wg; task < 4 * 72; task += F.G) {
            const int l = task / 72, col0 = (task % 72) * 128;
            f32x4 a0 = {0.f, 0.f, 0.f, 0.f}, a1 = {0.f, 0.f, 0.f, 0.f};
            const float* wp = ((const float*)F.ka->in[3]) + ((size_t)l * 1024 + kg * 64) * 9216 + col0 + l32 * 4;
#pragma unroll 8
            for (int kk = 0; kk < 64; ++kk) {
                const f32x4 w = *(const f32x4*)(wp + (size_t)kk * 9216);
                const float c0 = ((const float*)F.ka->in[1])[kg * 64 + kk], c1 = ((const float*)F.ka->in[1])[1024 + kg * 64 + kk];
                a0 += w * pg8::silu_f(c0); a1 += w * pg8::silu_f(c1);
            }
            *(LAS f32x4*)(red + (kg * 2 + 0) * 128 + l32 * 4) = a0; *(LAS f32x4*)(red + (kg * 2 + 1) * 128 + l32 * 4) = a1;
            __syncthreads();
            if (F.tid < 256) { const int b = F.tid >> 7, col = F.tid & 127; float s = 0.f;
#pragma unroll
                for (int g = 0; g < 16; ++g) s += red[(g * 2 + b) * 128 + col];
                ADA[(size_t)(l * 2 + b) * 9216 + col0 + col] = s + ((const float*)F.ka->in[4])[(size_t)l * 9216 + col0 + col]; }
            __syncthreads();
        }
    }
    for (int i = F.wg * 512 + F.tid; i < 2 * 8 * 1024; i += F.G * 512) { const int jj = i >> 13, g = (i >> 10) & 7, k = i & 1023;
        ((float*)(F.ws + WS_WGT))[i] = ((const float*)F.ka->in[8])[((size_t)jj * 1024 + k) * 3080 + 3072 + g]; }
    {
        LAS float* scr = (LAS float*)(lds + 16384 + F.wave * 8448);
        const int gw = F.wg * NWAVES + F.wave, NGW = F.G * NWAVES;
        constexpr int I13 = 16 * 176, I2 = 44 * 32, IIN = 16 * 96, IOUT = 16 * 32;
        constexpr int T0 = 8 * I13, T1 = T0 + 8 * I2, T2 = T1 + 2 * IIN, T3 = T2 + 2 * IIN, T4 = T3 + 2 * IOUT, T5 = T4 + 2 * IOUT;
        for (int it = gw; it < T5; it += NGW) {
            if (it < T0) { const int mat = it / I13, r = it % I13, kb = r / 176, n0 = (r % 176) * 32;
                const int drow = n0 < 2816 ? (n0 >> 7) * 256 + (n0 & 127) : ((n0 - 2816) >> 7) * 256 + 128 + ((n0 - 2816) & 127);
                transpose_item(((const float*)F.ka->in[6]) + (size_t)mat * 1024 * 5632, 5632, kb * 64, n0, (bf16r*)(F.ws + WS_W13) + ((size_t)mat * 5632 + drow) * 1024, 1024, scr, F.lane); }
            else if (it < T1) { const int q = it - T0, mat = q / I2, r = q % I2, kb = r / 32, n0 = (r % 32) * 32;
                transpose_item(((const float*)F.ka->in[7]) + (size_t)mat * 2816 * 1024, 1024, kb * 64, n0, (bf16r*)(F.ws + WS_W2) + ((size_t)mat * 1024 + n0) * 2816, 2816, scr, F.lane); }
            else if (it < T2) { const int q = it - T1, mat = q / IIN, r = q % IIN, kb = r / 96, n0 = (r % 96) * 32;
                transpose_item(((const float*)F.ka->in[8]) + (size_t)mat * 1024 * 3080, 3080, kb * 64, n0, (bf16r*)(F.ws + WS_WINA) + ((size_t)mat * 3072 + n0) * 1024, 1024, scr, F.lane); }
            else if (it < T3) { const int q = it - T2, mat = q / IIN, r = q % IIN, kb = r / 96, n0 = (r % 96) * 32;
                transpose_item(((const float*)F.ka->in[14]) + (size_t)mat * 1024 * 3072, 3072, kb * 64, n0, (bf16r*)(F.ws + WS_WINB) + ((size_t)mat * 3072 + n0) * 1024, 1024, scr, F.lane); }
            else if (it < T4) { const int q = it - T3, mat = q / IOUT, r = q % IOUT, kb = r / 32, n0 = (r % 32) * 32;
                transpose_item(((const float*)F.ka->in[13]) + (size_t)mat * 1024 * 1024, 1024, kb * 64, n0, (bf16r*)(F.ws + WS_WOA) + ((size_t)mat * 1024 + n0) * 1024, 1024, scr, F.lane); }
            else { const int q = it - T4, mat = q / IOUT, r = q % IOUT, kb = r / 32, n0 = (r % 32) * 32;
                transpose_item(((const float*)F.ka->in[17]) + (size_t)mat * 1024 * 1024, 1024, kb * 64, n0, (bf16r*)(F.ws + WS_WOB) + ((size_t)mat * 1024 + n0) * 1024, 1024, scr, F.lane); }
        }
    }
}
__device__ __forceinline__ void p1_phase(const Ctx& F) {
    const float* ADA = (const float*)(F.ws + WS_ADA);
    float* GS = (float*)(F.ws + WS_GS);
    const int gw = F.wg * NWAVES + F.wave, NGW = F.G * NWAVES;
    for (int i = F.wg * 512 + F.tid; i < 4 * 3 * 2 * 1024; i += F.G * 512) {
        const int d = i & 1023, b = (i >> 10) & 1, ls = i >> 11, l = ls / 3, sub = ls % 3;
        GS[i] = ((const float*)F.ka->in[5])[(size_t)ls * 1024 + d] * (1.0f + ADA[(size_t)(l * 2 + b) * 9216 + sub * 3072 + 1024 + d]);
    }
    if (F.wg == 0 && F.tid < 2) {
        const float* lm = ((const float*)F.ka->in[15]) + F.tid * 512; float s1 = 0.f, s2 = 0.f;
        for (int k = 0; k < 128; ++k) { s1 += lm[k] * lm[128 + k]; s2 += lm[256 + k] * lm[384 + k]; }
        const float lam_init = F.tid == 0 ? 0.35550906759096934f : 0.5560582041556406f;
        ((float*)(F.ws + WS_LAM))[F.tid] = expf(s1) - expf(s2) + lam_init;
    }
    if (gw < 32) { const int jj = gw >> 4, b = (gw >> 3) & 1, g = gw & 7, l = jj * 2; const float* sh = ADA + (size_t)(l * 2 + b) * 9216 + 3072; const float* w = (const float*)(F.ws + WS_WGT) + (size_t)(jj * 8 + g) * 1024;
        float s = 0.f;
#pragma unroll
        for (int q = 0; q < 16; ++q) s += sh[q * 64 + F.lane] * w[q * 64 + F.lane];
        s = wave_sum(s); if (F.lane == 0) ((float*)(F.ws + WS_SWG))[gw] = s; }
    {
        float* ssqp = (float*)(F.ws + WS_SSQP); bf16r* XS = (bf16r*)(F.ws + WS_XS);
        for (int m = gw; m < M; m += NGW) {
            const int b = m >> 13;
            const f32x4* xr = (const f32x4*)(((const float*)F.ka->in[0]) + (size_t)m * 1024) + F.lane;
            v2u* xsr = (v2u*)(XS + (size_t)m * 1024) + F.lane;
            float ss = 0.f;
#pragma unroll
            for (int j = 0; j < 4; ++j) {
                const f32x4 v = xr[64 * j];
                ss += (v[0] * v[0] + v[1] * v[1]) + (v[2] * v[2] + v[3] * v[3]);
                const int col = 4 * F.lane + 256 * j;
                const f32x4 ng = *(const f32x4*)(((const float*)F.ka->in[5]) + col);
                const f32x4 sc = *(const f32x4*)(ADA + (size_t)b * 9216 + 1024 + col);
                const f32x4 y = v * ng * (sc + 1.0f);
                v2u w; w.x = pk2(y[0], y[1]); w.y = pk2(y[2], y[3]); xsr[64 * j] = w;
            }
            ss = wave_sum(ss);
            if (F.lane < 16) ssqp[(size_t)F.lane * M + m] = F.lane == 0 ? ss : 0.f;
        }
    }
    {
        float* SWF = (float*)(F.ws + WS_SWF); float* SWM = (float*)(F.ws + WS_SWM);
        constexpr int RF = 8 * 5632, RT = RF + 4 * 3072;
        for (int r = gw; r < RT; r += NGW) {
            const bf16r* wt; const float* sh; float* o; int ostride;
            if (r < RF) { const int q = r / 5632, n = r % 5632, l = q >> 1, f = q & 1;
                wt = (const bf16r*)(F.ws + WS_W13) + (size_t)r * 1024; sh = ADA + (size_t)l * 2 * 9216 + (f ? 2 : 0) * 3072; o = SWF + (size_t)q * 2 * 5632 + n; ostride = 5632; }
            else { const int rr = r - RF, l = rr / 3072, n = rr % 3072;
                wt = (const bf16r*)(F.ws + ((l & 1) ? WS_WINB : WS_WINA)) + ((size_t)(l >> 1) * 3072 + n) * 1024; sh = ADA + (size_t)l * 2 * 9216 + 3072; o = SWM + (size_t)l * 2 * 3072 + n; ostride = 3072; }
            const v4u w0 = *(const v4u*)(wt + F.lane * 16), w1 = *(const v4u*)(wt + F.lane * 16 + 8);
            float wv[16] = {bflo(w0.x), bfhi(w0.x), bflo(w0.y), bfhi(w0.y), bflo(w0.z), bfhi(w0.z), bflo(w0.w), bfhi(w0.w),
                            bflo(w1.x), bfhi(w1.x), bflo(w1.y), bfhi(w1.y), bflo(w1.z), bfhi(w1.z), bflo(w1.w), bfhi(w1.w)};
            float s0 = 0.f, s1 = 0.f;
#pragma unroll
            for (int j = 0; j < 4; ++j) {
                const f32x4 h0 = *(const f32x4*)(sh + F.lane * 16 + 4 * j), h1 = *(const f32x4*)(sh + 9216 + F.lane * 16 + 4 * j);
#pragma unroll
                for (int e = 0; e < 4; ++e) { s0 += wv[4 * j + e] * h0[e]; s1 += wv[4 * j + e] * h1[e]; }
            }
            s0 = wave_sum(s0); s1 = wave_sum(s1);
            if (F.lane == 0) { o[0] = s0; o[ostride] = s1; }
        }
    }
}
__device__ __forceinline__ void gates_phase(const Ctx& F, LAS unsigned char* lds, int l) {
    const int j = l >> 1;
    const float* ssqp = (const float*)(F.ws + WS_SSQP); const bf16r* XS = (const bf16r*)(F.ws + WS_XS); float* GT = (float*)(F.ws + WS_GATES);
    const float* WGT = (const float*)(F.ws + WS_WGT) + (size_t)j * 8192; const float* SWG = (const float*)(F.ws + WS_SWG) + j * 16;
    for (int ch = F.wg; ch < 256; ch += F.G) {
        const int b = ch >> 7, m0 = ch * 64;
        f32x4 w[8][2][2];
#pragma unroll
        for (int g = 0; g < 8; ++g)
#pragma unroll
            for (int jj = 0; jj < 2; ++jj) { const float* p = WGT + g * 1024 + jj * 512 + F.lane * 8; w[g][jj][0] = *(const f32x4*)p; w[g][jj][1] = *(const f32x4*)(p + 4); }
        const float swg = F.lane < 8 ? SWG[b * 8 + F.lane] : 0.f;
#pragma unroll
        for (int half = 0; half < 2; ++half) {
            v4u xr[4][2]; float ssv[4];
#pragma unroll
            for (int i = 0; i < 4; ++i) { const int row = m0 + F.wave * 8 + half * 4 + i;
                xr[i][0] = *(const v4u*)(XS + (size_t)row * 1024 + F.lane * 8); xr[i][1] = *(const v4u*)(XS + (size_t)row * 1024 + 512 + F.lane * 8);
                ssv[i] = F.lane < 16 ? ssqp[(size_t)F.lane * M + row] : 0.f; }
#pragma unroll
            for (int i = 0; i < 4; ++i) { const int row = m0 + F.wave * 8 + half * 4 + i;
                const float rs = rsqrtf(wave_sum(ssv[i]) * (1.0f / 1024.0f) + EPS);
                float mine = 0.f;
#pragma unroll
                for (int g = 0; g < 8; ++g) { float a = 0.f;
#pragma unroll
                    for (int jj = 0; jj < 2; ++jj) { const v4u x = xr[i][jj]; const f32x4 w0 = w[g][jj][0], w1 = w[g][jj][1];
                        a += bflo(x.x) * w0[0] + bfhi(x.x) * w0[1] + bflo(x.y) * w0[2] + bfhi(x.y) * w0[3] + bflo(x.z) * w1[0] + bfhi(x.z) * w1[1] + bflo(x.w) * w1[2] + bfhi(x.w) * w1[3]; }
                    a = wave_sum(a); if (F.lane == g) mine = a; }
                if (F.lane < 8) GT[(size_t)row * 8 + F.lane] = mine * rs + swg; }
        }
    }
}
__device__ __forceinline__ bf16x8 ldfrag(const LAS bf16r* base, int row0, int stride, int k0, int lane) {
    return *(const LAS bf16x8*)(base + (row0 + (lane & 15)) * stride + k0 + (lane >> 4) * 8);
}
__device__ __forceinline__ void conv8(const bf16r* P, size_t mrow, int ps, int ch0, const float* cw, const float* cb, float scale, float (&o)[8]) {
    float acc[8];
    { const f32x4 b0 = *(const f32x4*)(cb + ch0), b1 = *(const f32x4*)(cb + ch0 + 4); acc[0] = b0[0]; acc[1] = b0[1]; acc[2] = b0[2]; acc[3] = b0[3]; acc[4] = b1[0]; acc[5] = b1[1]; acc[6] = b1[2]; acc[7] = b1[3]; }
#pragma unroll
    for (int jt = 0; jt < 4; ++jt) {
        if (ps - 3 + jt >= 0) {
            const v4u w = *(const v4u*)(P + (mrow - 3 + jt) * 3072 + ch0);
            const f32x4 c0 = *(const f32x4*)(cw + jt * 1024 + ch0), c1 = *(const f32x4*)(cw + jt * 1024 + ch0 + 4);
            acc[0] += bflo(w.x) * c0[0]; acc[1] += bfhi(w.x) * c0[1]; acc[2] += bflo(w.y) * c0[2]; acc[3] += bfhi(w.y) * c0[3];
            acc[4] += bflo(w.z) * c1[0]; acc[5] += bfhi(w.z) * c1[1]; acc[6] += bflo(w.w) * c1[2]; acc[7] += bfhi(w.w) * c1[3];
        }
    }
#pragma unroll
    for (int e = 0; e < 8; ++e) o[e] = pg8::silu_f(acc[e]) * scale;
}
__device__ __forceinline__ void conv_load(const bf16r* P, size_t mrow, int ps, int ch0, v4u (&raw)[4]) {
#pragma unroll
    for (int jt = 0; jt < 4; ++jt) raw[jt] = (ps - 3 + jt >= 0) ? *(const v4u*)(P + (mrow - 3 + jt) * 3072 + ch0) : (v4u){0u, 0u, 0u, 0u};
}
__device__ __forceinline__ void conv_apply(const v4u (&raw)[4], const f32x4 (&cwv)[4][2], const f32x4 (&cbv)[2], float scale, float (&o)[8]) {
    float acc[8] = {cbv[0][0], cbv[0][1], cbv[0][2], cbv[0][3], cbv[1][0], cbv[1][1], cbv[1][2], cbv[1][3]};
#pragma unroll
    for (int jt = 0; jt < 4; ++jt) { const v4u w = raw[jt]; const f32x4 c0 = cwv[jt][0], c1 = cwv[jt][1];
        acc[0] += bflo(w.x) * c0[0]; acc[1] += bfhi(w.x) * c0[1]; acc[2] += bflo(w.y) * c0[2]; acc[3] += bfhi(w.y) * c0[3];
        acc[4] += bflo(w.z) * c1[0]; acc[5] += bfhi(w.z) * c1[1]; acc[6] += bflo(w.w) * c1[2]; acc[7] += bfhi(w.w) * c1[3]; }
#pragma unroll
    for (int e = 0; e < 8; ++e) o[e] = pg8::silu_f(acc[e]) * scale;
}
__device__ __forceinline__ void conv_weights(const float* cw, const float* cb, int ch0, f32x4 (&cwv)[4][2], f32x4 (&cbv)[2]) {
#pragma unroll
    for (int jt = 0; jt < 4; ++jt) { cwv[jt][0] = *(const f32x4*)(cw + jt * 1024 + ch0); cwv[jt][1] = *(const f32x4*)(cw + jt * 1024 + ch0 + 4); }
    cbv[0] = *(const f32x4*)(cb + ch0); cbv[1] = *(const f32x4*)(cb + ch0 + 4);
}
__device__ __forceinline__ int vt_idx(int r, int s) { return r * 72 + ((((s >> 3) ^ (r >> 3)) & 7) << 3) + (s & 7); }
__device__ __forceinline__ void vt_scatter(LAS bf16r* T, int r0  , int s, const v4u w) {
    LAS bf16r* d = T + vt_idx(r0, s);
    d[0] = (bf16r)(w.x & 0xffffu); d[72] = (bf16r)(w.x >> 16); d[2 * 72] = (bf16r)(w.y & 0xffffu); d[3 * 72] = (bf16r)(w.y >> 16);
    d[4 * 72] = (bf16r)(w.z & 0xffffu); d[5 * 72] = (bf16r)(w.z >> 16); d[6 * 72] = (bf16r)(w.w & 0xffffu); d[7 * 72] = (bf16r)(w.w >> 16);
}
__device__ __forceinline__ bf16x8 ldfrag_swp(const LAS bf16r* base, int nt, int k0, int lane) {
    const int i = lane & 15, r = 32 * (nt >> 1) + 8 * (i >> 2) + 4 * (nt & 1) + (i & 3);
    return *(const LAS bf16x8*)(base + r * 72 + (((((k0 >> 3) + (lane >> 4)) ^ (r >> 3)) & 7) << 3));
}
__device__ __forceinline__ bf16x8 ldfrag_sw(const LAS bf16r* base, int row0, int k0, int lane) {
    const int r = row0 + (lane & 15);
    return *(const LAS bf16x8*)(base + r * 72 + (((((k0 >> 3) + (lane >> 4)) ^ (r >> 3)) & 7) << 3));
}
constexpr int VT_STRIDE = 72, QK_STRIDE = 136;
__device__ __forceinline__ void s1_phase(const Ctx& F, LAS unsigned char* lds, int l) {
    const int j = l >> 1;
    LAS bf16r* VT = (LAS bf16r*)lds;
    LAS bf16r* KT = (LAS bf16r*)(lds + 36864);
    LAS float* wS = (LAS float*)(lds + 36864 + 18432);
    const bf16r* P = (const bf16r*)(F.ws + WS_P); const float* GT = (const float*)(F.ws + WS_GATES);
    float* BCUM = (float*)(F.ws + WS_BCUM); float* LOGI = (float*)(F.ws + WS_LOGI); float* BLAST = (float*)(F.ws + WS_SCAL); float* MLOC = BLAST + 16384;
    float* NLOC = (float*)(F.ws + WS_NLOC); bf16r* U = (bf16r*)(F.ws + WS_U);
    const float* cw = ((const float*)F.ka->in[9]) + (size_t)j * 4096; const float* cb = ((const float*)F.ka->in[10]) + (size_t)j * 1024; const float* bif = ((const float*)F.ka->in[11]) + j * 8;
    for (int u = F.wg; u < 1024; u += F.G) {
        const int b = u >> 9, h = (u >> 7) & 3, c = u & 127, bh = b * 4 + h;
        const size_t m0 = (size_t)b * 8192 + c * 64;
        if (F.wave == 0) {
            const int s = F.lane;
            const float gi = GT[(m0 + s) * 8 + h] + bif[h], gf = GT[(m0 + s) * 8 + 4 + h] + bif[4 + h];
            const float lf = fminf(gf, 0.f) - log1pf(expf(-fabsf(gf)));
            float bc = lf;
#pragma unroll
            for (int o = 1; o < 64; o <<= 1) { const float t = lane_up(bc, s, o); if (s >= o) bc += t; }
            const float blast = __builtin_bit_cast(float, __builtin_amdgcn_readlane(__builtin_bit_cast(int, bc), 63));
            const float wl = blast - bc + gi;
            const float mloc = wave_max(wl);
            wS[s] = __expf(wl - mloc);
            BCUM[(size_t)bh * 8192 + c * 64 + s] = bc; LOGI[(size_t)bh * 8192 + c * 64 + s] = gi;
            if (s == 0) { BLAST[bh * 128 + c] = blast; MLOC[bh * 128 + c] = mloc; }
        }
        __syncthreads();
        {
            const int cg = F.tid & 15, s0 = F.tid >> 4, vg = F.tid & 31, sv0 = F.tid >> 5, kch = 512 + h * 128 + cg * 8;
            v4u rk[2][4], rv[4];
#pragma unroll
            for (int i = 0; i < 2; ++i) conv_load(P, m0 + s0 + 32 * i, c * 64 + s0 + 32 * i, kch, rk[i]);
#pragma unroll
            for (int i = 0; i < 4; ++i) rv[i] = *(const v4u*)(P + (m0 + sv0 + 16 * i) * 3072 + 1024 + h * 256 + vg * 8);
            f32x4 cwv[4][2], cbv[2]; conv_weights(cw, cb, kch, cwv, cbv);
#pragma unroll
            for (int i = 0; i < 2; ++i) { const int s = s0 + 32 * i; float kv[8]; conv_apply(rk[i], cwv, cbv, 0.08838834764831845f, kv);
                const float w = wS[s];
#pragma unroll
                for (int e2 = 0; e2 < 8; ++e2) KT[vt_idx(cg * 8, s) + e2 * 72] = (bf16r)f2bf(kv[e2] * w); }
#pragma unroll
            for (int i = 0; i < 4; ++i) vt_scatter(VT, vg * 8, sv0 + 16 * i, rv[i]);
        }
        __syncthreads();
        { const int d = F.tid >> 2, q4 = F.tid & 3; float s = 0.f;
#pragma unroll
          for (int e = 0; e < 16; ++e) s += bf2f(KT[vt_idx(d, q4 * 16 + e)]);
          s += swz_xor<1>(s); s += swz_xor<2>(s);
          if (q4 == 0) NLOC[(size_t)u * 128 + d] = s; }
        {
            f32x4 acc[2][8];
#pragma unroll
            for (int mt = 0; mt < 2; ++mt)
#pragma unroll
                for (int nt = 0; nt < 8; ++nt) acc[mt][nt] = (f32x4){0.f, 0.f, 0.f, 0.f};
#pragma unroll
            for (int ks = 0; ks < 2; ++ks) {
                bf16x8 av[2];
#pragma unroll
                for (int mt = 0; mt < 2; ++mt) av[mt] = ldfrag_sw(VT, 32 * F.wave + 16 * mt, ks * 32, F.lane);
#pragma unroll
                for (int nt = 0; nt < 8; ++nt) { const bf16x8 bk = ldfrag_swp(KT, nt, ks * 32, F.lane);
#pragma unroll
                    for (int mt = 0; mt < 2; ++mt) acc[mt][nt] = __builtin_amdgcn_mfma_f32_16x16x32_bf16(bk, av[mt], acc[mt][nt], 0, 0, 0); }
            }
            bf16r* up = U + (size_t)u * 32768;
#pragma unroll
            for (int mt = 0; mt < 2; ++mt)
#pragma unroll
                for (int p = 0; p < 4; ++p) { v4u w; w.x = pk2(acc[mt][2 * p][0], acc[mt][2 * p][1]); w.y = pk2(acc[mt][2 * p][2], acc[mt][2 * p][3]);
                    w.z = pk2(acc[mt][2 * p + 1][0], acc[mt][2 * p + 1][1]); w.w = pk2(acc[mt][2 * p + 1][2], acc[mt][2 * p + 1][3]);
                    *(v4u*)(up + (size_t)(32 * F.wave + 16 * mt + (F.lane & 15)) * 128 + 32 * p + 8 * (F.lane >> 4)) = w; }
        }
        __syncthreads();
    }
}
__device__ __forceinline__ void s2_phase(const Ctx& F, LAS unsigned char* lds) {
    const float* BLAST = (const float*)(F.ws + WS_SCAL); const float* MLOC = BLAST + 16384; float* MST = (float*)(F.ws + WS_SCAL) + 32768;
    const bf16r* U = (const bf16r*)(F.ws + WS_U); const float* NLOC = (const float*)(F.ws + WS_NLOC); float* NST = (float*)(F.ws + WS_NST); bf16r* CST = (bf16r*)(F.ws + WS_CST);
    LAS float* decS = (LAS float*)lds; LAS float* gainS = decS + 128;
    for (int w = F.wg; w < 256; w += F.G) {
        const int bh = w >> 5, slice = w & 31;
        LAS float* blS = gainS + 128; LAS float* mlS = blS + 128; LAS float* mS = mlS + 128;
        if (F.tid < 128) { blS[F.tid] = BLAST[bh * 128 + F.tid]; mlS[F.tid] = MLOC[bh * 128 + F.tid]; }
        __syncthreads();
        if (F.tid == 0) { float m = 0.f;
            for (int c = 0; c < 128; ++c) { const float bl = blS[c], ml = mlS[c], mn = fmaxf(bl + m, ml); mS[c] = m; blS[c] = bl + m - mn; mlS[c] = ml - mn; m = mn; } }
        __syncthreads();
        if (F.tid < 128) { decS[F.tid] = expf(blS[F.tid]); gainS[F.tid] = expf(mlS[F.tid]); if (slice == 0) MST[bh * 128 + F.tid] = mS[F.tid]; }
        __syncthreads();
        const size_t e2 = (size_t)slice * 1024 + F.tid * 2;
        float s0 = 0.f, s1 = 0.f;
        for (int c0 = 0; c0 < 128; c0 += 16) {
            unsigned uv[16];
#pragma unroll
            for (int i = 0; i < 16; ++i) uv[i] = *(const unsigned*)(U + (size_t)(bh * 128 + c0 + i) * 32768 + e2);
#pragma unroll
            for (int i = 0; i < 16; ++i) { const int c = c0 + i;
                *(unsigned*)(CST + (size_t)(bh * 128 + c) * 32768 + e2) = pk2(s0, s1);
                const float dec = decS[c], gain = gainS[c];
                s0 = s0 * dec + bflo(uv[i]) * gain; s1 = s1 * dec + bfhi(uv[i]) * gain; }
        }
        if (slice == 0 && F.tid < 128) { float s = 0.f;
            for (int c0 = 0; c0 < 128; c0 += 16) { float nv[16];
#pragma unroll
                for (int i = 0; i < 16; ++i) nv[i] = NLOC[(size_t)(bh * 128 + c0 + i) * 128 + F.tid];
#pragma unroll
                for (int i = 0; i < 16; ++i) { const int c = c0 + i; NST[(size_t)(bh * 128 + c) * 128 + F.tid] = s; s = s * decS[c] + nv[i] * gainS[c]; } } }
        __syncthreads();
    }
}
__device__ __forceinline__ void s3_phase(const Ctx& F, LAS unsigned char* lds, int l) {
    const int j = l >> 1;
    LAS bf16r* VT = (LAS bf16r*)lds;
    LAS bf16r* Qs = (LAS bf16r*)(lds + 36864);
    LAS bf16r* Ks = (LAS bf16r*)(lds + 36864 + 17408);
    LAS bf16r* Sw = (LAS bf16r*)(lds + 36864 + 34816);
    LAS float* fa = (LAS float*)(lds + 36864 + 34816 + 9216);
    LAS float* bS = fa, *zS = fa + 64, *mtS = fa + 128, *inS = fa + 192, *dnS = fa + 256, *nS = fa + 320  , *sqS = fa + 448  ;
    const bf16r* P = (const bf16r*)(F.ws + WS_P);
    const float* BCUM = (const float*)(F.ws + WS_BCUM); const float* LOGI = (const float*)(F.ws + WS_LOGI); const float* MST = (const float*)(F.ws + WS_SCAL) + 32768;
    const float* NST = (const float*)(F.ws + WS_NST); const bf16r* CST = (const bf16r*)(F.ws + WS_CST); bf16r* Y = (bf16r*)(F.ws + WS_Y);
    const float* cw = ((const float*)F.ka->in[9]) + (size_t)j * 4096; const float* cb = ((const float*)F.ka->in[10]) + (size_t)j * 1024; const float* ng = ((const float*)F.ka->in[12]) + (size_t)j * 1024;
    const int lane = F.lane, w = F.wave, fr = lane & 15, fq = lane >> 4;
    for (int u = F.wg; u < 1024; u += F.G) {
        const int b = u >> 9, h = (u >> 7) & 3, c = u & 127, bh = b * 4 + h;
        const size_t m0 = (size_t)b * 8192 + c * 64;
        bf16x8 cf[2][4];
#pragma unroll
        for (int nt = 0; nt < 2; ++nt)
#pragma unroll
            for (int ks = 0; ks < 4; ++ks) cf[nt][ks] = *(const bf16x8*)(CST + (size_t)u * 32768 + (size_t)(32 * w + 16 * nt + fr) * 128 + ks * 32 + fq * 8);
        if (w == 0) {
            const int s = lane;
            const float bs = BCUM[(size_t)bh * 8192 + c * 64 + s], li = LOGI[(size_t)bh * 8192 + c * 64 + s], mc = MST[bh * 128 + c];
            const float a = bs + mc, z = li - bs;
            float pm = z;
#pragma unroll
            for (int o = 1; o < 64; o <<= 1) { const float t = lane_up(pm, s, o); if (s >= o) pm = fmaxf(pm, t); }
            const float mt = fmaxf(a, bs + pm);
            bS[s] = bs; zS[s] = z; mtS[s] = mt; inS[s] = __expf(a - mt);
        } else if (w <= 2) { const int d = (w - 1) * 64 + lane; nS[d] = NST[(size_t)u * 128 + d]; }
        {
            const int cg = F.tid & 15, s0 = F.tid >> 4, vg = F.tid & 31, sv0 = F.tid >> 5, qch = h * 128 + cg * 8, kch = 512 + qch;
            v4u rq[2][4], rk[2][4], rv[4];
#pragma unroll
            for (int i = 0; i < 2; ++i) { conv_load(P, m0 + s0 + 32 * i, c * 64 + s0 + 32 * i, qch, rq[i]); conv_load(P, m0 + s0 + 32 * i, c * 64 + s0 + 32 * i, kch, rk[i]); }
#pragma unroll
            for (int i = 0; i < 4; ++i) rv[i] = *(const v4u*)(P + (m0 + sv0 + 16 * i) * 3072 + 1024 + h * 256 + vg * 8);
            { f32x4 cwv[4][2], cbv[2]; conv_weights(cw, cb, qch, cwv, cbv);
#pragma unroll
              for (int i = 0; i < 2; ++i) { float kv[8]; conv_apply(rq[i], cwv, cbv, 1.0f, kv);
                  v4u o; o.x = pk2(kv[0], kv[1]); o.y = pk2(kv[2], kv[3]); o.z = pk2(kv[4], kv[5]); o.w = pk2(kv[6], kv[7]); *(LAS v4u*)(Qs + (s0 + 32 * i) * QK_STRIDE + cg * 8) = o; } }
            { f32x4 cwv[4][2], cbv[2]; conv_weights(cw, cb, kch, cwv, cbv);
#pragma unroll
              for (int i = 0; i < 2; ++i) { float kv[8]; conv_apply(rk[i], cwv, cbv, 0.08838834764831845f, kv);
                  v4u o; o.x = pk2(kv[0], kv[1]); o.y = pk2(kv[2], kv[3]); o.z = pk2(kv[4], kv[5]); o.w = pk2(kv[6], kv[7]); *(LAS v4u*)(Ks + (s0 + 32 * i) * QK_STRIDE + cg * 8) = o; } }
#pragma unroll
            for (int i = 0; i < 4; ++i) vt_scatter(VT, vg * 8, sv0 + 16 * i, rv[i]);
        }
#if S3_REP > 1
        __syncthreads();
        {
            const int cg = F.tid & 15, s0 = F.tid >> 4, vg = F.tid & 31, sv0 = F.tid >> 5, qch = h * 128 + cg * 8, kch = 512 + qch;
            v4u rq[2][4], rk[2][4], rv[4];
#pragma unroll
            for (int i = 0; i < 2; ++i) { conv_load(P, m0 + s0 + 32 * i, c * 64 + s0 + 32 * i, qch, rq[i]); conv_load(P, m0 + s0 + 32 * i, c * 64 + s0 + 32 * i, kch, rk[i]); }
#pragma unroll
            for (int i = 0; i < 4; ++i) rv[i] = *(const v4u*)(P + (m0 + sv0 + 16 * i) * 3072 + 1024 + h * 256 + vg * 8);
            { f32x4 cwv[4][2], cbv[2]; conv_weights(cw, cb, qch, cwv, cbv);
#pragma unroll
              for (int i = 0; i < 2; ++i) { float kv[8]; conv_apply(rq[i], cwv, cbv, 1.0f, kv);
                  v4u o; o.x = pk2(kv[0], kv[1]); o.y = pk2(kv[2], kv[3]); o.z = pk2(kv[4], kv[5]); o.w = pk2(kv[6], kv[7]); *(LAS v4u*)(Qs + (s0 + 32 * i) * QK_STRIDE + cg * 8) = o; } }
            { f32x4 cwv[4][2], cbv[2]; conv_weights(cw, cb, kch, cwv, cbv);
#pragma unroll
              for (int i = 0; i < 2; ++i) { float kv[8]; conv_apply(rk[i], cwv, cbv, 0.08838834764831845f, kv);
                  v4u o; o.x = pk2(kv[0], kv[1]); o.y = pk2(kv[2], kv[3]); o.z = pk2(kv[4], kv[5]); o.w = pk2(kv[6], kv[7]); *(LAS v4u*)(Ks + (s0 + 32 * i) * QK_STRIDE + cg * 8) = o; } }
#pragma unroll
            for (int i = 0; i < 4; ++i) vt_scatter(VT, vg * 8, sv0 + 16 * i, rv[i]);
        }
#endif
        __syncthreads();
        {
            const int tt = w >> 1;
            const int t = 16 * tt + fr; const float bt = bS[t], mt = mtS[t];
#pragma unroll
            for (int i = 0; i < 2; ++i) {
                const int st = 2 * (w & 1) + i;
                f32x4 acc = {0.f, 0.f, 0.f, 0.f};
                if (st <= tt) {
#pragma unroll
                    for (int ks = 0; ks < 4; ++ks) acc = __builtin_amdgcn_mfma_f32_16x16x32_bf16(ldfrag(Ks, 16 * st, QK_STRIDE, ks * 32, lane), ldfrag(Qs, 16 * tt, QK_STRIDE, ks * 32, lane), acc, 0, 0, 0);
                }
                float o[4];
#pragma unroll
                for (int e = 0; e < 4; ++e) { const int s = 16 * st + 4 * fq + e; o[e] = (s <= t) ? acc[e] * __expf(bt + zS[s] - mt) : 0.f; }
                v2u pw; pw.x = pk2(o[0], o[1]); pw.y = pk2(o[2], o[3]);
                *(LAS v2u*)(Sw + t * VT_STRIDE + 16 * st + 4 * fq) = pw;
            }
        }
        __syncthreads();
        { const int t = F.tid >> 3, part = F.tid & 7; float rsum = 0.f, qn = 0.f;
#pragma unroll
          for (int e = 0; e < 8; ++e) rsum += bf2f(Sw[t * VT_STRIDE + part * 8 + e]);
#pragma unroll
          for (int e = 0; e < 16; ++e) qn += bf2f(Qs[t * QK_STRIDE + part * 16 + e]) * nS[part * 16 + e];
          rsum += swz_xor<1>(rsum); rsum += swz_xor<2>(rsum); rsum += swz_xor<4>(rsum);
          qn += swz_xor<1>(qn); qn += swz_xor<2>(qn); qn += swz_xor<4>(qn);
          if (part == 0) { const float den = inS[t] * qn + rsum; dnS[t] = __builtin_amdgcn_rcpf(fmaxf(fabsf(den), __expf(-mtS[t]))); } }
        f32x4 a1[4][2], a2[4][2];
#pragma unroll
        for (int mt = 0; mt < 4; ++mt)
#pragma unroll
            for (int nt = 0; nt < 2; ++nt) { a1[mt][nt] = (f32x4){0.f, 0.f, 0.f, 0.f}; a2[mt][nt] = (f32x4){0.f, 0.f, 0.f, 0.f}; }
#pragma unroll
        for (int ks = 0; ks < 4; ++ks)
#pragma unroll
            for (int mt = 0; mt < 4; ++mt) { const bf16x8 qf = ldfrag(Qs, 16 * mt, QK_STRIDE, ks * 32, lane);
#pragma unroll
                for (int nt = 0; nt < 2; ++nt) a1[mt][nt] = __builtin_amdgcn_mfma_f32_16x16x32_bf16(cf[nt][ks], qf, a1[mt][nt], 0, 0, 0); }
#pragma unroll
        for (int ks = 0; ks < 2; ++ks) {
            bf16x8 vf[2];
#pragma unroll
            for (int nt = 0; nt < 2; ++nt) vf[nt] = ldfrag_sw(VT, 32 * w + 16 * nt, ks * 32, lane);
#pragma unroll
            for (int mt = 0; mt < 4; ++mt) { const bf16x8 sf = ldfrag(Sw, 16 * mt, VT_STRIDE, ks * 32, lane);
#pragma unroll
                for (int nt = 0; nt < 2; ++nt) a2[mt][nt] = __builtin_amdgcn_mfma_f32_16x16x32_bf16(vf[nt], sf, a2[mt][nt], 0, 0, 0); }
        }
        v2u owv[4][2]; f32x4 gv[2];
#pragma unroll
        for (int mt = 0; mt < 4; ++mt)
#pragma unroll
            for (int nt = 0; nt < 2; ++nt) owv[mt][nt] = *(const v2u*)(P + (m0 + 16 * mt + fr) * 3072 + 2048 + h * 256 + 32 * w + 16 * nt + 4 * fq);
#pragma unroll
        for (int nt = 0; nt < 2; ++nt) gv[nt] = *(const f32x4*)(ng + h * 256 + 32 * w + 16 * nt + 4 * fq);
        __syncthreads();
#pragma unroll
        for (int mt = 0; mt < 4; ++mt) {
            const int t = 16 * mt + fr; const float it = inS[t], dn = dnS[t]; float ss = 0.f;
#pragma unroll
            for (int nt = 0; nt < 2; ++nt) { a1[mt][nt] = (a1[mt][nt] * it + a2[mt][nt]) * dn;
                ss += (a1[mt][nt][0] * a1[mt][nt][0] + a1[mt][nt][1] * a1[mt][nt][1]) + (a1[mt][nt][2] * a1[mt][nt][2] + a1[mt][nt][3] * a1[mt][nt][3]); }
            ss += swz_xor<16>(ss); ss = sum_x32(ss);
            if (fq == 0) sqS[w * 64 + t] = ss;
        }
        __syncthreads();
#pragma unroll
        for (int mt = 0; mt < 4; ++mt) {
            const int t = 16 * mt + fr; float tot = 0.f;
#pragma unroll
            for (int ww = 0; ww < 8; ++ww) tot += sqS[ww * 64 + t];
            const float r = rsqrtf(tot * (1.0f / 256.0f) + EPS);
#pragma unroll
            for (int nt = 0; nt < 2; ++nt) {
                const int vv = 32 * w + 16 * nt + 4 * fq;
                const v2u ow = owv[mt][nt];
                const f32x4 g = gv[nt];
                const float o0 = bflo(ow.x), o1 = bfhi(ow.x), o2 = bflo(ow.y), o3 = bfhi(ow.y);
                const f32x4 hv = a1[mt][nt] * r * g;
                v2u yw; yw.x = pk2(hv[0] * __builtin_amdgcn_rcpf(1.0f + __expf(-o0)), hv[1] * __builtin_amdgcn_rcpf(1.0f + __expf(-o1)));
                yw.y = pk2(hv[2] * __builtin_amdgcn_rcpf(1.0f + __expf(-o2)), hv[3] * __builtin_amdgcn_rcpf(1.0f + __expf(-o3)));
                *(v2u*)(Y + (m0 + t) * 1024 + h * 256 + vv) = yw;
            }
        }
        __syncthreads();
    }
}
__device__ __forceinline__ att::BlockRef<att::bf16, att::bf16> attn_ref(int item, int grp, int pass, const att::bf16* Qb, const att::bf16* Kb, const att::bf16* Vb, att::bf16* Ob) {
    const int pc = item & 3, y = item >> 2, qb = pass ? 31 - y : y;
    const int b = grp >> 2, h = grp & 3, c = pc >> 1, vh = pc & 1, hd = ((b * 4 + h) * 2 + c) * 2 + vh;
    att::BlockRef<att::bf16, att::bf16> r;
    r.Q = Qb + ((size_t)(b * 8 + h * 2 + c) * 8192 + (size_t)qb * 256) * 128;
    r.K = Kb + (size_t)(b * 8 + h * 2 + c) * 8192 * 128;
    r.V = Vb + (size_t)(b * 8 + h * 2 + vh) * 8192 * 128;
    r.O = Ob + ((size_t)hd * 8192 + (size_t)qb * 256) * 128;
    r.P0 = qb * 256;
    return r;
}
__device__ __forceinline__ void attn_phase(const Ctx& F, char* lds) {
    const att::bf16* Qb = (const att::bf16*)(F.ws + WS_P); const att::bf16* Kb = Qb + 16777216; const att::bf16* Vb = Kb + 16777216; att::bf16* Ob = (att::bf16*)(F.ws + WS_O);
    constexpr int total = 512; const int stride = F.G;
    int L = F.wg; if (L >= total) return;
    int pass = 0;
#define ATT_ITEM(L_) (((L_) >> 3) & 63)
#define ATT_GRP(L_) ((L_) & 7)
    att::BlockRef<att::bf16, att::bf16> cur = attn_ref(ATT_ITEM(L), ATT_GRP(L), 0, Qb, Kb, Vb, Ob);
    att::Seam<att::bf16> S;
    att::causal_swa_prime<att::bf16, att::bf16>(cur, 8192, lds, S, F.tid);
    for (;;) {
        const bool more_pass = pass == 0, more_item = L + stride < total, last = !more_pass && !more_item;
        int passn = pass + 1, Ln = L;
        if (!more_pass) { passn = 0; Ln = more_item ? L + stride : L; }
        const att::BlockRef<att::bf16, att::bf16> nxt = last ? cur : attn_ref(ATT_ITEM(Ln), ATT_GRP(Ln), passn, Qb, Kb, Vb, Ob);
        att::causal_swa_block<att::bf16, att::bf16>(cur, nxt, 8192, 8192, lds, S, F.tid);
        if (last) break;
        cur = nxt; pass = passn; L = Ln;
    }
#undef ATT_ITEM
#undef ATT_GRP
}
__device__ __forceinline__ void combine_phase(const Ctx& F, int l) {
    const int j = l >> 1;
    const bf16r* Ob = (const bf16r*)(F.ws + WS_O); bf16r* Y = (bf16r*)(F.ws + WS_Y);
    const float lam = ((const float*)(F.ws + WS_LAM))[j];
    const float omi = 1.0f - (j == 0 ? 0.35550906759096934f : 0.5560582041556406f);
    const float* ng = ((const float*)F.ka->in[16]) + j * 256;
    const int gw = F.wg * NWAVES + F.wave, NGW = F.G * NWAVES;
    const int vv = F.lane * 4, vh = vv >> 7, dd = vv & 127;
    const f32x4 g = *(const f32x4*)(ng + vv);
    for (int task = gw; task < M * 4; task += NGW) {
        const int m = task >> 2, h = task & 3, b = m >> 13, s = m & 8191;
        const int hd0 = ((b * 4 + h) * 2 + 0) * 2 + vh, hd1 = hd0 + 2;
        const v2u w0 = *(const v2u*)(Ob + ((size_t)hd0 * 8192 + s) * 128 + dd), w1 = *(const v2u*)(Ob + ((size_t)hd1 * 8192 + s) * 128 + dd);
        f32x4 o = {bflo(w0.x) - lam * bflo(w1.x), bfhi(w0.x) - lam * bfhi(w1.x), bflo(w0.y) - lam * bflo(w1.y), bfhi(w0.y) - lam * bfhi(w1.y)};
        const float ss = wave_sum((o[0] * o[0] + o[1] * o[1]) + (o[2] * o[2] + o[3] * o[3]));
        const float r = rsqrtf(ss * (1.0f / 256.0f) + EPS) * omi;
        o = o * r * g;
        v2u yw; yw.x = pk2(o[0], o[1]); yw.y = pk2(o[2], o[3]);
        *(v2u*)(Y + (size_t)m * 1024 + h * 256 + vv) = yw;
    }
}
__device__ __forceinline__ void final_phase(const Ctx& F) {
    const float* ssqp = (const float*)(F.ws + WS_SSQP);
    const int gw = F.wg * NWAVES + F.wave, NGW = F.G * NWAVES;
    for (int m = gw; m < M; m += NGW) {
        float ss = F.lane < 16 ? ssqp[(size_t)F.lane * M + m] : 0.f; ss = wave_sum(ss);
        const float rs = rsqrtf(ss * (1.0f / 1024.0f) + EPS);
        f32x4* orow = (f32x4*)(F.out + (size_t)m * 1024) + F.lane;
#pragma unroll
        for (int jj = 0; jj < 4; ++jj) { const f32x4 g = *(const f32x4*)(((const float*)F.ka->in[18]) + 4 * F.lane + 256 * jj); orow[64 * jj] = orow[64 * jj] * rs * g; }
    }
}

#if MK_DEBUG
#ifndef DBG_SET
#define DBG_SET 0
#endif
__device__ __forceinline__ void dbg_flag(const Ctx& F, bool bad, unsigned code) {
    int bit = -1;
    switch (code) { case 30: bit = 0; break; case 8: case 31: case 9: bit = 1; break; case 10: bit = 2; break; case 11: bit = 3; break; case 13: case 14: case 15: bit = 4; break;
                    case 16: case 17: bit = 5; break; case 18: bit = 6; break; case 19: bit = 7; break; case 20: bit = 8; break; case 21: bit = 9; break; case 23: bit = 10; break; default: break; }
    if (bad && bit >= 0) atomicOr((unsigned*)(F.ws + 64), 1u << bit);
}
__device__ __forceinline__ bool dbg_ne(float got, float ref) { return !(fabsf(got - ref) <= 0.03f * fabsf(ref) + 0.03f); }
__device__ __forceinline__ unsigned dbg_hash(unsigned i) { i = i * 2654435761u + 12345u; i ^= i >> 15; i *= 2246822519u; i ^= i >> 13; i *= 3266489917u; i ^= i >> 16; return i; }
__device__ __forceinline__ float dbg_rstd(const Ctx& F, int m) { const float* ssqp = (const float*)(F.ws + WS_SSQP); float s = 0.f; for (int p = 0; p < 16; ++p) s += ssqp[(size_t)p * M + m]; return rsqrtf(s * (1.0f / 1024.0f) + EPS); }
__device__ __forceinline__ float dbg_silu(float g) { return g / (1.0f + expf(-g)); }
__device__ __forceinline__ void dbg_check_p0(const Ctx& F) {
    if (F.wg != 0) return;
    const unsigned r = dbg_hash(F.tid);
    const float* ADA = (const float*)(F.ws + WS_ADA);
    { const float t = wave_sum((float)(F.lane + 1)), t2 = wave_max((float)((F.lane * 37) & 63)); dbg_flag(F, t != 2080.0f || t2 != 63.0f, 30); }
    { const int l = r % 4, b = (r >> 2) & 1, j = (r >> 3) % 9216; float ref = ((const float*)F.ka->in[4])[(size_t)l * 9216 + j];
      for (int k = 0; k < 1024; ++k) ref += dbg_silu(((const float*)F.ka->in[1])[b * 1024 + k]) * ((const float*)F.ka->in[3])[((size_t)l * 1024 + k) * 9216 + j];
      dbg_flag(F, dbg_ne(ADA[(size_t)(l * 2 + b) * 9216 + j], ref), 1); }
    { const int mat = r % 8, k = (r >> 3) % 1024, n = (r >> 13) % 5632; const float src = ((const float*)F.ka->in[6])[((size_t)mat * 1024 + k) * 5632 + n];
      const int drow = n < 2816 ? (n >> 7) * 256 + (n & 127) : ((n - 2816) >> 7) * 256 + 128 + ((n - 2816) & 127);
      dbg_flag(F, dbg_ne(bf2f(((const bf16r*)(F.ws + WS_W13))[((size_t)mat * 5632 + drow) * 1024 + k]), src), 2); }
    { const int mat = r % 8, k = (r >> 3) % 2816, n = (r >> 15) % 1024; const float src = ((const float*)F.ka->in[7])[((size_t)mat * 2816 + k) * 1024 + n];
      dbg_flag(F, dbg_ne(bf2f(((const bf16r*)(F.ws + WS_W2))[((size_t)mat * 1024 + n) * 2816 + k]), src), 3); }
    { const int mat = r % 2, k = (r >> 1) % 1024, n = (r >> 11) % 3072; const float src = ((const float*)F.ka->in[8])[((size_t)mat * 1024 + k) * 3080 + n];
      dbg_flag(F, dbg_ne(bf2f(((const bf16r*)(F.ws + WS_WINA))[((size_t)mat * 3072 + n) * 1024 + k]), src), 4); }
    { const int mat = r % 2, k = (r >> 1) % 1024, n = (r >> 11) % 3072; const float src = ((const float*)F.ka->in[14])[((size_t)mat * 1024 + k) * 3072 + n];
      dbg_flag(F, dbg_ne(bf2f(((const bf16r*)(F.ws + WS_WINB))[((size_t)mat * 3072 + n) * 1024 + k]), src), 5); }
    { const int mat = r % 2, k = (r >> 1) % 1024, n = (r >> 11) % 1024; const float sa = ((const float*)F.ka->in[13])[((size_t)mat * 1024 + k) * 1024 + n], sb = ((const float*)F.ka->in[17])[((size_t)mat * 1024 + k) * 1024 + n];
      dbg_flag(F, dbg_ne(bf2f(((const bf16r*)(F.ws + WS_WOA))[((size_t)mat * 1024 + n) * 1024 + k]), sa) || dbg_ne(bf2f(((const bf16r*)(F.ws + WS_WOB))[((size_t)mat * 1024 + n) * 1024 + k]), sb), 6); }
}
__device__ __forceinline__ void dbg_check_p1(const Ctx& F) {
    if (F.wg != 0) return;
    const unsigned r = dbg_hash(F.tid + 1000);
    const float* ADA = (const float*)(F.ws + WS_ADA);
    { const int m = r % 16384, col = (r >> 14) % 1024, b = m >> 13;
      const float ref = ((const float*)F.ka->in[0])[(size_t)m * 1024 + col] * ((const float*)F.ka->in[5])[col] * (1.0f + ADA[(size_t)b * 9216 + 1024 + col]);
      dbg_flag(F, dbg_ne(bf2f(((const bf16r*)(F.ws + WS_XS))[(size_t)m * 1024 + col]), ref) || dbg_ne(F.out[(size_t)m * 1024 + col], ((const float*)F.ka->in[0])[(size_t)m * 1024 + col]), 7); }
    { const int q = r % 8, b = (r >> 3) & 1, n = (r >> 4) % 5632, l = q >> 1, f = q & 1; float ref = 0.f;
      for (int k = 0; k < 1024; ++k) ref += ADA[(size_t)(l * 2 + b) * 9216 + (f ? 2 : 0) * 3072 + k] * bf2f(((const bf16r*)(F.ws + WS_W13))[((size_t)q * 5632 + n) * 1024 + k]);
      dbg_flag(F, dbg_ne(((const float*)(F.ws + WS_SWF))[(size_t)(q * 2 + b) * 5632 + n], ref), b ? 31 : 8); }
    { const int l = r % 4, b = (r >> 2) & 1, n = (r >> 3) % 3072; const bf16r* W = (const bf16r*)(F.ws + ((l & 1) ? WS_WINB : WS_WINA)) + ((size_t)(l >> 1) * 3072 + n) * 1024; float ref = 0.f;
      for (int k = 0; k < 1024; ++k) ref += ADA[(size_t)(l * 2 + b) * 9216 + 3072 + k] * bf2f(W[k]);
      dbg_flag(F, dbg_ne(((const float*)(F.ws + WS_SWM))[(size_t)(l * 2 + b) * 3072 + n], ref), 9); }
    { const int m = r % 16384; float s = 0.f; for (int k = 0; k < 1024; ++k) { const float v = ((const float*)F.ka->in[0])[(size_t)m * 1024 + k]; s += v * v; }
      const float rs = rsqrtf(s * (1.0f / 1024.0f) + EPS); dbg_flag(F, fabsf(dbg_rstd(F, m) - rs) > 1e-3f * rs, 10); }
}
__device__ __forceinline__ void dbg_check_up(const Ctx& F) {
    if (F.wg != 0) return;
    const unsigned r = dbg_hash(F.tid + 2000);
    const int m = r % 16384, n = (r >> 14) % 2816, b = m >> 13, grow = (n >> 7) * 256 + (n & 127), urow = grow + 128;
    const float rs = dbg_rstd(F, m); const bf16r* XS = (const bf16r*)(F.ws + WS_XS) + (size_t)m * 1024; const bf16r* W = (const bf16r*)(F.ws + WS_W13);
    float g = 0.f, u = 0.f;
    for (int k = 0; k < 1024; ++k) { const float xv = bf2f(XS[k]); g += xv * bf2f(W[(size_t)grow * 1024 + k]); u += xv * bf2f(W[(size_t)urow * 1024 + k]); }
    const float* SWF = (const float*)(F.ws + WS_SWF) + (size_t)b * 5632;
    g = g * rs + SWF[grow]; u = u * rs + SWF[urow];
    dbg_flag(F, dbg_ne(bf2f(((const bf16r*)(F.ws + WS_H))[(size_t)m * 2816 + n]), dbg_silu(g) * u), 11);
}
__device__ __forceinline__ void dbg_check_down(const Ctx& F) {
    if (F.wg != 0) return;
    const unsigned r = dbg_hash(F.tid + 3000);
    const int m = r % 16384, n = (r >> 14) % 1024, b = m >> 13;
    const bf16r* H = (const bf16r*)(F.ws + WS_H) + (size_t)m * 2816; const bf16r* W = (const bf16r*)(F.ws + WS_W2) + (size_t)n * 2816;
    float d = 0.f; for (int k = 0; k < 2816; ++k) d += bf2f(H[k]) * bf2f(W[k]);
    const float* ADA = (const float*)(F.ws + WS_ADA);
    const float ref = ((const float*)F.ka->in[0])[(size_t)m * 1024 + n] + 0.5f * ADA[(size_t)b * 9216 + 2048 + n] * d, got = F.out[(size_t)m * 1024 + n];
    dbg_flag(F, dbg_ne(got, ref), 13);
    dbg_flag(F, dbg_ne(bf2f(((const bf16r*)(F.ws + WS_XS))[(size_t)m * 1024 + n]), got * ((const float*)(F.ws + WS_GS))[(size_t)(0 * 3 + 1) * 2048 + b * 1024 + n]), 14);
    float s = 0.f; for (int k = 0; k < 1024; ++k) { const float v = F.out[(size_t)m * 1024 + k]; s += v * v; }
    const float rs = rsqrtf(s * (1.0f / 1024.0f) + EPS); dbg_flag(F, fabsf(dbg_rstd(F, m) - rs) > 1e-3f * rs, 15);
}
__device__ __forceinline__ float dbg_inproj(const Ctx& F, int l, int m, int n) {
    const int b = m >> 13; const float rs = dbg_rstd(F, m);
    const bf16r* XS = (const bf16r*)(F.ws + WS_XS) + (size_t)m * 1024; const bf16r* W = (const bf16r*)(F.ws + ((l & 1) ? WS_WINB : WS_WINA)) + ((size_t)(l >> 1) * 3072 + n) * 1024;
    float a = 0.f; for (int k = 0; k < 1024; ++k) a += bf2f(XS[k]) * bf2f(W[k]);
    return a * rs + ((const float*)(F.ws + WS_SWM))[(size_t)(l * 2 + b) * 3072 + n];
}
__device__ __forceinline__ void dbg_check_inproj0(const Ctx& F) {
    if (F.wg != 0) return;
    const unsigned r = dbg_hash(F.tid + 4000);
    const int m = r % 16384, n = (r >> 14) % 3072, b = m >> 13;
    dbg_flag(F, dbg_ne(bf2f(((const bf16r*)(F.ws + WS_P))[(size_t)m * 3072 + n]), dbg_inproj(F, 0, m, n)), 16);
    const int g = n & 7; const float rs = dbg_rstd(F, m); const bf16r* XS = (const bf16r*)(F.ws + WS_XS) + (size_t)m * 1024; const float* ADA = (const float*)(F.ws + WS_ADA);
    float a = 0.f, sgw = 0.f; for (int k = 0; k < 1024; ++k) { const float w = ((const float*)F.ka->in[8])[(size_t)k * 3080 + 3072 + g]; a += bf2f(XS[k]) * w; sgw += ADA[(size_t)b * 9216 + 3072 + k] * w; }
    dbg_flag(F, dbg_ne(((const float*)(F.ws + WS_GATES))[(size_t)m * 8 + g], a * rs + sgw), 17);
}
__device__ __forceinline__ void dbg_check_inproj1(const Ctx& F) {
    if (F.wg != 0) return;
    const unsigned r = dbg_hash(F.tid + 5000);
    const int m = r % 16384, n = (r >> 14) % 3072, b = m >> 13, s = m & 8191, blk = n >> 7, d = n & 127, which = blk >> 3, idx = blk & 7;
    float ref = dbg_inproj(F, 1, m, n);
    if (which < 2 && d < 32) {
        const int fi = d & 15; const float other = dbg_inproj(F, 1, m, d < 16 ? n + 16 : n - 16);
        const float a = (float)((const int*)F.ka->in[2])[m] * pg8::ROPE_INVF[fi];
        const float kk = rintf(a * 0.15915494309189535f); float rr = fmaf(-kk, 6.2831854820251465f, a); rr = fmaf(-kk, -1.7484555314695172e-07f, rr);
        const float c = __cosf(rr), sn = __sinf(rr);
        ref = d < 16 ? ref * c - other * sn : ref * c + other * sn;
    }
    dbg_flag(F, dbg_ne(bf2f(((const bf16r*)(F.ws + WS_P))[(size_t)which * 16777216 + ((size_t)(b * 8 + idx) * 8192 + s) * 128 + d]), ref), 20);
}
__device__ __forceinline__ void dbg_check_mlstm(const Ctx& F, LAS unsigned char* lds) {
    if (F.wg != 0) return;
    LAS float* C = (LAS float*)lds;
    LAS float* qs = C + 32768, *ks = qs + 128, *vs = ks + 128, *nn = vs + 256, *hv = nn + 128, *red = hv + 256;
    const int h = 1, tid = F.tid;
    const bf16r* P = (const bf16r*)(F.ws + WS_P); const float* GT = (const float*)(F.ws + WS_GATES); const bf16r* Y = (const bf16r*)(F.ws + WS_Y);
    const float* cw = (const float*)F.ka->in[9]; const float* cb = (const float*)F.ka->in[10]; const float* bif = (const float*)F.ka->in[11]; const float* ng = (const float*)F.ka->in[12];
    for (int i = tid; i < 32768; i += 512) C[i] = 0.f;
    if (tid < 128) nn[tid] = 0.f;
    float mstate = 0.f;
    __syncthreads();
    for (int t = 0; t < 160; ++t) {
        if (tid < 256) { const int isk = tid >> 7, d = tid & 127, ch = isk * 512 + h * 128 + d; float a = cb[ch];
            for (int jt = 0; jt < 4; ++jt) if (t - 3 + jt >= 0) a += cw[jt * 1024 + ch] * bf2f(P[(size_t)(t - 3 + jt) * 3072 + ch]);
            a = dbg_silu(a); if (isk) ks[d] = a * 0.08838834764831845f; else qs[d] = a; }
        else { const int v = tid - 256; vs[v] = bf2f(P[(size_t)t * 3072 + 1024 + h * 256 + v]); }
        __syncthreads();
        const float li = GT[(size_t)t * 8 + h] + bif[h], gf = GT[(size_t)t * 8 + 4 + h] + bif[4 + h];
        const float lf = fminf(gf, 0.f) - log1pf(expf(-fabsf(gf)));
        const float mn = fmaxf(lf + mstate, li), fd = expf(lf + mstate - mn), ig = expf(li - mn);
        for (int i = tid; i < 32768; i += 512) { const int v = i >> 7, d = i & 127; C[i] = fd * C[i] + ig * vs[v] * ks[d]; }
        if (tid < 128) nn[tid] = fd * nn[tid] + ig * ks[tid];
        mstate = mn;
        __syncthreads();
        float den = 0.f; for (int d = 0; d < 128; ++d) den += nn[d] * qs[d];
        const float dn = 1.0f / fmaxf(fabsf(den), expf(-mn));
        { const int v = tid >> 1, half = tid & 1; float a = 0.f; for (int d = 0; d < 64; ++d) a += C[v * 128 + half * 64 + d] * qs[half * 64 + d];
          a += swz_xor<1>(a); if (half == 0) hv[v] = a * dn; }
        __syncthreads();
        float ss = 0.f; for (int v = 0; v < 256; ++v) ss += hv[v] * hv[v];
        const float rr = rsqrtf(ss * (1.0f / 256.0f) + EPS);
        if (tid < 256) { const int v = tid; const float o = bf2f(P[(size_t)t * 3072 + 2048 + h * 256 + v]);
            const float ref = hv[v] * rr * ng[h * 256 + v] / (1.0f + expf(-o));
            dbg_flag(F, dbg_ne(bf2f(Y[(size_t)t * 1024 + h * 256 + v]), ref), t < 64 ? 18 : 19); }
        __syncthreads();
    }
}
__device__ __forceinline__ void dbg_check_attn(const Ctx& F) {
    if (F.wg >= 8) return;
    const bf16r* Qb = (const bf16r*)(F.ws + WS_P); const bf16r* Kb = Qb + 16777216; const bf16r* Vb = Kb + 16777216; const bf16r* Ob = (const bf16r*)(F.ws + WS_O);
    const unsigned r = dbg_hash(F.wg * 8 + F.wave + 6000);
    const int hd = r % 32, row = (F.wave == 0) ? (int)((r >> 5) % 300) : (int)((r >> 5) % 8192);
    const int b = hd >> 4, h = (hd >> 2) & 3, c = (hd >> 1) & 1, vh = hd & 1, lane = F.lane;
    const bf16r* q = Qb + ((size_t)(b * 8 + h * 2 + c) * 8192 + row) * 128; const bf16r* K = Kb + (size_t)(b * 8 + h * 2 + c) * 8192 * 128; const bf16r* V = Vb + (size_t)(b * 8 + h * 2 + vh) * 8192 * 128;
    const float q0 = bf2f(q[lane * 2]), q1 = bf2f(q[lane * 2 + 1]);
    float mx = -1e30f, l = 0.f, o0 = 0.f, o1 = 0.f;
    for (int jk = 0; jk <= row; ++jk) {
        float sc = q0 * bf2f(K[(size_t)jk * 128 + lane * 2]) + q1 * bf2f(K[(size_t)jk * 128 + lane * 2 + 1]); sc = wave_sum(sc) * 0.08838834764831845f;
        const float mn = fmaxf(mx, sc), al = expf(mx - mn), p = expf(sc - mn);
        l = l * al + p; o0 = o0 * al + p * bf2f(V[(size_t)jk * 128 + lane * 2]); o1 = o1 * al + p * bf2f(V[(size_t)jk * 128 + lane * 2 + 1]); mx = mn;
    }
    const bf16r* O = Ob + ((size_t)hd * 8192 + row) * 128;
    dbg_flag(F, dbg_ne(bf2f(O[lane * 2]), o0 / l) || dbg_ne(bf2f(O[lane * 2 + 1]), o1 / l), 21);
}
__device__ __forceinline__ void dbg_check_combine(const Ctx& F) {
    if (F.wg != 0) return;
    const unsigned r = dbg_hash(F.tid + 7000);
    const int m = r % 16384, h = (r >> 14) & 3, vv = (r >> 16) & 255, b = m >> 13, s = m & 8191;
    const bf16r* Ob = (const bf16r*)(F.ws + WS_O); const float lam = ((const float*)(F.ws + WS_LAM))[0];
    float ss = 0.f, mine = 0.f;
    for (int v = 0; v < 256; ++v) { const int hd0 = ((b * 4 + h) * 2) * 2 + (v >> 7);
        const float o = bf2f(Ob[((size_t)hd0 * 8192 + s) * 128 + (v & 127)]) - lam * bf2f(Ob[((size_t)(hd0 + 2) * 8192 + s) * 128 + (v & 127)]); ss += o * o; if (v == vv) mine = o; }
    const float ref = mine * rsqrtf(ss * (1.0f / 256.0f) + EPS) * ((const float*)F.ka->in[16])[vv] * (1.0f - 0.35550906759096934f);
    dbg_flag(F, dbg_ne(bf2f(((const bf16r*)(F.ws + WS_Y))[(size_t)m * 1024 + h * 256 + vv]), ref), 23);
}
#endif

constexpr int N_PHASES = 2 + 9 * DEPTH + 1;
constexpr int PH_ATT1 = 2 + 9 * 1 + 3, PH_ATT3 = 2 + 9 * 3 + 3;
#ifndef DBL_MASK
#define DBL_MASK 0
#endif
#ifndef MK_ONE_LAUNCH
#define MK_ONE_LAUNCH 1
#endif
__device__ __forceinline__ Ctx make_ctx(int wave_s) {
    KArgs ka = (KArgs)__builtin_amdgcn_kernarg_segment_ptr();
    asm volatile("" : "+s"(ka));
    Ctx F; F.ka = ka; F.out = ka->out; F.ws = ka->ws;
    { unsigned z0 = 0u; asm volatile("" : "+v"(z0)); const int t0 = wave_s * 64 + (int)__builtin_amdgcn_mbcnt_hi(~0u, __builtin_amdgcn_mbcnt_lo(~0u, z0)); F.tid = t0 & 511; }
    F.lane = F.tid & 63; F.wave = __builtin_amdgcn_readfirstlane(F.tid >> 6);
    { int g0 = gridDim.x, w0 = blockIdx.x; asm volatile("" : "+s"(g0), "+s"(w0)); F.G = g0; F.wg = w0; }
    return F;
}
#define XB_TMO      128
#define XB_XCNT(j)  (256  + 64 * (j))
#define XB_XSUB(j)  (1280 + 64 * (j))
#define XB_XGEN(j)  (2304 + 64 * (j))
#define XB_TOP      3328
#define XB_TOPGEN   3392
#define XCD_BAR_WORDS 3456
#define XB_SPIN_CAP (1u << 18)

__device__ __forceinline__ unsigned xb_ld(unsigned* p)              { return __hip_atomic_load(p, __ATOMIC_RELAXED, __HIP_MEMORY_SCOPE_AGENT); }
__device__ __forceinline__ unsigned xb_add(unsigned* p, unsigned v) { return __hip_atomic_fetch_add(p, v, __ATOMIC_RELAXED, __HIP_MEMORY_SCOPE_AGENT); }
__device__ __forceinline__ unsigned xb_xcc_id() { return (unsigned)__builtin_amdgcn_s_getreg((3 << 11) | 20) & 0xFu; }
#define XB_SPIN(cond, bar) do { unsigned _sp = 0; while (cond) { __builtin_amdgcn_s_sleep(1); \
    if ((++_sp & 255u) == 0u) { if (xb_ld(&(bar)[XB_TMO])) break; if (_sp > XB_SPIN_CAP) { atomicAdd(&(bar)[XB_TMO], 1u); break; } } } } while (0)

struct XcdBarrier {
    unsigned* bar; unsigned x;
    volatile LAS unsigned* st;
};

__device__ __forceinline__ XcdBarrier xcd_barrier_post(unsigned* bar, volatile LAS unsigned* st, int tid) {
    XcdBarrier b; b.bar = bar; b.x = xb_xcc_id(); b.st = st;
    if (tid == 0) (void)xb_add(&bar[XB_XCNT(b.x)], 1u);
    return b;
}
__device__ __forceinline__ void xcd_barrier_complete(unsigned* bar, unsigned x, unsigned& nloc, unsigned& nx) {
    const unsigned G = gridDim.x;
    unsigned sum, cnt, mine, sp = 0u;
    for (;;) {
        sum = 0u; cnt = 0u; mine = 0u;
#pragma unroll
        for (unsigned j = 0; j < 16; ++j) { const unsigned c = xb_ld(&bar[XB_XCNT(j)]); sum += c; cnt += (c > 0u) ? 1u : 0u; mine = (j == x) ? c : mine; }
        if (sum == G) break;
        __builtin_amdgcn_s_sleep(1);
        if ((++sp & 255u) == 0u) { if (xb_ld(&bar[XB_TMO])) break; if (sp > XB_SPIN_CAP) { atomicAdd(&bar[XB_TMO], 1u); break; } }
    }
    nloc = mine > 0u ? mine : 1u; nx = cnt > 0u ? cnt : 1u;
}

__device__ __forceinline__ void xcd_barrier(const XcdBarrier& b, int tid) {
    asm volatile("s_waitcnt vmcnt(0)" ::: "memory");
    __syncthreads();
    if (tid == 0) {
        unsigned* bar = b.bar;
        __builtin_amdgcn_s_waitcnt(0);
        unsigned nloc = b.st[0], nx = b.st[1];
        if (nloc == 0u) { xcd_barrier_complete(bar, b.x, nloc, nx); b.st[0] = nloc; b.st[1] = nx; }
        const unsigned old = xb_add(&bar[XB_XSUB(b.x)], 1u);
        const unsigned gen = old / nloc;
        if (old + 1u == (gen + 1u) * nloc) {
            __builtin_amdgcn_fence(__ATOMIC_RELEASE, "agent");
            asm volatile("s_waitcnt vmcnt(0)" ::: "memory");
            const unsigned og = xb_add(&bar[XB_TOP], 1u);
            const unsigned tg = og / nx;
            if (og + 1u == (tg + 1u) * nx) xb_add(&bar[XB_TOPGEN], 1u);
            else XB_SPIN(xb_ld(&bar[XB_TOPGEN]) == tg, bar);
            __builtin_amdgcn_fence(__ATOMIC_ACQUIRE, "agent");
            xb_add(&bar[XB_XGEN(b.x)], 1u);
            asm volatile("s_waitcnt vmcnt(0)" ::: "memory");
        } else {
            XB_SPIN(xb_ld(&bar[XB_XGEN(b.x)]) == gen, bar);
            __builtin_amdgcn_fence(__ATOMIC_ACQUIRE, "agent");
            asm volatile("s_waitcnt vmcnt(0)" ::: "memory");
        }
    }
    __syncthreads();
}

constexpr int BAR_OFF = 4096, BAR_ST_OFF = 131072 + 352;
template <bool FIRST> __device__ __forceinline__ void grid_seam(const Ctx& F, int& epoch, LAS unsigned char* lds) {
    unsigned* bar = (unsigned*)(F.ws + BAR_OFF);
    volatile LAS unsigned* st = (volatile LAS unsigned*)(lds + BAR_ST_OFF);
    if (FIRST && epoch == 0) {
        if (F.wg == 0) for (int i = F.tid; i < XCD_BAR_WORDS; i += 512) __hip_atomic_store(bar + i, 0u, __ATOMIC_RELAXED, __HIP_MEMORY_SCOPE_AGENT);
        if (F.tid < 2) st[F.tid] = 0u;
        asm volatile("s_waitcnt vmcnt(0) lgkmcnt(0)" ::: "memory");
        cg::this_grid().sync();
        (void)xcd_barrier_post(bar, st, F.tid);
        epoch = 1; return;
    }
    XcdBarrier b; b.bar = bar; b.x = xb_xcc_id(); b.st = st;
    xcd_barrier(b, F.tid);
    epoch += 1;
}
template <int PH, bool DRY = false> __device__ __forceinline__ void do_phase(int lo, int hi, int wave_s, LAS unsigned char* lds, unsigned char* lds_raw, int& epoch) {
    if (!(lo <= PH && PH < hi)) return;
    const Ctx F = make_ctx(wave_s);
    unsigned char* ws = F.ws;
    const float* ADA = (const float*)(ws + WS_ADA); const float* GS = (const float*)(ws + WS_GS); float* SSQP = (float*)(ws + WS_SSQP);
    bf16r* XS = (bf16r*)(ws + WS_XS); bf16r* H = (bf16r*)(ws + WS_H); bf16r* P = (bf16r*)(ws + WS_P); bf16r* Y = (bf16r*)(ws + WS_Y);
    constexpr bool is_layer = PH >= 2 && PH < N_PHASES - 1;
    constexpr int l = is_layer ? (PH - 2) / 9 : 0, s = is_layer ? (PH - 2) % 9 : -1, isattn = l & 1, j = l >> 1;
    constexpr bool empty = is_layer && s == 5 && isattn;
#if MK_DEBUG
    if constexpr (PH == 1) dbg_check_p0(F); else if constexpr (PH == 2) dbg_check_p1(F); else if constexpr (PH == 3) dbg_check_up(F); else if constexpr (PH == 4) dbg_check_down(F);
    else if constexpr (PH == 5) dbg_check_inproj0(F); else if constexpr (PH == 8) dbg_check_mlstm(F, lds); else if constexpr (PH == 14) dbg_check_inproj1(F);
    else if constexpr (PH == 15) dbg_check_attn(F); else if constexpr (PH == 17) dbg_check_combine(F);
    __syncthreads();
#endif
    if constexpr (PH == 0) p0_phase(F, lds);
    else if constexpr (PH == 1) p1_phase(F);
    else if constexpr (PH == N_PHASES - 1) { final_phase(F);
#if MK_DEBUG
        if (F.wg == 0) { asm volatile("s_waitcnt vmcnt(0)" ::: "memory"); __syncthreads(); const unsigned code = *(const unsigned*)(F.ws + 64); if (code) { float v = (float)(10 + (code % 90)) * 100.0f; for (unsigned q = 0; q < code / 90; ++q) v *= 10.0f; F.out[F.tid] = v; } }
#endif
    }
    else if constexpr (s == 0 || s == 7) {
        constexpr int f = s == 0 ? 0 : 1;
        pg8::Gemm g{XS, (const bf16r*)(ws + WS_W13) + (size_t)(l * 2 + f) * NUP * 1024, M, NUP, 1024};
        pg8::EpiGen E{0, H, (const float*)(ws + WS_SWF) + (size_t)(l * 2 + f) * 2 * NUP, SSQP, nullptr, nullptr, nullptr};
        pg8::StaticOrder S; S.init(M, NUP, F.G, F.wg);
        pg8::gemm_phase<pg8::EpiGen, pg8::StaticOrder, true, true>(lds, g, S, E, F.tid);
    } else if constexpr (s == 1 || s == 8) {
        constexpr int f = s == 1 ? 0 : 1, sub = f ? 2 : 0;
        pg8::Gemm g{H, (const bf16r*)(ws + WS_W2) + (size_t)(l * 2 + f) * 1024 * DFF, M, 1024, DFF};
        const float* gsn = f == 0 ? GS + (size_t)(l * 3 + 1) * 2048 : GS + (size_t)((l + 1 < DEPTH ? l + 1 : 0) * 3) * 2048;
        pg8::EpiGen E{DRY ? 5 : 1, F.out, ADA + (size_t)l * 2 * 9216 + sub * 3072 + 2048, gsn, (l == 0 && f == 0) ? (const void*)((const float*)F.ka->in[0]) : (const void*)F.out, XS, SSQP};
        pg8::StaticOrder S; S.init(M, 1024, F.G, F.wg);
        pg8::gemm_phase<pg8::EpiGen, pg8::StaticOrder, true, true>(lds, g, S, E, F.tid);
    } else if constexpr (s == 2) {
        pg8::Gemm g{XS, (const bf16r*)(ws + (isattn ? WS_WINB : WS_WINA)) + (size_t)j * NIN * 1024, M, NIN, 1024};
        pg8::EpiGen E{isattn ? 4 : 3, P, (const float*)(ws + WS_SWM) + (size_t)l * 2 * NIN, SSQP, ((const int*)F.ka->in[2]), nullptr, nullptr};
        pg8::StaticOrder S; S.init(M, NIN, F.G, F.wg);
        pg8::gemm_phase<pg8::EpiGen, pg8::StaticOrder, true, true>(lds, g, S, E, F.tid);
        if constexpr (!isattn) { __syncthreads(); gates_phase(F, lds, l); }
    } else if constexpr (s == 6) {
        pg8::Gemm g{Y, (const bf16r*)(ws + (isattn ? WS_WOB : WS_WOA)) + (size_t)j * 1024 * 1024, M, 1024, 1024};
        pg8::EpiGen E{DRY ? 5 : 2, F.out, ADA + (size_t)l * 2 * 9216 + 3072 + 2048, GS + (size_t)(l * 3 + 2) * 2048, (const void*)F.out, XS, SSQP};
        pg8::StaticOrder S; S.init(M, 1024, F.G, F.wg);
        pg8::gemm_phase<pg8::EpiGen, pg8::StaticOrder, true, true>(lds, g, S, E, F.tid);
    }
    else if constexpr (s == 3) { if constexpr (isattn) attn_phase(F, (char*)lds_raw); else s1_phase(F, lds, l); }
    else if constexpr (s == 4) { if constexpr (isattn) combine_phase(F, l); else s2_phase(F, lds); }
    else if constexpr (s == 5) { if constexpr (!isattn) s3_phase(F, lds, l); }
    if (PH + 1 < hi && !empty) grid_seam<PH == 0>(F, epoch, lds);
}
template <int PH> __device__ __forceinline__ void do_twice(int lo, int hi, int wave_s, LAS unsigned char* lds, unsigned char* lds_raw, int& epoch) {
    constexpr bool is_layer = PH >= 2 && PH < N_PHASES - 1;
    constexpr int l = is_layer ? (PH - 2) / 9 : 0, s = is_layer ? (PH - 2) % 9 : -1, isattn = l & 1;
    constexpr bool dbl = ((DBL_MASK & 1) && (PH == 0 || PH == 1)) || ((DBL_MASK & 2) && is_layer && !isattn && (s == 3 || s == 4 || s == 5)) || ((DBL_MASK & 4) && is_layer && isattn && s == 3)
                      || ((DBL_MASK & 8) && is_layer && (s == 0 || s == 7)) || ((DBL_MASK & 16) && is_layer && s == 2) || ((DBL_MASK & 32) && is_layer && isattn && s == 4) || ((DBL_MASK & 256) && is_layer && !isattn && s == 3) || ((DBL_MASK & 512) && is_layer && !isattn && s == 4) || ((DBL_MASK & 1024) && is_layer && !isattn && s == 5) || ((DBL_MASK & 2048) && PH == 0) || ((DBL_MASK & 4096) && PH == 1);
    constexpr bool dry = ((DBL_MASK & 64) && is_layer && (s == 1 || s == 8)) || ((DBL_MASK & 128) && is_layer && s == 6);
    if constexpr (dry) do_phase<PH, true>(lo, hi, wave_s, lds, lds_raw, epoch);
    do_phase<PH>(lo, hi, wave_s, lds, lds_raw, epoch);
    if constexpr (dbl) do_phase<PH>(lo, hi, wave_s, lds, lds_raw, epoch);
}
template <int... I> __device__ __forceinline__ void all_phases(std::integer_sequence<int, I...>, int lo, int hi, int wave_s, LAS unsigned char* lds, unsigned char* lds_raw, int& epoch) {
    (do_twice<I>(lo, hi, wave_s, lds, lds_raw, epoch), ...);
}
__global__ void __launch_bounds__(NWAVES * 64, 2) mk_fwd(Args args) {
    extern __shared__ __attribute__((aligned(16))) unsigned char lds_raw[];
    LAS unsigned char* lds = (LAS unsigned char*)lds_raw;
    const int ph_lo = args.ph_lo, ph_hi = args.ph_hi;
    const int wave_s = __builtin_amdgcn_readfirstlane(threadIdx.x >> 6);
    if (ph_lo != 0 && ph_hi - ph_lo > 1) return;
    int epoch = 0;
    all_phases(std::make_integer_sequence<int, N_PHASES>{}, ph_lo, ph_hi, wave_s, lds, lds_raw, epoch);
}

extern "C" void kernel_launch(void* const* d_in, const int* in_sizes, int n_in, void* d_out, int out_size, void* d_ws, size_t ws_size, hipStream_t stream) {
    static int grid = 0;
    if (grid == 0) {
        if (n_in != 19 || out_size != M * DM || ws_size < WS_END) { fprintf(stderr, "kernel_launch: unexpected shapes (n_in %d out %d ws %zu)\n", n_in, out_size, ws_size); grid = -1; return; }
        int dev = 0, cus = 0, per_cu = 0;
        (void)hipGetDevice(&dev); (void)hipDeviceGetAttribute(&cus, hipDeviceAttributeMultiprocessorCount, dev);
        if (hipFuncSetAttribute((const void*)mk_fwd, hipFuncAttributeMaxDynamicSharedMemorySize, LDS_BYTES) != hipSuccess) { fprintf(stderr, "kernel_launch: hipFuncSetAttribute failed\n"); grid = -1; return; }
        if (hipOccupancyMaxActiveBlocksPerMultiprocessor(&per_cu, (const void*)mk_fwd, NWAVES * 64, LDS_BYTES) != hipSuccess || per_cu < 1) { fprintf(stderr, "kernel_launch: occupancy query gave %d\n", per_cu); per_cu = 1; }
        (void)hipGetLastError();
        grid = cus > 0 ? cus : 256;
    }
    if (grid < 0) return;
    Args a{};
    for (int i = 0; i < 19; ++i) a.in[i] = d_in[i];
    a.out = (float*)d_out; a.ws = (unsigned char*)d_ws;
#if MK_ONE_LAUNCH
    a.ph_lo = 0; a.ph_hi = N_PHASES;
    void* kargs[] = {&a};
    hipError_t e = hipLaunchCooperativeKernel((const void*)mk_fwd, dim3(grid), dim3(NWAVES * 64), kargs, LDS_BYTES, stream);
    if (e != hipSuccess) fprintf(stderr, "kernel_launch: cooperative launch failed: %s (grid %d)\n", hipGetErrorString(e), grid);
#else
    for (int ph = 0; ph < N_PHASES; ++ph) {
        if (ph >= 2 && ph < N_PHASES - 1 && ((ph - 2) / 9 & 1) && ((ph - 2) % 9 == 5)) continue;
        a.ph_lo = ph; a.ph_hi = ph + 1;
        hipLaunchKernelGGL(mk_fwd, dim3(grid), dim3(NWAVES * 64), LDS_BYTES, stream, a);
    }
#endif
}
```
